# Optimizing an MI355X kernel written in HIP

```python
import math
import jax, jax.numpy as jnp
from jax import lax
import numpy as np

D_MODEL = 1024
BATCH = 8
SEQ = 2048
DEPTH = 1

N_META = 16
D_MIX = 1024
ATTN_HEADS = 8
QK_NOPE = 64
QK_ROPE = 32
V_HEAD = 64
Q_LORA = 384
KV_LORA = 256
ROPE_THETA = 10000.0
QBLK = 128
D_ATTN = ATTN_HEADS * V_HEAD
ATTN_SCALE = 1.0 / math.sqrt(QK_NOPE + QK_ROPE)
D_CONV = D_MIX - D_ATTN
CONV_W = 3
D_IN = Q_LORA + KV_LORA + QK_ROPE + 3 * D_CONV
N_EXPERTS = 256
TOP_K = 8
N_GROUPS = 8
TOPK_GROUPS = 4
D_EXPERT = 256
D_SHARED = 256
ROUTED_SCALE = 2.5
MOE_BLK = 128
ALPHA = (2.0 * DEPTH) ** 0.25
BETA = (8.0 * DEPTH) ** -0.25

kernel_name = "hymba_mla_shortconv_moe_deepnorm"


def _rms(x, g, eps=1e-6):
    xf = x.astype(jnp.float32)
    y = xf * lax.rsqrt(jnp.mean(xf * xf, axis=-1, keepdims=True) + eps) * g.astype(jnp.float32)
    return y.astype(x.dtype)


def _layernorm(x, g, b, eps=1e-5):
    xf = x.astype(jnp.float32)
    mu = jnp.mean(xf, axis=-1, keepdims=True)
    var = jnp.mean(jnp.square(xf - mu), axis=-1, keepdims=True)
    y = (xf - mu) * lax.rsqrt(var + eps) * g.astype(jnp.float32) + b.astype(jnp.float32)
    return y.astype(x.dtype)


def _rope_tables(L):
    pos = jnp.arange(L, dtype=jnp.float32)
    inv = ROPE_THETA ** (-jnp.arange(0, QK_ROPE, 2, dtype=jnp.float32) / QK_ROPE)
    ang = pos[:, None] * inv[None, :]
    return jnp.cos(ang), jnp.sin(ang)


def _apply_rope(x, cos, sin):
    half = x.shape[-1] // 2
    x1, x2 = x[..., :half], x[..., half:]
    c, s = cos.astype(x.dtype), sin.astype(x.dtype)
    return jnp.concatenate([x1 * c - x2 * s, x2 * c + x1 * s], axis=-1)


def _pad_seq(a, pad):
    return jnp.pad(a, ((0, 0), (0, pad)) + ((0, 0),) * (a.ndim - 2))


def _mla(c_q, c_kv, k_pe, q_norm, w_uq, kv_norm, w_ukv):
    B, L, _ = c_q.shape
    cos, sin = _rope_tables(L)
    q = (_rms(c_q, q_norm) @ w_uq).reshape(B, L, ATTN_HEADS, QK_NOPE + QK_ROPE)
    q_nope = q[..., :QK_NOPE]
    q_pe = _apply_rope(q[..., QK_NOPE:], cos[:, None, :], sin[:, None, :])
    k_pe = _apply_rope(k_pe, cos, sin)
    kv = (_rms(c_kv, kv_norm) @ w_ukv).reshape(B, L, ATTN_HEADS, QK_NOPE + V_HEAD)
    k_nope, v = kv[..., :QK_NOPE], kv[..., QK_NOPE:]

    n_blk = -(-L // QBLK)
    L_pad = n_blk * QBLK
    pad = L_pad - L
    q_nope, q_pe, k_nope, k_pe, v = (_pad_seq(a, pad) for a in (q_nope, q_pe, k_nope, k_pe, v))
    kpos = jnp.arange(L_pad)

    def one_block(i):
        s0 = i * QBLK
        qn = lax.dynamic_slice_in_dim(q_nope, s0, QBLK, axis=1)
        qp = lax.dynamic_slice_in_dim(q_pe, s0, QBLK, axis=1)
        sc = (jnp.einsum('bqhd,bkhd->bhqk', qn, k_nope)
              + jnp.einsum('bqhr,bkr->bhqk', qp, k_pe)).astype(jnp.float32) * ATTN_SCALE
        qpos = s0 + jnp.arange(QBLK)
        sc = jnp.where(kpos[None, :] <= qpos[:, None], sc, -jnp.inf)
        p = jax.nn.softmax(sc, axis=-1).astype(v.dtype)
        return jnp.einsum('bhqk,bkhd->bqhd', p, v)

    o = lax.map(one_block, jnp.arange(n_blk))
    o = jnp.moveaxis(o, 0, 1).reshape(B, L_pad, D_ATTN)
    return o[:, :L]


def _short_conv(b_g, c_g, u, conv_w):
    v = c_g * u
    y = lax.conv_general_dilated(v, conv_w.astype(v.dtype)[:, None, :], window_strides=(1,),
                                 padding=[(CONV_W - 1, 0)],
                                 dimension_numbers=('NWC', 'WIO', 'NWC'),
                                 feature_group_count=D_CONV)
    return b_g * y


def _swiglu(x, wg, wu, wd):
    return (jax.nn.silu(x @ wg) * (x @ wu)) @ wd


def _moe(h, w_router, router_bias, w_gate, w_up, w_down, ws_gate, ws_up, ws_down):
    Bn, L, D = h.shape
    xt = h.reshape(-1, D)
    N = xt.shape[0]
    s = jax.nn.sigmoid((xt @ w_router).astype(jnp.float32))
    sel = s + router_bias.astype(jnp.float32)
    gscore = lax.top_k(sel.reshape(N, N_GROUPS, N_EXPERTS // N_GROUPS), 2)[0].sum(-1)
    _, gidx = lax.top_k(gscore, TOPK_GROUPS)
    gmask = jnp.any(gidx[..., None] == jnp.arange(N_GROUPS), axis=1)
    emask = jnp.repeat(gmask, N_EXPERTS // N_GROUPS, axis=1)
    _, eidx = lax.top_k(jnp.where(emask, sel, -jnp.inf), TOP_K)
    gates = jnp.take_along_axis(s, eidx, axis=1)
    gates = gates / jnp.sum(gates, axis=-1, keepdims=True) * ROUTED_SCALE

    A = N * TOP_K
    flat_e = eidx.reshape(-1)
    flat_w = gates.reshape(-1).astype(xt.dtype)
    order = jnp.argsort(flat_e)
    sorted_e = flat_e[order]
    tok = order // TOP_K
    counts = jnp.bincount(flat_e, length=N_EXPERTS)
    padded = (counts + MOE_BLK - 1) // MOE_BLK * MOE_BLK
    pad_end = jnp.cumsum(padded)
    pad_start = pad_end - padded
    start = jnp.cumsum(counts) - counts
    dest = pad_start[sorted_e] + jnp.arange(A) - start[sorted_e]
    n_blocks = -(-A // MOE_BLK) + N_EXPERTS
    P = n_blocks * MOE_BLK
    buf_tok = jnp.full((P,), N, dtype=jnp.int32).at[dest].set(tok.astype(jnp.int32))
    buf_w = jnp.zeros((P,), dtype=xt.dtype).at[dest].set(flat_w[order])
    blk_e = jnp.minimum(jnp.searchsorted(pad_end, jnp.arange(n_blocks) * MOE_BLK, side='right'),
                        N_EXPERTS - 1)
    x_pad = jnp.concatenate([xt, jnp.zeros((1, D), xt.dtype)], axis=0)

    def run_block(args):
        t, g, e = args
        xb = x_pad[t]
        return _swiglu(xb, w_gate[e], w_up[e], w_down[e]) * g[:, None]

    out = lax.map(run_block, (buf_tok.reshape(n_blocks, MOE_BLK),
                              buf_w.reshape(n_blocks, MOE_BLK), blk_e))
    routed = jnp.zeros((N + 1, D), xt.dtype).at[buf_tok].add(out.reshape(P, D))[:N]
    shared = _swiglu(xt, ws_gate, ws_up, ws_down)
    return (routed + shared).reshape(Bn, L, D)


def setup_inputs(seed: int = 0) -> dict:
    key = jax.random.key(seed)
    ks = jax.random.split(key, 32)
    f32 = jnp.float32

    def nrm(k, shape, scale):
        return jax.random.normal(k, shape, f32) * scale

    def gain(k, shape):
        return 1.0 + 0.02 * jax.random.normal(k, shape, f32)

    Ld = DEPTH
    return {
        "x": nrm(ks[0], (BATCH, SEQ, D_MODEL), 1.0),
        "meta_tokens": nrm(ks[1], (N_META, D_MODEL), 1.0),
        "emb_ln_g": gain(ks[2], (D_MODEL,)),
        "emb_ln_b": nrm(ks[3], (D_MODEL,), 0.02),
        "w_in": nrm(ks[4], (Ld, D_MODEL, D_IN), D_MODEL ** -0.5),
        "q_norm": gain(ks[5], (Ld, Q_LORA)),
        "w_uq": nrm(ks[6], (Ld, Q_LORA, ATTN_HEADS * (QK_NOPE + QK_ROPE)), Q_LORA ** -0.5),
        "kv_norm": gain(ks[7], (Ld, KV_LORA)),
        "w_ukv": nrm(ks[8], (Ld, KV_LORA, ATTN_HEADS * (QK_NOPE + V_HEAD)), KV_LORA ** -0.5),
        "conv_w": nrm(ks[9], (Ld, CONV_W, D_CONV), CONV_W ** -0.5),
        "attn_out_norm": gain(ks[10], (Ld, D_ATTN)),
        "conv_out_norm": gain(ks[11], (Ld, D_CONV)),
        "w_o": nrm(ks[12], (Ld, D_MIX, D_MODEL), BETA * D_MIX ** -0.5),
        "ln1_g": gain(ks[13], (Ld, D_MODEL)),
        "ln1_b": nrm(ks[14], (Ld, D_MODEL), 0.02),
        "w_router": nrm(ks[15], (Ld, D_MODEL, N_EXPERTS), D_MODEL ** -0.5),
        "router_bias": nrm(ks[16], (Ld, N_EXPERTS), 0.01),
        "w_gate": nrm(ks[17], (Ld, N_EXPERTS, D_MODEL, D_EXPERT), D_MODEL ** -0.5),
        "w_up": nrm(ks[18], (Ld, N_EXPERTS, D_MODEL, D_EXPERT), D_MODEL ** -0.5),
        "w_down": nrm(ks[19], (Ld, N_EXPERTS, D_EXPERT, D_MODEL), BETA * D_EXPERT ** -0.5),
        "ws_gate": nrm(ks[20], (Ld, D_MODEL, D_SHARED), D_MODEL ** -0.5),
        "ws_up": nrm(ks[21], (Ld, D_MODEL, D_SHARED), D_MODEL ** -0.5),
        "ws_down": nrm(ks[22], (Ld, D_SHARED, D_MODEL), BETA * D_SHARED ** -0.5),
        "ln2_g": gain(ks[23], (Ld, D_MODEL)),
        "ln2_b": nrm(ks[24], (Ld, D_MODEL), 0.02),
    }


def reference(x, meta_tokens, emb_ln_g, emb_ln_b, w_in, q_norm, w_uq, kv_norm, w_ukv, conv_w,
              attn_out_norm, conv_out_norm, w_o, ln1_g, ln1_b, w_router, router_bias,
              w_gate, w_up, w_down, ws_gate, ws_up, ws_down, ln2_g, ln2_b):
    B = x.shape[0]
    meta = jnp.broadcast_to(meta_tokens.astype(x.dtype)[None], (B, N_META, D_MODEL))
    h = jnp.concatenate([meta, x], axis=1)
    h = _layernorm(h, emb_ln_g, emb_ln_b)
    o1 = Q_LORA
    o2 = o1 + KV_LORA
    o3 = o2 + QK_ROPE
    o4 = o3 + D_CONV
    o5 = o4 + D_CONV
    for l in range(DEPTH):
        z = h @ w_in[l]
        attn = _mla(z[..., :o1], z[..., o1:o2], z[..., o2:o3],
                    q_norm[l], w_uq[l], kv_norm[l], w_ukv[l])
        conv = _short_conv(z[..., o3:o4], z[..., o4:o5], z[..., o5:], conv_w[l])
        mix = jnp.concatenate([_rms(attn, attn_out_norm[l]), _rms(conv, conv_out_norm[l])],
                              axis=-1) @ w_o[l]
        h = _layernorm(ALPHA * h + mix, ln1_g[l], ln1_b[l])
        ff = _moe(h, w_router[l], router_bias[l], w_gate[l], w_up[l], w_down[l],
                  ws_gate[l], ws_up[l], ws_down[l])
        h = _layernorm(ALPHA * h + ff, ln2_g[l], ln2_b[l])
    return h[:, N_META:]
```

```cpp
#include <hip/hip_runtime.h>
#include <hip/hip_cooperative_groups.h>
#include <cstdint>
#include <cstdio>
namespace cg = cooperative_groups;

#ifndef NAIVE_GEMM
#define NAIVE_GEMM 0
#endif
#ifndef MEGA
#define MEGA 0
#endif

#define LAS __attribute__((address_space(3)))
typedef unsigned short bf16_t;
typedef short bf16x8 __attribute__((ext_vector_type(8)));
typedef float f32x4 __attribute__((ext_vector_type(4)));
typedef unsigned u32x4 __attribute__((ext_vector_type(4)));
typedef unsigned u32x2 __attribute__((ext_vector_type(2)));

constexpr int D = 1024, NBATCH = 8, SEQ = 2048, NMETA = 16, LPOS = SEQ + NMETA;
constexpr int NTOK = NBATCH * SEQ;
constexpr int NROWS = NTOK + NMETA;
constexpr int NROWSP = 16512;
constexpr int NH = 8, DQK = 96, DNOPE = 64, DROPE = 32, DV = 64;
constexpr int QLORA = 384, KVLORA = 256;
constexpr int ZC = 2304;
constexpr int ZQ = 0, ZKV = 384, ZKPE = 640, ZB = 704, ZCG = 1216, ZU = 1728;
constexpr int DIN = 2208;
constexpr int NEXP = 256, DEXP = 256, TOPK = 8, CAP = 16384;
constexpr float ALPHA = 1.189207115002721f;
constexpr float QSCALE = 0.10206207261596577f * 1.4426950408889634f;

constexpr int NTHREADS = 512, NWAVES = 8;
constexpr int LDS_BYTES = 131072;
constexpr int STAGE_BYTES = 49152;
constexpr int LDS_MISC = 2 * STAGE_BYTES;

constexpr size_t MiB = 1u << 20;
constexpr size_t WS_CTL = 0;
constexpr size_t CTL_BYTES = 1 * MiB;
constexpr size_t CT_CNT = 0;
constexpr size_t CT_BAR = 4096;
constexpr size_t CT_SSQ_Q = 32768;
constexpr size_t CT_SSQ_KV = CT_SSQ_Q + 66048;
constexpr size_t CT_SSQ_ATT = CT_SSQ_KV + 66048;
constexpr size_t CT_STATS1 = CT_SSQ_ATT + 65536;
static_assert(CT_STATS1 + 131072 <= CTL_BYTES, "ctl");
constexpr size_t WS_WIN = 1 * MiB;
constexpr size_t WS_WUQ = 6 * MiB;
constexpr size_t WS_WUKV = 7 * MiB;
constexpr size_t WS_WO = 8 * MiB;
constexpr size_t WS_WR = 10 * MiB;
constexpr size_t WS_WSGU = 11 * MiB;
constexpr size_t WS_WSD = 12 * MiB;
constexpr size_t WS_ROPE = 13 * MiB;
constexpr size_t WS_WGU = 14 * MiB;
constexpr size_t WS_WD = 270 * MiB;
constexpr size_t WS_H1 = 398 * MiB;
constexpr size_t WS_HID = 430 * MiB;
constexpr size_t WS_LAID = 502 * MiB;
constexpr size_t WS_LGATE = 518 * MiB;
constexpr size_t WS_Y = 534 * MiB;
constexpr size_t WS_Z = WS_Y;
constexpr size_t WS_H0 = WS_Y + 73 * MiB;
constexpr size_t WS_Q = WS_Y + 106 * MiB;
constexpr size_t WS_K = WS_Y + 130 * MiB;
constexpr size_t WS_V = WS_Y + 155 * MiB;
constexpr size_t WS_ATT = WS_Y + 172 * MiB;
constexpr size_t WS_CONV = WS_Y + 188 * MiB;
constexpr size_t WS_SSQC = WS_Y + 204 * MiB;
constexpr size_t WS_Y1 = WS_Y + 205 * MiB;
constexpr size_t WS_LOG = WS_Y + 237 * MiB;
constexpr size_t WS_PSQ = WS_Y + 253 * MiB;
constexpr size_t WS_PATT = WS_Y + 254 * MiB;
constexpr size_t WS_PST = WS_Y + 255 * MiB;
constexpr size_t WS_END = WS_Y + 288 * MiB;

struct Params {
    const float *x, *meta, *emb_g, *emb_b, *w_in, *q_norm, *w_uq, *kv_norm, *w_ukv, *conv_w, *attn_on, *conv_on, *w_o,
        *ln1_g, *ln1_b, *w_router, *router_bias, *w_gate, *w_up, *w_down, *ws_gate, *ws_up, *ws_down, *ln2_g, *ln2_b;
    float* out;
    unsigned char* ws;
};

__device__ __forceinline__ unsigned f2bf(float f) { unsigned u = __float_as_uint(f); return (u + 0x7fffu + ((u >> 16) & 1u)) >> 16; }
__device__ __forceinline__ unsigned pk2(float lo, float hi) { return f2bf(lo) | (f2bf(hi) << 16); }
__device__ __forceinline__ float bf2f(unsigned b) { return __uint_as_float(b << 16); }
__device__ __forceinline__ float bflo(unsigned w) { return __uint_as_float(w << 16); }
__device__ __forceinline__ float bfhi(unsigned w) { return __uint_as_float(w & 0xffff0000u); }
__device__ __forceinline__ float wave_sum(float v) {
#pragma unroll
    for (int o = 1; o < 64; o <<= 1) v += __shfl_xor(v, o);
    return v;
}
__device__ __forceinline__ float wave_max(float v) {
#pragma unroll
    for (int o = 1; o < 64; o <<= 1) v = fmaxf(v, __shfl_xor(v, o));
    return v;
}

struct Ctx {
    LAS unsigned char* lds;
    int tid, lane, wave, vcu, G;
};

template <class RowPtr>
__device__ __forceinline__ void gemm_kloop(f32x4 (&acc)[4][4], const Ctx& c, const RowPtr& rp, const bf16_t* Bt, long ldb, int K) {
    const int tid = c.tid, lane = c.lane, wid = c.wave, wr = wid >> 2, wc = wid & 3, fr = lane & 15, fq = lane >> 4;
#if NAIVE_GEMM
    const bf16_t* ar[4];
#pragma unroll
    for (int mi = 0; mi < 4; ++mi) ar[mi] = rp(wr * 64 + mi * 16 + fr);
    const bf16_t* br = Bt + (long)(wc * 64 + fq * 4) * ldb;
#pragma nounroll
    for (int k = 0; k < K; k += 2) {
        unsigned av[4];
#pragma unroll
        for (int mi = 0; mi < 4; ++mi) av[mi] = *(const unsigned*)(ar[mi] + k);
#pragma unroll
        for (int ni = 0; ni < 4; ++ni)
#pragma unroll
            for (int j = 0; j < 4; ++j) {
                const unsigned bv = *(const unsigned*)(br + (long)(ni * 16 + j) * ldb + k);
#pragma unroll
                for (int mi = 0; mi < 4; ++mi) acc[mi][ni][j] += bflo(av[mi]) * bflo(bv) + bfhi(av[mi]) * bfhi(bv);
            }
    }
#else
    LAS unsigned char* lds = c.lds;
    const int nt = K >> 6;
    const int srow = tid >> 3, sch = tid & 7;
    const bf16_t* ap0 = rp(srow) + sch * 8;
    const bf16_t* ap1 = rp(srow + 64) + sch * 8;
    const bf16_t* bp = Bt + (long)srow * ldb + sch * 8;
    const long bstep = 64 * ldb;
    const int so = srow * 128 + ((sch ^ ((srow >> 1) & 7)) << 4);
    u32x4 ra0, ra1, rb0, rb1, rb2, rb3;
#define G_LOAD(t) do { const int ko = (t) * 64; ra0 = *(const u32x4*)(ap0 + ko); ra1 = *(const u32x4*)(ap1 + ko); \
        rb0 = *(const u32x4*)(bp + ko); rb1 = *(const u32x4*)(bp + bstep + ko); rb2 = *(const u32x4*)(bp + 2 * bstep + ko); rb3 = *(const u32x4*)(bp + 3 * bstep + ko); } while (0)
#define G_STORE(buf) do { LAS unsigned char* sb = lds + (buf) * STAGE_BYTES; \
        *(LAS u32x4*)(sb + so) = ra0; *(LAS u32x4*)(sb + so + 8192) = ra1; \
        *(LAS u32x4*)(sb + 16384 + so) = rb0; *(LAS u32x4*)(sb + 16384 + so + 8192) = rb1; \
        *(LAS u32x4*)(sb + 16384 + so + 16384) = rb2; *(LAS u32x4*)(sb + 16384 + so + 24576) = rb3; } while (0)
    __syncthreads();
    G_LOAD(0);
    G_STORE(0);
    __syncthreads();
    const int sw0 = ((0 + fq) ^ ((fr >> 1) & 7)) << 4, sw1 = ((4 + fq) ^ ((fr >> 1) & 7)) << 4;
    const int aoff = (wr * 64 + fr) * 128, boff = 16384 + (wc * 64 + fr) * 128;
    for (int t = 0; t < nt; ++t) {
        if (t + 1 < nt) G_LOAD(t + 1);
        const LAS unsigned char* sb = lds + (t & 1) * STAGE_BYTES;
#pragma unroll
        for (int ks = 0; ks < 2; ++ks) {
            const int sw = ks ? sw1 : sw0;
            bf16x8 af[4], bfr[4];
#pragma unroll
            for (int mi = 0; mi < 4; ++mi) af[mi] = *(const LAS bf16x8*)(sb + aoff + mi * 2048 + sw);
#pragma unroll
            for (int ni = 0; ni < 4; ++ni) bfr[ni] = *(const LAS bf16x8*)(sb + boff + ni * 2048 + sw);
#pragma unroll
            for (int mi = 0; mi < 4; ++mi)
#pragma unroll
                for (int ni = 0; ni < 4; ++ni) acc[mi][ni] = __builtin_amdgcn_mfma_f32_16x16x32_bf16(bfr[ni], af[mi], acc[mi][ni], 0, 0, 0);
        }
        if (t + 1 < nt) G_STORE((t + 1) & 1);
        __syncthreads();
    }
#undef G_LOAD
#undef G_STORE
#endif
}
__device__ __forceinline__ void acc_zero(f32x4 (&acc)[4][4]) {
#pragma unroll
    for (int a = 0; a < 4; ++a)
#pragma unroll
        for (int b = 0; b < 4; ++b) acc[a][b] = (f32x4){0.f, 0.f, 0.f, 0.f};
}
__device__ __forceinline__ void store_bf4(bf16_t* p, f32x4 v) { u32x2 w; w.x = pk2(v[0], v[1]); w.y = pk2(v[2], v[3]); *(u32x2*)p = w; }

enum { MAP_ID = 0, MAP_WIN = 1, MAP_GATE = 2, MAP_UP = 3 };
template <int MAP> __device__ __forceinline__ int rowmap(int n) {
    if (MAP == MAP_WIN) return n < 672 ? n : n + 32;
    if (MAP == MAP_GATE) return 32 * (n >> 4) + (n & 15);
    if (MAP == MAP_UP) return 32 * (n >> 4) + 16 + (n & 15);
    return n;
}
template <int MAP>
__device__ __forceinline__ void transpose_item(const float* W, int K, int N, bf16_t* WT, const float* gain, LAS float* scr, int item, int lane) {
    const int nblk = N / 32, kb = item / nblk, nb = item % nblk, k0 = 64 * kb, n0 = 32 * nb;
#pragma unroll 8
    for (int i = 0; i < 32; ++i) {
        const int kk = 2 * i + (lane >> 5);
        float v = W[(size_t)(k0 + kk) * N + n0 + (lane & 31)];
        if (gain) v *= gain[k0 + kk];
        scr[kk * 33 + (lane & 31)] = v;
    }
    asm volatile("s_waitcnt lgkmcnt(0)" ::: "memory");
    const int ch = lane & 7;
#pragma unroll
    for (int j = 0; j < 4; ++j) {
        const int n = (lane >> 3) + 8 * j;
        const LAS float* s = scr + (8 * ch) * 33 + n;
        u32x4 o;
        o.x = pk2(s[0 * 33], s[1 * 33]); o.y = pk2(s[2 * 33], s[3 * 33]); o.z = pk2(s[4 * 33], s[5 * 33]); o.w = pk2(s[6 * 33], s[7 * 33]);
        *(u32x4*)(WT + (size_t)rowmap<MAP>(n0 + n) * K + k0 + 8 * ch) = o;
    }
    asm volatile("s_waitcnt lgkmcnt(0)" ::: "memory");
}
__device__ __forceinline__ void phase0(const Params& p, const Ctx& c) {
    unsigned char* ws = p.ws;
    LAS float* scr = (LAS float*)(c.lds + c.wave * 8704);
    const int gw = c.vcu * NWAVES + c.wave, NGW = c.G * NWAVES, lane = c.lane;
    bf16_t* H0 = (bf16_t*)(ws + WS_H0);
    for (int r = gw; r < NROWSP; r += NGW) {
        u32x2* o = (u32x2*)(H0 + (size_t)r * D) + lane;
        if (r >= NROWS) {
#pragma unroll
            for (int j = 0; j < 4; ++j) o[64 * j] = (u32x2){0u, 0u};
            continue;
        }
        const float* xr = r < NTOK ? p.x + (size_t)r * D : p.meta + (size_t)(r - NTOK) * D;
        f32x4 v[4]; float s = 0.f;
#pragma unroll
        for (int j = 0; j < 4; ++j) { v[j] = *((const f32x4*)xr + lane + 64 * j); s += (v[j][0] + v[j][1]) + (v[j][2] + v[j][3]); }
        const float mean = wave_sum(s) * (1.f / D);
        float s2 = 0.f;
#pragma unroll
        for (int j = 0; j < 4; ++j) { v[j] = v[j] - mean; s2 += (v[j][0] * v[j][0] + v[j][1] * v[j][1]) + (v[j][2] * v[j][2] + v[j][3] * v[j][3]); }
        const float rstd = 1.f / sqrtf(wave_sum(s2) * (1.f / D) + 1e-5f);
#pragma unroll
        for (int j = 0; j < 4; ++j) {
            const f32x4 g = *((const f32x4*)p.emb_g + lane + 64 * j), b = *((const f32x4*)p.emb_b + lane + 64 * j);
            const f32x4 y = v[j] * rstd * g + b;
            u32x2 w; w.x = pk2(y[0], y[1]); w.y = pk2(y[2], y[3]); o[64 * j] = w;
        }
    }
    {
        float* rope = (float*)(ws + WS_ROPE);
        for (int idx = gw * 64 + lane; idx < LPOS * 16; idx += NGW * 64) {
            const int pos = idx >> 4, i = idx & 15;
            const float inv = exp2f(-(float)i * (13.287712379549449f / 16.f));
            const float ang = (float)pos * inv;
            double rev = (double)ang * 0.15915494309189535; rev -= floor(rev);
            const float rf = (float)rev;
            rope[idx * 2 + 0] = __builtin_amdgcn_cosf(rf);
            rope[idx * 2 + 1] = __builtin_amdgcn_sinf(rf);
        }
    }
    {
        bf16_t* WinT = (bf16_t*)(ws + WS_WIN);
        for (int it = gw; it < 96; it += NGW) {
            const int row = it < 32 ? 672 + it : 2240 + (it - 32);
            u32x2* o = (u32x2*)(WinT + (size_t)row * D) + lane;
#pragma unroll
            for (int j = 0; j < 4; ++j) o[64 * j] = (u32x2){0u, 0u};
        }
    }
    constexpr int I_WIN = 16 * 69, I_UQ = 6 * 24, I_UKV = 4 * 32, I_WO = 16 * 32, I_WR = 16 * 8, I_SG = 128, I_SD = 128;
    constexpr int I_SMALL = I_WIN + I_UQ + I_UKV + I_WO + I_WR + 2 * I_SG + I_SD;
    constexpr int I_EXP = NEXP * 128;
    constexpr int NITEMS = I_SMALL + 3 * I_EXP;
    for (int it = gw; it < NITEMS; it += NGW) {
        int r = it;
        if (r < I_WIN) { transpose_item<MAP_WIN>(p.w_in, D, DIN, (bf16_t*)(ws + WS_WIN), nullptr, scr, r, lane); continue; } r -= I_WIN;
        if (r < I_UQ) { transpose_item<MAP_ID>(p.w_uq, QLORA, 768, (bf16_t*)(ws + WS_WUQ), p.q_norm, scr, r, lane); continue; } r -= I_UQ;
        if (r < I_UKV) { transpose_item<MAP_ID>(p.w_ukv, KVLORA, 1024, (bf16_t*)(ws + WS_WUKV), p.kv_norm, scr, r, lane); continue; } r -= I_UKV;
        if (r < I_WO) {
            const int kb = r / 32;
            transpose_item<MAP_ID>(p.w_o, D, D, (bf16_t*)(ws + WS_WO), kb < 8 ? p.attn_on : p.conv_on - 512, scr, r, lane); continue; } r -= I_WO;
        if (r < I_WR) { transpose_item<MAP_ID>(p.w_router, D, 256, (bf16_t*)(ws + WS_WR), nullptr, scr, r, lane); continue; } r -= I_WR;
        if (r < I_SG) { transpose_item<MAP_GATE>(p.ws_gate, D, 256, (bf16_t*)(ws + WS_WSGU), nullptr, scr, r, lane); continue; } r -= I_SG;
        if (r < I_SG) { transpose_item<MAP_UP>(p.ws_up, D, 256, (bf16_t*)(ws + WS_WSGU), nullptr, scr, r, lane); continue; } r -= I_SG;
        if (r < I_SD) { transpose_item<MAP_ID>(p.ws_down, DEXP, D, (bf16_t*)(ws + WS_WSD), nullptr, scr, r, lane); continue; } r -= I_SD;
        if (r < I_EXP) { const int e = r >> 7; transpose_item<MAP_GATE>(p.w_gate + (size_t)e * D * DEXP, D, 256, (bf16_t*)(ws + WS_WGU) + (size_t)e * 512 * D, nullptr, scr, r & 127, lane); continue; } r -= I_EXP;
        if (r < I_EXP) { const int e = r >> 7; transpose_item<MAP_UP>(p.w_up + (size_t)e * D * DEXP, D, 256, (bf16_t*)(ws + WS_WGU) + (size_t)e * 512 * D, nullptr, scr, r & 127, lane); continue; } r -= I_EXP;
        { const int e = r >> 7; transpose_item<MAP_ID>(p.w_down + (size_t)e * DEXP * D, DEXP, D, (bf16_t*)(ws + WS_WD) + (size_t)e * D * DEXP, nullptr, scr, r & 127, lane); }
    }
}

__device__ __forceinline__ void phase1(const Params& p, const Ctx& c) {
    unsigned char* ws = p.ws;
    const bf16_t* H0 = (const bf16_t*)(ws + WS_H0); const bf16_t* WinT = (const bf16_t*)(ws + WS_WIN);
    bf16_t* Z = (bf16_t*)(ws + WS_Z);
    float* psq = (float*)(ws + WS_PSQ);
    const int lane = c.lane, wr = c.wave >> 2, wc = c.wave & 3, fr = lane & 15, fq = lane >> 4;
    constexpr int NU = 129 * 9;
    for (int u = c.vcu; u < NU; u += c.G) {
        const int mt = u / 9, nt = u % 9, row0 = mt * 128, n0 = nt * 256;
        f32x4 acc[4][4]; acc_zero(acc);
        auto rp = [&](int r) { return H0 + (size_t)(row0 + r) * D; };
        gemm_kloop(acc, c, rp, WinT + (size_t)n0 * D, D, D);
        const int s0 = n0 + wc * 64;
#pragma unroll
        for (int mi = 0; mi < 4; ++mi) {
            const int row = row0 + wr * 64 + mi * 16 + fr;
            float ss = 0.f;
#pragma unroll
            for (int ni = 0; ni < 4; ++ni) {
                const f32x4 v = acc[mi][ni];
                store_bf4(Z + (size_t)row * ZC + s0 + ni * 16 + fq * 4, v);
                ss += (v[0] * v[0] + v[1] * v[1]) + (v[2] * v[2] + v[3] * v[3]);
            }
            if (s0 < ZKPE) {
                ss += __shfl_xor(ss, 16); ss += __shfl_xor(ss, 32);
                if (fq == 0) psq[(size_t)row * 16 + (s0 >> 6)] = ss;
            }
        }
    }
}

__device__ __forceinline__ void phase2(const Params& p, const Ctx& c) {
    unsigned char* ws = p.ws;
    const bf16_t* Z = (const bf16_t*)(ws + WS_Z);
    const float* psq = (const float*)(ws + WS_PSQ);
    const float* rope = (const float*)(ws + WS_ROPE);
    bf16_t* Q = (bf16_t*)(ws + WS_Q); bf16_t* Kb = (bf16_t*)(ws + WS_K); bf16_t* Vb = (bf16_t*)(ws + WS_V);
    const int lane = c.lane, wr = c.wave >> 2, wc = c.wave & 3, fr = lane & 15, fq = lane >> 4;
    constexpr int NUQ = 128 * 3, NUKV = 129 * 4;
    for (int u = c.vcu; u < NUQ + NUKV; u += c.G) {
        f32x4 acc[4][4]; acc_zero(acc);
        if (u < NUQ) {
            const int mt = u / 3, nt = u % 3, row0 = mt * 128, n0 = nt * 256;
            auto rp = [&](int r) { return Z + (size_t)(row0 + r) * ZC + ZQ; };
            gemm_kloop(acc, c, rp, (const bf16_t*)(ws + WS_WUQ) + (size_t)n0 * QLORA, QLORA, QLORA);
            const int s0 = n0 + wc * 64;
#pragma unroll
            for (int mi = 0; mi < 4; ++mi) {
                const int row = row0 + wr * 64 + mi * 16 + fr;
                const f32x4 pa = *(const f32x4*)(psq + (size_t)row * 16), pb = *(const f32x4*)(psq + (size_t)row * 16 + 4);
                const float rq = rsqrtf((((pa[0] + pa[1]) + (pa[2] + pa[3])) + (pb[0] + pb[1])) * (1.f / QLORA) + 1e-6f) * QSCALE;
                const int pos = NMETA + (row & (SEQ - 1));
#pragma unroll
                for (int np = 0; np < 2; ++np) {
                    const int c0 = s0 + np * 32 + fq * 4;
                    f32x4 a = acc[mi][2 * np] * rq, b = acc[mi][2 * np + 1] * rq;
                    if (((s0 + np * 32) % 96) == 64) {
                        const f32x4 cs0 = *(const f32x4*)(rope + ((size_t)pos * 16 + fq * 4) * 2);
                        const f32x4 cs1 = *(const f32x4*)(rope + ((size_t)pos * 16 + fq * 4 + 2) * 2);
                        const float co[4] = {cs0[0], cs0[2], cs1[0], cs1[2]}, si[4] = {cs0[1], cs0[3], cs1[1], cs1[3]};
                        f32x4 na, nb;
#pragma unroll
                        for (int j = 0; j < 4; ++j) { na[j] = a[j] * co[j] - b[j] * si[j]; nb[j] = b[j] * co[j] + a[j] * si[j]; }
                        a = na; b = nb;
                    }
                    store_bf4(Q + (size_t)row * 768 + c0, a);
                    store_bf4(Q + (size_t)row * 768 + c0 + 16, b);
                }
            }
        } else {
            const int uu = u - NUQ, mt = uu / 4, nt = uu % 4, row0 = mt * 128, n0 = nt * 256;
            auto rp = [&](int r) { return Z + (size_t)(row0 + r) * ZC + ZKV; };
            gemm_kloop(acc, c, rp, (const bf16_t*)(ws + WS_WUKV) + (size_t)n0 * KVLORA, KVLORA, KVLORA);
            const int s0 = n0 + wc * 64;
            const int h = s0 >> 7; const bool isv = (s0 & 64) != 0;
#pragma unroll
            for (int mi = 0; mi < 4; ++mi) {
                const int row = row0 + wr * 64 + mi * 16 + fr;
                if (row >= NROWS) continue;
                const f32x4 pa = *(const f32x4*)(psq + (size_t)row * 16 + 4), pb = *(const f32x4*)(psq + (size_t)row * 16 + 8);
                const float rk = rsqrtf(((pa[2] + pa[3]) + (pb[0] + pb[1])) * (1.f / KVLORA) + 1e-6f);
                const int nb = row < NTOK ? 1 : NBATCH;
                const int b0 = row < NTOK ? (row >> 11) : 0, pos = row < NTOK ? NMETA + (row & (SEQ - 1)) : row - NTOK;
                for (int bb = 0; bb < nb; ++bb) {
                    const size_t prow = (size_t)(b0 + bb) * LPOS + pos;
#pragma unroll
                    for (int ni = 0; ni < 4; ++ni) {
                        const int d = ni * 16 + fq * 4;
                        const f32x4 v = acc[mi][ni] * rk;
                        if (isv) store_bf4(Vb + prow * 512 + h * 64 + d, v);
                        else store_bf4(Kb + prow * 768 + h * 96 + d, v);
                    }
                }
            }
        }
    }
    const int gw = c.vcu * NWAVES + c.wave, NGW = c.G * NWAVES;
    const bf16_t* Zc = Z;
    for (int row = gw; row < NROWS; row += NGW) {
        const int nb = row < NTOK ? 1 : NBATCH;
        const int b0 = row < NTOK ? (row >> 11) : 0, pos = row < NTOK ? NMETA + (row & (SEQ - 1)) : row - NTOK;
        if (lane < 16) {
            const float x1 = bf2f(Zc[(size_t)row * ZC + ZKPE + lane]), x2 = bf2f(Zc[(size_t)row * ZC + ZKPE + 16 + lane]);
            const float co = rope[((size_t)pos * 16 + lane) * 2], si = rope[((size_t)pos * 16 + lane) * 2 + 1];
            const bf16_t o1 = (bf16_t)f2bf(x1 * co - x2 * si), o2 = (bf16_t)f2bf(x2 * co + x1 * si);
            for (int bb = 0; bb < nb; ++bb) {
                bf16_t* kp = Kb + ((size_t)(b0 + bb) * LPOS + pos) * 768;
#pragma unroll
                for (int h = 0; h < NH; ++h) { kp[h * 96 + 64 + lane] = o1; kp[h * 96 + 80 + lane] = o2; }
            }
        }
        if (row < NTOK) {
            const int i = row & (SEQ - 1);
            const int r1 = i >= 1 ? row - 1 : NTOK + 15;
            const int r2 = i >= 2 ? row - 2 : (i == 1 ? NTOK + 15 : NTOK + 14);
            const int ch = lane * 8;
            const u32x4 c0 = *(const u32x4*)(Zc + (size_t)row * ZC + ZCG + ch), u0 = *(const u32x4*)(Zc + (size_t)row * ZC + ZU + ch);
            const u32x4 c1 = *(const u32x4*)(Zc + (size_t)r1 * ZC + ZCG + ch), u1 = *(const u32x4*)(Zc + (size_t)r1 * ZC + ZU + ch);
            const u32x4 c2 = *(const u32x4*)(Zc + (size_t)r2 * ZC + ZCG + ch), u2 = *(const u32x4*)(Zc + (size_t)r2 * ZC + ZU + ch);
            const u32x4 bg = *(const u32x4*)(Zc + (size_t)row * ZC + ZB + ch);
            float y[8]; float ss = 0.f;
#pragma unroll
            for (int e = 0; e < 4; ++e) {
#pragma unroll
                for (int hh = 0; hh < 2; ++hh) {
                    const int cc = ch + e * 2 + hh;
                    const float w0 = p.conv_w[cc], w1 = p.conv_w[512 + cc], w2 = p.conv_w[1024 + cc];
                    const float v0 = hh ? bfhi(c0[e]) * bfhi(u0[e]) : bflo(c0[e]) * bflo(u0[e]);
                    const float v1 = hh ? bfhi(c1[e]) * bfhi(u1[e]) : bflo(c1[e]) * bflo(u1[e]);
                    const float v2 = hh ? bfhi(c2[e]) * bfhi(u2[e]) : bflo(c2[e]) * bflo(u2[e]);
                    const float bgv = hh ? bfhi(bg[e]) : bflo(bg[e]);
                    const float yy = bgv * (w0 * v2 + w1 * v1 + w2 * v0);
                    y[e * 2 + hh] = yy; ss += yy * yy;
                }
            }
            ss = wave_sum(ss);
            u32x4 o; o.x = pk2(y[0], y[1]); o.y = pk2(y[2], y[3]); o.z = pk2(y[4], y[5]); o.w = pk2(y[6], y[7]);
            *(u32x4*)((bf16_t*)(ws + WS_CONV) + (size_t)row * 512 + ch) = o;
            if (lane == 0) ((float*)(ws + WS_SSQC))[row] = ss;
        }
    }
}

__device__ __forceinline__ void phase3_naive(const Params& p, const Ctx& c) {
    unsigned char* ws = p.ws;
    const bf16_t* Q = (const bf16_t*)(ws + WS_Q); const bf16_t* Kb = (const bf16_t*)(ws + WS_K); const bf16_t* Vb = (const bf16_t*)(ws + WS_V);
    bf16_t* ATT = (bf16_t*)(ws + WS_ATT); float* patt = (float*)(ws + WS_PATT);
    const int gw = c.vcu * NWAVES + c.wave, NGW = c.G * NWAVES, lane = c.lane;
    for (int it = gw; it < NTOK * NH; it += NGW) {
        const int row = it >> 3, h = it & 7, b = row >> 11, i = row & (SEQ - 1), nkeys = NMETA + i + 1;
        float q[96];
#pragma unroll
        for (int j = 0; j < 12; ++j) {
            const u32x4 w = *(const u32x4*)(Q + (size_t)row * 768 + h * 96 + j * 8);
#pragma unroll
            for (int e = 0; e < 4; ++e) { q[j * 8 + e * 2] = bflo(w[e]); q[j * 8 + e * 2 + 1] = bfhi(w[e]); }
        }
        float m = -INFINITY, l = 0.f; float o[64];
#pragma unroll
        for (int d = 0; d < 64; ++d) o[d] = 0.f;
        for (int kk = lane; kk < nkeys; kk += 64) {
            const bf16_t* kp = Kb + ((size_t)b * LPOS + kk) * 768 + h * 96;
            float s = 0.f;
#pragma unroll
            for (int j = 0; j < 12; ++j) {
                const u32x4 w = *(const u32x4*)(kp + j * 8);
#pragma unroll
                for (int e = 0; e < 4; ++e) { s += q[j * 8 + e * 2] * bflo(w[e]); s += q[j * 8 + e * 2 + 1] * bfhi(w[e]); }
            }
            const float mn = fmaxf(m, s), f = exp2f(m - mn), pe = exp2f(s - mn);
            l = l * f + pe; m = mn;
            const bf16_t* vp = Vb + ((size_t)b * LPOS + kk) * 512 + h * 64;
#pragma unroll
            for (int j = 0; j < 8; ++j) {
                const u32x4 w = *(const u32x4*)(vp + j * 8);
#pragma unroll
                for (int e = 0; e < 4; ++e) { o[j * 8 + e * 2] = o[j * 8 + e * 2] * f + pe * bflo(w[e]); o[j * 8 + e * 2 + 1] = o[j * 8 + e * 2 + 1] * f + pe * bfhi(w[e]); }
            }
        }
        const float M = wave_max(m);
        const float f = (m == -INFINITY) ? 0.f : exp2f(m - M);
        const float lt = wave_sum(l * f);
        float res = 0.f;
#pragma unroll
        for (int d = 0; d < 64; ++d) { const float v = wave_sum(o[d] * f); if (lane == d) res = v; }
        res /= lt;
        ATT[(size_t)row * 512 + h * 64 + lane] = (bf16_t)f2bf(res);
        const float ss = wave_sum(res * res);
        if (lane == 0) patt[(size_t)row * 8 + h] = ss;
    }
}

__device__ __forceinline__ void phase4(const Params& p, const Ctx& c) {
    unsigned char* ws = p.ws;
    const bf16_t* ATT = (const bf16_t*)(ws + WS_ATT); const bf16_t* CONV = (const bf16_t*)(ws + WS_CONV);
    const bf16_t* WoT = (const bf16_t*)(ws + WS_WO); const bf16_t* H0 = (const bf16_t*)(ws + WS_H0);
    const float* patt = (const float*)(ws + WS_PATT); const float* ssq_c = (const float*)(ws + WS_SSQC);
    bf16_t* Y1 = (bf16_t*)(ws + WS_Y1); float* pst = (float*)(ws + WS_PST);
    const int lane = c.lane, wr = c.wave >> 2, wc = c.wave & 3, fr = lane & 15, fq = lane >> 4;
    constexpr int NU = 128 * 4;
    for (int u = c.vcu; u < NU; u += c.G) {
        const int mt = u >> 2, nt = u & 3, row0 = mt * 128, n0 = nt * 256;
        f32x4 acc[4][4]; acc_zero(acc);
        auto rpa = [&](int r) { return ATT + (size_t)(row0 + r) * 512; };
        gemm_kloop(acc, c, rpa, WoT + (size_t)n0 * D, D, 512);
        float rc[4];
#pragma unroll
        for (int mi = 0; mi < 4; ++mi) {
            const int row = row0 + wr * 64 + mi * 16 + fr;
            const f32x4 pa = *(const f32x4*)(patt + (size_t)row * 8), pb = *(const f32x4*)(patt + (size_t)row * 8 + 4);
            const float ra = rsqrtf((((pa[0] + pa[1]) + (pa[2] + pa[3])) + ((pb[0] + pb[1]) + (pb[2] + pb[3]))) * (1.f / 512) + 1e-6f);
            rc[mi] = rsqrtf(ssq_c[row] * (1.f / 512) + 1e-6f);
            const float f = ra / rc[mi];
#pragma unroll
            for (int ni = 0; ni < 4; ++ni) acc[mi][ni] = acc[mi][ni] * f;
        }
        auto rpc = [&](int r) { return CONV + (size_t)(row0 + r) * 512; };
        gemm_kloop(acc, c, rpc, WoT + (size_t)n0 * D + 512, D, 512);
        const int s0 = n0 + wc * 64;
#pragma unroll
        for (int mi = 0; mi < 4; ++mi) {
            const int row = row0 + wr * 64 + mi * 16 + fr;
            float s = 0.f, ss = 0.f;
#pragma unroll
            for (int ni = 0; ni < 4; ++ni) {
                const int col = s0 + ni * 16 + fq * 4;
                const u32x2 hw = *(const u32x2*)(H0 + (size_t)row * D + col);
                f32x4 v = acc[mi][ni] * rc[mi];
                v[0] += ALPHA * bflo(hw.x); v[1] += ALPHA * bfhi(hw.x); v[2] += ALPHA * bflo(hw.y); v[3] += ALPHA * bfhi(hw.y);
                store_bf4(Y1 + (size_t)row * D + col, v);
                s += (v[0] + v[1]) + (v[2] + v[3]);
                ss += (v[0] * v[0] + v[1] * v[1]) + (v[2] * v[2] + v[3] * v[3]);
            }
            s += __shfl_xor(s, 16); s += __shfl_xor(s, 32);
            ss += __shfl_xor(ss, 16); ss += __shfl_xor(ss, 32);
            if (fq == 0) { float* q = pst + ((size_t)row * 16 + nt * 4 + wc) * 2; q[0] = s; q[1] = ss; }
        }
    }
}

__device__ __forceinline__ void phase5a(const Params& p, const Ctx& c) {
    unsigned char* ws = p.ws;
    const bf16_t* Y1 = (const bf16_t*)(ws + WS_Y1); bf16_t* H1 = (bf16_t*)(ws + WS_H1); const float* pst = (const float*)(ws + WS_PST);
    const int gw = c.vcu * NWAVES + c.wave, NGW = c.G * NWAVES, lane = c.lane;
    for (int row = gw; row < NTOK; row += NGW) {
        float s1 = 0.f, s2 = 0.f;
#pragma unroll
        for (int k = 0; k < 16; ++k) { s1 += pst[((size_t)row * 16 + k) * 2]; s2 += pst[((size_t)row * 16 + k) * 2 + 1]; }
        const float mean = s1 * (1.f / D), var = fmaxf(s2 * (1.f / D) - mean * mean, 0.f), rstd = rsqrtf(var + 1e-5f);
#pragma unroll
        for (int j = 0; j < 2; ++j) {
            const int col = (lane + 64 * j) * 8;
            const u32x4 w = *(const u32x4*)(Y1 + (size_t)row * D + col);
            float y[8];
#pragma unroll
            for (int e = 0; e < 4; ++e) { y[2 * e] = bflo(w[e]); y[2 * e + 1] = bfhi(w[e]); }
#pragma unroll
            for (int e = 0; e < 8; ++e) y[e] = (y[e] - mean) * rstd * p.ln1_g[col + e] + p.ln1_b[col + e];
            u32x4 o; o.x = pk2(y[0], y[1]); o.y = pk2(y[2], y[3]); o.z = pk2(y[4], y[5]); o.w = pk2(y[6], y[7]);
            *(u32x4*)(H1 + (size_t)row * D + col) = o;
        }
    }
}
__device__ __forceinline__ void phase5b(const Params& p, const Ctx& c) {
    unsigned char* ws = p.ws;
    const bf16_t* H1 = (const bf16_t*)(ws + WS_H1); float* LOG = (float*)(ws + WS_LOG);
    const int lane = c.lane, wr = c.wave >> 2, wc = c.wave & 3, fr = lane & 15, fq = lane >> 4;
    for (int u = c.vcu; u < 128; u += c.G) {
        const int row0 = u * 128;
        f32x4 acc[4][4]; acc_zero(acc);
        auto rp = [&](int r) { return H1 + (size_t)(row0 + r) * D; };
        gemm_kloop(acc, c, rp, (const bf16_t*)(ws + WS_WR), D, D);
#pragma unroll
        for (int mi = 0; mi < 4; ++mi) {
            const int row = row0 + wr * 64 + mi * 16 + fr;
#pragma unroll
            for (int ni = 0; ni < 4; ++ni) *(f32x4*)(LOG + (size_t)row * 256 + wc * 64 + ni * 16 + fq * 4) = acc[mi][ni];
        }
    }
}
__device__ __forceinline__ void phase5c(const Params& p, const Ctx& c) {
    unsigned char* ws = p.ws;
    const float* LOG = (const float*)(ws + WS_LOG);
    unsigned* cnt = (unsigned*)(ws + WS_CTL + CT_CNT); unsigned* laid = (unsigned*)(ws + WS_LAID); float* lgate = (float*)(ws + WS_LGATE);
    const int gw = c.vcu * NWAVES + c.wave, NGW = c.G * NWAVES, lane = c.lane;
    const f32x4 bias = *((const f32x4*)p.router_bias + lane);
    for (int t = gw; t < NTOK; t += NGW) {
        const f32x4 lg = *((const f32x4*)(LOG + (size_t)t * 256) + lane);
        float s[4], sel[4];
#pragma unroll
        for (int i = 0; i < 4; ++i) { s[i] = 1.f / (1.f + expf(-lg[i])); sel[i] = s[i] + bias[i]; }
        float a = fmaxf(sel[0], sel[1]), b = fminf(sel[0], sel[1]), cc = fmaxf(sel[2], sel[3]), d = fminf(sel[2], sel[3]);
        float t1 = fmaxf(a, cc), t2 = fmaxf(fminf(a, cc), a >= cc ? b : d);
#pragma unroll
        for (int o = 1; o < 8; o <<= 1) {
            const float y1 = __shfl_xor(t1, o), y2 = __shfl_xor(t2, o);
            const float n1 = fmaxf(t1, y1), n2 = fmaxf(fminf(t1, y1), t1 >= y1 ? t2 : y2);
            t1 = n1; t2 = n2;
        }
        const float gs = t1 + t2; const int g = lane >> 3;
        int better = 0;
#pragma unroll
        for (int gg = 0; gg < 8; ++gg) { const float o = __shfl(gs, gg * 8); better += (o > gs || (o == gs && gg < g)) ? 1 : 0; }
        if (better >= 4) { sel[0] = sel[1] = sel[2] = sel[3] = -INFINITY; }
        int ek[8]; float sk[8]; float ssum = 0.f;
#pragma unroll
        for (int k = 0; k < 8; ++k) {
            float bv = sel[0]; int bi = 0;
            if (sel[1] > bv) { bv = sel[1]; bi = 1; }
            if (sel[2] > bv) { bv = sel[2]; bi = 2; }
            if (sel[3] > bv) { bv = sel[3]; bi = 3; }
            const float wm = wave_max(bv);
            const unsigned long long mask = __ballot(bv == wm);
            const int src = __ffsll((long long)mask) - 1;
            const float sb = bi == 0 ? s[0] : bi == 1 ? s[1] : bi == 2 ? s[2] : s[3];
            ek[k] = src * 4 + __shfl(bi, src); sk[k] = __shfl(sb, src); ssum += sk[k];
            if (lane == src) { if (bi == 0) sel[0] = -INFINITY; else if (bi == 1) sel[1] = -INFINITY; else if (bi == 2) sel[2] = -INFINITY; else sel[3] = -INFINITY; }
        }
        int me = ek[0]; float mg = sk[0];
#pragma unroll
        for (int k = 1; k < 8; ++k) if (lane == k) { me = ek[k]; mg = sk[k]; }
        if (lane < 8) {
            const unsigned pos = atomicAdd(cnt + me, 1u);
            laid[(size_t)me * CAP + pos] = (unsigned)(t * 8 + lane);
            lgate[(size_t)me * CAP + pos] = mg / ssum * 2.5f;
        }
    }
}

struct MoeTab { LAS int* tstart; LAS int* roff; LAS int* tok; LAS float* gate; };
__device__ __forceinline__ MoeTab moe_tab_build(const Params& p, const Ctx& c) {
    MoeTab T; T.tstart = (LAS int*)(c.lds + LDS_MISC); T.roff = T.tstart + 260; T.tok = T.roff + 260; T.gate = (LAS float*)(T.tok + 128);
    const unsigned* cnt = (const unsigned*)(p.ws + WS_CTL + CT_CNT);
    __syncthreads();
    if (c.tid < 64) {
        int cv[4], tv[4]; int ls = 0, lt = 0;
#pragma unroll
        for (int i = 0; i < 4; ++i) { cv[i] = (int)cnt[c.tid * 4 + i]; tv[i] = (cv[i] + 127) >> 7; ls += cv[i]; lt += tv[i]; }
        int ps = ls, pt = lt;
#pragma unroll
        for (int o = 1; o < 64; o <<= 1) { const int a = __shfl_up(ps, o), b = __shfl_up(pt, o); if (c.tid >= o) { ps += a; pt += b; } }
        int es = ps - ls, et = pt - lt;
#pragma unroll
        for (int i = 0; i < 4; ++i) { T.roff[c.tid * 4 + i] = es; T.tstart[c.tid * 4 + i] = et; es += cv[i]; et += tv[i]; }
        if (c.tid == 63) { T.roff[256] = es; T.tstart[256] = et; }
    }
    __syncthreads();
    return T;
}
__device__ __forceinline__ int moe_find(const MoeTab& T, int g) {
    int lo = 0, hi = 255;
    while (lo < hi) { const int mid = (lo + hi + 1) >> 1; if (T.tstart[mid] <= g) lo = mid; else hi = mid - 1; }
    return lo;
}

__device__ __forceinline__ void phase6(const Params& p, const Ctx& c) {
    unsigned char* ws = p.ws;
    const bf16_t* H1 = (const bf16_t*)(ws + WS_H1); bf16_t* HID = (bf16_t*)(ws + WS_HID);
    const unsigned* laid = (const unsigned*)(ws + WS_LAID);
    const unsigned* cnt = (const unsigned*)(ws + WS_CTL + CT_CNT);
    const int lane = c.lane, wr = c.wave >> 2, wc = c.wave & 3, fr = lane & 15, fq = lane >> 4;
    const MoeTab T = moe_tab_build(p, c);
    const int tmt = T.tstart[256], NU = (tmt + 128) * 2;
    for (int u = c.vcu; u < NU; u += c.G) {
        const int g = u >> 1, nt = u & 1;
        int e, mt, nrows; size_t hbase;
        __syncthreads();
        if (g < tmt) {
            e = moe_find(T, g); mt = g - T.tstart[e]; nrows = min(128, (int)cnt[e] - mt * 128); hbase = (size_t)T.roff[e] + mt * 128;
            if (c.tid < 128) T.tok[c.tid] = (int)(laid[(size_t)e * CAP + mt * 128 + min(c.tid, nrows - 1)] >> 3);
        } else {
            e = NEXP; mt = g - tmt; nrows = 128; hbase = (size_t)NTOK * 8 + mt * 128;
            if (c.tid < 128) T.tok[c.tid] = mt * 128 + c.tid;
        }
        __syncthreads();
        f32x4 acc[4][4]; acc_zero(acc);
        auto rp = [&](int r) { return H1 + (size_t)T.tok[r] * D; };
        const bf16_t* Bt = (e < NEXP ? (const bf16_t*)(ws + WS_WGU) + (size_t)e * 512 * D : (const bf16_t*)(ws + WS_WSGU)) + (size_t)nt * 256 * D;
        gemm_kloop(acc, c, rp, Bt, D, D);
#pragma unroll
        for (int mi = 0; mi < 4; ++mi) {
            const int r = wr * 64 + mi * 16 + fr;
            if (r >= nrows) continue;
#pragma unroll
            for (int np = 0; np < 2; ++np) {
                const f32x4 gt = acc[mi][2 * np], up = acc[mi][2 * np + 1];
                f32x4 hv;
#pragma unroll
                for (int j = 0; j < 4; ++j) hv[j] = gt[j] / (1.f + __expf(-gt[j])) * up[j];
                store_bf4(HID + (hbase + r) * DEXP + nt * 128 + wc * 32 + np * 16 + fq * 4, hv);
            }
        }
    }
}
__device__ __forceinline__ void phase7(const Params& p, const Ctx& c) {
    unsigned char* ws = p.ws;
    const bf16_t* HID = (const bf16_t*)(ws + WS_HID); bf16_t* Y = (bf16_t*)(ws + WS_Y);
    const unsigned* laid = (const unsigned*)(ws + WS_LAID); const float* lgate = (const float*)(ws + WS_LGATE);
    const unsigned* cnt = (const unsigned*)(ws + WS_CTL + CT_CNT);
    const int lane = c.lane, wr = c.wave >> 2, wc = c.wave & 3, fr = lane & 15, fq = lane >> 4;
    const MoeTab T = moe_tab_build(p, c);
    const int tmt = T.tstart[256], NU = (tmt + 128) * 4;
    for (int u = c.vcu; u < NU; u += c.G) {
        const int g = u >> 2, nt = u & 3;
        int e, mt, nrows; size_t hbase;
        __syncthreads();
        if (g < tmt) {
            e = moe_find(T, g); mt = g - T.tstart[e]; nrows = min(128, (int)cnt[e] - mt * 128); hbase = (size_t)T.roff[e] + mt * 128;
            if (c.tid < 128) {
                const int rr = min(c.tid, nrows - 1);
                const unsigned aid = laid[(size_t)e * CAP + mt * 128 + rr];
                T.tok[c.tid] = (int)((aid >> 3) * 9 + (aid & 7)); T.gate[c.tid] = lgate[(size_t)e * CAP + mt * 128 + rr];
            }
        } else {
            e = NEXP; mt = g - tmt; nrows = 128; hbase = (size_t)NTOK * 8 + mt * 128;
            if (c.tid < 128) { T.tok[c.tid] = (mt * 128 + c.tid) * 9 + 8; T.gate[c.tid] = 1.f; }
        }
        __syncthreads();
        f32x4 acc[4][4]; acc_zero(acc);
        auto rp = [&](int r) { return HID + (hbase + min(r, nrows - 1)) * DEXP; };
        const bf16_t* Bt = (e < NEXP ? (const bf16_t*)(ws + WS_WD) + (size_t)e * D * DEXP : (const bf16_t*)(ws + WS_WSD)) + (size_t)nt * 256 * DEXP;
        gemm_kloop(acc, c, rp, Bt, DEXP, DEXP);
#pragma unroll
        for (int mi = 0; mi < 4; ++mi) {
            const int r = wr * 64 + mi * 16 + fr;
            if (r >= nrows) continue;
            const float gt = T.gate[r]; const size_t yrow = (size_t)T.tok[r];
#pragma unroll
            for (int ni = 0; ni < 4; ++ni) store_bf4(Y + yrow * D + nt * 256 + wc * 64 + ni * 16 + fq * 4, acc[mi][ni] * gt);
        }
    }
}
__device__ __forceinline__ void phase8(const Params& p, const Ctx& c) {
    unsigned char* ws = p.ws;
    const bf16_t* H1 = (const bf16_t*)(ws + WS_H1); const bf16_t* Y = (const bf16_t*)(ws + WS_Y);
    const int gw = c.vcu * NWAVES + c.wave, NGW = c.G * NWAVES, lane = c.lane;
    for (int t = gw; t < NTOK; t += NGW) {
        float v[16];
#pragma unroll
        for (int j = 0; j < 2; ++j) {
            const int col = (lane + 64 * j) * 8;
            const u32x4 w = *(const u32x4*)(H1 + (size_t)t * D + col);
#pragma unroll
            for (int e = 0; e < 4; ++e) { v[j * 8 + 2 * e] = ALPHA * bflo(w[e]); v[j * 8 + 2 * e + 1] = ALPHA * bfhi(w[e]); }
#pragma unroll
            for (int k = 0; k < 9; ++k) {
                const u32x4 y = *(const u32x4*)(Y + ((size_t)t * 9 + k) * D + col);
#pragma unroll
                for (int e = 0; e < 4; ++e) { v[j * 8 + 2 * e] += bflo(y[e]); v[j * 8 + 2 * e + 1] += bfhi(y[e]); }
            }
        }
        float s = 0.f;
#pragma unroll
        for (int e = 0; e < 16; ++e) s += v[e];
        const float mean = wave_sum(s) * (1.f / D);
        float ss = 0.f;
#pragma unroll
        for (int e = 0; e < 16; ++e) { v[e] -= mean; ss += v[e] * v[e]; }
        const float rstd = rsqrtf(wave_sum(ss) * (1.f / D) + 1e-5f);
#pragma unroll
        for (int j = 0; j < 2; ++j) {
            const int col = (lane + 64 * j) * 8;
            f32x4 o0, o1;
#pragma unroll
            for (int e = 0; e < 4; ++e) { o0[e] = v[j * 8 + e] * rstd * p.ln2_g[col + e] + p.ln2_b[col + e]; o1[e] = v[j * 8 + 4 + e] * rstd * p.ln2_g[col + 4 + e] + p.ln2_b[col + 4 + e]; }
            *(f32x4*)(p.out + (size_t)t * D + col) = o0; *(f32x4*)(p.out + (size_t)t * D + col + 4) = o1;
        }
    }
}

template <int PH> __device__ __forceinline__ void run_phase(const Params& p, const Ctx& c) {
    if (PH == 0) phase0(p, c);
    if (PH == 1) phase1(p, c);
    if (PH == 2) phase2(p, c);
    if (PH == 3) phase3_naive(p, c);
    if (PH == 4) phase4(p, c);
    if (PH == 5) phase5a(p, c);
    if (PH == 6) phase5b(p, c);
    if (PH == 7) phase5c(p, c);
    if (PH == 8) phase6(p, c);
    if (PH == 9) phase7(p, c);
    if (PH == 10) phase8(p, c);
}
constexpr int NPHASES = 11;
__device__ __forceinline__ Ctx make_ctx(unsigned char* lds) {
    Ctx c; c.lds = (LAS unsigned char*)lds; c.tid = threadIdx.x; c.lane = c.tid & 63; c.wave = __builtin_amdgcn_readfirstlane(c.tid >> 6);
    c.G = gridDim.x; const int bx = blockIdx.x; c.vcu = (c.G % 8 == 0) ? (bx % 8) * (c.G / 8) + bx / 8 : bx;
    return c;
}
template <int PH> __global__ void __launch_bounds__(NTHREADS, 2) phase_kernel(Params p) {
    extern __shared__ __attribute__((aligned(16))) unsigned char lds[];
    const Ctx c = make_ctx(lds);
    run_phase<PH>(p, c);
}
#if MEGA
__global__ void __launch_bounds__(NTHREADS, 2) mega_kernel(Params p) {
    extern __shared__ __attribute__((aligned(16))) unsigned char lds[];
    const Ctx c = make_ctx(lds);
    cg::grid_group grid = cg::this_grid();
    run_phase<0>(p, c); grid.sync();
    run_phase<1>(p, c); grid.sync();
    run_phase<2>(p, c); grid.sync();
    run_phase<3>(p, c); grid.sync();
    run_phase<4>(p, c); grid.sync();
    run_phase<5>(p, c); grid.sync();
    run_phase<6>(p, c); grid.sync();
    run_phase<7>(p, c); grid.sync();
    run_phase<8>(p, c); grid.sync();
    run_phase<9>(p, c); grid.sync();
    run_phase<10>(p, c);
}

#endif
template <int PH> static void launch_phase(const Params& p, int grid, hipStream_t stream) {
    static bool attr = false;
    if (!attr) { (void)hipFuncSetAttribute((const void*)phase_kernel<PH>, hipFuncAttributeMaxDynamicSharedMemorySize, LDS_BYTES); attr = true; }
    hipLaunchKernelGGL(phase_kernel<PH>, dim3(grid), dim3(NTHREADS), LDS_BYTES, stream, p);
}

extern "C" void kernel_launch(void* const* d_in, const int* in_sizes, int n_in, void* d_out, int out_size, void* d_ws, size_t ws_size, hipStream_t stream) {
    if (n_in != 25 || ws_size < WS_END) { fprintf(stderr, "kernel_launch: unexpected n_in %d or ws_size %zu (need %zu)\n", n_in, ws_size, (size_t)WS_END); return; }
    Params p{};
    const float** pp = (const float**)&p;
    for (int i = 0; i < 25; ++i) pp[i] = (const float*)d_in[i];
    p.out = (float*)d_out; p.ws = (unsigned char*)d_ws;
    (void)hipMemsetAsync((char*)d_ws + WS_CTL, 0, CTL_BYTES, stream);
#if MEGA
    static int grid = 0;
    if (!grid) {
        int dev = 0, cus = 0, per_cu = 0;
        (void)hipGetDevice(&dev);
        (void)hipDeviceGetAttribute(&cus, hipDeviceAttributeMultiprocessorCount, dev);
        (void)hipFuncSetAttribute((const void*)mega_kernel, hipFuncAttributeMaxDynamicSharedMemorySize, LDS_BYTES);
        (void)hipOccupancyMaxActiveBlocksPerMultiprocessor(&per_cu, (const void*)mega_kernel, NTHREADS, LDS_BYTES);
        if (per_cu < 1) per_cu = 1;
        grid = cus;
        (void)per_cu;
    }
    void* args[] = {&p};
    hipError_t e = hipLaunchCooperativeKernel((const void*)mega_kernel, dim3(grid), dim3(NTHREADS), args, LDS_BYTES, stream);
    if (e != hipSuccess) fprintf(stderr, "cooperative launch failed: %s (grid %d)\n", hipGetErrorString(e), grid);
#else
    const int grid = 256;
    launch_phase<0>(p, grid, stream); launch_phase<1>(p, grid, stream); launch_phase<2>(p, grid, stream); launch_phase<3>(p, grid, stream);
    launch_phase<4>(p, grid, stream); launch_phase<5>(p, grid, stream); launch_phase<6>(p, grid, stream); launch_phase<7>(p, grid, stream);
    launch_phase<8>(p, grid, stream); launch_phase<9>(p, grid, stream); launch_phase<10>(p, grid, stream);
#endif
}
```

```cpp
#include <hip/hip_runtime.h>
#include <hip/hip_cooperative_groups.h>
#include <cstdint>
#include <cstdio>
namespace cg = cooperative_groups;

#ifndef NAIVE_GEMM
#define NAIVE_GEMM 0
#endif
#ifndef NAIVE_ATTN
#define NAIVE_ATTN 0
#endif
#ifndef MEGA
#define MEGA 1
#endif

#define LAS __attribute__((address_space(3)))
typedef unsigned short bf16_t;
typedef short bf16x8 __attribute__((ext_vector_type(8)));
typedef float f32x4 __attribute__((ext_vector_type(4)));
typedef unsigned u32x4 __attribute__((ext_vector_type(4)));
typedef unsigned u32x2 __attribute__((ext_vector_type(2)));

constexpr int D = 1024, NBATCH = 8, SEQ = 2048, NMETA = 16, LPOS = SEQ + NMETA;
constexpr int NTOK = NBATCH * SEQ;
constexpr int NROWS = NTOK + NMETA;
constexpr int NROWSP = 16512;
constexpr int NH = 8, DQK = 96, DNOPE = 64, DROPE = 32, DV = 64;
constexpr int QLORA = 384, KVLORA = 256;
constexpr int ZC = 2304;
constexpr int ZQ = 0, ZKV = 384, ZKPE = 640, ZB = 704, ZCG = 1216, ZU = 1728;
constexpr int DIN = 2208;
constexpr int NEXP = 256, DEXP = 256, TOPK = 8, CAP = 16384;
constexpr float ALPHA = 1.189207115002721f;
constexpr float QSCALE = 0.10206207261596577f * 1.4426950408889634f;

constexpr int NTHREADS = 512, NWAVES = 8;
constexpr int LDS_BYTES = 131072;
constexpr int STAGE_BYTES = 49152;
constexpr int LDS_MISC = 2 * STAGE_BYTES;

constexpr size_t MiB = 1u << 20;
constexpr size_t WS_CTL = 0;
constexpr size_t CTL_BYTES = 1 * MiB;
constexpr size_t CT_CNT = 0;
constexpr size_t CT_BAR = 4096;
constexpr size_t CT_SSQ_Q = 32768;
constexpr size_t CT_SSQ_KV = CT_SSQ_Q + 66048;
constexpr size_t CT_SSQ_ATT = CT_SSQ_KV + 66048;
constexpr size_t CT_STATS1 = CT_SSQ_ATT + 65536;
static_assert(CT_STATS1 + 131072 <= CTL_BYTES, "ctl");
constexpr size_t WS_WIN = 1 * MiB;
constexpr size_t WS_WUQ = 6 * MiB;
constexpr size_t WS_WUKV = 7 * MiB;
constexpr size_t WS_WO = 8 * MiB;
constexpr size_t WS_WR = 10 * MiB;
constexpr size_t WS_WSGU = 11 * MiB;
constexpr size_t WS_WSD = 12 * MiB;
constexpr size_t WS_ROPE = 13 * MiB;
constexpr size_t WS_WGU = 14 * MiB;
constexpr size_t WS_WD = 270 * MiB;
constexpr size_t WS_H1 = 398 * MiB;
constexpr size_t WS_HID = 430 * MiB;
constexpr size_t WS_LAID = 502 * MiB;
constexpr size_t WS_LGATE = 518 * MiB;
constexpr size_t WS_Y = 534 * MiB;
constexpr size_t WS_Z = WS_Y;
constexpr size_t WS_H0 = WS_Y + 73 * MiB;
constexpr size_t WS_Q = WS_Y + 106 * MiB;
constexpr size_t WS_K = WS_Y + 130 * MiB;
constexpr size_t WS_V = WS_Y + 155 * MiB;
constexpr size_t WS_ATT = WS_Y + 172 * MiB;
constexpr size_t WS_CONV = WS_Y + 188 * MiB;
constexpr size_t WS_SSQC = WS_Y + 204 * MiB;
constexpr size_t WS_Y1 = WS_Y + 205 * MiB;
constexpr size_t WS_LOG = WS_Y + 237 * MiB;
constexpr size_t WS_PSQ = WS_Y + 253 * MiB;
constexpr size_t WS_PATT = WS_Y + 254 * MiB;
constexpr size_t WS_PST = WS_Y + 255 * MiB;
constexpr size_t WS_END = WS_Y + 288 * MiB;

struct Params {
    const float *x, *meta, *emb_g, *emb_b, *w_in, *q_norm, *w_uq, *kv_norm, *w_ukv, *conv_w, *attn_on, *conv_on, *w_o,
        *ln1_g, *ln1_b, *w_router, *router_bias, *w_gate, *w_up, *w_down, *ws_gate, *ws_up, *ws_down, *ln2_g, *ln2_b;
    float* out;
    unsigned char* ws;
};

__device__ __forceinline__ unsigned f2bf(float f) { unsigned u = __float_as_uint(f); return (u + 0x7fffu + ((u >> 16) & 1u)) >> 16; }
__device__ __forceinline__ unsigned pk2(float lo, float hi) { return f2bf(lo) | (f2bf(hi) << 16); }
__device__ __forceinline__ float bf2f(unsigned b) { return __uint_as_float(b << 16); }
__device__ __forceinline__ float bflo(unsigned w) { return __uint_as_float(w << 16); }
__device__ __forceinline__ float bfhi(unsigned w) { return __uint_as_float(w & 0xffff0000u); }
__device__ __forceinline__ float wave_sum(float v) {
#pragma unroll
    for (int o = 1; o < 64; o <<= 1) v += __shfl_xor(v, o);
    return v;
}
__device__ __forceinline__ float wave_max(float v) {
#pragma unroll
    for (int o = 1; o < 64; o <<= 1) v = fmaxf(v, __shfl_xor(v, o));
    return v;
}

struct Ctx {
    LAS unsigned char* lds;
    int tid, lane, wave, vcu, G;
};

template <class RowPtr>
__device__ __forceinline__ void gemm_kloop(f32x4 (&acc)[4][4], const Ctx& c, const RowPtr& rp, const bf16_t* Bt, long ldb, int K) {
    const int tid = c.tid, lane = c.lane, wid = c.wave, wr = wid >> 2, wc = wid & 3, fr = lane & 15, fq = lane >> 4;
#if NAIVE_GEMM
    const bf16_t* ar[4];
#pragma unroll
    for (int mi = 0; mi < 4; ++mi) ar[mi] = rp(wr * 64 + mi * 16 + fr);
    const bf16_t* br = Bt + (long)(wc * 64 + fq * 4) * ldb;
#pragma nounroll
    for (int k = 0; k < K; k += 2) {
        unsigned av[4];
#pragma unroll
        for (int mi = 0; mi < 4; ++mi) av[mi] = *(const unsigned*)(ar[mi] + k);
#pragma unroll
        for (int ni = 0; ni < 4; ++ni)
#pragma unroll
            for (int j = 0; j < 4; ++j) {
                const unsigned bv = *(const unsigned*)(br + (long)(ni * 16 + j) * ldb + k);
#pragma unroll
                for (int mi = 0; mi < 4; ++mi) acc[mi][ni][j] += bflo(av[mi]) * bflo(bv) + bfhi(av[mi]) * bfhi(bv);
            }
    }
#else
    LAS unsigned char* lds = c.lds;
    const int nt = K >> 6;
    const int srow = tid >> 3, sch = tid & 7;
    const bf16_t* ap0 = rp(srow) + sch * 8;
    const bf16_t* ap1 = rp(srow + 64) + sch * 8;
    const bf16_t* bp = Bt + (long)srow * ldb + sch * 8;
    const long bstep = 64 * ldb;
    const int so = srow * 128 + ((sch ^ ((srow >> 1) & 7)) << 4);
    u32x4 ra0, ra1, rb0, rb1, rb2, rb3;
#define G_LOAD(t) do { const int ko = (t) * 64; ra0 = *(const u32x4*)(ap0 + ko); ra1 = *(const u32x4*)(ap1 + ko); \
        rb0 = *(const u32x4*)(bp + ko); rb1 = *(const u32x4*)(bp + bstep + ko); rb2 = *(const u32x4*)(bp + 2 * bstep + ko); rb3 = *(const u32x4*)(bp + 3 * bstep + ko); } while (0)
#define G_STORE(buf) do { LAS unsigned char* sb = lds + (buf) * STAGE_BYTES; \
        *(LAS u32x4*)(sb + so) = ra0; *(LAS u32x4*)(sb + so + 8192) = ra1; \
        *(LAS u32x4*)(sb + 16384 + so) = rb0; *(LAS u32x4*)(sb + 16384 + so + 8192) = rb1; \
        *(LAS u32x4*)(sb + 16384 + so + 16384) = rb2; *(LAS u32x4*)(sb + 16384 + so + 24576) = rb3; } while (0)
    __syncthreads();
    G_LOAD(0);
    G_STORE(0);
    __syncthreads();
    const int sw0 = ((0 + fq) ^ ((fr >> 1) & 7)) << 4, sw1 = ((4 + fq) ^ ((fr >> 1) & 7)) << 4;
    const int aoff = (wr * 64 + fr) * 128, boff = 16384 + (wc * 64 + fr) * 128;
    for (int t = 0; t < nt; ++t) {
        if (t + 1 < nt) G_LOAD(t + 1);
        const LAS unsigned char* sb = lds + (t & 1) * STAGE_BYTES;
#pragma unroll
        for (int ks = 0; ks < 2; ++ks) {
            const int sw = ks ? sw1 : sw0;
            bf16x8 af[4], bfr[4];
#pragma unroll
            for (int mi = 0; mi < 4; ++mi) af[mi] = *(const LAS bf16x8*)(sb + aoff + mi * 2048 + sw);
#pragma unroll
            for (int ni = 0; ni < 4; ++ni) bfr[ni] = *(const LAS bf16x8*)(sb + boff + ni * 2048 + sw);
#pragma unroll
            for (int mi = 0; mi < 4; ++mi)
#pragma unroll
                for (int ni = 0; ni < 4; ++ni) acc[mi][ni] = __builtin_amdgcn_mfma_f32_16x16x32_bf16(bfr[ni], af[mi], acc[mi][ni], 0, 0, 0);
        }
        if (t + 1 < nt) G_STORE((t + 1) & 1);
        __syncthreads();
    }
#undef G_LOAD
#undef G_STORE
#endif
}
__device__ __forceinline__ void acc_zero(f32x4 (&acc)[4][4]) {
#pragma unroll
    for (int a = 0; a < 4; ++a)
#pragma unroll
        for (int b = 0; b < 4; ++b) acc[a][b] = (f32x4){0.f, 0.f, 0.f, 0.f};
}
__device__ __forceinline__ void store_bf4(bf16_t* p, f32x4 v) { u32x2 w; w.x = pk2(v[0], v[1]); w.y = pk2(v[2], v[3]); *(u32x2*)p = w; }

enum { MAP_ID = 0, MAP_WIN = 1, MAP_GATE = 2, MAP_UP = 3 };
template <int MAP> __device__ __forceinline__ int rowmap(int n) {
    if (MAP == MAP_WIN) return n < 672 ? n : n + 32;
    if (MAP == MAP_GATE) return 32 * (n >> 4) + (n & 15);
    if (MAP == MAP_UP) return 32 * (n >> 4) + 16 + (n & 15);
    return n;
}
template <int MAP>
__device__ __forceinline__ void transpose_item(const float* W, int K, int N, bf16_t* WT, const float* gain, LAS float* scr, int item, int lane) {
    const int nblk = N / 32, kb = item / nblk, nb = item % nblk, k0 = 64 * kb, n0 = 32 * nb;
#pragma unroll 8
    for (int i = 0; i < 32; ++i) {
        const int kk = 2 * i + (lane >> 5);
        float v = W[(size_t)(k0 + kk) * N + n0 + (lane & 31)];
        if (gain) v *= gain[k0 + kk];
        scr[kk * 33 + (lane & 31)] = v;
    }
    asm volatile("s_waitcnt lgkmcnt(0)" ::: "memory");
    const int ch = lane & 7;
#pragma unroll
    for (int j = 0; j < 4; ++j) {
        const int n = (lane >> 3) + 8 * j;
        const LAS float* s = scr + (8 * ch) * 33 + n;
        u32x4 o;
        o.x = pk2(s[0 * 33], s[1 * 33]); o.y = pk2(s[2 * 33], s[3 * 33]); o.z = pk2(s[4 * 33], s[5 * 33]); o.w = pk2(s[6 * 33], s[7 * 33]);
        *(u32x4*)(WT + (size_t)rowmap<MAP>(n0 + n) * K + k0 + 8 * ch) = o;
    }
    asm volatile("s_waitcnt lgkmcnt(0)" ::: "memory");
}
__device__ __forceinline__ void phase0(const Params& p, const Ctx& c) {
    unsigned char* ws = p.ws;
    LAS float* scr = (LAS float*)(c.lds + c.wave * 8704);
    const int gw = c.vcu * NWAVES + c.wave, NGW = c.G * NWAVES, lane = c.lane;
    bf16_t* H0 = (bf16_t*)(ws + WS_H0);
    for (int r = gw; r < NROWSP; r += NGW) {
        u32x2* o = (u32x2*)(H0 + (size_t)r * D) + lane;
        if (r >= NROWS) {
#pragma unroll
            for (int j = 0; j < 4; ++j) o[64 * j] = (u32x2){0u, 0u};
            continue;
        }
        const float* xr = r < NTOK ? p.x + (size_t)r * D : p.meta + (size_t)(r - NTOK) * D;
        f32x4 v[4]; float s = 0.f;
#pragma unroll
        for (int j = 0; j < 4; ++j) { v[j] = *((const f32x4*)xr + lane + 64 * j); s += (v[j][0] + v[j][1]) + (v[j][2] + v[j][3]); }
        const float mean = wave_sum(s) * (1.f / D);
        float s2 = 0.f;
#pragma unroll
        for (int j = 0; j < 4; ++j) { v[j] = v[j] - mean; s2 += (v[j][0] * v[j][0] + v[j][1] * v[j][1]) + (v[j][2] * v[j][2] + v[j][3] * v[j][3]); }
        const float rstd = 1.f / sqrtf(wave_sum(s2) * (1.f / D) + 1e-5f);
#pragma unroll
        for (int j = 0; j < 4; ++j) {
            const f32x4 g = *((const f32x4*)p.emb_g + lane + 64 * j), b = *((const f32x4*)p.emb_b + lane + 64 * j);
            const f32x4 y = v[j] * rstd * g + b;
            u32x2 w; w.x = pk2(y[0], y[1]); w.y = pk2(y[2], y[3]); o[64 * j] = w;
        }
    }
    {
        float* rope = (float*)(ws + WS_ROPE);
        for (int idx = gw * 64 + lane; idx < LPOS * 16; idx += NGW * 64) {
            const int pos = idx >> 4, i = idx & 15;
            const float inv = exp2f(-(float)i * (13.287712379549449f / 16.f));
            const float ang = (float)pos * inv;
            double rev = (double)ang * 0.15915494309189535; rev -= floor(rev);
            const float rf = (float)rev;
            rope[idx * 2 + 0] = __builtin_amdgcn_cosf(rf);
            rope[idx * 2 + 1] = __builtin_amdgcn_sinf(rf);
        }
    }
    {
        bf16_t* WinT = (bf16_t*)(ws + WS_WIN);
        for (int it = gw; it < 96; it += NGW) {
            const int row = it < 32 ? 672 + it : 2240 + (it - 32);
            u32x2* o = (u32x2*)(WinT + (size_t)row * D) + lane;
#pragma unroll
            for (int j = 0; j < 4; ++j) o[64 * j] = (u32x2){0u, 0u};
        }
    }
    constexpr int I_WIN = 16 * 69, I_UQ = 6 * 24, I_UKV = 4 * 32, I_WO = 16 * 32, I_WR = 16 * 8, I_SG = 128, I_SD = 128;
    constexpr int I_SMALL = I_WIN + I_UQ + I_UKV + I_WO + I_WR + 2 * I_SG + I_SD;
    constexpr int I_EXP = NEXP * 128;
    constexpr int NITEMS = I_SMALL + 3 * I_EXP;
    for (int it = gw; it < NITEMS; it += NGW) {
        int r = it;
        if (r < I_WIN) { transpose_item<MAP_WIN>(p.w_in, D, DIN, (bf16_t*)(ws + WS_WIN), nullptr, scr, r, lane); continue; } r -= I_WIN;
        if (r < I_UQ) { transpose_item<MAP_ID>(p.w_uq, QLORA, 768, (bf16_t*)(ws + WS_WUQ), p.q_norm, scr, r, lane); continue; } r -= I_UQ;
        if (r < I_UKV) { transpose_item<MAP_ID>(p.w_ukv, KVLORA, 1024, (bf16_t*)(ws + WS_WUKV), p.kv_norm, scr, r, lane); continue; } r -= I_UKV;
        if (r < I_WO) {
            const int kb = r / 32;
            transpose_item<MAP_ID>(p.w_o, D, D, (bf16_t*)(ws + WS_WO), kb < 8 ? p.attn_on : p.conv_on - 512, scr, r, lane); continue; } r -= I_WO;
        if (r < I_WR) { transpose_item<MAP_ID>(p.w_router, D, 256, (bf16_t*)(ws + WS_WR), nullptr, scr, r, lane); continue; } r -= I_WR;
        if (r < I_SG) { transpose_item<MAP_GATE>(p.ws_gate, D, 256, (bf16_t*)(ws + WS_WSGU), nullptr, scr, r, lane); continue; } r -= I_SG;
        if (r < I_SG) { transpose_item<MAP_UP>(p.ws_up, D, 256, (bf16_t*)(ws + WS_WSGU), nullptr, scr, r, lane); continue; } r -= I_SG;
        if (r < I_SD) { transpose_item<MAP_ID>(p.ws_down, DEXP, D, (bf16_t*)(ws + WS_WSD), nullptr, scr, r, lane); continue; } r -= I_SD;
        if (r < I_EXP) { const int e = r >> 7; transpose_item<MAP_GATE>(p.w_gate + (size_t)e * D * DEXP, D, 256, (bf16_t*)(ws + WS_WGU) + (size_t)e * 512 * D, nullptr, scr, r & 127, lane); continue; } r -= I_EXP;
        if (r < I_EXP) { const int e = r >> 7; transpose_item<MAP_UP>(p.w_up + (size_t)e * D * DEXP, D, 256, (bf16_t*)(ws + WS_WGU) + (size_t)e * 512 * D, nullptr, scr, r & 127, lane); continue; } r -= I_EXP;
        { const int e = r >> 7; transpose_item<MAP_ID>(p.w_down + (size_t)e * DEXP * D, DEXP, D, (bf16_t*)(ws + WS_WD) + (size_t)e * D * DEXP, nullptr, scr, r & 127, lane); }
    }
}

__device__ __forceinline__ void phase1(const Params& p, const Ctx& c) {
    unsigned char* ws = p.ws;
    const bf16_t* H0 = (const bf16_t*)(ws + WS_H0); const bf16_t* WinT = (const bf16_t*)(ws + WS_WIN);
    bf16_t* Z = (bf16_t*)(ws + WS_Z);
    float* psq = (float*)(ws + WS_PSQ);
    const int lane = c.lane, wr = c.wave >> 2, wc = c.wave & 3, fr = lane & 15, fq = lane >> 4;
    constexpr int NU = 129 * 9;
    for (int u = c.vcu; u < NU; u += c.G) {
        const int mt = u / 9, nt = u % 9, row0 = mt * 128, n0 = nt * 256;
        f32x4 acc[4][4]; acc_zero(acc);
        auto rp = [&](int r) { return H0 + (size_t)(row0 + r) * D; };
        gemm_kloop(acc, c, rp, WinT + (size_t)n0 * D, D, D);
        const int s0 = n0 + wc * 64;
#pragma unroll
        for (int mi = 0; mi < 4; ++mi) {
            const int row = row0 + wr * 64 + mi * 16 + fr;
            float ss = 0.f;
#pragma unroll
            for (int ni = 0; ni < 4; ++ni) {
                const f32x4 v = acc[mi][ni];
                store_bf4(Z + (size_t)row * ZC + s0 + ni * 16 + fq * 4, v);
                ss += (v[0] * v[0] + v[1] * v[1]) + (v[2] * v[2] + v[3] * v[3]);
            }
            if (s0 < ZKPE) {
                ss += __shfl_xor(ss, 16); ss += __shfl_xor(ss, 32);
                if (fq == 0) psq[(size_t)row * 16 + (s0 >> 6)] = ss;
            }
        }
    }
}

__device__ __forceinline__ void phase2(const Params& p, const Ctx& c) {
    unsigned char* ws = p.ws;
    const bf16_t* Z = (const bf16_t*)(ws + WS_Z);
    const float* psq = (const float*)(ws + WS_PSQ);
    const float* rope = (const float*)(ws + WS_ROPE);
    bf16_t* Q = (bf16_t*)(ws + WS_Q); bf16_t* Kb = (bf16_t*)(ws + WS_K); bf16_t* Vb = (bf16_t*)(ws + WS_V);
    const int lane = c.lane, wr = c.wave >> 2, wc = c.wave & 3, fr = lane & 15, fq = lane >> 4;
    constexpr int NUQ = 128 * 3, NUKV = 129 * 4;
    for (int u = c.vcu; u < NUQ + NUKV; u += c.G) {
        f32x4 acc[4][4]; acc_zero(acc);
        if (u < NUQ) {
            const int mt = u / 3, nt = u % 3, row0 = mt * 128, n0 = nt * 256;
            auto rp = [&](int r) { return Z + (size_t)(row0 + r) * ZC + ZQ; };
            gemm_kloop(acc, c, rp, (const bf16_t*)(ws + WS_WUQ) + (size_t)n0 * QLORA, QLORA, QLORA);
            const int s0 = n0 + wc * 64;
#pragma unroll
            for (int mi = 0; mi < 4; ++mi) {
                const int row = row0 + wr * 64 + mi * 16 + fr;
                const f32x4 pa = *(const f32x4*)(psq + (size_t)row * 16), pb = *(const f32x4*)(psq + (size_t)row * 16 + 4);
                const float rq = rsqrtf((((pa[0] + pa[1]) + (pa[2] + pa[3])) + (pb[0] + pb[1])) * (1.f / QLORA) + 1e-6f) * QSCALE;
                const int pos = NMETA + (row & (SEQ - 1));
#pragma unroll
                for (int np = 0; np < 2; ++np) {
                    const int c0 = s0 + np * 32 + fq * 4;
                    f32x4 a = acc[mi][2 * np] * rq, b = acc[mi][2 * np + 1] * rq;
                    if (((s0 + np * 32) % 96) == 64) {
                        const f32x4 cs0 = *(const f32x4*)(rope + ((size_t)pos * 16 + fq * 4) * 2);
                        const f32x4 cs1 = *(const f32x4*)(rope + ((size_t)pos * 16 + fq * 4 + 2) * 2);
                        const float co[4] = {cs0[0], cs0[2], cs1[0], cs1[2]}, si[4] = {cs0[1], cs0[3], cs1[1], cs1[3]};
                        f32x4 na, nb;
#pragma unroll
                        for (int j = 0; j < 4; ++j) { na[j] = a[j] * co[j] - b[j] * si[j]; nb[j] = b[j] * co[j] + a[j] * si[j]; }
                        a = na; b = nb;
                    }
                    store_bf4(Q + (size_t)row * 768 + c0, a);
                    store_bf4(Q + (size_t)row * 768 + c0 + 16, b);
                }
            }
        } else {
            const int uu = u - NUQ, mt = uu / 4, nt = uu % 4, row0 = mt * 128, n0 = nt * 256;
            auto rp = [&](int r) { return Z + (size_t)(row0 + r) * ZC + ZKV; };
            gemm_kloop(acc, c, rp, (const bf16_t*)(ws + WS_WUKV) + (size_t)n0 * KVLORA, KVLORA, KVLORA);
            const int s0 = n0 + wc * 64;
            const int h = s0 >> 7; const bool isv = (s0 & 64) != 0;
#pragma unroll
            for (int mi = 0; mi < 4; ++mi) {
                const int row = row0 + wr * 64 + mi * 16 + fr;
                if (row >= NROWS) continue;
                const f32x4 pa = *(const f32x4*)(psq + (size_t)row * 16 + 4), pb = *(const f32x4*)(psq + (size_t)row * 16 + 8);
                const float rk = rsqrtf(((pa[2] + pa[3]) + (pb[0] + pb[1])) * (1.f / KVLORA) + 1e-6f);
                const int nb = row < NTOK ? 1 : NBATCH;
                const int b0 = row < NTOK ? (row >> 11) : 0, pos = row < NTOK ? NMETA + (row & (SEQ - 1)) : row - NTOK;
                for (int bb = 0; bb < nb; ++bb) {
                    const size_t prow = (size_t)(b0 + bb) * LPOS + pos;
#pragma unroll
                    for (int ni = 0; ni < 4; ++ni) {
                        const int d = ni * 16 + fq * 4;
                        const f32x4 v = acc[mi][ni] * rk;
                        if (isv) store_bf4(Vb + prow * 512 + h * 64 + d, v);
                        else store_bf4(Kb + prow * 768 + h * 96 + d, v);
                    }
                }
            }
        }
    }
    const int gw = c.vcu * NWAVES + c.wave, NGW = c.G * NWAVES;
    const bf16_t* Zc = Z;
    for (int row = gw; row < NROWS; row += NGW) {
        const int nb = row < NTOK ? 1 : NBATCH;
        const int b0 = row < NTOK ? (row >> 11) : 0, pos = row < NTOK ? NMETA + (row & (SEQ - 1)) : row - NTOK;
        if (lane < 16) {
            const float x1 = bf2f(Zc[(size_t)row * ZC + ZKPE + lane]), x2 = bf2f(Zc[(size_t)row * ZC + ZKPE + 16 + lane]);
            const float co = rope[((size_t)pos * 16 + lane) * 2], si = rope[((size_t)pos * 16 + lane) * 2 + 1];
            const bf16_t o1 = (bf16_t)f2bf(x1 * co - x2 * si), o2 = (bf16_t)f2bf(x2 * co + x1 * si);
            for (int bb = 0; bb < nb; ++bb) {
                bf16_t* kp = Kb + ((size_t)(b0 + bb) * LPOS + pos) * 768;
#pragma unroll
                for (int h = 0; h < NH; ++h) { kp[h * 96 + 64 + lane] = o1; kp[h * 96 + 80 + lane] = o2; }
            }
        }
        if (row < NTOK) {
            const int i = row & (SEQ - 1);
            const int r1 = i >= 1 ? row - 1 : NTOK + 15;
            const int r2 = i >= 2 ? row - 2 : (i == 1 ? NTOK + 15 : NTOK + 14);
            const int ch = lane * 8;
            const u32x4 c0 = *(const u32x4*)(Zc + (size_t)row * ZC + ZCG + ch), u0 = *(const u32x4*)(Zc + (size_t)row * ZC + ZU + ch);
            const u32x4 c1 = *(const u32x4*)(Zc + (size_t)r1 * ZC + ZCG + ch), u1 = *(const u32x4*)(Zc + (size_t)r1 * ZC + ZU + ch);
            const u32x4 c2 = *(const u32x4*)(Zc + (size_t)r2 * ZC + ZCG + ch), u2 = *(const u32x4*)(Zc + (size_t)r2 * ZC + ZU + ch);
            const u32x4 bg = *(const u32x4*)(Zc + (size_t)row * ZC + ZB + ch);
            float y[8]; float ss = 0.f;
#pragma unroll
            for (int e = 0; e < 4; ++e) {
#pragma unroll
                for (int hh = 0; hh < 2; ++hh) {
                    const int cc = ch + e * 2 + hh;
                    const float w0 = p.conv_w[cc], w1 = p.conv_w[512 + cc], w2 = p.conv_w[1024 + cc];
                    const float v0 = hh ? bfhi(c0[e]) * bfhi(u0[e]) : bflo(c0[e]) * bflo(u0[e]);
                    const float v1 = hh ? bfhi(c1[e]) * bfhi(u1[e]) : bflo(c1[e]) * bflo(u1[e]);
                    const float v2 = hh ? bfhi(c2[e]) * bfhi(u2[e]) : bflo(c2[e]) * bflo(u2[e]);
                    const float bgv = hh ? bfhi(bg[e]) : bflo(bg[e]);
                    const float yy = bgv * (w0 * v2 + w1 * v1 + w2 * v0);
                    y[e * 2 + hh] = yy; ss += yy * yy;
                }
            }
            ss = wave_sum(ss);
            u32x4 o; o.x = pk2(y[0], y[1]); o.y = pk2(y[2], y[3]); o.z = pk2(y[4], y[5]); o.w = pk2(y[6], y[7]);
            *(u32x4*)((bf16_t*)(ws + WS_CONV) + (size_t)row * 512 + ch) = o;
            if (lane == 0) ((float*)(ws + WS_SSQC))[row] = ss;
        }
    }
}

__device__ __forceinline__ void phase3_naive(const Params& p, const Ctx& c) {
    unsigned char* ws = p.ws;
    const bf16_t* Q = (const bf16_t*)(ws + WS_Q); const bf16_t* Kb = (const bf16_t*)(ws + WS_K); const bf16_t* Vb = (const bf16_t*)(ws + WS_V);
    bf16_t* ATT = (bf16_t*)(ws + WS_ATT); float* patt = (float*)(ws + WS_PATT);
    const int gw = c.vcu * NWAVES + c.wave, NGW = c.G * NWAVES, lane = c.lane;
    for (int it = gw; it < NTOK * NH; it += NGW) {
        const int row = it >> 3, h = it & 7, b = row >> 11, i = row & (SEQ - 1), nkeys = NMETA + i + 1;
        float q[96];
#pragma unroll
        for (int j = 0; j < 12; ++j) {
            const u32x4 w = *(const u32x4*)(Q + (size_t)row * 768 + h * 96 + j * 8);
#pragma unroll
            for (int e = 0; e < 4; ++e) { q[j * 8 + e * 2] = bflo(w[e]); q[j * 8 + e * 2 + 1] = bfhi(w[e]); }
        }
        float m = -INFINITY, l = 0.f; float o[64];
#pragma unroll
        for (int d = 0; d < 64; ++d) o[d] = 0.f;
        for (int kk = lane; kk < nkeys; kk += 64) {
            const bf16_t* kp = Kb + ((size_t)b * LPOS + kk) * 768 + h * 96;
            float s = 0.f;
#pragma unroll
            for (int j = 0; j < 12; ++j) {
                const u32x4 w = *(const u32x4*)(kp + j * 8);
#pragma unroll
                for (int e = 0; e < 4; ++e) { s += q[j * 8 + e * 2] * bflo(w[e]); s += q[j * 8 + e * 2 + 1] * bfhi(w[e]); }
            }
            const float mn = fmaxf(m, s), f = exp2f(m - mn), pe = exp2f(s - mn);
            l = l * f + pe; m = mn;
            const bf16_t* vp = Vb + ((size_t)b * LPOS + kk) * 512 + h * 64;
#pragma unroll
            for (int j = 0; j < 8; ++j) {
                const u32x4 w = *(const u32x4*)(vp + j * 8);
#pragma unroll
                for (int e = 0; e < 4; ++e) { o[j * 8 + e * 2] = o[j * 8 + e * 2] * f + pe * bflo(w[e]); o[j * 8 + e * 2 + 1] = o[j * 8 + e * 2 + 1] * f + pe * bfhi(w[e]); }
            }
        }
        const float M = wave_max(m);
        const float f = (m == -INFINITY) ? 0.f : exp2f(m - M);
        const float lt = wave_sum(l * f);
        float res = 0.f;
#pragma unroll
        for (int d = 0; d < 64; ++d) { const float v = wave_sum(o[d] * f); if (lane == d) res = v; }
        res /= lt;
        ATT[(size_t)row * 512 + h * 64 + lane] = (bf16_t)f2bf(res);
        const float ss = wave_sum(res * res);
        if (lane == 0) patt[(size_t)row * 8 + h] = ss;
    }
}


typedef float f32x16 __attribute__((ext_vector_type(16)));
typedef short s16x4 __attribute__((ext_vector_type(4)));
constexpr int AK_PITCH = 208, AK_BYTES = 64 * AK_PITCH, AV_BYTES = 8192, ASTAGE = AK_BYTES + AV_BYTES, A_WSF = 2 * ASTAGE;
__device__ __forceinline__ int crow(int r, int hi) { return (r & 3) + 8 * (r >> 2) + 4 * hi; }
__device__ __forceinline__ s16x4 vtr(const LAS unsigned char* p) {
    return __builtin_bit_cast(s16x4, __builtin_amdgcn_ds_read_tr16_b64_v4i16((LAS s16x4*)p));
}
__device__ __forceinline__ void attn_unit(const Params& p, const Ctx& c, int b, int h, int qb) {
    unsigned char* ws = p.ws;
    const bf16_t* Q = (const bf16_t*)(ws + WS_Q); const bf16_t* Kb = (const bf16_t*)(ws + WS_K); const bf16_t* Vb = (const bf16_t*)(ws + WS_V);
    bf16_t* ATT = (bf16_t*)(ws + WS_ATT); float* patt = (float*)(ws + WS_PATT);
    const int tid = c.tid, lane = c.lane, w = c.wave, r32 = lane & 31, hi = lane >> 5;
    LAS unsigned char* lds = c.lds;
    LAS float* wsf = (LAS float*)(lds + A_WSF) + w * 32;
    const int row0 = b * SEQ + qb * 256;
    const int qpos0 = NMETA + qb * 256 + w * 32, myq = qpos0 + r32;
    bf16x8 qf[6];
#pragma unroll
    for (int ds = 0; ds < 6; ++ds) qf[ds] = *(const bf16x8*)(Q + (size_t)(row0 + w * 32 + r32) * 768 + h * 96 + ds * 16 + hi * 8);
    const bf16_t* Kg = Kb + (size_t)b * LPOS * 768 + h * 96;
    const bf16_t* Vg = Vb + (size_t)b * LPOS * 512 + h * 64;
    const int T = 4 * qb + 5;
    const int tl = (qpos0 + 31) >> 6;
    const int k0row = tid / 12, k0ch = tid % 12, k1row = (512 + tid) / 12, k1ch = (512 + tid) % 12;
    const int vrow = tid >> 3, vch = tid & 7;
    const int k0off = k0row * AK_PITCH + k0ch * 16, k1off = k1row * AK_PITCH + k1ch * 16;
    const int voff = AK_BYTES + (vch >> 2) * 4096 + vrow * 64 + (vch & 3) * 16;
    u32x4 rk0, rk1, rv;
#define A_LOAD(t) do { const int kb_ = (t) * 64; \
        rk0 = *(const u32x4*)(Kg + (size_t)min(kb_ + k0row, LPOS - 1) * 768 + k0ch * 8); \
        if (tid < 256) rk1 = *(const u32x4*)(Kg + (size_t)min(kb_ + k1row, LPOS - 1) * 768 + k1ch * 8); \
        rv = *(const u32x4*)(Vg + (size_t)min(kb_ + vrow, LPOS - 1) * 512 + vch * 8); } while (0)
#define A_STORE(buf) do { LAS unsigned char* sb_ = lds + (buf) * ASTAGE; \
        *(LAS u32x4*)(sb_ + k0off) = rk0; if (tid < 256) *(LAS u32x4*)(sb_ + k1off) = rk1; *(LAS u32x4*)(sb_ + voff) = rv; } while (0)
    float m = -INFINITY, l = 0.f;
    f32x16 o0, o1;
#pragma unroll
    for (int r = 0; r < 16; ++r) { o0[r] = 0.f; o1[r] = 0.f; }
    const int kfo = r32 * AK_PITCH + hi * 16;
    const int vfo = AK_BYTES + ((lane >> 4) & 1) * 32 + (lane & 3) * 8 + (4 * hi + ((lane & 15) >> 2)) * 64;
    __syncthreads();
    A_LOAD(0);
    A_STORE(0);
    __syncthreads();
    for (int t = 0; t < T; ++t) {
        if (t + 1 < T) A_LOAD(t + 1);
        if (t <= tl) {
            const LAS unsigned char* sb = lds + (t & 1) * ASTAGE;
            f32x16 p0, p1;
#pragma unroll
            for (int r = 0; r < 16; ++r) { p0[r] = 0.f; p1[r] = 0.f; }
#pragma unroll
            for (int ds = 0; ds < 6; ++ds) {
                const bf16x8 a0 = *(const LAS bf16x8*)(sb + kfo + ds * 32);
                const bf16x8 a1 = *(const LAS bf16x8*)(sb + kfo + 32 * AK_PITCH + ds * 32);
                p0 = __builtin_amdgcn_mfma_f32_32x32x16_bf16(a0, qf[ds], p0, 0, 0, 0);
                p1 = __builtin_amdgcn_mfma_f32_32x32x16_bf16(a1, qf[ds], p1, 0, 0, 0);
            }
            if (t * 64 + 63 > qpos0) {
                const int kb0 = t * 64 + 4 * hi;
#pragma unroll
                for (int r = 0; r < 16; ++r) {
                    const int kv = kb0 + (r & 3) + 8 * (r >> 2);
                    if (kv > myq) p0[r] = -INFINITY;
                    if (kv + 32 > myq) p1[r] = -INFINITY;
                }
            }
            float mx = fmaxf(p0[0], p1[0]);
#pragma unroll
            for (int r = 1; r < 16; ++r) mx = fmaxf(mx, fmaxf(p0[r], p1[r]));
            mx = fmaxf(mx, __shfl_xor(mx, 32));
            if (__any(mx > m)) {
                const float mn = fmaxf(m, mx), alpha = __builtin_amdgcn_exp2f(m - mn);
                m = mn; l *= alpha;
                if (hi == 0) wsf[r32] = alpha;
                asm volatile("s_waitcnt lgkmcnt(0)" ::: "memory");
#pragma unroll
                for (int k = 0; k < 4; ++k) {
                    const f32x4 a = *(const LAS f32x4*)(wsf + 8 * k + 4 * hi);
#pragma unroll
                    for (int j = 0; j < 4; ++j) { o0[4 * k + j] *= a[j]; o1[4 * k + j] *= a[j]; }
                }
                asm volatile("s_waitcnt lgkmcnt(0)" ::: "memory");
            }
            float ls = 0.f;
#pragma unroll
            for (int r = 0; r < 16; ++r) { p0[r] = __builtin_amdgcn_exp2f(p0[r] - m); p1[r] = __builtin_amdgcn_exp2f(p1[r] - m); ls += p0[r] + p1[r]; }
            l += ls;
            bf16x8 pa[4];
#pragma unroll
            for (int s = 0; s < 4; ++s) {
                u32x4 wv;
#pragma unroll
                for (int e = 0; e < 4; ++e) {
                    const int r = 8 * (s & 1) + 2 * e;
                    wv[e] = (s >> 1) ? pk2(p1[r], p1[r + 1]) : pk2(p0[r], p0[r + 1]);
                }
                pa[s] = __builtin_bit_cast(bf16x8, wv);
            }
#pragma unroll
            for (int s = 0; s < 4; ++s) {
                const s16x4 l0 = vtr(sb + vfo + s * 1024), h0 = vtr(sb + vfo + s * 1024 + 512);
                const s16x4 l1 = vtr(sb + vfo + 4096 + s * 1024), h1 = vtr(sb + vfo + 4096 + s * 1024 + 512);
                const bf16x8 v0 = (bf16x8){l0[0], l0[1], l0[2], l0[3], h0[0], h0[1], h0[2], h0[3]};
                const bf16x8 v1 = (bf16x8){l1[0], l1[1], l1[2], l1[3], h1[0], h1[1], h1[2], h1[3]};
                o0 = __builtin_amdgcn_mfma_f32_32x32x16_bf16(pa[s], v0, o0, 0, 0, 0);
                o1 = __builtin_amdgcn_mfma_f32_32x32x16_bf16(pa[s], v1, o1, 0, 0, 0);
            }
        }
        if (t + 1 < T) A_STORE((t + 1) & 1);
        __syncthreads();
    }
#undef A_LOAD
#undef A_STORE
    l += __shfl_xor(l, 32);
    if (hi == 0) wsf[r32] = 1.f / l;
    asm volatile("s_waitcnt lgkmcnt(0)" ::: "memory");
    float sq[16];
#pragma unroll
    for (int k = 0; k < 4; ++k) {
        const f32x4 a = *(const LAS f32x4*)(wsf + 8 * k + 4 * hi);
#pragma unroll
        for (int j = 0; j < 4; ++j) {
            const int r = 4 * k + j;
            const float x0 = o0[r] * a[j], x1 = o1[r] * a[j];
            bf16_t* op = ATT + (size_t)(row0 + w * 32 + crow(r, hi)) * 512 + h * 64 + r32;
            op[0] = (bf16_t)f2bf(x0); op[32] = (bf16_t)f2bf(x1);
            sq[r] = x0 * x0 + x1 * x1;
        }
    }
#pragma unroll
    for (int r = 0; r < 16; ++r) {
        float v = sq[r];
#pragma unroll
        for (int o = 1; o < 32; o <<= 1) v += __shfl_xor(v, o);
        if (r32 == 0) patt[(size_t)(row0 + w * 32 + crow(r, hi)) * 8 + h] = v;
    }
    asm volatile("s_waitcnt lgkmcnt(0)" ::: "memory");
}
__device__ __forceinline__ void phase3(const Params& p, const Ctx& c) {
    for (int pi = c.vcu; pi < 256; pi += c.G) {
        const int bh = pi >> 2, s = pi & 3;
        attn_unit(p, c, bh >> 3, bh & 7, 7 - s);
        attn_unit(p, c, bh >> 3, bh & 7, s);
    }
}

__device__ __forceinline__ void phase4(const Params& p, const Ctx& c) {
    unsigned char* ws = p.ws;
    const bf16_t* ATT = (const bf16_t*)(ws + WS_ATT); const bf16_t* CONV = (const bf16_t*)(ws + WS_CONV);
    const bf16_t* WoT = (const bf16_t*)(ws + WS_WO); const bf16_t* H0 = (const bf16_t*)(ws + WS_H0);
    const float* patt = (const float*)(ws + WS_PATT); const float* ssq_c = (const float*)(ws + WS_SSQC);
    bf16_t* Y1 = (bf16_t*)(ws + WS_Y1); float* pst = (float*)(ws + WS_PST);
    const int lane = c.lane, wr = c.wave >> 2, wc = c.wave & 3, fr = lane & 15, fq = lane >> 4;
    constexpr int NU = 128 * 4;
    for (int u = c.vcu; u < NU; u += c.G) {
        const int mt = u >> 2, nt = u & 3, row0 = mt * 128, n0 = nt * 256;
        f32x4 acc[4][4]; acc_zero(acc);
        auto rpa = [&](int r) { return ATT + (size_t)(row0 + r) * 512; };
        gemm_kloop(acc, c, rpa, WoT + (size_t)n0 * D, D, 512);
        float rc[4];
#pragma unroll
        for (int mi = 0; mi < 4; ++mi) {
            const int row = row0 + wr * 64 + mi * 16 + fr;
            const f32x4 pa = *(const f32x4*)(patt + (size_t)row * 8), pb = *(const f32x4*)(patt + (size_t)row * 8 + 4);
            const float ra = rsqrtf((((pa[0] + pa[1]) + (pa[2] + pa[3])) + ((pb[0] + pb[1]) + (pb[2] + pb[3]))) * (1.f / 512) + 1e-6f);
            rc[mi] = rsqrtf(ssq_c[row] * (1.f / 512) + 1e-6f);
            const float f = ra / rc[mi];
#pragma unroll
            for (int ni = 0; ni < 4; ++ni) acc[mi][ni] = acc[mi][ni] * f;
        }
        auto rpc = [&](int r) { return CONV + (size_t)(row0 + r) * 512; };
        gemm_kloop(acc, c, rpc, WoT + (size_t)n0 * D + 512, D, 512);
        const int s0 = n0 + wc * 64;
#pragma unroll
        for (int mi = 0; mi < 4; ++mi) {
            const int row = row0 + wr * 64 + mi * 16 + fr;
            float s = 0.f, ss = 0.f;
#pragma unroll
            for (int ni = 0; ni < 4; ++ni) {
                const int col = s0 + ni * 16 + fq * 4;
                const u32x2 hw = *(const u32x2*)(H0 + (size_t)row * D + col);
                f32x4 v = acc[mi][ni] * rc[mi];
                v[0] += ALPHA * bflo(hw.x); v[1] += ALPHA * bfhi(hw.x); v[2] += ALPHA * bflo(hw.y); v[3] += ALPHA * bfhi(hw.y);
                store_bf4(Y1 + (size_t)row * D + col, v);
                s += (v[0] + v[1]) + (v[2] + v[3]);
                ss += (v[0] * v[0] + v[1] * v[1]) + (v[2] * v[2] + v[3] * v[3]);
            }
            s += __shfl_xor(s, 16); s += __shfl_xor(s, 32);
            ss += __shfl_xor(ss, 16); ss += __shfl_xor(ss, 32);
            if (fq == 0) { float* q = pst + ((size_t)row * 16 + nt * 4 + wc) * 2; q[0] = s; q[1] = ss; }
        }
    }
}

__device__ __forceinline__ void phase5a(const Params& p, const Ctx& c) {
    unsigned char* ws = p.ws;
    const bf16_t* Y1 = (const bf16_t*)(ws + WS_Y1); bf16_t* H1 = (bf16_t*)(ws + WS_H1); const float* pst = (const float*)(ws + WS_PST);
    const int gw = c.vcu * NWAVES + c.wave, NGW = c.G * NWAVES, lane = c.lane;
    for (int row = gw; row < NTOK; row += NGW) {
        float s1 = 0.f, s2 = 0.f;
#pragma unroll
        for (int k = 0; k < 16; ++k) { s1 += pst[((size_t)row * 16 + k) * 2]; s2 += pst[((size_t)row * 16 + k) * 2 + 1]; }
        const float mean = s1 * (1.f / D), var = fmaxf(s2 * (1.f / D) - mean * mean, 0.f), rstd = rsqrtf(var + 1e-5f);
#pragma unroll
        for (int j = 0; j < 2; ++j) {
            const int col = (lane + 64 * j) * 8;
            const u32x4 w = *(const u32x4*)(Y1 + (size_t)row * D + col);
            float y[8];
#pragma unroll
            for (int e = 0; e < 4; ++e) { y[2 * e] = bflo(w[e]); y[2 * e + 1] = bfhi(w[e]); }
#pragma unroll
            for (int e = 0; e < 8; ++e) y[e] = (y[e] - mean) * rstd * p.ln1_g[col + e] + p.ln1_b[col + e];
            u32x4 o; o.x = pk2(y[0], y[1]); o.y = pk2(y[2], y[3]); o.z = pk2(y[4], y[5]); o.w = pk2(y[6], y[7]);
            *(u32x4*)(H1 + (size_t)row * D + col) = o;
        }
    }
}
__device__ __forceinline__ void phase5b(const Params& p, const Ctx& c) {
    unsigned char* ws = p.ws;
    const bf16_t* H1 = (const bf16_t*)(ws + WS_H1); float* LOG = (float*)(ws + WS_LOG);
    const int lane = c.lane, wr = c.wave >> 2, wc = c.wave & 3, fr = lane & 15, fq = lane >> 4;
    for (int u = c.vcu; u < 128; u += c.G) {
        const int row0 = u * 128;
        f32x4 acc[4][4]; acc_zero(acc);
        auto rp = [&](int r) { return H1 + (size_t)(row0 + r) * D; };
        gemm_kloop(acc, c, rp, (const bf16_t*)(ws + WS_WR), D, D);
#pragma unroll
        for (int mi = 0; mi < 4; ++mi) {
            const int row = row0 + wr * 64 + mi * 16 + fr;
#pragma unroll
            for (int ni = 0; ni < 4; ++ni) *(f32x4*)(LOG + (size_t)row * 256 + wc * 64 + ni * 16 + fq * 4) = acc[mi][ni];
        }
    }
}
__device__ __forceinline__ void phase5c(const Params& p, const Ctx& c) {
    unsigned char* ws = p.ws;
    const float* LOG = (const float*)(ws + WS_LOG);
    unsigned* cnt = (unsigned*)(ws + WS_CTL + CT_CNT); unsigned* laid = (unsigned*)(ws + WS_LAID); float* lgate = (float*)(ws + WS_LGATE);
    const int gw = c.vcu * NWAVES + c.wave, NGW = c.G * NWAVES, lane = c.lane;
    const f32x4 bias = *((const f32x4*)p.router_bias + lane);
    for (int t = gw; t < NTOK; t += NGW) {
        const f32x4 lg = *((const f32x4*)(LOG + (size_t)t * 256) + lane);
        float s[4], sel[4];
#pragma unroll
        for (int i = 0; i < 4; ++i) { s[i] = 1.f / (1.f + expf(-lg[i])); sel[i] = s[i] + bias[i]; }
        float a = fmaxf(sel[0], sel[1]), b = fminf(sel[0], sel[1]), cc = fmaxf(sel[2], sel[3]), d = fminf(sel[2], sel[3]);
        float t1 = fmaxf(a, cc), t2 = fmaxf(fminf(a, cc), a >= cc ? b : d);
#pragma unroll
        for (int o = 1; o < 8; o <<= 1) {
            const float y1 = __shfl_xor(t1, o), y2 = __shfl_xor(t2, o);
            const float n1 = fmaxf(t1, y1), n2 = fmaxf(fminf(t1, y1), t1 >= y1 ? t2 : y2);
            t1 = n1; t2 = n2;
        }
        const float gs = t1 + t2; const int g = lane >> 3;
        int better = 0;
#pragma unroll
        for (int gg = 0; gg < 8; ++gg) { const float o = __shfl(gs, gg * 8); better += (o > gs || (o == gs && gg < g)) ? 1 : 0; }
        if (better >= 4) { sel[0] = sel[1] = sel[2] = sel[3] = -INFINITY; }
        int ek[8]; float sk[8]; float ssum = 0.f;
#pragma unroll
        for (int k = 0; k < 8; ++k) {
            float bv = sel[0]; int bi = 0;
            if (sel[1] > bv) { bv = sel[1]; bi = 1; }
            if (sel[2] > bv) { bv = sel[2]; bi = 2; }
            if (sel[3] > bv) { bv = sel[3]; bi = 3; }
            const float wm = wave_max(bv);
            const unsigned long long mask = __ballot(bv == wm);
            const int src = __ffsll((long long)mask) - 1;
            const float sb = bi == 0 ? s[0] : bi == 1 ? s[1] : bi == 2 ? s[2] : s[3];
            ek[k] = src * 4 + __shfl(bi, src); sk[k] = __shfl(sb, src); ssum += sk[k];
            if (lane == src) { if (bi == 0) sel[0] = -INFINITY; else if (bi == 1) sel[1] = -INFINITY; else if (bi == 2) sel[2] = -INFINITY; else sel[3] = -INFINITY; }
        }
        int me = ek[0]; float mg = sk[0];
#pragma unroll
        for (int k = 1; k < 8; ++k) if (lane == k) { me = ek[k]; mg = sk[k]; }
        if (lane < 8) {
            const unsigned pos = atomicAdd(cnt + me, 1u);
            laid[(size_t)me * CAP + pos] = (unsigned)(t * 8 + lane);
            lgate[(size_t)me * CAP + pos] = mg / ssum * 2.5f;
        }
    }
}

struct MoeTab { LAS int* tstart; LAS int* roff; LAS int* tok; LAS float* gate; };
__device__ __forceinline__ MoeTab moe_tab_build(const Params& p, const Ctx& c) {
    MoeTab T; T.tstart = (LAS int*)(c.lds + LDS_MISC); T.roff = T.tstart + 260; T.tok = T.roff + 260; T.gate = (LAS float*)(T.tok + 128);
    const unsigned* cnt = (const unsigned*)(p.ws + WS_CTL + CT_CNT);
    __syncthreads();
    if (c.tid < 64) {
        int cv[4], tv[4]; int ls = 0, lt = 0;
#pragma unroll
        for (int i = 0; i < 4; ++i) { cv[i] = (int)cnt[c.tid * 4 + i]; tv[i] = (cv[i] + 127) >> 7; ls += cv[i]; lt += tv[i]; }
        int ps = ls, pt = lt;
#pragma unroll
        for (int o = 1; o < 64; o <<= 1) { const int a = __shfl_up(ps, o), b = __shfl_up(pt, o); if (c.tid >= o) { ps += a; pt += b; } }
        int es = ps - ls, et = pt - lt;
#pragma unroll
        for (int i = 0; i < 4; ++i) { T.roff[c.tid * 4 + i] = es; T.tstart[c.tid * 4 + i] = et; es += cv[i]; et += tv[i]; }
        if (c.tid == 63) { T.roff[256] = es; T.tstart[256] = et; }
    }
    __syncthreads();
    return T;
}
__device__ __forceinline__ int moe_find(const MoeTab& T, int g) {
    int lo = 0, hi = 255;
    while (lo < hi) { const int mid = (lo + hi + 1) >> 1; if (T.tstart[mid] <= g) lo = mid; else hi = mid - 1; }
    return lo;
}

__device__ __forceinline__ void phase6(const Params& p, const Ctx& c) {
    unsigned char* ws = p.ws;
    const bf16_t* H1 = (const bf16_t*)(ws + WS_H1); bf16_t* HID = (bf16_t*)(ws + WS_HID);
    const unsigned* laid = (const unsigned*)(ws + WS_LAID);
    const unsigned* cnt = (const unsigned*)(ws + WS_CTL + CT_CNT);
    const int lane = c.lane, wr = c.wave >> 2, wc = c.wave & 3, fr = lane & 15, fq = lane >> 4;
    const MoeTab T = moe_tab_build(p, c);
    const int tmt = T.tstart[256], NU = (tmt + 128) * 2;
    for (int u = c.vcu; u < NU; u += c.G) {
        const int g = u >> 1, nt = u & 1;
        int e, mt, nrows; size_t hbase;
        __syncthreads();
        if (g < tmt) {
            e = moe_find(T, g); mt = g - T.tstart[e]; nrows = min(128, (int)cnt[e] - mt * 128); hbase = (size_t)T.roff[e] + mt * 128;
            if (c.tid < 128) T.tok[c.tid] = (int)(laid[(size_t)e * CAP + mt * 128 + min(c.tid, nrows - 1)] >> 3);
        } else {
            e = NEXP; mt = g - tmt; nrows = 128; hbase = (size_t)NTOK * 8 + mt * 128;
            if (c.tid < 128) T.tok[c.tid] = mt * 128 + c.tid;
        }
        __syncthreads();
        f32x4 acc[4][4]; acc_zero(acc);
        auto rp = [&](int r) { return H1 + (size_t)T.tok[r] * D; };
        const bf16_t* Bt = (e < NEXP ? (const bf16_t*)(ws + WS_WGU) + (size_t)e * 512 * D : (const bf16_t*)(ws + WS_WSGU)) + (size_t)nt * 256 * D;
        gemm_kloop(acc, c, rp, Bt, D, D);
#pragma unroll
        for (int mi = 0; mi < 4; ++mi) {
            const int r = wr * 64 + mi * 16 + fr;
            if (r >= nrows) continue;
#pragma unroll
            for (int np = 0; np < 2; ++np) {
                const f32x4 gt = acc[mi][2 * np], up = acc[mi][2 * np + 1];
                f32x4 hv;
#pragma unroll
                for (int j = 0; j < 4; ++j) hv[j] = gt[j] / (1.f + __expf(-gt[j])) * up[j];
                store_bf4(HID + (hbase + r) * DEXP + nt * 128 + wc * 32 + np * 16 + fq * 4, hv);
            }
        }
    }
}
__device__ __forceinline__ void phase7(const Params& p, const Ctx& c) {
    unsigned char* ws = p.ws;
    const bf16_t* HID = (const bf16_t*)(ws + WS_HID); bf16_t* Y = (bf16_t*)(ws + WS_Y);
    const unsigned* laid = (const unsigned*)(ws + WS_LAID); const float* lgate = (const float*)(ws + WS_LGATE);
    const unsigned* cnt = (const unsigned*)(ws + WS_CTL + CT_CNT);
    const int lane = c.lane, wr = c.wave >> 2, wc = c.wave & 3, fr = lane & 15, fq = lane >> 4;
    const MoeTab T = moe_tab_build(p, c);
    const int tmt = T.tstart[256], NU = (tmt + 128) * 4;
    for (int u = c.vcu; u < NU; u += c.G) {
        const int g = u >> 2, nt = u & 3;
        int e, mt, nrows; size_t hbase;
        __syncthreads();
        if (g < tmt) {
            e = moe_find(T, g); mt = g - T.tstart[e]; nrows = min(128, (int)cnt[e] - mt * 128); hbase = (size_t)T.roff[e] + mt * 128;
            if (c.tid < 128) {
                const int rr = min(c.tid, nrows - 1);
                const unsigned aid = laid[(size_t)e * CAP + mt * 128 + rr];
                T.tok[c.tid] = (int)((aid >> 3) * 9 + (aid & 7)); T.gate[c.tid] = lgate[(size_t)e * CAP + mt * 128 + rr];
            }
        } else {
            e = NEXP; mt = g - tmt; nrows = 128; hbase = (size_t)NTOK * 8 + mt * 128;
            if (c.tid < 128) { T.tok[c.tid] = (mt * 128 + c.tid) * 9 + 8; T.gate[c.tid] = 1.f; }
        }
        __syncthreads();
        f32x4 acc[4][4]; acc_zero(acc);
        auto rp = [&](int r) { return HID + (hbase + min(r, nrows - 1)) * DEXP; };
        const bf16_t* Bt = (e < NEXP ? (const bf16_t*)(ws + WS_WD) + (size_t)e * D * DEXP : (const bf16_t*)(ws + WS_WSD)) + (size_t)nt * 256 * DEXP;
        gemm_kloop(acc, c, rp, Bt, DEXP, DEXP);
#pragma unroll
        for (int mi = 0; mi < 4; ++mi) {
            const int r = wr * 64 + mi * 16 + fr;
            if (r >= nrows) continue;
            const float gt = T.gate[r]; const size_t yrow = (size_t)T.tok[r];
#pragma unroll
            for (int ni = 0; ni < 4; ++ni) store_bf4(Y + yrow * D + nt * 256 + wc * 64 + ni * 16 + fq * 4, acc[mi][ni] * gt);
        }
    }
}
__device__ __forceinline__ void phase8(const Params& p, const Ctx& c) {
    unsigned char* ws = p.ws;
    const bf16_t* H1 = (const bf16_t*)(ws + WS_H1); const bf16_t* Y = (const bf16_t*)(ws + WS_Y);
    const int gw = c.vcu * NWAVES + c.wave, NGW = c.G * NWAVES, lane = c.lane;
    for (int t = gw; t < NTOK; t += NGW) {
        float v[16];
#pragma unroll
        for (int j = 0; j < 2; ++j) {
            const int col = (lane + 64 * j) * 8;
            const u32x4 w = *(const u32x4*)(H1 + (size_t)t * D + col);
#pragma unroll
            for (int e = 0; e < 4; ++e) { v[j * 8 + 2 * e] = ALPHA * bflo(w[e]); v[j * 8 + 2 * e + 1] = ALPHA * bfhi(w[e]); }
#pragma unroll
            for (int k = 0; k < 9; ++k) {
                const u32x4 y = *(const u32x4*)(Y + ((size_t)t * 9 + k) * D + col);
#pragma unroll
                for (int e = 0; e < 4; ++e) { v[j * 8 + 2 * e] += bflo(y[e]); v[j * 8 + 2 * e + 1] += bfhi(y[e]); }
            }
        }
        float s = 0.f;
#pragma unroll
        for (int e = 0; e < 16; ++e) s += v[e];
        const float mean = wave_sum(s) * (1.f / D);
        float ss = 0.f;
#pragma unroll
        for (int e = 0; e < 16; ++e) { v[e] -= mean; ss += v[e] * v[e]; }
        const float rstd = rsqrtf(wave_sum(ss) * (1.f / D) + 1e-5f);
#pragma unroll
        for (int j = 0; j < 2; ++j) {
            const int col = (lane + 64 * j) * 8;
            f32x4 o0, o1;
#pragma unroll
            for (int e = 0; e < 4; ++e) { o0[e] = v[j * 8 + e] * rstd * p.ln2_g[col + e] + p.ln2_b[col + e]; o1[e] = v[j * 8 + 4 + e] * rstd * p.ln2_g[col + 4 + e] + p.ln2_b[col + 4 + e]; }
            *(f32x4*)(p.out + (size_t)t * D + col) = o0; *(f32x4*)(p.out + (size_t)t * D + col + 4) = o1;
        }
    }
}

template <int PH> __device__ __forceinline__ void run_phase(const Params& p, const Ctx& c) {
    if (PH == 0) phase0(p, c);
    if (PH == 1) phase1(p, c);
    if (PH == 2) phase2(p, c);
#if NAIVE_ATTN
    if (PH == 3) phase3_naive(p, c);
#else
    if (PH == 3) phase3(p, c);
#endif
    if (PH == 4) phase4(p, c);
    if (PH == 5) phase5a(p, c);
    if (PH == 6) phase5b(p, c);
    if (PH == 7) phase5c(p, c);
    if (PH == 8) phase6(p, c);
    if (PH == 9) phase7(p, c);
    if (PH == 10) phase8(p, c);
}
constexpr int NPHASES = 11;
__device__ __forceinline__ Ctx make_ctx(unsigned char* lds) {
    Ctx c; c.lds = (LAS unsigned char*)lds; c.tid = threadIdx.x; c.lane = c.tid & 63; c.wave = __builtin_amdgcn_readfirstlane(c.tid >> 6);
    c.G = gridDim.x; const int bx = blockIdx.x; c.vcu = (c.G % 8 == 0) ? (bx % 8) * (c.G / 8) + bx / 8 : bx;
    return c;
}
template <int PH> __global__ void __launch_bounds__(NTHREADS, 2) phase_kernel(Params p) {
    extern __shared__ __attribute__((aligned(16))) unsigned char lds[];
    const Ctx c = make_ctx(lds);
    run_phase<PH>(p, c);
}
#if MEGA
__global__ void __launch_bounds__(NTHREADS, 2) mega_kernel(Params p) {
    extern __shared__ __attribute__((aligned(16))) unsigned char lds[];
    const Ctx c = make_ctx(lds);
    cg::grid_group grid = cg::this_grid();
    run_phase<0>(p, c); grid.sync();
    run_phase<1>(p, c); grid.sync();
    run_phase<2>(p, c); grid.sync();
    run_phase<3>(p, c); grid.sync();
    run_phase<4>(p, c); grid.sync();
    run_phase<5>(p, c); grid.sync();
    run_phase<6>(p, c); grid.sync();
    run_phase<7>(p, c); grid.sync();
    run_phase<8>(p, c); grid.sync();
    run_phase<9>(p, c); grid.sync();
    run_phase<10>(p, c);
}

#endif
template <int PH> static void launch_phase(const Params& p, int grid, hipStream_t stream) {
    static bool attr = false;
    if (!attr) { (void)hipFuncSetAttribute((const void*)phase_kernel<PH>, hipFuncAttributeMaxDynamicSharedMemorySize, LDS_BYTES); attr = true; }
    hipLaunchKernelGGL(phase_kernel<PH>, dim3(grid), dim3(NTHREADS), LDS_BYTES, stream, p);
}

extern "C" void kernel_launch(void* const* d_in, const int* in_sizes, int n_in, void* d_out, int out_size, void* d_ws, size_t ws_size, hipStream_t stream) {
    if (n_in != 25 || ws_size < WS_END) { fprintf(stderr, "kernel_launch: unexpected n_in %d or ws_size %zu (need %zu)\n", n_in, ws_size, (size_t)WS_END); return; }
    Params p{};
    const float** pp = (const float**)&p;
    for (int i = 0; i < 25; ++i) pp[i] = (const float*)d_in[i];
    p.out = (float*)d_out; p.ws = (unsigned char*)d_ws;
    (void)hipMemsetAsync((char*)d_ws + WS_CTL, 0, CTL_BYTES, stream);
#if MEGA
    static int grid = 0;
    if (!grid) {
        int dev = 0, cus = 0, per_cu = 0;
        (void)hipGetDevice(&dev);
        (void)hipDeviceGetAttribute(&cus, hipDeviceAttributeMultiprocessorCount, dev);
        (void)hipFuncSetAttribute((const void*)mega_kernel, hipFuncAttributeMaxDynamicSharedMemorySize, LDS_BYTES);
        (void)hipOccupancyMaxActiveBlocksPerMultiprocessor(&per_cu, (const void*)mega_kernel, NTHREADS, LDS_BYTES);
        if (per_cu < 1) per_cu = 1;
        grid = cus;
        (void)per_cu;
    }
    void* args[] = {&p};
    hipError_t e = hipLaunchCooperativeKernel((const void*)mega_kernel, dim3(grid), dim3(NTHREADS), args, LDS_BYTES, stream);
    if (e != hipSuccess) fprintf(stderr, "cooperative launch failed: %s (grid %d)\n", hipGetErrorString(e), grid);
#else
    const int grid = 256;
    launch_phase<0>(p, grid, stream); launch_phase<1>(p, grid, stream); launch_phase<2>(p, grid, stream); launch_phase<3>(p, grid, stream);
    launch_phase<4>(p, grid, stream); launch_phase<5>(p, grid, stream); launch_phase<6>(p, grid, stream); launch_phase<7>(p, grid, stream);
    launch_phase<8>(p, grid, stream); launch_phase<9>(p, grid, stream); launch_phase<10>(p, grid, stream);
#endif
}
```

```cpp
#include <hip/hip_runtime.h>
#include <hip/hip_cooperative_groups.h>
#include <cstdint>
#include <cstdio>
namespace cg = cooperative_groups;

#ifndef NAIVE_GEMM
#define NAIVE_GEMM 0
#endif
#ifndef NAIVE_ATTN
#define NAIVE_ATTN 0
#endif
#ifndef REPEAT_PH
#define REPEAT_PH -1
#endif
#ifndef MEGA
#define MEGA 1
#endif

#define LAS __attribute__((address_space(3)))
typedef unsigned short bf16_t;
typedef short bf16x8 __attribute__((ext_vector_type(8)));
typedef float f32x4 __attribute__((ext_vector_type(4)));
typedef unsigned u32x4 __attribute__((ext_vector_type(4)));
typedef unsigned u32x2 __attribute__((ext_vector_type(2)));

constexpr int D = 1024, NBATCH = 8, SEQ = 2048, NMETA = 16, LPOS = SEQ + NMETA;
constexpr int NTOK = NBATCH * SEQ;
constexpr int NROWS = NTOK + NMETA;
constexpr int NROWSP = 16512;
constexpr int NH = 8, DQK = 96, DNOPE = 64, DROPE = 32, DV = 64;
constexpr int QLORA = 384, KVLORA = 256;
constexpr int ZC = 2304;
constexpr int ZQ = 0, ZKV = 384, ZKPE = 640, ZB = 704, ZCG = 1216, ZU = 1728;
constexpr int DIN = 2208;
constexpr int NEXP = 256, DEXP = 256, TOPK = 8, CAP = 16384;
constexpr float ALPHA = 1.189207115002721f;
constexpr float QSCALE = 0.10206207261596577f * 1.4426950408889634f;

constexpr int NTHREADS = 512, NWAVES = 8;
constexpr int LDS_BYTES = 131072;
constexpr int STAGE_BYTES = 49152;
constexpr int LDS_MISC = 2 * STAGE_BYTES;

constexpr size_t MiB = 1u << 20;
constexpr size_t WS_CTL = 0;
constexpr size_t CTL_BYTES = 1 * MiB;
constexpr size_t CT_CNT = 0;
constexpr size_t CT_BAR = 4096;
constexpr size_t CT_SSQ_Q = 32768;
constexpr size_t CT_SSQ_KV = CT_SSQ_Q + 66048;
constexpr size_t CT_SSQ_ATT = CT_SSQ_KV + 66048;
constexpr size_t CT_STATS1 = CT_SSQ_ATT + 65536;
static_assert(CT_STATS1 + 131072 <= CTL_BYTES, "ctl");
constexpr size_t WS_WIN = 1 * MiB;
constexpr size_t WS_WUQ = 6 * MiB;
constexpr size_t WS_WUKV = 7 * MiB;
constexpr size_t WS_WO = 8 * MiB;
constexpr size_t WS_WR = 10 * MiB;
constexpr size_t WS_WSGU = 11 * MiB;
constexpr size_t WS_WSD = 12 * MiB;
constexpr size_t WS_ROPE = 13 * MiB;
constexpr size_t WS_WGU = 14 * MiB;
constexpr size_t WS_WD = 270 * MiB;
constexpr size_t WS_H1 = 398 * MiB;
constexpr size_t WS_HID = 430 * MiB;
constexpr size_t WS_LAID = 502 * MiB;
constexpr size_t WS_LGATE = 518 * MiB;
constexpr size_t WS_Y = 534 * MiB;
constexpr size_t WS_Z = WS_Y;
constexpr size_t WS_H0 = WS_Y + 73 * MiB;
constexpr size_t WS_Q = WS_Y + 106 * MiB;
constexpr size_t WS_K = WS_Y + 130 * MiB;
constexpr size_t WS_V = WS_Y + 155 * MiB;
constexpr size_t WS_ATT = WS_Y + 172 * MiB;
constexpr size_t WS_CONV = WS_Y + 188 * MiB;
constexpr size_t WS_SSQC = WS_Y + 204 * MiB;
constexpr size_t WS_Y1 = WS_Y + 205 * MiB;
constexpr size_t WS_LOG = WS_Y + 237 * MiB;
constexpr size_t WS_PSQ = WS_Y + 253 * MiB;
constexpr size_t WS_PATT = WS_Y + 254 * MiB;
constexpr size_t WS_PST = WS_Y + 255 * MiB;
constexpr size_t WS_END = WS_Y + 288 * MiB;

struct Params {
    const float *x, *meta, *emb_g, *emb_b, *w_in, *q_norm, *w_uq, *kv_norm, *w_ukv, *conv_w, *attn_on, *conv_on, *w_o,
        *ln1_g, *ln1_b, *w_router, *router_bias, *w_gate, *w_up, *w_down, *ws_gate, *ws_up, *ws_down, *ln2_g, *ln2_b;
    float* out;
    unsigned char* ws;
};

__device__ __forceinline__ unsigned f2bf(float f) { unsigned u = __float_as_uint(f); return (u + 0x7fffu + ((u >> 16) & 1u)) >> 16; }
__device__ __forceinline__ unsigned pk2(float lo, float hi) { return f2bf(lo) | (f2bf(hi) << 16); }
__device__ __forceinline__ float bf2f(unsigned b) { return __uint_as_float(b << 16); }
__device__ __forceinline__ float bflo(unsigned w) { return __uint_as_float(w << 16); }
__device__ __forceinline__ float bfhi(unsigned w) { return __uint_as_float(w & 0xffff0000u); }
__device__ __forceinline__ float wave_sum(float v) {
#pragma unroll
    for (int o = 1; o < 64; o <<= 1) v += __shfl_xor(v, o);
    return v;
}
__device__ __forceinline__ float wave_max(float v) {
#pragma unroll
    for (int o = 1; o < 64; o <<= 1) v = fmaxf(v, __shfl_xor(v, o));
    return v;
}

struct Ctx {
    LAS unsigned char* lds;
    int tid, lane, wave, vcu, G;
};

template <class RowPtr>
__device__ __forceinline__ void gemm_kloop(f32x4 (&acc)[4][4], const Ctx& c, const RowPtr& rp, const bf16_t* Bt, long ldb, int K) {
    const int tid = c.tid, lane = c.lane, wid = c.wave, wr = wid >> 2, wc = wid & 3, fr = lane & 15, fq = lane >> 4;
#if NAIVE_GEMM
    const bf16_t* ar[4];
#pragma unroll
    for (int mi = 0; mi < 4; ++mi) ar[mi] = rp(wr * 64 + mi * 16 + fr);
    const bf16_t* br = Bt + (long)(wc * 64 + fq * 4) * ldb;
#pragma nounroll
    for (int k = 0; k < K; k += 2) {
        unsigned av[4];
#pragma unroll
        for (int mi = 0; mi < 4; ++mi) av[mi] = *(const unsigned*)(ar[mi] + k);
#pragma unroll
        for (int ni = 0; ni < 4; ++ni)
#pragma unroll
            for (int j = 0; j < 4; ++j) {
                const unsigned bv = *(const unsigned*)(br + (long)(ni * 16 + j) * ldb + k);
#pragma unroll
                for (int mi = 0; mi < 4; ++mi) acc[mi][ni][j] += bflo(av[mi]) * bflo(bv) + bfhi(av[mi]) * bfhi(bv);
            }
    }
#else
    LAS unsigned char* lds = c.lds;
    const int nt = K >> 6;
    const int srow = tid >> 3, sch = tid & 7;
    const bf16_t* ap0 = rp(srow) + sch * 8;
    const bf16_t* ap1 = rp(srow + 64) + sch * 8;
    const bf16_t* bp = Bt + (long)srow * ldb + sch * 8;
    const long bstep = 64 * ldb;
    const int so = srow * 128 + ((sch ^ ((srow >> 1) & 7)) << 4);
    u32x4 ra0, ra1, rb0, rb1, rb2, rb3;
#define G_LOAD(t) do { const int ko = (t) * 64; ra0 = *(const u32x4*)(ap0 + ko); ra1 = *(const u32x4*)(ap1 + ko); \
        rb0 = *(const u32x4*)(bp + ko); rb1 = *(const u32x4*)(bp + bstep + ko); rb2 = *(const u32x4*)(bp + 2 * bstep + ko); rb3 = *(const u32x4*)(bp + 3 * bstep + ko); } while (0)
#define G_STORE(buf) do { LAS unsigned char* sb = lds + (buf) * STAGE_BYTES; \
        *(LAS u32x4*)(sb + so) = ra0; *(LAS u32x4*)(sb + so + 8192) = ra1; \
        *(LAS u32x4*)(sb + 16384 + so) = rb0; *(LAS u32x4*)(sb + 16384 + so + 8192) = rb1; \
        *(LAS u32x4*)(sb + 16384 + so + 16384) = rb2; *(LAS u32x4*)(sb + 16384 + so + 24576) = rb3; } while (0)
    __syncthreads();
    G_LOAD(0);
    G_STORE(0);
    __syncthreads();
    const int sw0 = ((0 + fq) ^ ((fr >> 1) & 7)) << 4, sw1 = ((4 + fq) ^ ((fr >> 1) & 7)) << 4;
    const int aoff = (wr * 64 + fr) * 128, boff = 16384 + (wc * 64 + fr) * 128;
    for (int t = 0; t < nt; ++t) {
        if (t + 1 < nt) G_LOAD(t + 1);
        const LAS unsigned char* sb = lds + (t & 1) * STAGE_BYTES;
#pragma unroll
        for (int ks = 0; ks < 2; ++ks) {
            const int sw = ks ? sw1 : sw0;
            bf16x8 af[4], bfr[4];
#pragma unroll
            for (int mi = 0; mi < 4; ++mi) af[mi] = *(const LAS bf16x8*)(sb + aoff + mi * 2048 + sw);
#pragma unroll
            for (int ni = 0; ni < 4; ++ni) bfr[ni] = *(const LAS bf16x8*)(sb + boff + ni * 2048 + sw);
#pragma unroll
            for (int mi = 0; mi < 4; ++mi)
#pragma unroll
                for (int ni = 0; ni < 4; ++ni) acc[mi][ni] = __builtin_amdgcn_mfma_f32_16x16x32_bf16(bfr[ni], af[mi], acc[mi][ni], 0, 0, 0);
        }
        if (t + 1 < nt) G_STORE((t + 1) & 1);
        __syncthreads();
    }
#undef G_LOAD
#undef G_STORE
#endif
}
__device__ __forceinline__ void acc_zero(f32x4 (&acc)[4][4]) {
#pragma unroll
    for (int a = 0; a < 4; ++a)
#pragma unroll
        for (int b = 0; b < 4; ++b) acc[a][b] = (f32x4){0.f, 0.f, 0.f, 0.f};
}
__device__ __forceinline__ void store_bf4(bf16_t* p, f32x4 v) { u32x2 w; w.x = pk2(v[0], v[1]); w.y = pk2(v[2], v[3]); *(u32x2*)p = w; }

enum { MAP_ID = 0, MAP_WIN = 1, MAP_GATE = 2, MAP_UP = 3 };
template <int MAP> __device__ __forceinline__ int rowmap(int n) {
    if (MAP == MAP_WIN) return n < 672 ? n : n + 32;
    if (MAP == MAP_GATE) return 32 * (n >> 4) + (n & 15);
    if (MAP == MAP_UP) return 32 * (n >> 4) + 16 + (n & 15);
    return n;
}
template <int MAP>
__device__ __forceinline__ void transpose_item(const float* W, int K, int N, bf16_t* WT, const float* gain, LAS float* scr, int item, int lane) {
    const int nblk = N / 32, kb = item / nblk, nb = item % nblk, k0 = 64 * kb, n0 = 32 * nb;
#pragma unroll 8
    for (int i = 0; i < 32; ++i) {
        const int kk = 2 * i + (lane >> 5);
        float v = W[(size_t)(k0 + kk) * N + n0 + (lane & 31)];
        if (gain) v *= gain[k0 + kk];
        scr[kk * 33 + (lane & 31)] = v;
    }
    asm volatile("s_waitcnt lgkmcnt(0)" ::: "memory");
    const int ch = lane & 7;
#pragma unroll
    for (int j = 0; j < 4; ++j) {
        const int n = (lane >> 3) + 8 * j;
        const LAS float* s = scr + (8 * ch) * 33 + n;
        u32x4 o;
        o.x = pk2(s[0 * 33], s[1 * 33]); o.y = pk2(s[2 * 33], s[3 * 33]); o.z = pk2(s[4 * 33], s[5 * 33]); o.w = pk2(s[6 * 33], s[7 * 33]);
        *(u32x4*)(WT + (size_t)rowmap<MAP>(n0 + n) * K + k0 + 8 * ch) = o;
    }
    asm volatile("s_waitcnt lgkmcnt(0)" ::: "memory");
}
__device__ __forceinline__ void phase0(const Params& p, const Ctx& c) {
    unsigned char* ws = p.ws;
    LAS float* scr = (LAS float*)(c.lds + c.wave * 8704);
    const int gw = c.vcu * NWAVES + c.wave, NGW = c.G * NWAVES, lane = c.lane;
    bf16_t* H0 = (bf16_t*)(ws + WS_H0);
    for (int r = gw; r < NROWSP; r += NGW) {
        u32x2* o = (u32x2*)(H0 + (size_t)r * D) + lane;
        if (r >= NROWS) {
#pragma unroll
            for (int j = 0; j < 4; ++j) o[64 * j] = (u32x2){0u, 0u};
            continue;
        }
        const float* xr = r < NTOK ? p.x + (size_t)r * D : p.meta + (size_t)(r - NTOK) * D;
        f32x4 v[4]; float s = 0.f;
#pragma unroll
        for (int j = 0; j < 4; ++j) { v[j] = *((const f32x4*)xr + lane + 64 * j); s += (v[j][0] + v[j][1]) + (v[j][2] + v[j][3]); }
        const float mean = wave_sum(s) * (1.f / D);
        float s2 = 0.f;
#pragma unroll
        for (int j = 0; j < 4; ++j) { v[j] = v[j] - mean; s2 += (v[j][0] * v[j][0] + v[j][1] * v[j][1]) + (v[j][2] * v[j][2] + v[j][3] * v[j][3]); }
        const float rstd = 1.f / sqrtf(wave_sum(s2) * (1.f / D) + 1e-5f);
#pragma unroll
        for (int j = 0; j < 4; ++j) {
            const f32x4 g = *((const f32x4*)p.emb_g + lane + 64 * j), b = *((const f32x4*)p.emb_b + lane + 64 * j);
            const f32x4 y = v[j] * rstd * g + b;
            u32x2 w; w.x = pk2(y[0], y[1]); w.y = pk2(y[2], y[3]); o[64 * j] = w;
        }
    }
    {
        float* rope = (float*)(ws + WS_ROPE);
        for (int idx = gw * 64 + lane; idx < LPOS * 16; idx += NGW * 64) {
            const int pos = idx >> 4, i = idx & 15;
            const float inv = exp2f(-(float)i * (13.287712379549449f / 16.f));
            const float ang = (float)pos * inv;
            double rev = (double)ang * 0.15915494309189535; rev -= floor(rev);
            const float rf = (float)rev;
            rope[idx * 2 + 0] = __builtin_amdgcn_cosf(rf);
            rope[idx * 2 + 1] = __builtin_amdgcn_sinf(rf);
        }
    }
    {
        bf16_t* WinT = (bf16_t*)(ws + WS_WIN);
        for (int it = gw; it < 96; it += NGW) {
            const int row = it < 32 ? 672 + it : 2240 + (it - 32);
            u32x2* o = (u32x2*)(WinT + (size_t)row * D) + lane;
#pragma unroll
            for (int j = 0; j < 4; ++j) o[64 * j] = (u32x2){0u, 0u};
        }
    }
    constexpr int I_WIN = 16 * 69, I_UQ = 6 * 24, I_UKV = 4 * 32, I_WO = 16 * 32, I_WR = 16 * 8, I_SG = 128, I_SD = 128;
    constexpr int I_SMALL = I_WIN + I_UQ + I_UKV + I_WO + I_WR + 2 * I_SG + I_SD;
    constexpr int I_EXP = NEXP * 128;
    constexpr int NITEMS = I_SMALL + 3 * I_EXP;
    for (int it = gw; it < NITEMS; it += NGW) {
        int r = it;
        if (r < I_WIN) { transpose_item<MAP_WIN>(p.w_in, D, DIN, (bf16_t*)(ws + WS_WIN), nullptr, scr, r, lane); continue; } r -= I_WIN;
        if (r < I_UQ) { transpose_item<MAP_ID>(p.w_uq, QLORA, 768, (bf16_t*)(ws + WS_WUQ), p.q_norm, scr, r, lane); continue; } r -= I_UQ;
        if (r < I_UKV) { transpose_item<MAP_ID>(p.w_ukv, KVLORA, 1024, (bf16_t*)(ws + WS_WUKV), p.kv_norm, scr, r, lane); continue; } r -= I_UKV;
        if (r < I_WO) {
            const int kb = r / 32;
            transpose_item<MAP_ID>(p.w_o, D, D, (bf16_t*)(ws + WS_WO), kb < 8 ? p.attn_on : p.conv_on - 512, scr, r, lane); continue; } r -= I_WO;
        if (r < I_WR) { transpose_item<MAP_ID>(p.w_router, D, 256, (bf16_t*)(ws + WS_WR), nullptr, scr, r, lane); continue; } r -= I_WR;
        if (r < I_SG) { transpose_item<MAP_GATE>(p.ws_gate, D, 256, (bf16_t*)(ws + WS_WSGU), nullptr, scr, r, lane); continue; } r -= I_SG;
        if (r < I_SG) { transpose_item<MAP_UP>(p.ws_up, D, 256, (bf16_t*)(ws + WS_WSGU), nullptr, scr, r, lane); continue; } r -= I_SG;
        if (r < I_SD) { transpose_item<MAP_ID>(p.ws_down, DEXP, D, (bf16_t*)(ws + WS_WSD), nullptr, scr, r, lane); continue; } r -= I_SD;
        if (r < I_EXP) { const int e = r >> 7; transpose_item<MAP_GATE>(p.w_gate + (size_t)e * D * DEXP, D, 256, (bf16_t*)(ws + WS_WGU) + (size_t)e * 512 * D, nullptr, scr, r & 127, lane); continue; } r -= I_EXP;
        if (r < I_EXP) { const int e = r >> 7; transpose_item<MAP_UP>(p.w_up + (size_t)e * D * DEXP, D, 256, (bf16_t*)(ws + WS_WGU) + (size_t)e * 512 * D, nullptr, scr, r & 127, lane); continue; } r -= I_EXP;
        { const int e = r >> 7; transpose_item<MAP_ID>(p.w_down + (size_t)e * DEXP * D, DEXP, D, (bf16_t*)(ws + WS_WD) + (size_t)e * D * DEXP, nullptr, scr, r & 127, lane); }
    }
}

__device__ __forceinline__ void phase1(const Params& p, const Ctx& c) {
    unsigned char* ws = p.ws;
    const bf16_t* H0 = (const bf16_t*)(ws + WS_H0); const bf16_t* WinT = (const bf16_t*)(ws + WS_WIN);
    bf16_t* Z = (bf16_t*)(ws + WS_Z);
    float* psq = (float*)(ws + WS_PSQ);
    const int lane = c.lane, wr = c.wave >> 2, wc = c.wave & 3, fr = lane & 15, fq = lane >> 4;
    constexpr int NU = 129 * 9;
    for (int u = c.vcu; u < NU; u += c.G) {
        const int mt = u / 9, nt = u % 9, row0 = mt * 128, n0 = nt * 256;
        f32x4 acc[4][4]; acc_zero(acc);
        auto rp = [&](int r) { return H0 + (size_t)(row0 + r) * D; };
        gemm_kloop(acc, c, rp, WinT + (size_t)n0 * D, D, D);
        const int s0 = n0 + wc * 64;
#pragma unroll
        for (int mi = 0; mi < 4; ++mi) {
            const int row = row0 + wr * 64 + mi * 16 + fr;
            float ss = 0.f;
#pragma unroll
            for (int ni = 0; ni < 4; ++ni) {
                const f32x4 v = acc[mi][ni];
                store_bf4(Z + (size_t)row * ZC + s0 + ni * 16 + fq * 4, v);
                ss += (v[0] * v[0] + v[1] * v[1]) + (v[2] * v[2] + v[3] * v[3]);
            }
            if (s0 < ZKPE) {
                ss += __shfl_xor(ss, 16); ss += __shfl_xor(ss, 32);
                if (fq == 0) psq[(size_t)row * 16 + (s0 >> 6)] = ss;
            }
        }
    }
}

__device__ __forceinline__ void phase2(const Params& p, const Ctx& c) {
    unsigned char* ws = p.ws;
    const bf16_t* Z = (const bf16_t*)(ws + WS_Z);
    const float* psq = (const float*)(ws + WS_PSQ);
    const float* rope = (const float*)(ws + WS_ROPE);
    bf16_t* Q = (bf16_t*)(ws + WS_Q); bf16_t* Kb = (bf16_t*)(ws + WS_K); bf16_t* Vb = (bf16_t*)(ws + WS_V);
    const int lane = c.lane, wr = c.wave >> 2, wc = c.wave & 3, fr = lane & 15, fq = lane >> 4;
    constexpr int NUQ = 128 * 3, NUKV = 129 * 4;
    for (int u = c.vcu; u < NUQ + NUKV; u += c.G) {
        f32x4 acc[4][4]; acc_zero(acc);
        if (u < NUQ) {
            const int mt = u / 3, nt = u % 3, row0 = mt * 128, n0 = nt * 256;
            auto rp = [&](int r) { return Z + (size_t)(row0 + r) * ZC + ZQ; };
            gemm_kloop(acc, c, rp, (const bf16_t*)(ws + WS_WUQ) + (size_t)n0 * QLORA, QLORA, QLORA);
            const int s0 = n0 + wc * 64;
#pragma unroll
            for (int mi = 0; mi < 4; ++mi) {
                const int row = row0 + wr * 64 + mi * 16 + fr;
                const f32x4 pa = *(const f32x4*)(psq + (size_t)row * 16), pb = *(const f32x4*)(psq + (size_t)row * 16 + 4);
                const float rq = rsqrtf((((pa[0] + pa[1]) + (pa[2] + pa[3])) + (pb[0] + pb[1])) * (1.f / QLORA) + 1e-6f) * QSCALE;
                const int pos = NMETA + (row & (SEQ - 1));
#pragma unroll
                for (int np = 0; np < 2; ++np) {
                    const int c0 = s0 + np * 32 + fq * 4;
                    f32x4 a = acc[mi][2 * np] * rq, b = acc[mi][2 * np + 1] * rq;
                    if (((s0 + np * 32) % 96) == 64) {
                        const f32x4 cs0 = *(const f32x4*)(rope + ((size_t)pos * 16 + fq * 4) * 2);
                        const f32x4 cs1 = *(const f32x4*)(rope + ((size_t)pos * 16 + fq * 4 + 2) * 2);
                        const float co[4] = {cs0[0], cs0[2], cs1[0], cs1[2]}, si[4] = {cs0[1], cs0[3], cs1[1], cs1[3]};
                        f32x4 na, nb;
#pragma unroll
                        for (int j = 0; j < 4; ++j) { na[j] = a[j] * co[j] - b[j] * si[j]; nb[j] = b[j] * co[j] + a[j] * si[j]; }
                        a = na; b = nb;
                    }
                    store_bf4(Q + (size_t)row * 768 + c0, a);
                    store_bf4(Q + (size_t)row * 768 + c0 + 16, b);
                }
            }
        } else {
            const int uu = u - NUQ, mt = uu / 4, nt = uu % 4, row0 = mt * 128, n0 = nt * 256;
            auto rp = [&](int r) { return Z + (size_t)(row0 + r) * ZC + ZKV; };
            gemm_kloop(acc, c, rp, (const bf16_t*)(ws + WS_WUKV) + (size_t)n0 * KVLORA, KVLORA, KVLORA);
            const int s0 = n0 + wc * 64;
            const int h = s0 >> 7; const bool isv = (s0 & 64) != 0;
#pragma unroll
            for (int mi = 0; mi < 4; ++mi) {
                const int row = row0 + wr * 64 + mi * 16 + fr;
                if (row >= NROWS) continue;
                const f32x4 pa = *(const f32x4*)(psq + (size_t)row * 16 + 4), pb = *(const f32x4*)(psq + (size_t)row * 16 + 8);
                const float rk = rsqrtf(((pa[2] + pa[3]) + (pb[0] + pb[1])) * (1.f / KVLORA) + 1e-6f);
                const int nb = row < NTOK ? 1 : NBATCH;
                const int b0 = row < NTOK ? (row >> 11) : 0, pos = row < NTOK ? NMETA + (row & (SEQ - 1)) : row - NTOK;
                for (int bb = 0; bb < nb; ++bb) {
                    const size_t prow = (size_t)(b0 + bb) * LPOS + pos;
#pragma unroll
                    for (int ni = 0; ni < 4; ++ni) {
                        const int d = ni * 16 + fq * 4;
                        const f32x4 v = acc[mi][ni] * rk;
                        if (isv) store_bf4(Vb + prow * 512 + h * 64 + d, v);
                        else store_bf4(Kb + prow * 768 + h * 96 + d, v);
                    }
                }
            }
        }
    }
    const int gw = c.vcu * NWAVES + c.wave, NGW = c.G * NWAVES;
    const bf16_t* Zc = Z;
    for (int row = gw; row < NROWS; row += NGW) {
        const int nb = row < NTOK ? 1 : NBATCH;
        const int b0 = row < NTOK ? (row >> 11) : 0, pos = row < NTOK ? NMETA + (row & (SEQ - 1)) : row - NTOK;
        if (lane < 16) {
            const float x1 = bf2f(Zc[(size_t)row * ZC + ZKPE + lane]), x2 = bf2f(Zc[(size_t)row * ZC + ZKPE + 16 + lane]);
            const float co = rope[((size_t)pos * 16 + lane) * 2], si = rope[((size_t)pos * 16 + lane) * 2 + 1];
            const bf16_t o1 = (bf16_t)f2bf(x1 * co - x2 * si), o2 = (bf16_t)f2bf(x2 * co + x1 * si);
            for (int bb = 0; bb < nb; ++bb) {
                bf16_t* kp = Kb + ((size_t)(b0 + bb) * LPOS + pos) * 768;
#pragma unroll
                for (int h = 0; h < NH; ++h) { kp[h * 96 + 64 + lane] = o1; kp[h * 96 + 80 + lane] = o2; }
            }
        }
        if (row < NTOK) {
            const int i = row & (SEQ - 1);
            const int r1 = i >= 1 ? row - 1 : NTOK + 15;
            const int r2 = i >= 2 ? row - 2 : (i == 1 ? NTOK + 15 : NTOK + 14);
            const int ch = lane * 8;
            const u32x4 c0 = *(const u32x4*)(Zc + (size_t)row * ZC + ZCG + ch), u0 = *(const u32x4*)(Zc + (size_t)row * ZC + ZU + ch);
            const u32x4 c1 = *(const u32x4*)(Zc + (size_t)r1 * ZC + ZCG + ch), u1 = *(const u32x4*)(Zc + (size_t)r1 * ZC + ZU + ch);
            const u32x4 c2 = *(const u32x4*)(Zc + (size_t)r2 * ZC + ZCG + ch), u2 = *(const u32x4*)(Zc + (size_t)r2 * ZC + ZU + ch);
            const u32x4 bg = *(const u32x4*)(Zc + (size_t)row * ZC + ZB + ch);
            float y[8]; float ss = 0.f;
#pragma unroll
            for (int e = 0; e < 4; ++e) {
#pragma unroll
                for (int hh = 0; hh < 2; ++hh) {
                    const int cc = ch + e * 2 + hh;
                    const float w0 = p.conv_w[cc], w1 = p.conv_w[512 + cc], w2 = p.conv_w[1024 + cc];
                    const float v0 = hh ? bfhi(c0[e]) * bfhi(u0[e]) : bflo(c0[e]) * bflo(u0[e]);
                    const float v1 = hh ? bfhi(c1[e]) * bfhi(u1[e]) : bflo(c1[e]) * bflo(u1[e]);
                    const float v2 = hh ? bfhi(c2[e]) * bfhi(u2[e]) : bflo(c2[e]) * bflo(u2[e]);
                    const float bgv = hh ? bfhi(bg[e]) : bflo(bg[e]);
                    const float yy = bgv * (w0 * v2 + w1 * v1 + w2 * v0);
                    y[e * 2 + hh] = yy; ss += yy * yy;
                }
            }
            ss = wave_sum(ss);
            u32x4 o; o.x = pk2(y[0], y[1]); o.y = pk2(y[2], y[3]); o.z = pk2(y[4], y[5]); o.w = pk2(y[6], y[7]);
            *(u32x4*)((bf16_t*)(ws + WS_CONV) + (size_t)row * 512 + ch) = o;
            if (lane == 0) ((float*)(ws + WS_SSQC))[row] = ss;
        }
    }
}

__device__ __forceinline__ void phase3_naive(const Params& p, const Ctx& c) {
    unsigned char* ws = p.ws;
    const bf16_t* Q = (const bf16_t*)(ws + WS_Q); const bf16_t* Kb = (const bf16_t*)(ws + WS_K); const bf16_t* Vb = (const bf16_t*)(ws + WS_V);
    bf16_t* ATT = (bf16_t*)(ws + WS_ATT); float* patt = (float*)(ws + WS_PATT);
    const int gw = c.vcu * NWAVES + c.wave, NGW = c.G * NWAVES, lane = c.lane;
    for (int it = gw; it < NTOK * NH; it += NGW) {
        const int row = it >> 3, h = it & 7, b = row >> 11, i = row & (SEQ - 1), nkeys = NMETA + i + 1;
        float q[96];
#pragma unroll
        for (int j = 0; j < 12; ++j) {
            const u32x4 w = *(const u32x4*)(Q + (size_t)row * 768 + h * 96 + j * 8);
#pragma unroll
            for (int e = 0; e < 4; ++e) { q[j * 8 + e * 2] = bflo(w[e]); q[j * 8 + e * 2 + 1] = bfhi(w[e]); }
        }
        float m = -INFINITY, l = 0.f; float o[64];
#pragma unroll
        for (int d = 0; d < 64; ++d) o[d] = 0.f;
        for (int kk = lane; kk < nkeys; kk += 64) {
            const bf16_t* kp = Kb + ((size_t)b * LPOS + kk) * 768 + h * 96;
            float s = 0.f;
#pragma unroll
            for (int j = 0; j < 12; ++j) {
                const u32x4 w = *(const u32x4*)(kp + j * 8);
#pragma unroll
                for (int e = 0; e < 4; ++e) { s += q[j * 8 + e * 2] * bflo(w[e]); s += q[j * 8 + e * 2 + 1] * bfhi(w[e]); }
            }
            const float mn = fmaxf(m, s), f = exp2f(m - mn), pe = exp2f(s - mn);
            l = l * f + pe; m = mn;
            const bf16_t* vp = Vb + ((size_t)b * LPOS + kk) * 512 + h * 64;
#pragma unroll
            for (int j = 0; j < 8; ++j) {
                const u32x4 w = *(const u32x4*)(vp + j * 8);
#pragma unroll
                for (int e = 0; e < 4; ++e) { o[j * 8 + e * 2] = o[j * 8 + e * 2] * f + pe * bflo(w[e]); o[j * 8 + e * 2 + 1] = o[j * 8 + e * 2 + 1] * f + pe * bfhi(w[e]); }
            }
        }
        const float M = wave_max(m);
        const float f = (m == -INFINITY) ? 0.f : exp2f(m - M);
        const float lt = wave_sum(l * f);
        float res = 0.f;
#pragma unroll
        for (int d = 0; d < 64; ++d) { const float v = wave_sum(o[d] * f); if (lane == d) res = v; }
        res /= lt;
        ATT[(size_t)row * 512 + h * 64 + lane] = (bf16_t)f2bf(res);
        const float ss = wave_sum(res * res);
        if (lane == 0) patt[(size_t)row * 8 + h] = ss;
    }
}


typedef float f32x16 __attribute__((ext_vector_type(16)));
typedef short s16x4 __attribute__((ext_vector_type(4)));
constexpr int AK_PITCH = 208, AK_BYTES = 64 * AK_PITCH, AV_BYTES = 8192, ASTAGE = AK_BYTES + AV_BYTES, A_WSF = 2 * ASTAGE;
__device__ __forceinline__ int crow(int r, int hi) { return (r & 3) + 8 * (r >> 2) + 4 * hi; }
__device__ __forceinline__ s16x4 vtr(const LAS unsigned char* p) {
    return __builtin_bit_cast(s16x4, __builtin_amdgcn_ds_read_tr16_b64_v4i16((LAS s16x4*)p));
}
__device__ __forceinline__ void attn_unit(const Params& p, const Ctx& c, int b, int h, int qb) {
    unsigned char* ws = p.ws;
    const bf16_t* Q = (const bf16_t*)(ws + WS_Q); const bf16_t* Kb = (const bf16_t*)(ws + WS_K); const bf16_t* Vb = (const bf16_t*)(ws + WS_V);
    bf16_t* ATT = (bf16_t*)(ws + WS_ATT); float* patt = (float*)(ws + WS_PATT);
    const int tid = c.tid, lane = c.lane, w = c.wave, r32 = lane & 31, hi = lane >> 5;
    LAS unsigned char* lds = c.lds;
    LAS float* wsf = (LAS float*)(lds + A_WSF) + w * 32;
    const int row0 = b * SEQ + qb * 256;
    const int qpos0 = NMETA + qb * 256 + w * 32, myq = qpos0 + r32;
    bf16x8 qf[6];
#pragma unroll
    for (int ds = 0; ds < 6; ++ds) qf[ds] = *(const bf16x8*)(Q + (size_t)(row0 + w * 32 + r32) * 768 + h * 96 + ds * 16 + hi * 8);
    const bf16_t* Kg = Kb + (size_t)b * LPOS * 768 + h * 96;
    const bf16_t* Vg = Vb + (size_t)b * LPOS * 512 + h * 64;
    const int T = 4 * qb + 5;
    const int tl = (qpos0 + 31) >> 6;
    const int k0row = tid / 12, k0ch = tid % 12, k1row = (512 + tid) / 12, k1ch = (512 + tid) % 12;
    const int vrow = tid >> 3, vch = tid & 7;
    const int k0off = k0row * AK_PITCH + k0ch * 16, k1off = k1row * AK_PITCH + k1ch * 16;
    const int voff = AK_BYTES + (vch >> 2) * 4096 + vrow * 64 + (vch & 3) * 16;
    u32x4 rk0, rk1, rv;
#define A_LOAD(t) do { const int kb_ = (t) * 64; \
        rk0 = *(const u32x4*)(Kg + (size_t)min(kb_ + k0row, LPOS - 1) * 768 + k0ch * 8); \
        if (tid < 256) rk1 = *(const u32x4*)(Kg + (size_t)min(kb_ + k1row, LPOS - 1) * 768 + k1ch * 8); \
        rv = *(const u32x4*)(Vg + (size_t)min(kb_ + vrow, LPOS - 1) * 512 + vch * 8); } while (0)
#define A_STORE(buf) do { LAS unsigned char* sb_ = lds + (buf) * ASTAGE; \
        *(LAS u32x4*)(sb_ + k0off) = rk0; if (tid < 256) *(LAS u32x4*)(sb_ + k1off) = rk1; *(LAS u32x4*)(sb_ + voff) = rv; } while (0)
    float m = -INFINITY, l = 0.f;
    f32x16 o0, o1;
#pragma unroll
    for (int r = 0; r < 16; ++r) { o0[r] = 0.f; o1[r] = 0.f; }
    const int kfo = r32 * AK_PITCH + hi * 16;
    const int vfo = AK_BYTES + ((lane >> 4) & 1) * 32 + (lane & 3) * 8 + (4 * hi + ((lane & 15) >> 2)) * 64;
    __syncthreads();
    A_LOAD(0);
    A_STORE(0);
    __syncthreads();
    for (int t = 0; t < T; ++t) {
        if (t + 1 < T) A_LOAD(t + 1);
        if (t <= tl) {
            const LAS unsigned char* sb = lds + (t & 1) * ASTAGE;
            f32x16 p0, p1;
#pragma unroll
            for (int r = 0; r < 16; ++r) { p0[r] = 0.f; p1[r] = 0.f; }
#pragma unroll
            for (int ds = 0; ds < 6; ++ds) {
                const bf16x8 a0 = *(const LAS bf16x8*)(sb + kfo + ds * 32);
                const bf16x8 a1 = *(const LAS bf16x8*)(sb + kfo + 32 * AK_PITCH + ds * 32);
                p0 = __builtin_amdgcn_mfma_f32_32x32x16_bf16(a0, qf[ds], p0, 0, 0, 0);
                p1 = __builtin_amdgcn_mfma_f32_32x32x16_bf16(a1, qf[ds], p1, 0, 0, 0);
            }
            if (t * 64 + 63 > qpos0) {
                const int kb0 = t * 64 + 4 * hi;
#pragma unroll
                for (int r = 0; r < 16; ++r) {
                    const int kv = kb0 + (r & 3) + 8 * (r >> 2);
                    if (kv > myq) p0[r] = -INFINITY;
                    if (kv + 32 > myq) p1[r] = -INFINITY;
                }
            }
            float mx = fmaxf(p0[0], p1[0]);
#pragma unroll
            for (int r = 1; r < 16; ++r) mx = fmaxf(mx, fmaxf(p0[r], p1[r]));
            mx = fmaxf(mx, __shfl_xor(mx, 32));
            if (__any(mx > m)) {
                const float mn = fmaxf(m, mx), alpha = __builtin_amdgcn_exp2f(m - mn);
                m = mn; l *= alpha;
                if (hi == 0) wsf[r32] = alpha;
                asm volatile("s_waitcnt lgkmcnt(0)" ::: "memory");
#pragma unroll
                for (int k = 0; k < 4; ++k) {
                    const f32x4 a = *(const LAS f32x4*)(wsf + 8 * k + 4 * hi);
#pragma unroll
                    for (int j = 0; j < 4; ++j) { o0[4 * k + j] *= a[j]; o1[4 * k + j] *= a[j]; }
                }
                asm volatile("s_waitcnt lgkmcnt(0)" ::: "memory");
            }
            float ls = 0.f;
#pragma unroll
            for (int r = 0; r < 16; ++r) { p0[r] = __builtin_amdgcn_exp2f(p0[r] - m); p1[r] = __builtin_amdgcn_exp2f(p1[r] - m); ls += p0[r] + p1[r]; }
            l += ls;
            bf16x8 pa[4];
#pragma unroll
            for (int s = 0; s < 4; ++s) {
                u32x4 wv;
#pragma unroll
                for (int e = 0; e < 4; ++e) {
                    const int r = 8 * (s & 1) + 2 * e;
                    wv[e] = (s >> 1) ? pk2(p1[r], p1[r + 1]) : pk2(p0[r], p0[r + 1]);
                }
                pa[s] = __builtin_bit_cast(bf16x8, wv);
            }
#pragma unroll
            for (int s = 0; s < 4; ++s) {
                const s16x4 l0 = vtr(sb + vfo + s * 1024), h0 = vtr(sb + vfo + s * 1024 + 512);
                const s16x4 l1 = vtr(sb + vfo + 4096 + s * 1024), h1 = vtr(sb + vfo + 4096 + s * 1024 + 512);
                const bf16x8 v0 = (bf16x8){l0[0], l0[1], l0[2], l0[3], h0[0], h0[1], h0[2], h0[3]};
                const bf16x8 v1 = (bf16x8){l1[0], l1[1], l1[2], l1[3], h1[0], h1[1], h1[2], h1[3]};
                o0 = __builtin_amdgcn_mfma_f32_32x32x16_bf16(pa[s], v0, o0, 0, 0, 0);
                o1 = __builtin_amdgcn_mfma_f32_32x32x16_bf16(pa[s], v1, o1, 0, 0, 0);
            }
        }
        if (t + 1 < T) A_STORE((t + 1) & 1);
        __syncthreads();
    }
#undef A_LOAD
#undef A_STORE
    l += __shfl_xor(l, 32);
    if (hi == 0) wsf[r32] = 1.f / l;
    asm volatile("s_waitcnt lgkmcnt(0)" ::: "memory");
    float sq[16];
#pragma unroll
    for (int k = 0; k < 4; ++k) {
        const f32x4 a = *(const LAS f32x4*)(wsf + 8 * k + 4 * hi);
#pragma unroll
        for (int j = 0; j < 4; ++j) {
            const int r = 4 * k + j;
            const float x0 = o0[r] * a[j], x1 = o1[r] * a[j];
            bf16_t* op = ATT + (size_t)(row0 + w * 32 + crow(r, hi)) * 512 + h * 64 + r32;
            op[0] = (bf16_t)f2bf(x0); op[32] = (bf16_t)f2bf(x1);
            sq[r] = x0 * x0 + x1 * x1;
        }
    }
#pragma unroll
    for (int r = 0; r < 16; ++r) {
        float v = sq[r];
#pragma unroll
        for (int o = 1; o < 32; o <<= 1) v += __shfl_xor(v, o);
        if (r32 == 0) patt[(size_t)(row0 + w * 32 + crow(r, hi)) * 8 + h] = v;
    }
    asm volatile("s_waitcnt lgkmcnt(0)" ::: "memory");
}
__device__ __forceinline__ void phase3(const Params& p, const Ctx& c) {
    for (int pi = c.vcu; pi < 256; pi += c.G) {
        const int bh = pi >> 2, s = pi & 3;
        attn_unit(p, c, bh >> 3, bh & 7, 7 - s);
        attn_unit(p, c, bh >> 3, bh & 7, s);
    }
}

__device__ __forceinline__ void phase4(const Params& p, const Ctx& c) {
    unsigned char* ws = p.ws;
    const bf16_t* ATT = (const bf16_t*)(ws + WS_ATT); const bf16_t* CONV = (const bf16_t*)(ws + WS_CONV);
    const bf16_t* WoT = (const bf16_t*)(ws + WS_WO); const bf16_t* H0 = (const bf16_t*)(ws + WS_H0);
    const float* patt = (const float*)(ws + WS_PATT); const float* ssq_c = (const float*)(ws + WS_SSQC);
    bf16_t* Y1 = (bf16_t*)(ws + WS_Y1); float* pst = (float*)(ws + WS_PST);
    const int lane = c.lane, wr = c.wave >> 2, wc = c.wave & 3, fr = lane & 15, fq = lane >> 4;
    constexpr int NU = 128 * 4;
    for (int u = c.vcu; u < NU; u += c.G) {
        const int mt = u >> 2, nt = u & 3, row0 = mt * 128, n0 = nt * 256;
        f32x4 acc[4][4]; acc_zero(acc);
        auto rpa = [&](int r) { return ATT + (size_t)(row0 + r) * 512; };
        gemm_kloop(acc, c, rpa, WoT + (size_t)n0 * D, D, 512);
        float rc[4];
#pragma unroll
        for (int mi = 0; mi < 4; ++mi) {
            const int row = row0 + wr * 64 + mi * 16 + fr;
            const f32x4 pa = *(const f32x4*)(patt + (size_t)row * 8), pb = *(const f32x4*)(patt + (size_t)row * 8 + 4);
            const float ra = rsqrtf((((pa[0] + pa[1]) + (pa[2] + pa[3])) + ((pb[0] + pb[1]) + (pb[2] + pb[3]))) * (1.f / 512) + 1e-6f);
            rc[mi] = rsqrtf(ssq_c[row] * (1.f / 512) + 1e-6f);
            const float f = ra / rc[mi];
#pragma unroll
            for (int ni = 0; ni < 4; ++ni) acc[mi][ni] = acc[mi][ni] * f;
        }
        auto rpc = [&](int r) { return CONV + (size_t)(row0 + r) * 512; };
        gemm_kloop(acc, c, rpc, WoT + (size_t)n0 * D + 512, D, 512);
        const int s0 = n0 + wc * 64;
#pragma unroll
        for (int mi = 0; mi < 4; ++mi) {
            const int row = row0 + wr * 64 + mi * 16 + fr;
            float s = 0.f, ss = 0.f;
#pragma unroll
            for (int ni = 0; ni < 4; ++ni) {
                const int col = s0 + ni * 16 + fq * 4;
                const u32x2 hw = *(const u32x2*)(H0 + (size_t)row * D + col);
                f32x4 v = acc[mi][ni] * rc[mi];
                v[0] += ALPHA * bflo(hw.x); v[1] += ALPHA * bfhi(hw.x); v[2] += ALPHA * bflo(hw.y); v[3] += ALPHA * bfhi(hw.y);
                store_bf4(Y1 + (size_t)row * D + col, v);
                s += (v[0] + v[1]) + (v[2] + v[3]);
                ss += (v[0] * v[0] + v[1] * v[1]) + (v[2] * v[2] + v[3] * v[3]);
            }
            s += __shfl_xor(s, 16); s += __shfl_xor(s, 32);
            ss += __shfl_xor(ss, 16); ss += __shfl_xor(ss, 32);
            if (fq == 0) { float* q = pst + ((size_t)row * 16 + nt * 4 + wc) * 2; q[0] = s; q[1] = ss; }
        }
    }
}

__device__ __forceinline__ void phase5a(const Params& p, const Ctx& c) {
    unsigned char* ws = p.ws;
    const bf16_t* Y1 = (const bf16_t*)(ws + WS_Y1); bf16_t* H1 = (bf16_t*)(ws + WS_H1); const float* pst = (const float*)(ws + WS_PST);
    const int gw = c.vcu * NWAVES + c.wave, NGW = c.G * NWAVES, lane = c.lane;
    for (int row = gw; row < NTOK; row += NGW) {
        float s1 = 0.f, s2 = 0.f;
#pragma unroll
        for (int k = 0; k < 16; ++k) { s1 += pst[((size_t)row * 16 + k) * 2]; s2 += pst[((size_t)row * 16 + k) * 2 + 1]; }
        const float mean = s1 * (1.f / D), var = fmaxf(s2 * (1.f / D) - mean * mean, 0.f), rstd = rsqrtf(var + 1e-5f);
#pragma unroll
        for (int j = 0; j < 2; ++j) {
            const int col = (lane + 64 * j) * 8;
            const u32x4 w = *(const u32x4*)(Y1 + (size_t)row * D + col);
            float y[8];
#pragma unroll
            for (int e = 0; e < 4; ++e) { y[2 * e] = bflo(w[e]); y[2 * e + 1] = bfhi(w[e]); }
#pragma unroll
            for (int e = 0; e < 8; ++e) y[e] = (y[e] - mean) * rstd * p.ln1_g[col + e] + p.ln1_b[col + e];
            u32x4 o; o.x = pk2(y[0], y[1]); o.y = pk2(y[2], y[3]); o.z = pk2(y[4], y[5]); o.w = pk2(y[6], y[7]);
            *(u32x4*)(H1 + (size_t)row * D + col) = o;
        }
    }
}
__device__ __forceinline__ void phase5b(const Params& p, const Ctx& c) {
    unsigned char* ws = p.ws;
    const bf16_t* H1 = (const bf16_t*)(ws + WS_H1); float* LOG = (float*)(ws + WS_LOG);
    const int lane = c.lane, wr = c.wave >> 2, wc = c.wave & 3, fr = lane & 15, fq = lane >> 4;
    for (int u = c.vcu; u < 128; u += c.G) {
        const int row0 = u * 128;
        f32x4 acc[4][4]; acc_zero(acc);
        auto rp = [&](int r) { return H1 + (size_t)(row0 + r) * D; };
        gemm_kloop(acc, c, rp, (const bf16_t*)(ws + WS_WR), D, D);
#pragma unroll
        for (int mi = 0; mi < 4; ++mi) {
            const int row = row0 + wr * 64 + mi * 16 + fr;
#pragma unroll
            for (int ni = 0; ni < 4; ++ni) *(f32x4*)(LOG + (size_t)row * 256 + wc * 64 + ni * 16 + fq * 4) = acc[mi][ni];
        }
    }
}
__device__ __forceinline__ void phase5c(const Params& p, const Ctx& c) {
    unsigned char* ws = p.ws;
    const float* LOG = (const float*)(ws + WS_LOG);
    unsigned* cnt = (unsigned*)(ws + WS_CTL + CT_CNT); unsigned* laid = (unsigned*)(ws + WS_LAID); float* lgate = (float*)(ws + WS_LGATE);
    const int gw = c.vcu * NWAVES + c.wave, NGW = c.G * NWAVES, lane = c.lane;
    const f32x4 bias = *((const f32x4*)p.router_bias + lane);
    for (int t = gw; t < NTOK; t += NGW) {
        const f32x4 lg = *((const f32x4*)(LOG + (size_t)t * 256) + lane);
        float s[4], sel[4];
#pragma unroll
        for (int i = 0; i < 4; ++i) { s[i] = 1.f / (1.f + expf(-lg[i])); sel[i] = s[i] + bias[i]; }
        float a = fmaxf(sel[0], sel[1]), b = fminf(sel[0], sel[1]), cc = fmaxf(sel[2], sel[3]), d = fminf(sel[2], sel[3]);
        float t1 = fmaxf(a, cc), t2 = fmaxf(fminf(a, cc), a >= cc ? b : d);
#pragma unroll
        for (int o = 1; o < 8; o <<= 1) {
            const float y1 = __shfl_xor(t1, o), y2 = __shfl_xor(t2, o);
            const float n1 = fmaxf(t1, y1), n2 = fmaxf(fminf(t1, y1), t1 >= y1 ? t2 : y2);
            t1 = n1; t2 = n2;
        }
        const float gs = t1 + t2; const int g = lane >> 3;
        int better = 0;
#pragma unroll
        for (int gg = 0; gg < 8; ++gg) { const float o = __shfl(gs, gg * 8); better += (o > gs || (o == gs && gg < g)) ? 1 : 0; }
        if (better >= 4) { sel[0] = sel[1] = sel[2] = sel[3] = -INFINITY; }
        int ek[8]; float sk[8]; float ssum = 0.f;
#pragma unroll
        for (int k = 0; k < 8; ++k) {
            float bv = sel[0]; int bi = 0;
            if (sel[1] > bv) { bv = sel[1]; bi = 1; }
            if (sel[2] > bv) { bv = sel[2]; bi = 2; }
            if (sel[3] > bv) { bv = sel[3]; bi = 3; }
            const float wm = wave_max(bv);
            const unsigned long long mask = __ballot(bv == wm);
            const int src = __ffsll((long long)mask) - 1;
            const float sb = bi == 0 ? s[0] : bi == 1 ? s[1] : bi == 2 ? s[2] : s[3];
            ek[k] = src * 4 + __shfl(bi, src); sk[k] = __shfl(sb, src); ssum += sk[k];
            if (lane == src) { if (bi == 0) sel[0] = -INFINITY; else if (bi == 1) sel[1] = -INFINITY; else if (bi == 2) sel[2] = -INFINITY; else sel[3] = -INFINITY; }
        }
        int me = ek[0]; float mg = sk[0];
#pragma unroll
        for (int k = 1; k < 8; ++k) if (lane == k) { me = ek[k]; mg = sk[k]; }
        if (lane < 8) {
            const unsigned pos = atomicAdd(cnt + me, 1u);
            laid[(size_t)me * CAP + pos] = (unsigned)(t * 8 + lane);
            lgate[(size_t)me * CAP + pos] = mg / ssum * 2.5f;
        }
    }
}

struct MoeTab { LAS int* tstart; LAS int* roff; LAS int* tok; LAS float* gate; };
__device__ __forceinline__ MoeTab moe_tab_build(const Params& p, const Ctx& c) {
    MoeTab T; T.tstart = (LAS int*)(c.lds + LDS_MISC); T.roff = T.tstart + 260; T.tok = T.roff + 260; T.gate = (LAS float*)(T.tok + 128);
    const unsigned* cnt = (const unsigned*)(p.ws + WS_CTL + CT_CNT);
    __syncthreads();
    if (c.tid < 64) {
        int cv[4], tv[4]; int ls = 0, lt = 0;
#pragma unroll
        for (int i = 0; i < 4; ++i) { cv[i] = (int)cnt[c.tid * 4 + i]; tv[i] = (cv[i] + 127) >> 7; ls += cv[i]; lt += tv[i]; }
        int ps = ls, pt = lt;
#pragma unroll
        for (int o = 1; o < 64; o <<= 1) { const int a = __shfl_up(ps, o), b = __shfl_up(pt, o); if (c.tid >= o) { ps += a; pt += b; } }
        int es = ps - ls, et = pt - lt;
#pragma unroll
        for (int i = 0; i < 4; ++i) { T.roff[c.tid * 4 + i] = es; T.tstart[c.tid * 4 + i] = et; es += cv[i]; et += tv[i]; }
        if (c.tid == 63) { T.roff[256] = es; T.tstart[256] = et; }
    }
    __syncthreads();
    return T;
}
__device__ __forceinline__ int moe_find(const MoeTab& T, int g) {
    int lo = 0, hi = 255;
    while (lo < hi) { const int mid = (lo + hi + 1) >> 1; if (T.tstart[mid] <= g) lo = mid; else hi = mid - 1; }
    return lo;
}

__device__ __forceinline__ void phase6(const Params& p, const Ctx& c) {
    unsigned char* ws = p.ws;
    const bf16_t* H1 = (const bf16_t*)(ws + WS_H1); bf16_t* HID = (bf16_t*)(ws + WS_HID);
    const unsigned* laid = (const unsigned*)(ws + WS_LAID);
    const unsigned* cnt = (const unsigned*)(ws + WS_CTL + CT_CNT);
    const int lane = c.lane, wr = c.wave >> 2, wc = c.wave & 3, fr = lane & 15, fq = lane >> 4;
    const MoeTab T = moe_tab_build(p, c);
    const int tmt = T.tstart[256], NU = (tmt + 128) * 2;
    for (int u = c.vcu; u < NU; u += c.G) {
        const int g = u >> 1, nt = u & 1;
        int e, mt, nrows; size_t hbase;
        __syncthreads();
        if (g < tmt) {
            e = moe_find(T, g); mt = g - T.tstart[e]; nrows = min(128, (int)cnt[e] - mt * 128); hbase = (size_t)T.roff[e] + mt * 128;
            if (c.tid < 128) T.tok[c.tid] = (int)(laid[(size_t)e * CAP + mt * 128 + min(c.tid, nrows - 1)] >> 3);
        } else {
            e = NEXP; mt = g - tmt; nrows = 128; hbase = (size_t)NTOK * 8 + mt * 128;
            if (c.tid < 128) T.tok[c.tid] = mt * 128 + c.tid;
        }
        __syncthreads();
        f32x4 acc[4][4]; acc_zero(acc);
        auto rp = [&](int r) { return H1 + (size_t)T.tok[r] * D; };
        const bf16_t* Bt = (e < NEXP ? (const bf16_t*)(ws + WS_WGU) + (size_t)e * 512 * D : (const bf16_t*)(ws + WS_WSGU)) + (size_t)nt * 256 * D;
        gemm_kloop(acc, c, rp, Bt, D, D);
#pragma unroll
        for (int mi = 0; mi < 4; ++mi) {
            const int r = wr * 64 + mi * 16 + fr;
            if (r >= nrows) continue;
#pragma unroll
            for (int np = 0; np < 2; ++np) {
                const f32x4 gt = acc[mi][2 * np], up = acc[mi][2 * np + 1];
                f32x4 hv;
#pragma unroll
                for (int j = 0; j < 4; ++j) hv[j] = gt[j] / (1.f + __expf(-gt[j])) * up[j];
                store_bf4(HID + (hbase + r) * DEXP + nt * 128 + wc * 32 + np * 16 + fq * 4, hv);
            }
        }
    }
}
__device__ __forceinline__ void phase7(const Params& p, const Ctx& c) {
    unsigned char* ws = p.ws;
    const bf16_t* HID = (const bf16_t*)(ws + WS_HID); bf16_t* Y = (bf16_t*)(ws + WS_Y);
    const unsigned* laid = (const unsigned*)(ws + WS_LAID); const float* lgate = (const float*)(ws + WS_LGATE);
    const unsigned* cnt = (const unsigned*)(ws + WS_CTL + CT_CNT);
    const int lane = c.lane, wr = c.wave >> 2, wc = c.wave & 3, fr = lane & 15, fq = lane >> 4;
    const MoeTab T = moe_tab_build(p, c);
    const int tmt = T.tstart[256], NU = (tmt + 128) * 4;
    for (int u = c.vcu; u < NU; u += c.G) {
        const int g = u >> 2, nt = u & 3;
        int e, mt, nrows; size_t hbase;
        __syncthreads();
        if (g < tmt) {
            e = moe_find(T, g); mt = g - T.tstart[e]; nrows = min(128, (int)cnt[e] - mt * 128); hbase = (size_t)T.roff[e] + mt * 128;
            if (c.tid < 128) {
                const int rr = min(c.tid, nrows - 1);
                const unsigned aid = laid[(size_t)e * CAP + mt * 128 + rr];
                T.tok[c.tid] = (int)((aid >> 3) * 9 + (aid & 7)); T.gate[c.tid] = lgate[(size_t)e * CAP + mt * 128 + rr];
            }
        } else {
            e = NEXP; mt = g - tmt; nrows = 128; hbase = (size_t)NTOK * 8 + mt * 128;
            if (c.tid < 128) { T.tok[c.tid] = (mt * 128 + c.tid) * 9 + 8; T.gate[c.tid] = 1.f; }
        }
        __syncthreads();
        f32x4 acc[4][4]; acc_zero(acc);
        auto rp = [&](int r) { return HID + (hbase + min(r, nrows - 1)) * DEXP; };
        const bf16_t* Bt = (e < NEXP ? (const bf16_t*)(ws + WS_WD) + (size_t)e * D * DEXP : (const bf16_t*)(ws + WS_WSD)) + (size_t)nt * 256 * DEXP;
        gemm_kloop(acc, c, rp, Bt, DEXP, DEXP);
#pragma unroll
        for (int mi = 0; mi < 4; ++mi) {
            const int r = wr * 64 + mi * 16 + fr;
            if (r >= nrows) continue;
            const float gt = T.gate[r]; const size_t yrow = (size_t)T.tok[r];
#pragma unroll
            for (int ni = 0; ni < 4; ++ni) store_bf4(Y + yrow * D + nt * 256 + wc * 64 + ni * 16 + fq * 4, acc[mi][ni] * gt);
        }
    }
}
__device__ __forceinline__ void phase8(const Params& p, const Ctx& c) {
    unsigned char* ws = p.ws;
    const bf16_t* H1 = (const bf16_t*)(ws + WS_H1); const bf16_t* Y = (const bf16_t*)(ws + WS_Y);
    const int gw = c.vcu * NWAVES + c.wave, NGW = c.G * NWAVES, lane = c.lane;
    for (int t = gw; t < NTOK; t += NGW) {
        float v[16];
#pragma unroll
        for (int j = 0; j < 2; ++j) {
            const int col = (lane + 64 * j) * 8;
            const u32x4 w = *(const u32x4*)(H1 + (size_t)t * D + col);
#pragma unroll
            for (int e = 0; e < 4; ++e) { v[j * 8 + 2 * e] = ALPHA * bflo(w[e]); v[j * 8 + 2 * e + 1] = ALPHA * bfhi(w[e]); }
#pragma unroll
            for (int k = 0; k < 9; ++k) {
                const u32x4 y = *(const u32x4*)(Y + ((size_t)t * 9 + k) * D + col);
#pragma unroll
                for (int e = 0; e < 4; ++e) { v[j * 8 + 2 * e] += bflo(y[e]); v[j * 8 + 2 * e + 1] += bfhi(y[e]); }
            }
        }
        float s = 0.f;
#pragma unroll
        for (int e = 0; e < 16; ++e) s += v[e];
        const float mean = wave_sum(s) * (1.f / D);
        float ss = 0.f;
#pragma unroll
        for (int e = 0; e < 16; ++e) { v[e] -= mean; ss += v[e] * v[e]; }
        const float rstd = rsqrtf(wave_sum(ss) * (1.f / D) + 1e-5f);
#pragma unroll
        for (int j = 0; j < 2; ++j) {
            const int col = (lane + 64 * j) * 8;
            f32x4 o0, o1;
#pragma unroll
            for (int e = 0; e < 4; ++e) { o0[e] = v[j * 8 + e] * rstd * p.ln2_g[col + e] + p.ln2_b[col + e]; o1[e] = v[j * 8 + 4 + e] * rstd * p.ln2_g[col + 4 + e] + p.ln2_b[col + 4 + e]; }
            *(f32x4*)(p.out + (size_t)t * D + col) = o0; *(f32x4*)(p.out + (size_t)t * D + col + 4) = o1;
        }
    }
}


#define XB_TMO      128
#define XB_XCNT(j)  (256  + 64 * (j))
#define XB_XSUB(j)  (1280 + 64 * (j))
#define XB_XGEN(j)  (2304 + 64 * (j))
#define XB_TOP      3328
#define XB_TOPGEN   3392
#define XB_SPIN_CAP (1u << 22)
__device__ __forceinline__ unsigned xb_ld(unsigned* p)              { return __hip_atomic_load(p, __ATOMIC_RELAXED, __HIP_MEMORY_SCOPE_AGENT); }
__device__ __forceinline__ unsigned xb_add(unsigned* p, unsigned v) { return __hip_atomic_fetch_add(p, v, __ATOMIC_RELAXED, __HIP_MEMORY_SCOPE_AGENT); }
__device__ __forceinline__ unsigned xb_xcc_id() { return (unsigned)__builtin_amdgcn_s_getreg((3 << 11) | 20) & 0xFu; }
#define XB_SPIN(cond, bar) do { unsigned _sp = 0; while (cond) { __builtin_amdgcn_s_sleep(1); \
    if ((++_sp & 255u) == 0u) { if (xb_ld(&(bar)[XB_TMO])) break; if (_sp > XB_SPIN_CAP) { atomicAdd(&(bar)[XB_TMO], 1u); break; } } } } while (0)
struct XcdBarrier { unsigned* bar; unsigned x; volatile LAS unsigned* st; };
__device__ __forceinline__ XcdBarrier xcd_barrier_post(unsigned* bar, volatile LAS unsigned* st) {
    XcdBarrier b; b.bar = bar; b.x = xb_xcc_id(); b.st = st;
    if (threadIdx.x == 0) (void)xb_add(&bar[XB_XCNT(b.x)], 1u);
    return b;
}
__device__ __forceinline__ void xcd_barrier_complete(unsigned* bar, unsigned x, unsigned& nloc, unsigned& nx) {
    const unsigned G = gridDim.x * gridDim.y * gridDim.z;
    unsigned sum, cnt, mine, sp = 0u;
    for (;;) {
        sum = 0u; cnt = 0u; mine = 0u;
#pragma unroll
        for (unsigned j = 0; j < 16; ++j) { const unsigned c = xb_ld(&bar[XB_XCNT(j)]); sum += c; cnt += (c > 0u) ? 1u : 0u; mine = (j == x) ? c : mine; }
        if (sum == G) break;
        __builtin_amdgcn_s_sleep(1);
        if ((++sp & 255u) == 0u) { if (xb_ld(&bar[XB_TMO])) break; if (sp > XB_SPIN_CAP) { atomicAdd(&bar[XB_TMO], 1u); break; } }
    }
    nloc = mine > 0u ? mine : 1u; nx = cnt > 0u ? cnt : 1u;
}
__device__ __forceinline__ void xcd_barrier(const XcdBarrier& b) {
    asm volatile("s_waitcnt vmcnt(0)" ::: "memory");
    __syncthreads();
    if (threadIdx.x == 0) {
        unsigned* bar = b.bar;
        __builtin_amdgcn_s_waitcnt(0);
        unsigned nloc = b.st[0], nx = b.st[1];
        if (nloc == 0u) { xcd_barrier_complete(bar, b.x, nloc, nx); b.st[0] = nloc; b.st[1] = nx; }
        const unsigned old = xb_add(&bar[XB_XSUB(b.x)], 1u);
        const unsigned gen = old / nloc;
        if (old + 1u == (gen + 1u) * nloc) {
            __builtin_amdgcn_fence(__ATOMIC_RELEASE, "agent");
            asm volatile("s_waitcnt vmcnt(0)" ::: "memory");
            const unsigned og = xb_add(&bar[XB_TOP], 1u);
            const unsigned tg = og / nx;
            if (og + 1u == (tg + 1u) * nx) xb_add(&bar[XB_TOPGEN], 1u);
            else XB_SPIN(xb_ld(&bar[XB_TOPGEN]) == tg, bar);
            __builtin_amdgcn_fence(__ATOMIC_ACQUIRE, "agent");
            xb_add(&bar[XB_XGEN(b.x)], 1u);
            asm volatile("s_waitcnt vmcnt(0)" ::: "memory");
        } else {
            XB_SPIN(xb_ld(&bar[XB_XGEN(b.x)]) == gen, bar);
            __builtin_amdgcn_fence(__ATOMIC_ACQUIRE, "agent");
            asm volatile("s_waitcnt vmcnt(0)" ::: "memory");
        }
    }
    __syncthreads();
}

template <int PH> __device__ __forceinline__ void run_phase(const Params& p, const Ctx& c) {
    if (PH == 0) phase0(p, c);
    if (PH == 1) phase1(p, c);
    if (PH == 2) phase2(p, c);
#if NAIVE_ATTN
    if (PH == 3) phase3_naive(p, c);
#else
    if (PH == 3) phase3(p, c);
#endif
    if (PH == 4) phase4(p, c);
    if (PH == 5) phase5a(p, c);
    if (PH == 6) phase5b(p, c);
    if (PH == 7) phase5c(p, c);
    if (PH == 8) phase6(p, c);
    if (PH == 9) phase7(p, c);
    if (PH == 10) phase8(p, c);
}
constexpr int NPHASES = 11;
__device__ __forceinline__ Ctx make_ctx(unsigned char* lds) {
    Ctx c; c.lds = (LAS unsigned char*)lds; c.tid = threadIdx.x; c.lane = c.tid & 63; c.wave = __builtin_amdgcn_readfirstlane(c.tid >> 6);
    c.G = gridDim.x; const int bx = blockIdx.x; c.vcu = (c.G % 8 == 0) ? (bx % 8) * (c.G / 8) + bx / 8 : bx;
    return c;
}
template <int PH> __global__ void __launch_bounds__(NTHREADS, 2) phase_kernel(Params p) {
    extern __shared__ __attribute__((aligned(16))) unsigned char lds[];
    const Ctx c = make_ctx(lds);
    run_phase<PH>(p, c);
}
#if MEGA
__global__ void __launch_bounds__(NTHREADS, 2) mega_kernel(Params p) {
    extern __shared__ __attribute__((aligned(16))) unsigned char lds[];
    const Ctx c = make_ctx(lds);
    cg::grid_group grid = cg::this_grid();
    volatile LAS unsigned* bst = (volatile LAS unsigned*)(c.lds + LDS_MISC + 8192);
    if (c.tid < 2) bst[c.tid] = 0u;
    __syncthreads();
    const XcdBarrier bar = xcd_barrier_post((unsigned*)(p.ws + WS_CTL + CT_BAR), bst);
    run_phase<0>(p, c); grid.sync();
    run_phase<1>(p, c); xcd_barrier(bar);
    run_phase<2>(p, c); xcd_barrier(bar);
    run_phase<3>(p, c); xcd_barrier(bar);
    run_phase<4>(p, c); xcd_barrier(bar);
    run_phase<5>(p, c); xcd_barrier(bar);
    run_phase<6>(p, c); xcd_barrier(bar);
    run_phase<7>(p, c); xcd_barrier(bar);
    run_phase<8>(p, c); xcd_barrier(bar);
    run_phase<9>(p, c); xcd_barrier(bar);
    run_phase<10>(p, c);
}

#endif
template <int PH> static void launch_phase(const Params& p, int grid, hipStream_t stream) {
    static bool attr = false;
    if (!attr) { (void)hipFuncSetAttribute((const void*)phase_kernel<PH>, hipFuncAttributeMaxDynamicSharedMemorySize, LDS_BYTES); attr = true; }
    hipLaunchKernelGGL(phase_kernel<PH>, dim3(grid), dim3(NTHREADS), LDS_BYTES, stream, p);
}

extern "C" void kernel_launch(void* const* d_in, const int* in_sizes, int n_in, void* d_out, int out_size, void* d_ws, size_t ws_size, hipStream_t stream) {
    if (n_in != 25 || ws_size < WS_END) { fprintf(stderr, "kernel_launch: unexpected n_in %d or ws_size %zu (need %zu)\n", n_in, ws_size, (size_t)WS_END); return; }
    Params p{};
    const float** pp = (const float**)&p;
    for (int i = 0; i < 25; ++i) pp[i] = (const float*)d_in[i];
    p.out = (float*)d_out; p.ws = (unsigned char*)d_ws;
    (void)hipMemsetAsync((char*)d_ws + WS_CTL, 0, CTL_BYTES, stream);
#if MEGA
    static int grid = 0;
    if (!grid) {
        int dev = 0, cus = 0, per_cu = 0;
        (void)hipGetDevice(&dev);
        (void)hipDeviceGetAttribute(&cus, hipDeviceAttributeMultiprocessorCount, dev);
        (void)hipFuncSetAttribute((const void*)mega_kernel, hipFuncAttributeMaxDynamicSharedMemorySize, LDS_BYTES);
        (void)hipOccupancyMaxActiveBlocksPerMultiprocessor(&per_cu, (const void*)mega_kernel, NTHREADS, LDS_BYTES);
        if (per_cu < 1) per_cu = 1;
        grid = cus;
        (void)per_cu;
    }
    void* args[] = {&p};
    hipError_t e = hipLaunchCooperativeKernel((const void*)mega_kernel, dim3(grid), dim3(NTHREADS), args, LDS_BYTES, stream);
    if (e != hipSuccess) fprintf(stderr, "cooperative launch failed: %s (grid %d)\n", hipGetErrorString(e), grid);
#else
    const int grid = 256;
#define LP(k) do { launch_phase<k>(p, grid, stream); if (REPEAT_PH == k) launch_phase<k>(p, grid, stream); } while (0)
    LP(0); LP(1); LP(2); LP(3); LP(4); LP(5); LP(6); LP(7); LP(8); LP(9); LP(10);
#undef LP
#endif
}
```

```cpp
#include <hip/hip_runtime.h>
#include <hip/hip_cooperative_groups.h>
#include <cstdint>
#include <cstdio>
namespace cg = cooperative_groups;

#ifndef NAIVE_GEMM
#define NAIVE_GEMM 0
#endif
#ifndef NAIVE_ATTN
#define NAIVE_ATTN 0
#endif
#ifndef REPEAT_PH
#define REPEAT_PH -1
#endif
#ifndef MEGA
#define MEGA 1
#endif

#define LAS __attribute__((address_space(3)))
typedef unsigned short bf16_t;
typedef short bf16x8 __attribute__((ext_vector_type(8)));
typedef float f32x4 __attribute__((ext_vector_type(4)));
typedef unsigned u32x4 __attribute__((ext_vector_type(4)));
typedef unsigned u32x2 __attribute__((ext_vector_type(2)));

constexpr int D = 1024, NBATCH = 8, SEQ = 2048, NMETA = 16, LPOS = SEQ + NMETA;
constexpr int NTOK = NBATCH * SEQ;
constexpr int NROWS = NTOK + NMETA;
constexpr int NROWSP = 16512;
constexpr int NH = 8, DQK = 96, DNOPE = 64, DROPE = 32, DV = 64;
constexpr int QLORA = 384, KVLORA = 256;
constexpr int ZC = 2304;
constexpr int ZQ = 0, ZKV = 384, ZKPE = 640, ZB = 704, ZCG = 1216, ZU = 1728;
constexpr int DIN = 2208;
constexpr int NEXP = 256, DEXP = 256, TOPK = 8, CAP = 16384;
constexpr float ALPHA = 1.189207115002721f;
constexpr float QSCALE = 0.10206207261596577f * 1.4426950408889634f;

constexpr int NTHREADS = 512, NWAVES = 8;
constexpr int LDS_BYTES = 147456;
constexpr int STAGE_BYTES = 49152;
constexpr int LDS_MISC = 2 * STAGE_BYTES;

constexpr size_t MiB = 1u << 20;
constexpr size_t WS_CTL = 0;
constexpr size_t CTL_BYTES = 1 * MiB;
constexpr size_t CT_CNT = 0;
constexpr size_t CT_BAR = 4096;
constexpr size_t CT_SSQ_Q = 32768;
constexpr size_t CT_SSQ_KV = CT_SSQ_Q + 66048;
constexpr size_t CT_SSQ_ATT = CT_SSQ_KV + 66048;
constexpr size_t CT_STATS1 = CT_SSQ_ATT + 65536;
static_assert(CT_STATS1 + 131072 <= CTL_BYTES, "ctl");
constexpr size_t WS_WIN = 1 * MiB;
constexpr size_t WS_WUQ = 6 * MiB;
constexpr size_t WS_WUKV = 7 * MiB;
constexpr size_t WS_WO = 8 * MiB;
constexpr size_t WS_WR = 10 * MiB;
constexpr size_t WS_WSGU = 11 * MiB;
constexpr size_t WS_WSD = 12 * MiB;
constexpr size_t WS_ROPE = 13 * MiB;
constexpr size_t WS_WGU = 14 * MiB;
constexpr size_t WS_WD = 270 * MiB;
constexpr size_t WS_H1 = 398 * MiB;
constexpr size_t WS_HID = 430 * MiB;
constexpr size_t WS_LAID = 502 * MiB;
constexpr size_t WS_LGATE = 518 * MiB;
constexpr size_t WS_Y = 534 * MiB;
constexpr size_t WS_Z = WS_Y;
constexpr size_t WS_H0 = WS_Y + 73 * MiB;
constexpr size_t WS_Q = WS_Y + 106 * MiB;
constexpr size_t WS_K = WS_Y + 130 * MiB;
constexpr size_t WS_V = WS_Y + 155 * MiB;
constexpr size_t WS_ATT = WS_Y + 172 * MiB;
constexpr size_t WS_CONV = WS_Y + 188 * MiB;
constexpr size_t WS_SSQC = WS_Y + 204 * MiB;
constexpr size_t WS_Y1 = WS_Y + 205 * MiB;
constexpr size_t WS_LOG = WS_Y + 237 * MiB;
constexpr size_t WS_PSQ = WS_Y + 253 * MiB;
constexpr size_t WS_PATT = WS_Y + 254 * MiB;
constexpr size_t WS_PST = WS_Y + 255 * MiB;
constexpr size_t WS_END = WS_Y + 288 * MiB;

struct Params {
    const float *x, *meta, *emb_g, *emb_b, *w_in, *q_norm, *w_uq, *kv_norm, *w_ukv, *conv_w, *attn_on, *conv_on, *w_o,
        *ln1_g, *ln1_b, *w_router, *router_bias, *w_gate, *w_up, *w_down, *ws_gate, *ws_up, *ws_down, *ln2_g, *ln2_b;
    float* out;
    unsigned char* ws;
};

__device__ __forceinline__ unsigned f2bf(float f) { unsigned u = __float_as_uint(f); return (u + 0x7fffu + ((u >> 16) & 1u)) >> 16; }
__device__ __forceinline__ unsigned pk2(float lo, float hi) { return f2bf(lo) | (f2bf(hi) << 16); }
__device__ __forceinline__ float bf2f(unsigned b) { return __uint_as_float(b << 16); }
__device__ __forceinline__ float bflo(unsigned w) { return __uint_as_float(w << 16); }
__device__ __forceinline__ float bfhi(unsigned w) { return __uint_as_float(w & 0xffff0000u); }
__device__ __forceinline__ float wave_sum(float v) {
#pragma unroll
    for (int o = 1; o < 64; o <<= 1) v += __shfl_xor(v, o);
    return v;
}
__device__ __forceinline__ float wave_max(float v) {
#pragma unroll
    for (int o = 1; o < 64; o <<= 1) v = fmaxf(v, __shfl_xor(v, o));
    return v;
}

struct Ctx {
    LAS unsigned char* lds;
    int tid, lane, wave, vcu, G;
};

template <class RowPtr>
__device__ __forceinline__ void gemm_kloop(f32x4 (&acc)[4][4], const Ctx& c, const RowPtr& rp, const bf16_t* Bt, long ldb, int K) {
    const int tid = c.tid, lane = c.lane, wid = c.wave, wr = wid >> 2, wc = wid & 3, fr = lane & 15, fq = lane >> 4;
#if NAIVE_GEMM
    const bf16_t* ar[4];
#pragma unroll
    for (int mi = 0; mi < 4; ++mi) ar[mi] = rp(wr * 64 + mi * 16 + fr);
    const bf16_t* br = Bt + (long)(wc * 64 + fq * 4) * ldb;
#pragma nounroll
    for (int k = 0; k < K; k += 2) {
        unsigned av[4];
#pragma unroll
        for (int mi = 0; mi < 4; ++mi) av[mi] = *(const unsigned*)(ar[mi] + k);
#pragma unroll
        for (int ni = 0; ni < 4; ++ni)
#pragma unroll
            for (int j = 0; j < 4; ++j) {
                const unsigned bv = *(const unsigned*)(br + (long)(ni * 16 + j) * ldb + k);
#pragma unroll
                for (int mi = 0; mi < 4; ++mi) acc[mi][ni][j] += bflo(av[mi]) * bflo(bv) + bfhi(av[mi]) * bfhi(bv);
            }
    }
#else
    LAS unsigned char* lds = c.lds;
    const int nt = K >> 6;
    const int srow = tid >> 3, sch = tid & 7;
    const bf16_t* ap0 = rp(srow) + sch * 8;
    const bf16_t* ap1 = rp(srow + 64) + sch * 8;
    const bf16_t* bp = Bt + (long)srow * ldb + sch * 8;
    const long bstep = 64 * ldb;
    const int so = srow * 128 + ((sch ^ ((srow >> 1) & 7)) << 4);
    u32x4 ra0, ra1, rb0, rb1, rb2, rb3;
#define G_LOAD(t) do { const int ko = (t) * 64; ra0 = *(const u32x4*)(ap0 + ko); ra1 = *(const u32x4*)(ap1 + ko); \
        rb0 = *(const u32x4*)(bp + ko); rb1 = *(const u32x4*)(bp + bstep + ko); rb2 = *(const u32x4*)(bp + 2 * bstep + ko); rb3 = *(const u32x4*)(bp + 3 * bstep + ko); } while (0)
#define G_STORE(buf) do { LAS unsigned char* sb = lds + (buf) * STAGE_BYTES; \
        *(LAS u32x4*)(sb + so) = ra0; *(LAS u32x4*)(sb + so + 8192) = ra1; \
        *(LAS u32x4*)(sb + 16384 + so) = rb0; *(LAS u32x4*)(sb + 16384 + so + 8192) = rb1; \
        *(LAS u32x4*)(sb + 16384 + so + 16384) = rb2; *(LAS u32x4*)(sb + 16384 + so + 24576) = rb3; } while (0)
    __syncthreads();
    G_LOAD(0);
    G_STORE(0);
    __syncthreads();
    const int sw0 = ((0 + fq) ^ ((fr >> 1) & 7)) << 4, sw1 = ((4 + fq) ^ ((fr >> 1) & 7)) << 4;
    const int aoff = (wr * 64 + fr) * 128, boff = 16384 + (wc * 64 + fr) * 128;
    for (int t = 0; t < nt; ++t) {
        if (t + 1 < nt) G_LOAD(t + 1);
        const LAS unsigned char* sb = lds + (t & 1) * STAGE_BYTES;
#pragma unroll
        for (int ks = 0; ks < 2; ++ks) {
            const int sw = ks ? sw1 : sw0;
            bf16x8 af[4], bfr[4];
#pragma unroll
            for (int mi = 0; mi < 4; ++mi) af[mi] = *(const LAS bf16x8*)(sb + aoff + mi * 2048 + sw);
#pragma unroll
            for (int ni = 0; ni < 4; ++ni) bfr[ni] = *(const LAS bf16x8*)(sb + boff + ni * 2048 + sw);
#pragma unroll
            for (int mi = 0; mi < 4; ++mi)
#pragma unroll
                for (int ni = 0; ni < 4; ++ni) acc[mi][ni] = __builtin_amdgcn_mfma_f32_16x16x32_bf16(bfr[ni], af[mi], acc[mi][ni], 0, 0, 0);
        }
        if (t + 1 < nt) G_STORE((t + 1) & 1);
        __syncthreads();
    }
#undef G_LOAD
#undef G_STORE
#endif
}
__device__ __forceinline__ void acc_zero(f32x4 (&acc)[4][4]) {
#pragma unroll
    for (int a = 0; a < 4; ++a)
#pragma unroll
        for (int b = 0; b < 4; ++b) acc[a][b] = (f32x4){0.f, 0.f, 0.f, 0.f};
}
__device__ __forceinline__ void store_bf4(bf16_t* p, f32x4 v) { u32x2 w; w.x = pk2(v[0], v[1]); w.y = pk2(v[2], v[3]); *(u32x2*)p = w; }

enum { MAP_ID = 0, MAP_WIN = 1, MAP_GATE = 2, MAP_UP = 3 };
template <int MAP> __device__ __forceinline__ int rowmap(int n) {
    if (MAP == MAP_WIN) return n < 672 ? n : n + 32;
    if (MAP == MAP_GATE) return 32 * (n >> 4) + (n & 15);
    if (MAP == MAP_UP) return 32 * (n >> 4) + 16 + (n & 15);
    return n;
}
template <int MAP>
__device__ __forceinline__ void transpose_item(const float* W, int K, int N, bf16_t* WT, const float* gain, LAS float* scr, int item, int lane) {
    const int nblk = N / 32, kb = item / nblk, nb = item % nblk, k0 = 64 * kb, n0 = 32 * nb;
#pragma unroll 8
    for (int i = 0; i < 32; ++i) {
        const int kk = 2 * i + (lane >> 5);
        float v = W[(size_t)(k0 + kk) * N + n0 + (lane & 31)];
        if (gain) v *= gain[k0 + kk];
        scr[kk * 33 + (lane & 31)] = v;
    }
    asm volatile("s_waitcnt lgkmcnt(0)" ::: "memory");
    const int ch = lane & 7;
#pragma unroll
    for (int j = 0; j < 4; ++j) {
        const int n = (lane >> 3) + 8 * j;
        const LAS float* s = scr + (8 * ch) * 33 + n;
        u32x4 o;
        o.x = pk2(s[0 * 33], s[1 * 33]); o.y = pk2(s[2 * 33], s[3 * 33]); o.z = pk2(s[4 * 33], s[5 * 33]); o.w = pk2(s[6 * 33], s[7 * 33]);
        *(u32x4*)(WT + (size_t)rowmap<MAP>(n0 + n) * K + k0 + 8 * ch) = o;
    }
    asm volatile("s_waitcnt lgkmcnt(0)" ::: "memory");
}
__device__ __forceinline__ void phase0(const Params& p, const Ctx& c) {
    unsigned char* ws = p.ws;
    LAS float* scr = (LAS float*)(c.lds + c.wave * 8704);
    const int gw = c.vcu * NWAVES + c.wave, NGW = c.G * NWAVES, lane = c.lane;
    bf16_t* H0 = (bf16_t*)(ws + WS_H0);
    for (int r = gw; r < NROWSP; r += NGW) {
        u32x2* o = (u32x2*)(H0 + (size_t)r * D) + lane;
        if (r >= NROWS) {
#pragma unroll
            for (int j = 0; j < 4; ++j) o[64 * j] = (u32x2){0u, 0u};
            continue;
        }
        const float* xr = r < NTOK ? p.x + (size_t)r * D : p.meta + (size_t)(r - NTOK) * D;
        f32x4 v[4]; float s = 0.f;
#pragma unroll
        for (int j = 0; j < 4; ++j) { v[j] = *((const f32x4*)xr + lane + 64 * j); s += (v[j][0] + v[j][1]) + (v[j][2] + v[j][3]); }
        const float mean = wave_sum(s) * (1.f / D);
        float s2 = 0.f;
#pragma unroll
        for (int j = 0; j < 4; ++j) { v[j] = v[j] - mean; s2 += (v[j][0] * v[j][0] + v[j][1] * v[j][1]) + (v[j][2] * v[j][2] + v[j][3] * v[j][3]); }
        const float rstd = 1.f / sqrtf(wave_sum(s2) * (1.f / D) + 1e-5f);
#pragma unroll
        for (int j = 0; j < 4; ++j) {
            const f32x4 g = *((const f32x4*)p.emb_g + lane + 64 * j), b = *((const f32x4*)p.emb_b + lane + 64 * j);
            const f32x4 y = v[j] * rstd * g + b;
            u32x2 w; w.x = pk2(y[0], y[1]); w.y = pk2(y[2], y[3]); o[64 * j] = w;
        }
    }
    {
        float* rope = (float*)(ws + WS_ROPE);
        for (int idx = gw * 64 + lane; idx < LPOS * 16; idx += NGW * 64) {
            const int pos = idx >> 4, i = idx & 15;
            const float inv = exp2f(-(float)i * (13.287712379549449f / 16.f));
            const float ang = (float)pos * inv;
            double rev = (double)ang * 0.15915494309189535; rev -= floor(rev);
            const float rf = (float)rev;
            rope[idx * 2 + 0] = __builtin_amdgcn_cosf(rf);
            rope[idx * 2 + 1] = __builtin_amdgcn_sinf(rf);
        }
    }
    {
        bf16_t* WinT = (bf16_t*)(ws + WS_WIN);
        for (int it = gw; it < 96; it += NGW) {
            const int row = it < 32 ? 672 + it : 2240 + (it - 32);
            u32x2* o = (u32x2*)(WinT + (size_t)row * D) + lane;
#pragma unroll
            for (int j = 0; j < 4; ++j) o[64 * j] = (u32x2){0u, 0u};
        }
    }
    constexpr int I_WIN = 16 * 69, I_UQ = 6 * 24, I_UKV = 4 * 32, I_WO = 16 * 32, I_WR = 16 * 8, I_SG = 128, I_SD = 128;
    constexpr int I_SMALL = I_WIN + I_UQ + I_UKV + I_WO + I_WR + 2 * I_SG + I_SD;
    constexpr int I_EXP = NEXP * 128;
    constexpr int NITEMS = I_WIN + I_UQ + I_UKV + I_WO + I_WR;
    for (int it = gw; it < NITEMS; it += NGW) {
        int r = it;
        if (r < I_WIN) { transpose_item<MAP_WIN>(p.w_in, D, DIN, (bf16_t*)(ws + WS_WIN), nullptr, scr, r, lane); continue; } r -= I_WIN;
        if (r < I_UQ) { transpose_item<MAP_ID>(p.w_uq, QLORA, 768, (bf16_t*)(ws + WS_WUQ), p.q_norm, scr, r, lane); continue; } r -= I_UQ;
        if (r < I_UKV) { transpose_item<MAP_ID>(p.w_ukv, KVLORA, 1024, (bf16_t*)(ws + WS_WUKV), p.kv_norm, scr, r, lane); continue; } r -= I_UKV;
        if (r < I_WO) {
            const int kb = r / 32;
            transpose_item<MAP_ID>(p.w_o, D, D, (bf16_t*)(ws + WS_WO), kb < 8 ? p.attn_on : p.conv_on - 512, scr, r, lane); continue; } r -= I_WO;
        if (r < I_WR) { transpose_item<MAP_ID>(p.w_router, D, 256, (bf16_t*)(ws + WS_WR), nullptr, scr, r, lane); continue; } r -= I_WR;
        if (r < I_SG) { transpose_item<MAP_GATE>(p.ws_gate, D, 256, (bf16_t*)(ws + WS_WSGU), nullptr, scr, r, lane); continue; } r -= I_SG;
        if (r < I_SG) { transpose_item<MAP_UP>(p.ws_up, D, 256, (bf16_t*)(ws + WS_WSGU), nullptr, scr, r, lane); continue; } r -= I_SG;
        if (r < I_SD) { transpose_item<MAP_ID>(p.ws_down, DEXP, D, (bf16_t*)(ws + WS_WSD), nullptr, scr, r, lane); continue; } r -= I_SD;
        if (r < I_EXP) { const int e = r >> 7; transpose_item<MAP_GATE>(p.w_gate + (size_t)e * D * DEXP, D, 256, (bf16_t*)(ws + WS_WGU) + (size_t)e * 512 * D, nullptr, scr, r & 127, lane); continue; } r -= I_EXP;
        if (r < I_EXP) { const int e = r >> 7; transpose_item<MAP_UP>(p.w_up + (size_t)e * D * DEXP, D, 256, (bf16_t*)(ws + WS_WGU) + (size_t)e * 512 * D, nullptr, scr, r & 127, lane); continue; } r -= I_EXP;
        { const int e = r >> 7; transpose_item<MAP_ID>(p.w_down + (size_t)e * DEXP * D, DEXP, D, (bf16_t*)(ws + WS_WD) + (size_t)e * D * DEXP, nullptr, scr, r & 127, lane); }
    }
}

__device__ __forceinline__ void phase1(const Params& p, const Ctx& c) {
    unsigned char* ws = p.ws;
    const bf16_t* H0 = (const bf16_t*)(ws + WS_H0); const bf16_t* WinT = (const bf16_t*)(ws + WS_WIN);
    bf16_t* Z = (bf16_t*)(ws + WS_Z);
    float* psq = (float*)(ws + WS_PSQ);
    const int lane = c.lane, wr = c.wave >> 2, wc = c.wave & 3, fr = lane & 15, fq = lane >> 4;
    constexpr int NU = 129 * 9;
    for (int u = c.vcu; u < NU; u += c.G) {
        const int mt = u / 9, nt = u % 9, row0 = mt * 128, n0 = nt * 256;
        f32x4 acc[4][4]; acc_zero(acc);
        auto rp = [&](int r) { return H0 + (size_t)(row0 + r) * D; };
        gemm_kloop(acc, c, rp, WinT + (size_t)n0 * D, D, D);
        const int s0 = n0 + wc * 64;
#pragma unroll
        for (int mi = 0; mi < 4; ++mi) {
            const int row = row0 + wr * 64 + mi * 16 + fr;
            float ss = 0.f;
#pragma unroll
            for (int ni = 0; ni < 4; ++ni) {
                const f32x4 v = acc[mi][ni];
                store_bf4(Z + (size_t)row * ZC + s0 + ni * 16 + fq * 4, v);
                ss += (v[0] * v[0] + v[1] * v[1]) + (v[2] * v[2] + v[3] * v[3]);
            }
            if (s0 < ZKPE) {
                ss += __shfl_xor(ss, 16); ss += __shfl_xor(ss, 32);
                if (fq == 0) psq[(size_t)row * 16 + (s0 >> 6)] = ss;
            }
        }
    }
}

__device__ __forceinline__ void phase2(const Params& p, const Ctx& c) {
    unsigned char* ws = p.ws;
    const bf16_t* Z = (const bf16_t*)(ws + WS_Z);
    const float* psq = (const float*)(ws + WS_PSQ);
    const float* rope = (const float*)(ws + WS_ROPE);
    bf16_t* Q = (bf16_t*)(ws + WS_Q); bf16_t* Kb = (bf16_t*)(ws + WS_K); bf16_t* Vb = (bf16_t*)(ws + WS_V);
    const int lane = c.lane, wr = c.wave >> 2, wc = c.wave & 3, fr = lane & 15, fq = lane >> 4;
    constexpr int NUQ = 128 * 3, NUKV = 129 * 4;
    for (int u = c.vcu; u < NUQ + NUKV; u += c.G) {
        f32x4 acc[4][4]; acc_zero(acc);
        if (u < NUQ) {
            const int mt = u / 3, nt = u % 3, row0 = mt * 128, n0 = nt * 256;
            auto rp = [&](int r) { return Z + (size_t)(row0 + r) * ZC + ZQ; };
            gemm_kloop(acc, c, rp, (const bf16_t*)(ws + WS_WUQ) + (size_t)n0 * QLORA, QLORA, QLORA);
            const int s0 = n0 + wc * 64;
#pragma unroll
            for (int mi = 0; mi < 4; ++mi) {
                const int row = row0 + wr * 64 + mi * 16 + fr;
                const f32x4 pa = *(const f32x4*)(psq + (size_t)row * 16), pb = *(const f32x4*)(psq + (size_t)row * 16 + 4);
                const float rq = rsqrtf((((pa[0] + pa[1]) + (pa[2] + pa[3])) + (pb[0] + pb[1])) * (1.f / QLORA) + 1e-6f) * QSCALE;
                const int pos = NMETA + (row & (SEQ - 1));
#pragma unroll
                for (int np = 0; np < 2; ++np) {
                    const int c0 = s0 + np * 32 + fq * 4;
                    f32x4 a = acc[mi][2 * np] * rq, b = acc[mi][2 * np + 1] * rq;
                    if (((s0 + np * 32) % 96) == 64) {
                        const f32x4 cs0 = *(const f32x4*)(rope + ((size_t)pos * 16 + fq * 4) * 2);
                        const f32x4 cs1 = *(const f32x4*)(rope + ((size_t)pos * 16 + fq * 4 + 2) * 2);
                        const float co[4] = {cs0[0], cs0[2], cs1[0], cs1[2]}, si[4] = {cs0[1], cs0[3], cs1[1], cs1[3]};
                        f32x4 na, nb;
#pragma unroll
                        for (int j = 0; j < 4; ++j) { na[j] = a[j] * co[j] - b[j] * si[j]; nb[j] = b[j] * co[j] + a[j] * si[j]; }
                        a = na; b = nb;
                    }
                    store_bf4(Q + (size_t)row * 768 + c0, a);
                    store_bf4(Q + (size_t)row * 768 + c0 + 16, b);
                }
            }
        } else {
            const int uu = u - NUQ, mt = uu / 4, nt = uu % 4, row0 = mt * 128, n0 = nt * 256;
            auto rp = [&](int r) { return Z + (size_t)(row0 + r) * ZC + ZKV; };
            gemm_kloop(acc, c, rp, (const bf16_t*)(ws + WS_WUKV) + (size_t)n0 * KVLORA, KVLORA, KVLORA);
            const int s0 = n0 + wc * 64;
            const int h = s0 >> 7; const bool isv = (s0 & 64) != 0;
#pragma unroll
            for (int mi = 0; mi < 4; ++mi) {
                const int row = row0 + wr * 64 + mi * 16 + fr;
                if (row >= NROWS) continue;
                const f32x4 pa = *(const f32x4*)(psq + (size_t)row * 16 + 4), pb = *(const f32x4*)(psq + (size_t)row * 16 + 8);
                const float rk = rsqrtf(((pa[2] + pa[3]) + (pb[0] + pb[1])) * (1.f / KVLORA) + 1e-6f);
                const int nb = row < NTOK ? 1 : NBATCH;
                const int b0 = row < NTOK ? (row >> 11) : 0, pos = row < NTOK ? NMETA + (row & (SEQ - 1)) : row - NTOK;
                for (int bb = 0; bb < nb; ++bb) {
                    const size_t prow = (size_t)(b0 + bb) * LPOS + pos;
#pragma unroll
                    for (int ni = 0; ni < 4; ++ni) {
                        const int d = ni * 16 + fq * 4;
                        const f32x4 v = acc[mi][ni] * rk;
                        if (isv) store_bf4(Vb + prow * 512 + h * 64 + d, v);
                        else store_bf4(Kb + prow * 768 + h * 96 + d, v);
                    }
                }
            }
        }
    }
    const int gw = c.vcu * NWAVES + c.wave, NGW = c.G * NWAVES;
    const bf16_t* Zc = Z;
    for (int row = gw; row < NROWS; row += NGW) {
        const int nb = row < NTOK ? 1 : NBATCH;
        const int b0 = row < NTOK ? (row >> 11) : 0, pos = row < NTOK ? NMETA + (row & (SEQ - 1)) : row - NTOK;
        if (lane < 16) {
            const float x1 = bf2f(Zc[(size_t)row * ZC + ZKPE + lane]), x2 = bf2f(Zc[(size_t)row * ZC + ZKPE + 16 + lane]);
            const float co = rope[((size_t)pos * 16 + lane) * 2], si = rope[((size_t)pos * 16 + lane) * 2 + 1];
            const bf16_t o1 = (bf16_t)f2bf(x1 * co - x2 * si), o2 = (bf16_t)f2bf(x2 * co + x1 * si);
            for (int bb = 0; bb < nb; ++bb) {
                bf16_t* kp = Kb + ((size_t)(b0 + bb) * LPOS + pos) * 768;
#pragma unroll
                for (int h = 0; h < NH; ++h) { kp[h * 96 + 64 + lane] = o1; kp[h * 96 + 80 + lane] = o2; }
            }
        }
        if (row < NTOK) {
            const int i = row & (SEQ - 1);
            const int r1 = i >= 1 ? row - 1 : NTOK + 15;
            const int r2 = i >= 2 ? row - 2 : (i == 1 ? NTOK + 15 : NTOK + 14);
            const int ch = lane * 8;
            const u32x4 c0 = *(const u32x4*)(Zc + (size_t)row * ZC + ZCG + ch), u0 = *(const u32x4*)(Zc + (size_t)row * ZC + ZU + ch);
            const u32x4 c1 = *(const u32x4*)(Zc + (size_t)r1 * ZC + ZCG + ch), u1 = *(const u32x4*)(Zc + (size_t)r1 * ZC + ZU + ch);
            const u32x4 c2 = *(const u32x4*)(Zc + (size_t)r2 * ZC + ZCG + ch), u2 = *(const u32x4*)(Zc + (size_t)r2 * ZC + ZU + ch);
            const u32x4 bg = *(const u32x4*)(Zc + (size_t)row * ZC + ZB + ch);
            float y[8]; float ss = 0.f;
#pragma unroll
            for (int e = 0; e < 4; ++e) {
#pragma unroll
                for (int hh = 0; hh < 2; ++hh) {
                    const int cc = ch + e * 2 + hh;
                    const float w0 = p.conv_w[cc], w1 = p.conv_w[512 + cc], w2 = p.conv_w[1024 + cc];
                    const float v0 = hh ? bfhi(c0[e]) * bfhi(u0[e]) : bflo(c0[e]) * bflo(u0[e]);
                    const float v1 = hh ? bfhi(c1[e]) * bfhi(u1[e]) : bflo(c1[e]) * bflo(u1[e]);
                    const float v2 = hh ? bfhi(c2[e]) * bfhi(u2[e]) : bflo(c2[e]) * bflo(u2[e]);
                    const float bgv = hh ? bfhi(bg[e]) : bflo(bg[e]);
                    const float yy = bgv * (w0 * v2 + w1 * v1 + w2 * v0);
                    y[e * 2 + hh] = yy; ss += yy * yy;
                }
            }
            ss = wave_sum(ss);
            u32x4 o; o.x = pk2(y[0], y[1]); o.y = pk2(y[2], y[3]); o.z = pk2(y[4], y[5]); o.w = pk2(y[6], y[7]);
            *(u32x4*)((bf16_t*)(ws + WS_CONV) + (size_t)row * 512 + ch) = o;
            if (lane == 0) ((float*)(ws + WS_SSQC))[row] = ss;
        }
    }
}

__device__ __forceinline__ void phase3_naive(const Params& p, const Ctx& c) {
    unsigned char* ws = p.ws;
    const bf16_t* Q = (const bf16_t*)(ws + WS_Q); const bf16_t* Kb = (const bf16_t*)(ws + WS_K); const bf16_t* Vb = (const bf16_t*)(ws + WS_V);
    bf16_t* ATT = (bf16_t*)(ws + WS_ATT); float* patt = (float*)(ws + WS_PATT);
    const int gw = c.vcu * NWAVES + c.wave, NGW = c.G * NWAVES, lane = c.lane;
    for (int it = gw; it < NTOK * NH; it += NGW) {
        const int row = it >> 3, h = it & 7, b = row >> 11, i = row & (SEQ - 1), nkeys = NMETA + i + 1;
        float q[96];
#pragma unroll
        for (int j = 0; j < 12; ++j) {
            const u32x4 w = *(const u32x4*)(Q + (size_t)row * 768 + h * 96 + j * 8);
#pragma unroll
            for (int e = 0; e < 4; ++e) { q[j * 8 + e * 2] = bflo(w[e]); q[j * 8 + e * 2 + 1] = bfhi(w[e]); }
        }
        float m = -INFINITY, l = 0.f; float o[64];
#pragma unroll
        for (int d = 0; d < 64; ++d) o[d] = 0.f;
        for (int kk = lane; kk < nkeys; kk += 64) {
            const bf16_t* kp = Kb + ((size_t)b * LPOS + kk) * 768 + h * 96;
            float s = 0.f;
#pragma unroll
            for (int j = 0; j < 12; ++j) {
                const u32x4 w = *(const u32x4*)(kp + j * 8);
#pragma unroll
                for (int e = 0; e < 4; ++e) { s += q[j * 8 + e * 2] * bflo(w[e]); s += q[j * 8 + e * 2 + 1] * bfhi(w[e]); }
            }
            const float mn = fmaxf(m, s), f = exp2f(m - mn), pe = exp2f(s - mn);
            l = l * f + pe; m = mn;
            const bf16_t* vp = Vb + ((size_t)b * LPOS + kk) * 512 + h * 64;
#pragma unroll
            for (int j = 0; j < 8; ++j) {
                const u32x4 w = *(const u32x4*)(vp + j * 8);
#pragma unroll
                for (int e = 0; e < 4; ++e) { o[j * 8 + e * 2] = o[j * 8 + e * 2] * f + pe * bflo(w[e]); o[j * 8 + e * 2 + 1] = o[j * 8 + e * 2 + 1] * f + pe * bfhi(w[e]); }
            }
        }
        const float M = wave_max(m);
        const float f = (m == -INFINITY) ? 0.f : exp2f(m - M);
        const float lt = wave_sum(l * f);
        float res = 0.f;
#pragma unroll
        for (int d = 0; d < 64; ++d) { const float v = wave_sum(o[d] * f); if (lane == d) res = v; }
        res /= lt;
        ATT[(size_t)row * 512 + h * 64 + lane] = (bf16_t)f2bf(res);
        const float ss = wave_sum(res * res);
        if (lane == 0) patt[(size_t)row * 8 + h] = ss;
    }
}


typedef float f32x16 __attribute__((ext_vector_type(16)));
typedef short s16x4 __attribute__((ext_vector_type(4)));
constexpr int AK_PITCH = 208, AK_BYTES = 64 * AK_PITCH, AV_BYTES = 8192, ASTAGE = AK_BYTES + AV_BYTES, A_WSF = 2 * ASTAGE;
__device__ __forceinline__ int crow(int r, int hi) { return (r & 3) + 8 * (r >> 2) + 4 * hi; }
__device__ __forceinline__ s16x4 vtr(const LAS unsigned char* p) {
    return __builtin_bit_cast(s16x4, __builtin_amdgcn_ds_read_tr16_b64_v4i16((LAS s16x4*)p));
}
__device__ __forceinline__ void attn_unit(const Params& p, const Ctx& c, int b, int h, int qb) {
    unsigned char* ws = p.ws;
    const bf16_t* Q = (const bf16_t*)(ws + WS_Q); const bf16_t* Kb = (const bf16_t*)(ws + WS_K); const bf16_t* Vb = (const bf16_t*)(ws + WS_V);
    bf16_t* ATT = (bf16_t*)(ws + WS_ATT); float* patt = (float*)(ws + WS_PATT);
    const int tid = c.tid, lane = c.lane, w = c.wave, r32 = lane & 31, hi = lane >> 5;
    LAS unsigned char* lds = c.lds;
    LAS float* wsf = (LAS float*)(lds + A_WSF) + w * 32;
    const int row0 = b * SEQ + qb * 256;
    const int qpos0 = NMETA + qb * 256 + w * 32, myq = qpos0 + r32;
    bf16x8 qf[6];
#pragma unroll
    for (int ds = 0; ds < 6; ++ds) qf[ds] = *(const bf16x8*)(Q + (size_t)(row0 + w * 32 + r32) * 768 + h * 96 + ds * 16 + hi * 8);
    const bf16_t* Kg = Kb + (size_t)b * LPOS * 768 + h * 96;
    const bf16_t* Vg = Vb + (size_t)b * LPOS * 512 + h * 64;
    const int T = 4 * qb + 5;
    const int tl = (qpos0 + 31) >> 6;
    const int k0row = tid / 12, k0ch = tid % 12, k1row = (512 + tid) / 12, k1ch = (512 + tid) % 12;
    const int vrow = tid >> 3, vch = tid & 7;
    const int k0off = k0row * AK_PITCH + k0ch * 16, k1off = k1row * AK_PITCH + k1ch * 16;
    const int voff = AK_BYTES + (vch >> 2) * 4096 + vrow * 64 + (vch & 3) * 16;
    u32x4 rk0, rk1, rv;
#define A_LOAD(t) do { const int kb_ = (t) * 64; \
        rk0 = *(const u32x4*)(Kg + (size_t)min(kb_ + k0row, LPOS - 1) * 768 + k0ch * 8); \
        if (tid < 256) rk1 = *(const u32x4*)(Kg + (size_t)min(kb_ + k1row, LPOS - 1) * 768 + k1ch * 8); \
        rv = *(const u32x4*)(Vg + (size_t)min(kb_ + vrow, LPOS - 1) * 512 + vch * 8); } while (0)
#define A_STORE(buf) do { LAS unsigned char* sb_ = lds + (buf) * ASTAGE; \
        *(LAS u32x4*)(sb_ + k0off) = rk0; if (tid < 256) *(LAS u32x4*)(sb_ + k1off) = rk1; *(LAS u32x4*)(sb_ + voff) = rv; } while (0)
    float m = -INFINITY, l = 0.f;
    f32x16 o0, o1;
#pragma unroll
    for (int r = 0; r < 16; ++r) { o0[r] = 0.f; o1[r] = 0.f; }
    const int kfo = r32 * AK_PITCH + hi * 16;
    const int vfo = AK_BYTES + ((lane >> 4) & 1) * 32 + (lane & 3) * 8 + (4 * hi + ((lane & 15) >> 2)) * 64;
    __syncthreads();
    A_LOAD(0);
    A_STORE(0);
    __syncthreads();
    for (int t = 0; t < T; ++t) {
        if (t + 1 < T) A_LOAD(t + 1);
        if (t <= tl) {
            const LAS unsigned char* sb = lds + (t & 1) * ASTAGE;
            f32x16 p0, p1;
#pragma unroll
            for (int r = 0; r < 16; ++r) { p0[r] = 0.f; p1[r] = 0.f; }
#pragma unroll
            for (int ds = 0; ds < 6; ++ds) {
                const bf16x8 a0 = *(const LAS bf16x8*)(sb + kfo + ds * 32);
                const bf16x8 a1 = *(const LAS bf16x8*)(sb + kfo + 32 * AK_PITCH + ds * 32);
                p0 = __builtin_amdgcn_mfma_f32_32x32x16_bf16(a0, qf[ds], p0, 0, 0, 0);
                p1 = __builtin_amdgcn_mfma_f32_32x32x16_bf16(a1, qf[ds], p1, 0, 0, 0);
            }
            if (t * 64 + 63 > qpos0) {
                const int kb0 = t * 64 + 4 * hi;
#pragma unroll
                for (int r = 0; r < 16; ++r) {
                    const int kv = kb0 + (r & 3) + 8 * (r >> 2);
                    if (kv > myq) p0[r] = -INFINITY;
                    if (kv + 32 > myq) p1[r] = -INFINITY;
                }
            }
            float mx = fmaxf(p0[0], p1[0]);
#pragma unroll
            for (int r = 1; r < 16; ++r) mx = fmaxf(mx, fmaxf(p0[r], p1[r]));
            mx = fmaxf(mx, __shfl_xor(mx, 32));
            if (__any(mx > m)) {
                const float mn = fmaxf(m, mx), alpha = __builtin_amdgcn_exp2f(m - mn);
                m = mn; l *= alpha;
                if (hi == 0) wsf[r32] = alpha;
                asm volatile("s_waitcnt lgkmcnt(0)" ::: "memory");
#pragma unroll
                for (int k = 0; k < 4; ++k) {
                    const f32x4 a = *(const LAS f32x4*)(wsf + 8 * k + 4 * hi);
#pragma unroll
                    for (int j = 0; j < 4; ++j) { o0[4 * k + j] *= a[j]; o1[4 * k + j] *= a[j]; }
                }
                asm volatile("s_waitcnt lgkmcnt(0)" ::: "memory");
            }
            float ls = 0.f;
#pragma unroll
            for (int r = 0; r < 16; ++r) { p0[r] = __builtin_amdgcn_exp2f(p0[r] - m); p1[r] = __builtin_amdgcn_exp2f(p1[r] - m); ls += p0[r] + p1[r]; }
            l += ls;
            bf16x8 pa[4];
#pragma unroll
            for (int s = 0; s < 4; ++s) {
                u32x4 wv;
#pragma unroll
                for (int e = 0; e < 4; ++e) {
                    const int r = 8 * (s & 1) + 2 * e;
                    wv[e] = (s >> 1) ? pk2(p1[r], p1[r + 1]) : pk2(p0[r], p0[r + 1]);
                }
                pa[s] = __builtin_bit_cast(bf16x8, wv);
            }
#pragma unroll
            for (int s = 0; s < 4; ++s) {
                const s16x4 l0 = vtr(sb + vfo + s * 1024), h0 = vtr(sb + vfo + s * 1024 + 512);
                const s16x4 l1 = vtr(sb + vfo + 4096 + s * 1024), h1 = vtr(sb + vfo + 4096 + s * 1024 + 512);
                const bf16x8 v0 = (bf16x8){l0[0], l0[1], l0[2], l0[3], h0[0], h0[1], h0[2], h0[3]};
                const bf16x8 v1 = (bf16x8){l1[0], l1[1], l1[2], l1[3], h1[0], h1[1], h1[2], h1[3]};
                o0 = __builtin_amdgcn_mfma_f32_32x32x16_bf16(pa[s], v0, o0, 0, 0, 0);
                o1 = __builtin_amdgcn_mfma_f32_32x32x16_bf16(pa[s], v1, o1, 0, 0, 0);
            }
        }
        if (t + 1 < T) A_STORE((t + 1) & 1);
        __syncthreads();
    }
#undef A_LOAD
#undef A_STORE
    l += __shfl_xor(l, 32);
    if (hi == 0) wsf[r32] = 1.f / l;
    asm volatile("s_waitcnt lgkmcnt(0)" ::: "memory");
    float sq[16];
#pragma unroll
    for (int k = 0; k < 4; ++k) {
        const f32x4 a = *(const LAS f32x4*)(wsf + 8 * k + 4 * hi);
#pragma unroll
        for (int j = 0; j < 4; ++j) {
            const int r = 4 * k + j;
            const float x0 = o0[r] * a[j], x1 = o1[r] * a[j];
            bf16_t* op = ATT + (size_t)(row0 + w * 32 + crow(r, hi)) * 512 + h * 64 + r32;
            op[0] = (bf16_t)f2bf(x0); op[32] = (bf16_t)f2bf(x1);
            sq[r] = x0 * x0 + x1 * x1;
        }
    }
#pragma unroll
    for (int r = 0; r < 16; ++r) {
        float v = sq[r];
#pragma unroll
        for (int o = 1; o < 32; o <<= 1) v += __shfl_xor(v, o);
        if (r32 == 0) patt[(size_t)(row0 + w * 32 + crow(r, hi)) * 8 + h] = v;
    }
    asm volatile("s_waitcnt lgkmcnt(0)" ::: "memory");
}
__device__ __forceinline__ void phase3(const Params& p, const Ctx& c) {
    for (int pi = c.vcu; pi < 256; pi += c.G) {
        const int bh = pi >> 2, s = pi & 3;
        attn_unit(p, c, bh >> 3, bh & 7, 7 - s);
        attn_unit(p, c, bh >> 3, bh & 7, s);
    }
}

__device__ __forceinline__ void phase4(const Params& p, const Ctx& c) {
    unsigned char* ws = p.ws;
    const bf16_t* ATT = (const bf16_t*)(ws + WS_ATT); const bf16_t* CONV = (const bf16_t*)(ws + WS_CONV);
    const bf16_t* WoT = (const bf16_t*)(ws + WS_WO); const bf16_t* H0 = (const bf16_t*)(ws + WS_H0);
    const float* patt = (const float*)(ws + WS_PATT); const float* ssq_c = (const float*)(ws + WS_SSQC);
    bf16_t* Y1 = (bf16_t*)(ws + WS_Y1); float* pst = (float*)(ws + WS_PST);
    const int lane = c.lane, wr = c.wave >> 2, wc = c.wave & 3, fr = lane & 15, fq = lane >> 4;
    constexpr int NU = 128 * 4;
    for (int u = c.vcu; u < NU; u += c.G) {
        const int mt = u >> 2, nt = u & 3, row0 = mt * 128, n0 = nt * 256;
        f32x4 acc[4][4]; acc_zero(acc);
        auto rpa = [&](int r) { return ATT + (size_t)(row0 + r) * 512; };
        gemm_kloop(acc, c, rpa, WoT + (size_t)n0 * D, D, 512);
        float rc[4];
#pragma unroll
        for (int mi = 0; mi < 4; ++mi) {
            const int row = row0 + wr * 64 + mi * 16 + fr;
            const f32x4 pa = *(const f32x4*)(patt + (size_t)row * 8), pb = *(const f32x4*)(patt + (size_t)row * 8 + 4);
            const float ra = rsqrtf((((pa[0] + pa[1]) + (pa[2] + pa[3])) + ((pb[0] + pb[1]) + (pb[2] + pb[3]))) * (1.f / 512) + 1e-6f);
            rc[mi] = rsqrtf(ssq_c[row] * (1.f / 512) + 1e-6f);
            const float f = ra / rc[mi];
#pragma unroll
            for (int ni = 0; ni < 4; ++ni) acc[mi][ni] = acc[mi][ni] * f;
        }
        auto rpc = [&](int r) { return CONV + (size_t)(row0 + r) * 512; };
        gemm_kloop(acc, c, rpc, WoT + (size_t)n0 * D + 512, D, 512);
        const int s0 = n0 + wc * 64;
#pragma unroll
        for (int mi = 0; mi < 4; ++mi) {
            const int row = row0 + wr * 64 + mi * 16 + fr;
            float s = 0.f, ss = 0.f;
#pragma unroll
            for (int ni = 0; ni < 4; ++ni) {
                const int col = s0 + ni * 16 + fq * 4;
                const u32x2 hw = *(const u32x2*)(H0 + (size_t)row * D + col);
                f32x4 v = acc[mi][ni] * rc[mi];
                v[0] += ALPHA * bflo(hw.x); v[1] += ALPHA * bfhi(hw.x); v[2] += ALPHA * bflo(hw.y); v[3] += ALPHA * bfhi(hw.y);
                store_bf4(Y1 + (size_t)row * D + col, v);
                s += (v[0] + v[1]) + (v[2] + v[3]);
                ss += (v[0] * v[0] + v[1] * v[1]) + (v[2] * v[2] + v[3] * v[3]);
            }
            s += __shfl_xor(s, 16); s += __shfl_xor(s, 32);
            ss += __shfl_xor(ss, 16); ss += __shfl_xor(ss, 32);
            if (fq == 0) { float* q = pst + ((size_t)row * 16 + nt * 4 + wc) * 2; q[0] = s; q[1] = ss; }
        }
    }
}

__device__ __forceinline__ void phase5a(const Params& p, const Ctx& c) {
    unsigned char* ws = p.ws;
    const bf16_t* Y1 = (const bf16_t*)(ws + WS_Y1); bf16_t* H1 = (bf16_t*)(ws + WS_H1); const float* pst = (const float*)(ws + WS_PST);
    const int gw = c.vcu * NWAVES + c.wave, NGW = c.G * NWAVES, lane = c.lane;
    for (int row = gw; row < NTOK; row += NGW) {
        float s1 = 0.f, s2 = 0.f;
#pragma unroll
        for (int k = 0; k < 16; ++k) { s1 += pst[((size_t)row * 16 + k) * 2]; s2 += pst[((size_t)row * 16 + k) * 2 + 1]; }
        const float mean = s1 * (1.f / D), var = fmaxf(s2 * (1.f / D) - mean * mean, 0.f), rstd = rsqrtf(var + 1e-5f);
#pragma unroll
        for (int j = 0; j < 2; ++j) {
            const int col = (lane + 64 * j) * 8;
            const u32x4 w = *(const u32x4*)(Y1 + (size_t)row * D + col);
            float y[8];
#pragma unroll
            for (int e = 0; e < 4; ++e) { y[2 * e] = bflo(w[e]); y[2 * e + 1] = bfhi(w[e]); }
#pragma unroll
            for (int e = 0; e < 8; ++e) y[e] = (y[e] - mean) * rstd * p.ln1_g[col + e] + p.ln1_b[col + e];
            u32x4 o; o.x = pk2(y[0], y[1]); o.y = pk2(y[2], y[3]); o.z = pk2(y[4], y[5]); o.w = pk2(y[6], y[7]);
            *(u32x4*)(H1 + (size_t)row * D + col) = o;
        }
    }
}
__device__ __forceinline__ void phase5b(const Params& p, const Ctx& c) {
    unsigned char* ws = p.ws;
    const bf16_t* H1 = (const bf16_t*)(ws + WS_H1); float* LOG = (float*)(ws + WS_LOG);
    const int lane = c.lane, wr = c.wave >> 2, wc = c.wave & 3, fr = lane & 15, fq = lane >> 4;
    for (int u = c.vcu; u < 128; u += c.G) {
        const int row0 = u * 128;
        f32x4 acc[4][4]; acc_zero(acc);
        auto rp = [&](int r) { return H1 + (size_t)(row0 + r) * D; };
        gemm_kloop(acc, c, rp, (const bf16_t*)(ws + WS_WR), D, D);
#pragma unroll
        for (int mi = 0; mi < 4; ++mi) {
            const int row = row0 + wr * 64 + mi * 16 + fr;
#pragma unroll
            for (int ni = 0; ni < 4; ++ni) *(f32x4*)(LOG + (size_t)row * 256 + wc * 64 + ni * 16 + fq * 4) = acc[mi][ni];
        }
    }
}
__device__ __forceinline__ void phase5c(const Params& p, const Ctx& c) {
    unsigned char* ws = p.ws;
    const float* LOG = (const float*)(ws + WS_LOG);
    unsigned* cnt = (unsigned*)(ws + WS_CTL + CT_CNT); unsigned* laid = (unsigned*)(ws + WS_LAID); float* lgate = (float*)(ws + WS_LGATE);
    const int gw = c.vcu * NWAVES + c.wave, NGW = c.G * NWAVES, lane = c.lane;
    const f32x4 bias = *((const f32x4*)p.router_bias + lane);
    for (int t = gw; t < NTOK; t += NGW) {
        const f32x4 lg = *((const f32x4*)(LOG + (size_t)t * 256) + lane);
        float s[4], sel[4];
#pragma unroll
        for (int i = 0; i < 4; ++i) { s[i] = 1.f / (1.f + expf(-lg[i])); sel[i] = s[i] + bias[i]; }
        float a = fmaxf(sel[0], sel[1]), b = fminf(sel[0], sel[1]), cc = fmaxf(sel[2], sel[3]), d = fminf(sel[2], sel[3]);
        float t1 = fmaxf(a, cc), t2 = fmaxf(fminf(a, cc), a >= cc ? b : d);
#pragma unroll
        for (int o = 1; o < 8; o <<= 1) {
            const float y1 = __shfl_xor(t1, o), y2 = __shfl_xor(t2, o);
            const float n1 = fmaxf(t1, y1), n2 = fmaxf(fminf(t1, y1), t1 >= y1 ? t2 : y2);
            t1 = n1; t2 = n2;
        }
        const float gs = t1 + t2; const int g = lane >> 3;
        int better = 0;
#pragma unroll
        for (int gg = 0; gg < 8; ++gg) { const float o = __shfl(gs, gg * 8); better += (o > gs || (o == gs && gg < g)) ? 1 : 0; }
        if (better >= 4) { sel[0] = sel[1] = sel[2] = sel[3] = -INFINITY; }
        int ek[8]; float sk[8]; float ssum = 0.f;
#pragma unroll
        for (int k = 0; k < 8; ++k) {
            float bv = sel[0]; int bi = 0;
            if (sel[1] > bv) { bv = sel[1]; bi = 1; }
            if (sel[2] > bv) { bv = sel[2]; bi = 2; }
            if (sel[3] > bv) { bv = sel[3]; bi = 3; }
            const float wm = wave_max(bv);
            const unsigned long long mask = __ballot(bv == wm);
            const int src = __ffsll((long long)mask) - 1;
            const float sb = bi == 0 ? s[0] : bi == 1 ? s[1] : bi == 2 ? s[2] : s[3];
            ek[k] = src * 4 + __shfl(bi, src); sk[k] = __shfl(sb, src); ssum += sk[k];
            if (lane == src) { if (bi == 0) sel[0] = -INFINITY; else if (bi == 1) sel[1] = -INFINITY; else if (bi == 2) sel[2] = -INFINITY; else sel[3] = -INFINITY; }
        }
        int me = ek[0]; float mg = sk[0];
#pragma unroll
        for (int k = 1; k < 8; ++k) if (lane == k) { me = ek[k]; mg = sk[k]; }
        if (lane < 8) {
            const unsigned pos = atomicAdd(cnt + me, 1u);
            laid[(size_t)me * CAP + pos] = (unsigned)(t * 8 + lane);
            lgate[(size_t)me * CAP + pos] = mg / ssum * 2.5f;
        }
    }
}

struct MoeTab { LAS int* tstart; LAS int* roff; LAS int* tok; LAS float* gate; };
__device__ __forceinline__ MoeTab moe_tab_build(const Params& p, const Ctx& c) {
    MoeTab T; T.tstart = (LAS int*)(c.lds + LDS_MISC); T.roff = T.tstart + 260; T.tok = T.roff + 260; T.gate = (LAS float*)(T.tok + 128);
    const unsigned* cnt = (const unsigned*)(p.ws + WS_CTL + CT_CNT);
    __syncthreads();
    if (c.tid < 64) {
        int cv[4], tv[4]; int ls = 0, lt = 0;
#pragma unroll
        for (int i = 0; i < 4; ++i) { cv[i] = (int)cnt[c.tid * 4 + i]; tv[i] = (cv[i] + 127) >> 7; ls += cv[i]; lt += tv[i]; }
        int ps = ls, pt = lt;
#pragma unroll
        for (int o = 1; o < 64; o <<= 1) { const int a = __shfl_up(ps, o), b = __shfl_up(pt, o); if (c.tid >= o) { ps += a; pt += b; } }
        int es = ps - ls, et = pt - lt;
#pragma unroll
        for (int i = 0; i < 4; ++i) { T.roff[c.tid * 4 + i] = es; T.tstart[c.tid * 4 + i] = et; es += cv[i]; et += tv[i]; }
        if (c.tid == 63) { T.roff[256] = es; T.tstart[256] = et; }
    }
    __syncthreads();
    return T;
}
__device__ __forceinline__ int moe_find(const MoeTab& T, int g) {
    int lo = 0, hi = 255;
    while (lo < hi) { const int mid = (lo + hi + 1) >> 1; if (T.tstart[mid] <= g) lo = mid; else hi = mid - 1; }
    return lo;
}

__device__ __forceinline__ void phase6(const Params& p, const Ctx& c) {
    unsigned char* ws = p.ws;
    const bf16_t* H1 = (const bf16_t*)(ws + WS_H1); bf16_t* HID = (bf16_t*)(ws + WS_HID);
    const unsigned* laid = (const unsigned*)(ws + WS_LAID);
    const unsigned* cnt = (const unsigned*)(ws + WS_CTL + CT_CNT);
    const int lane = c.lane, wr = c.wave >> 2, wc = c.wave & 3, fr = lane & 15, fq = lane >> 4;
    const MoeTab T = moe_tab_build(p, c);
    const int tmt = T.tstart[256], NU = (tmt + 128) * 2;
    for (int u = c.vcu; u < NU; u += c.G) {
        const int g = u >> 1, nt = u & 1;
        int e, mt, nrows; size_t hbase;
        __syncthreads();
        if (g < tmt) {
            e = moe_find(T, g); mt = g - T.tstart[e]; nrows = min(128, (int)cnt[e] - mt * 128); hbase = (size_t)T.roff[e] + mt * 128;
            if (c.tid < 128) T.tok[c.tid] = (int)(laid[(size_t)e * CAP + mt * 128 + min(c.tid, nrows - 1)] >> 3);
        } else {
            e = NEXP; mt = g - tmt; nrows = 128; hbase = (size_t)NTOK * 8 + mt * 128;
            if (c.tid < 128) T.tok[c.tid] = mt * 128 + c.tid;
        }
        __syncthreads();
        f32x4 acc[4][4]; acc_zero(acc);
        auto rp = [&](int r) { return H1 + (size_t)T.tok[r] * D; };
        const bf16_t* Bt = (e < NEXP ? (const bf16_t*)(ws + WS_WGU) + (size_t)e * 512 * D : (const bf16_t*)(ws + WS_WSGU)) + (size_t)nt * 256 * D;
        gemm_kloop(acc, c, rp, Bt, D, D);
#pragma unroll
        for (int mi = 0; mi < 4; ++mi) {
            const int r = wr * 64 + mi * 16 + fr;
            if (r >= nrows) continue;
#pragma unroll
            for (int np = 0; np < 2; ++np) {
                const f32x4 gt = acc[mi][2 * np], up = acc[mi][2 * np + 1];
                f32x4 hv;
#pragma unroll
                for (int j = 0; j < 4; ++j) hv[j] = gt[j] / (1.f + __expf(-gt[j])) * up[j];
                store_bf4(HID + (hbase + r) * DEXP + nt * 128 + wc * 32 + np * 16 + fq * 4, hv);
            }
        }
    }
}
__device__ __forceinline__ void phase7(const Params& p, const Ctx& c) {
    unsigned char* ws = p.ws;
    const bf16_t* HID = (const bf16_t*)(ws + WS_HID); bf16_t* Y = (bf16_t*)(ws + WS_Y);
    const unsigned* laid = (const unsigned*)(ws + WS_LAID); const float* lgate = (const float*)(ws + WS_LGATE);
    const unsigned* cnt = (const unsigned*)(ws + WS_CTL + CT_CNT);
    const int lane = c.lane, wr = c.wave >> 2, wc = c.wave & 3, fr = lane & 15, fq = lane >> 4;
    const MoeTab T = moe_tab_build(p, c);
    const int tmt = T.tstart[256], NU = (tmt + 128) * 4;
    for (int u = c.vcu; u < NU; u += c.G) {
        const int g = u >> 2, nt = u & 3;
        int e, mt, nrows; size_t hbase;
        __syncthreads();
        if (g < tmt) {
            e = moe_find(T, g); mt = g - T.tstart[e]; nrows = min(128, (int)cnt[e] - mt * 128); hbase = (size_t)T.roff[e] + mt * 128;
            if (c.tid < 128) {
                const int rr = min(c.tid, nrows - 1);
                const unsigned aid = laid[(size_t)e * CAP + mt * 128 + rr];
                T.tok[c.tid] = (int)((aid >> 3) * 9 + (aid & 7)); T.gate[c.tid] = lgate[(size_t)e * CAP + mt * 128 + rr];
            }
        } else {
            e = NEXP; mt = g - tmt; nrows = 128; hbase = (size_t)NTOK * 8 + mt * 128;
            if (c.tid < 128) { T.tok[c.tid] = (mt * 128 + c.tid) * 9 + 8; T.gate[c.tid] = 1.f; }
        }
        __syncthreads();
        f32x4 acc[4][4]; acc_zero(acc);
        auto rp = [&](int r) { return HID + (hbase + min(r, nrows - 1)) * DEXP; };
        const bf16_t* Bt = (e < NEXP ? (const bf16_t*)(ws + WS_WD) + (size_t)e * D * DEXP : (const bf16_t*)(ws + WS_WSD)) + (size_t)nt * 256 * DEXP;
        gemm_kloop(acc, c, rp, Bt, DEXP, DEXP);
#pragma unroll
        for (int mi = 0; mi < 4; ++mi) {
            const int r = wr * 64 + mi * 16 + fr;
            if (r >= nrows) continue;
            const float gt = T.gate[r]; const size_t yrow = (size_t)T.tok[r];
#pragma unroll
            for (int ni = 0; ni < 4; ++ni) store_bf4(Y + yrow * D + nt * 256 + wc * 64 + ni * 16 + fq * 4, acc[mi][ni] * gt);
        }
    }
}

__device__ __forceinline__ int moe_find_l(const LAS int* tstart, int g) {
    int lo = 0, hi = 255;
    while (lo < hi) { const int mid = (lo + hi + 1) >> 1; if (tstart[mid] <= g) lo = mid; else hi = mid - 1; }
    return lo;
}

typedef float f32x2 __attribute__((ext_vector_type(2)));
typedef __bf16 bf16x2_t __attribute__((ext_vector_type(2)));
__device__ __forceinline__ unsigned cvtpk(float lo, float hi) { f32x2 v = {lo, hi}; bf16x2_t b = __builtin_convertvector(v, bf16x2_t); return __builtin_bit_cast(unsigned, b); }
constexpr int MOE_A = 0, MOE_B = 32768, MOE_H0 = 98304, MOE_H1 = 0, MOE_MISC = 131072;
struct MoeUnit { const float* wg; const float* wu; const float* wd; int nrows; int par; };

__device__ __forceinline__ void phase_moe(const Params& p, const Ctx& c) {
    unsigned char* ws = p.ws;
    const bf16_t* H1 = (const bf16_t*)(ws + WS_H1); bf16_t* Y = (bf16_t*)(ws + WS_Y);
    const unsigned* laid = (const unsigned*)(ws + WS_LAID); const float* lgate = (const float*)(ws + WS_LGATE);
    const unsigned* cnt = (const unsigned*)(ws + WS_CTL + CT_CNT);
    const int tid = c.tid, lane = c.lane, wr = c.wave >> 2, wc = c.wave & 3, fr = lane & 15, fq = lane >> 4;
    LAS unsigned char* lds = c.lds;
    LAS int* tstart = (LAS int*)(lds + MOE_MISC); LAS int* cntl = tstart + 260;
    LAS int* tokT = cntl + 260; LAS int* yrowT = tokT + 256; LAS float* gateT = (LAS float*)(yrowT + 256);
    __syncthreads();
    if (tid < 64) {
        int cv[4], tv[4]; int lt = 0;
#pragma unroll
        for (int i = 0; i < 4; ++i) { cv[i] = (int)cnt[tid * 4 + i]; tv[i] = (cv[i] + 127) >> 7; lt += tv[i]; }
        int pt = lt;
#pragma unroll
        for (int o = 1; o < 64; o <<= 1) { const int b = __shfl_up(pt, o); if (tid >= o) pt += b; }
        int et = pt - lt;
#pragma unroll
        for (int i = 0; i < 4; ++i) { cntl[tid * 4 + i] = cv[i]; tstart[tid * 4 + i] = et; et += tv[i]; }
        if (tid == 63) tstart[256] = et;
    }
    __syncthreads();
    const int tmt = tstart[256], NU = tmt + 128;
    if (c.vcu >= NU) return;

    const int srow = tid >> 3, sch = tid & 7;
    const int soA = srow * 128 + ((sch ^ ((srow >> 1) & 7)) << 4);
    const int kk1 = tid >> 5, n4 = tid & 31;
    const int s1 = (kk1 & 3) | (((kk1 >> 3) & 1) << 2);
    const int soB1g = kk1 * 512 + (((2 * (n4 >> 2)) ^ s1) << 5) + (n4 & 3) * 8;
    const int soB1u = kk1 * 512 + (((2 * (n4 >> 2) + 1) ^ s1) << 5) + (n4 & 3) * 8;
    const int kk2 = tid >> 6, c4 = tid & 63;
    const int soB2e = kk2 * 512 + ((((c4 >> 2)) ^ (kk2 & 3)) << 5) + (c4 & 3) * 8;
    const int soB2o = kk2 * 512 + ((((c4 >> 2)) ^ ((kk2 & 3) | 4)) << 5) + (c4 & 3) * 8;
    const int sw0 = ((0 + fq) ^ ((fr >> 1) & 7)) << 4, sw1 = ((4 + fq) ^ ((fr >> 1) & 7)) << 4;
    const int aoff = (wr * 64 + fr) * 128;
    const int qp = fr >> 2, pp = fr & 3, sB = qp | ((fq & 1) << 2);
    const int brow = (8 * fq + qp) * 512 + pp * 8;
    int bblk[4];
#pragma unroll
    for (int ni = 0; ni < 4; ++ni) bblk[ni] = ((4 * wc + ni) ^ sB) << 5;
    const int hoff = (wr * 64 + fr) * 256;

    const unsigned lo1 = (unsigned)(kk1 * 256 + n4 * 4), lo2 = (unsigned)(kk2 * D + c4 * 4);
    u32x4 ra0, ra1; f32x4 rb[8];
    f32x4 acc[4][4];

#define M_LOAD1(U, nt, kt) do { \
        const int t0_ = tokT[(U).par * 128 + srow], t1_ = tokT[(U).par * 128 + srow + 64]; \
        ra0 = *(const u32x4*)(H1 + (size_t)t0_ * D + (kt) * 64 + sch * 8); ra1 = *(const u32x4*)(H1 + (size_t)t1_ * D + (kt) * 64 + sch * 8); \
        const float* g_ = (U).wg + ((kt) * 64 * 256 + (nt) * 128); const float* u_ = (U).wu + ((kt) * 64 * 256 + (nt) * 128); \
        _Pragma("unroll") for (int j = 0; j < 4; ++j) { rb[j] = *(const f32x4*)(g_ + j * 4096 + lo1); rb[4 + j] = *(const f32x4*)(u_ + j * 4096 + lo1); } } while (0)
#define M_STORE1(buf) do { LAS unsigned char* sa_ = lds + MOE_A + (buf) * 16384; LAS unsigned char* sb_ = lds + MOE_B + (buf) * 32768; \
        *(LAS u32x4*)(sa_ + soA) = ra0; *(LAS u32x4*)(sa_ + soA + 8192) = ra1; \
        _Pragma("unroll") for (int j = 0; j < 4; ++j) { \
            *(LAS u32x2*)(sb_ + soB1g + j * 8192) = (u32x2){cvtpk(rb[j][0], rb[j][1]), cvtpk(rb[j][2], rb[j][3])}; \
            *(LAS u32x2*)(sb_ + soB1u + j * 8192) = (u32x2){cvtpk(rb[4 + j][0], rb[4 + j][1]), cvtpk(rb[4 + j][2], rb[4 + j][3])}; } } while (0)
#define M_LOAD2(U, nt2, ksm) do { \
        const float* d_ = (U).wd + ((ksm) * 64 * D + (nt2) * 256); \
        _Pragma("unroll") for (int j = 0; j < 8; ++j) rb[j] = *(const f32x4*)(d_ + j * 8192 + lo2); } while (0)
#define M_STORE2(buf) do { LAS unsigned char* sb_ = lds + MOE_B + (buf) * 32768; \
        _Pragma("unroll") for (int j = 0; j < 8; ++j) \
            *(LAS u32x2*)(sb_ + ((j & 1) ? soB2o : soB2e) + j * 4096) = (u32x2){cvtpk(rb[j][0], rb[j][1]), cvtpk(rb[j][2], rb[j][3])}; } while (0)
#define M_BFRAG(dst, sbB, ks) do { _Pragma("unroll") for (int ni = 0; ni < 4; ++ni) { \
            const s16x4 lo_ = vtr((sbB) + brow + (ks) * 16384 + bblk[ni]), hi_ = vtr((sbB) + brow + (ks) * 16384 + 2048 + bblk[ni]); \
            dst[ni] = (bf16x8){lo_[0], lo_[1], lo_[2], lo_[3], hi_[0], hi_[1], hi_[2], hi_[3]}; } } while (0)
#define M_COMPUTE1(buf) do { const LAS unsigned char* sa_ = lds + MOE_A + (buf) * 16384; const LAS unsigned char* sbb_ = lds + MOE_B + (buf) * 32768; \
        _Pragma("unroll") for (int ks = 0; ks < 2; ++ks) { bf16x8 af[4], bfr[4]; \
            _Pragma("unroll") for (int mi = 0; mi < 4; ++mi) af[mi] = *(const LAS bf16x8*)(sa_ + aoff + mi * 2048 + (ks ? sw1 : sw0)); \
            M_BFRAG(bfr, sbb_, ks); \
            _Pragma("unroll") for (int mi = 0; mi < 4; ++mi) _Pragma("unroll") for (int ni = 0; ni < 4; ++ni) \
                acc[mi][ni] = __builtin_amdgcn_mfma_f32_16x16x32_bf16(bfr[ni], af[mi], acc[mi][ni], 0, 0, 0); } } while (0)
#define M_COMPUTE2(buf, ksm) do { const LAS unsigned char* sh_ = lds + (((ksm) >> 1) ? MOE_H1 : MOE_H0); const LAS unsigned char* sbb_ = lds + MOE_B + (buf) * 32768; \
        _Pragma("unroll") for (int ks = 0; ks < 2; ++ks) { bf16x8 af[4], bfr[4]; \
            _Pragma("unroll") for (int mi = 0; mi < 4; ++mi) af[mi] = *(const LAS bf16x8*)(sh_ + hoff + mi * 4096 + (((((ksm) & 1) * 8 + ks * 4 + fq) ^ fr) << 4)); \
            M_BFRAG(bfr, sbb_, ks); \
            _Pragma("unroll") for (int mi = 0; mi < 4; ++mi) _Pragma("unroll") for (int ni = 0; ni < 4; ++ni) \
                acc[mi][ni] = __builtin_amdgcn_mfma_f32_16x16x32_bf16(bfr[ni], af[mi], acc[mi][ni], 0, 0, 0); } } while (0)

    auto unit_make = [&](int u, int par, MoeUnit& U, int& e, int& mt) {
        if (u < tmt) { e = moe_find_l(tstart, u); mt = u - tstart[e]; U.nrows = min(128, cntl[e] - mt * 128);
            U.wg = p.w_gate + (size_t)e * D * DEXP; U.wu = p.w_up + (size_t)e * D * DEXP; U.wd = p.w_down + (size_t)e * D * DEXP; }
        else { e = NEXP; mt = u - tmt; U.nrows = 128; U.wg = p.ws_gate; U.wu = p.ws_up; U.wd = p.ws_down; }
        U.par = par;
    };
    auto unit_tables = [&](const MoeUnit& U, int e, int mt) {
        if (tid < 128) {
            int tok, yr; float gt;
            if (e < NEXP) { const int rr = min(tid, U.nrows - 1); const unsigned aid = laid[(size_t)e * CAP + mt * 128 + rr];
                tok = (int)(aid >> 3); yr = tok * 9 + (int)(aid & 7); gt = lgate[(size_t)e * CAP + mt * 128 + rr]; }
            else { tok = mt * 128 + tid; yr = tok * 9 + 8; gt = 1.f; }
            tokT[U.par * 128 + tid] = tok; yrowT[U.par * 128 + tid] = yr; gateT[U.par * 128 + tid] = gt;
        }
    };

    MoeUnit cur, nxt; int e_, mt_;
    unit_make(c.vcu, 0, cur, e_, mt_);
    unit_tables(cur, e_, mt_);
    __syncthreads();
    M_LOAD1(cur, 0, 0);
    M_STORE1(0);
    __syncthreads();
    for (int u = c.vcu, ui = 0; u < NU; u += c.G, ++ui) {
        const bool has_next = (u + c.G) < NU;
#pragma unroll 1
        for (int nt = 0; nt < 2; ++nt) {
            acc_zero(acc);
#pragma unroll 1
            for (int kt = 0; kt < 16; ++kt) {
                const bool last = (kt == 15);
                if (!last) M_LOAD1(cur, nt, kt + 1);
                else if (nt == 0) M_LOAD1(cur, 1, 0);
                else M_LOAD2(cur, 0, 2);
                M_COMPUTE1(kt & 1);
                if (!(last && nt == 1)) M_STORE1((kt + 1) & 1); else M_STORE2(0);
                __syncthreads();
            }
            {
                LAS unsigned char* hb = lds + (nt ? MOE_H1 : MOE_H0);
#pragma unroll
                for (int mi = 0; mi < 4; ++mi) {
                    const int r = wr * 64 + mi * 16 + fr;
#pragma unroll
                    for (int np = 0; np < 2; ++np) {
                        const f32x4 gt = acc[mi][2 * np], up = acc[mi][2 * np + 1];
                        float hv[4];
#pragma unroll
                        for (int j = 0; j < 4; ++j) hv[j] = gt[j] / (1.f + __expf(-gt[j])) * up[j];
                        const int chunk = wc * 4 + np * 2 + (fq >> 1);
                        *(LAS u32x2*)(hb + r * 256 + ((chunk ^ fr) << 4) + (fq & 1) * 8) = (u32x2){cvtpk(hv[0], hv[1]), cvtpk(hv[2], hv[3])};
                    }
                }
            }
            if (nt == 1) __syncthreads();
        }
#pragma unroll 1
        for (int nt2 = 0; nt2 < 4; ++nt2) {
            acc_zero(acc);
            if (nt2 == 0 && has_next) { unit_make(u + c.G, (ui + 1) & 1, nxt, e_, mt_); unit_tables(nxt, e_, mt_); }
#pragma unroll 1
            for (int kq = 0; kq < 4; ++kq) {
                const int ksm = kq ^ 2;
                const bool last = (kq == 3);
                if (!last) M_LOAD2(cur, nt2, (kq + 1) ^ 2);
                else if (nt2 < 3) M_LOAD2(cur, nt2 + 1, 2);
                else if (has_next) M_LOAD1(nxt, 0, 0);
                M_COMPUTE2(kq & 1, ksm);
                if (!(last && nt2 == 3)) M_STORE2((kq + 1) & 1); else if (has_next) M_STORE1(0);
                __syncthreads();
            }
#pragma unroll
            for (int mi = 0; mi < 4; ++mi) {
                const int r = wr * 64 + mi * 16 + fr;
                if (r < cur.nrows) {
                    const float gt = gateT[cur.par * 128 + r]; const size_t yrow = (size_t)yrowT[cur.par * 128 + r];
#pragma unroll
                    for (int ni = 0; ni < 4; ++ni) store_bf4(Y + yrow * D + nt2 * 256 + wc * 64 + ni * 16 + fq * 4, acc[mi][ni] * gt);
                }
            }
        }
        cur = nxt;
    }
#undef M_LOAD1
#undef M_STORE1
#undef M_LOAD2
#undef M_STORE2
#undef M_BFRAG
#undef M_COMPUTE1
#undef M_COMPUTE2
}


__device__ __forceinline__ void store_strip_bf16(bf16_t* p, const f32x4 (&v)[4], int fq, bool pred = true) {
    unsigned x[4], y[4];
#pragma unroll
    for (int ni = 0; ni < 4; ++ni) { x[ni] = cvtpk(v[ni][0], v[ni][1]); y[ni] = cvtpk(v[ni][2], v[ni][3]); }
#define SWAP32(a, b) do { auto r_ = __builtin_amdgcn_permlane32_swap(a, b, false, false); a = r_[0]; b = r_[1]; } while (0)
#define SWAP16(a, b) do { auto r_ = __builtin_amdgcn_permlane16_swap(a, b, false, false); a = r_[0]; b = r_[1]; } while (0)
    SWAP32(x[0], x[2]); SWAP32(y[0], y[2]); SWAP32(x[1], x[3]); SWAP32(y[1], y[3]);
    SWAP16(x[0], x[1]); SWAP16(y[0], y[1]); SWAP16(x[2], x[3]); SWAP16(y[2], y[3]);
#undef SWAP32
#undef SWAP16
    u32x4 lo = {x[0], y[0], x[1], y[1]}, hi = {x[2], y[2], x[3], y[3]};
    if (pred) { *(u32x4*)(p + fq * 16) = lo; *(u32x4*)(p + fq * 16 + 8) = hi; }
}

constexpr int G2_A = 0, G2_B = 65536, G2_MISC = 131072;
constexpr int G2_GATE = G2_MISC + 4096, G2_YROW = G2_GATE + 2048, G2_TAB = G2_YROW + 2048;
constexpr int BM_BF16T = 0, BM_F32 = 1, BM_F32_GU = 2;
struct G2Unit { const void* b0; const void* b1; int ldb; int nsteps; int nrows; int par; int i0, i1, i2; };

template <int BMODE, class Sched, class Epi>
__device__ __forceinline__ void gemm256_stream(const Ctx& c, Sched& S, const Epi& E) {
    const int tid = c.tid, lane = c.lane, wr = c.wave >> 2, wc = c.wave & 3, fr = lane & 15, fq = lane >> 4;
    LAS unsigned char* lds = c.lds;
    const LAS unsigned long long* rowT = (const LAS unsigned long long*)(lds + G2_MISC);
    const int srow = tid >> 3, sch = tid & 7;
    const int soA = srow * 128 + ((sch ^ ((srow >> 1) & 7)) << 4);
    const int kk1 = tid >> 5, n4 = tid & 31;
    const int s1 = (kk1 & 3) | (((kk1 >> 3) & 1) << 2);
    const int soB1g = kk1 * 512 + (((2 * (n4 >> 2)) ^ s1) << 5) + (n4 & 3) * 8;
    const int soB1u = kk1 * 512 + (((2 * (n4 >> 2) + 1) ^ s1) << 5) + (n4 & 3) * 8;
    const int kk2 = tid >> 6, c4 = tid & 63;
    const int soB2e = kk2 * 512 + ((((c4 >> 2)) ^ (kk2 & 3)) << 5) + (c4 & 3) * 8;
    const int soB2o = kk2 * 512 + ((((c4 >> 2)) ^ ((kk2 & 3) | 4)) << 5) + (c4 & 3) * 8;
    const int sw0 = ((0 + fq) ^ ((fr >> 1) & 7)) << 4, sw1 = ((4 + fq) ^ ((fr >> 1) & 7)) << 4;
    const int aoff = (16 * wr + fr) * 128;
    const int boffT = (wc * 64 + fr) * 128;
    const int qp = fr >> 2, pp = fr & 3, sB = qp | ((fq & 1) << 2);
    const int brow = (8 * fq + qp) * 512 + pp * 8;
    int bblk[4];
#pragma unroll
    for (int ni = 0; ni < 4; ++ni) bblk[ni] = ((4 * wc + ni) ^ sB) << 5;

    u32x4 ra[4]; u32x4 rbh[4]; f32x4 rb[8];
    f32x4 acc[8][4];
    int ld_rows = 0;

#define G2_LOAD(U, st) do { \
        ld_rows = (((U).nrows + 15) >> 4) << 4; \
        const LAS unsigned long long* rt_ = rowT + (U).par * 256 + srow; \
        _Pragma("unroll") for (int j = 0; j < 4; ++j) if (srow + 64 * j < ld_rows) ra[j] = *(const u32x4*)((const char*)rt_[64 * j] + ((st) * 64 + sch * 8) * 2); \
        if (BMODE == BM_BF16T) { const bf16_t* bp_ = (const bf16_t*)(U).b0 + (size_t)srow * (U).ldb + sch * 8 + (st) * 64; \
            _Pragma("unroll") for (int j = 0; j < 4; ++j) rbh[j] = *(const u32x4*)(bp_ + (size_t)j * 64 * (U).ldb); } \
        else if (BMODE == BM_F32) { const float* d_ = (const float*)(U).b0 + (size_t)((st) * 64 + kk2) * (U).ldb + c4 * 4; \
            _Pragma("unroll") for (int j = 0; j < 8; ++j) rb[j] = *(const f32x4*)(d_ + (size_t)j * 8 * (U).ldb); } \
        else { const float* g_ = (const float*)(U).b0 + (size_t)((st) * 64 + kk1) * (U).ldb + n4 * 4; const float* u_ = (const float*)(U).b1 + (size_t)((st) * 64 + kk1) * (U).ldb + n4 * 4; \
            _Pragma("unroll") for (int j = 0; j < 4; ++j) { rb[j] = *(const f32x4*)(g_ + (size_t)j * 16 * (U).ldb); rb[4 + j] = *(const f32x4*)(u_ + (size_t)j * 16 * (U).ldb); } } \
    } while (0)
#define G2_STORE(buf) do { LAS unsigned char* sa_ = lds + G2_A + (buf) * 32768; LAS unsigned char* sb_ = lds + G2_B + (buf) * 32768; \
        _Pragma("unroll") for (int j = 0; j < 4; ++j) if (srow + 64 * j < ld_rows) *(LAS u32x4*)(sa_ + soA + j * 8192) = ra[j]; \
        if (BMODE == BM_BF16T) { _Pragma("unroll") for (int j = 0; j < 4; ++j) *(LAS u32x4*)(sb_ + soA + j * 8192) = rbh[j]; } \
        else if (BMODE == BM_F32) { _Pragma("unroll") for (int j = 0; j < 8; ++j) \
            *(LAS u32x2*)(sb_ + ((j & 1) ? soB2o : soB2e) + j * 4096) = (u32x2){cvtpk(rb[j][0], rb[j][1]), cvtpk(rb[j][2], rb[j][3])}; } \
        else { _Pragma("unroll") for (int j = 0; j < 4; ++j) { \
            *(LAS u32x2*)(sb_ + soB1g + j * 8192) = (u32x2){cvtpk(rb[j][0], rb[j][1]), cvtpk(rb[j][2], rb[j][3])}; \
            *(LAS u32x2*)(sb_ + soB1u + j * 8192) = (u32x2){cvtpk(rb[4 + j][0], rb[4 + j][1]), cvtpk(rb[4 + j][2], rb[4 + j][3])}; } } \
    } while (0)
#define G2_COMPUTE(buf, nmi) do { const LAS unsigned char* sa_ = lds + G2_A + (buf) * 32768; const LAS unsigned char* sbb_ = lds + G2_B + (buf) * 32768; \
        _Pragma("unroll") for (int ks = 0; ks < 2; ++ks) { bf16x8 bfr[4]; \
            if (BMODE == BM_BF16T) { _Pragma("unroll") for (int ni = 0; ni < 4; ++ni) bfr[ni] = *(const LAS bf16x8*)(sbb_ + boffT + ni * 2048 + (ks ? sw1 : sw0)); } \
            else { _Pragma("unroll") for (int ni = 0; ni < 4; ++ni) { \
                const s16x4 lo_ = vtr(sbb_ + brow + ks * 16384 + bblk[ni]), hi_ = vtr(sbb_ + brow + ks * 16384 + 2048 + bblk[ni]); \
                bfr[ni] = (bf16x8){lo_[0], lo_[1], lo_[2], lo_[3], hi_[0], hi_[1], hi_[2], hi_[3]}; } } \
            _Pragma("unroll") for (int mi = 0; mi < 8; ++mi) if (mi < (nmi)) { \
                const bf16x8 af_ = *(const LAS bf16x8*)(sa_ + aoff + mi * 4096 + (ks ? sw1 : sw0)); \
                _Pragma("unroll") for (int ni = 0; ni < 4; ++ni) acc[mi][ni] = __builtin_amdgcn_mfma_f32_16x16x32_bf16(bfr[ni], af_, acc[mi][ni], 0, 0, 0); } } \
    } while (0)

    G2Unit cur, nxt;
    if (!S.next(cur, 0)) return;
    __syncthreads();
    G2_LOAD(cur, 0);
    G2_STORE(0);
    __syncthreads();
    int gs = 0;
    bool has_cur = true;
    while (has_cur) {
#pragma unroll
        for (int a = 0; a < 8; ++a)
#pragma unroll
            for (int b = 0; b < 4; ++b) acc[a][b] = (f32x4){0.f, 0.f, 0.f, 0.f};
        const int nb = (cur.nrows + 15) >> 4, nmi = (nb - wr + 1) >> 1;
        bool has_next = false;
#pragma unroll 1
        for (int st = 0; st < cur.nsteps; ++st) {
            if (st == 1) has_next = S.next(nxt, cur.par ^ 1);
            const bool last = (st == cur.nsteps - 1);
            if (!last) G2_LOAD(cur, st + 1); else if (has_next) G2_LOAD(nxt, 0);
            G2_COMPUTE(gs & 1, nmi);
            if (!last || has_next) G2_STORE((gs + 1) & 1);
            __syncthreads();
            ++gs;
            if (Epi::HAS_MID) E.mid(acc, cur, st, nmi, wr, fr);
        }
        E(acc, cur, nmi, wr, wc, fr, fq);
        cur = nxt; has_cur = has_next;
    }
#undef G2_LOAD
#undef G2_STORE
#undef G2_COMPUTE
}

struct MoeSched2 {
    const Params& p; const Ctx& c; int NT; bool isB; int tru, NU, i;
    LAS int* tstart; LAS int* roff; LAS int* cntl; LAS int* rpuT;
    __device__ __forceinline__ MoeSched2(const Params& p_, const Ctx& c_, int NT_, bool isB_) : p(p_), c(c_), NT(NT_), isB(isB_), i(0) {
        tstart = (LAS int*)(c.lds + G2_TAB); roff = tstart + 260; cntl = roff + 260; rpuT = cntl + 260;
        const unsigned* cnt = (const unsigned*)(p.ws + WS_CTL + CT_CNT);
        __syncthreads();
        if (c.tid < 64) {
            int cv[4], tv[4], rp[4]; int ls = 0, lt = 0;
#pragma unroll
            for (int k = 0; k < 4; ++k) { cv[k] = (int)cnt[c.tid * 4 + k]; tv[k] = (cv[k] + 255) >> 8; rp[k] = tv[k] ? ((((cv[k] + tv[k] - 1) / tv[k]) + 15) & ~15) : 0; ls += cv[k]; lt += tv[k]; }
            int ps = ls, pt = lt;
#pragma unroll
            for (int o = 1; o < 64; o <<= 1) { const int a = __shfl_up(ps, o), b = __shfl_up(pt, o); if (c.tid >= o) { ps += a; pt += b; } }
            int es = ps - ls, et = pt - lt;
#pragma unroll
            for (int k = 0; k < 4; ++k) { cntl[c.tid * 4 + k] = cv[k]; rpuT[c.tid * 4 + k] = rp[k]; roff[c.tid * 4 + k] = es; tstart[c.tid * 4 + k] = et; es += cv[k]; et += tv[k]; }
            if (c.tid == 63) { roff[256] = es; tstart[256] = et; }
        }
        __syncthreads();
        tru = tstart[256]; NU = (tru + 64) * NT;
    }
    __device__ __forceinline__ bool next(G2Unit& U, int par) {
        const int idx = c.vcu + i * c.G; ++i;
        if (idx >= NU) return false;
        const int g = idx / NT, nt = idx - g * NT;
        int e, r0, nrows; size_t hbase, lbase = 0;
        if (g < tru) { e = moe_find_l(tstart, g); const int ui = g - tstart[e], rpu = rpuT[e]; r0 = ui * rpu; nrows = min(rpu, cntl[e] - r0); hbase = (size_t)roff[e] + r0; lbase = (size_t)e * CAP + r0; }
        else { e = NEXP; r0 = (g - tru) * 256; nrows = 256; hbase = (size_t)NTOK * 8 + r0; }
        U.nrows = nrows; U.par = par; U.i0 = (int)hbase; U.i1 = nt; U.i2 = 0;
        const unsigned* laid = (const unsigned*)(p.ws + WS_LAID); const float* lgate = (const float*)(p.ws + WS_LGATE);
        LAS unsigned long long* rowT = (LAS unsigned long long*)(c.lds + G2_MISC) + par * 256;
        if (!isB) {
            U.b0 = (e < NEXP ? p.w_gate + (size_t)e * D * DEXP : p.ws_gate) + nt * 128; U.b1 = (e < NEXP ? p.w_up + (size_t)e * D * DEXP : p.ws_up) + nt * 128;
            U.ldb = DEXP; U.nsteps = D / 64;
            if (c.tid < 256) {
                const int rr = min(c.tid, nrows - 1);
                const int tok = e < NEXP ? (int)(laid[lbase + rr] >> 3) : r0 + rr;
                rowT[c.tid] = (unsigned long long)(uintptr_t)((const bf16_t*)(p.ws + WS_H1) + (size_t)tok * D);
            }
        } else {
            U.b0 = (e < NEXP ? p.w_down + (size_t)e * DEXP * D : p.ws_down) + nt * 256; U.b1 = nullptr;
            U.ldb = D; U.nsteps = DEXP / 64;
            if (c.tid < 256) {
                const int rr = min(c.tid, nrows - 1);
                rowT[c.tid] = (unsigned long long)(uintptr_t)((const bf16_t*)(p.ws + WS_HID) + (hbase + rr) * DEXP);
                int yr; float gt;
                if (e < NEXP) { const unsigned aid = laid[lbase + rr]; yr = (int)((aid >> 3) * 9 + (aid & 7)); gt = lgate[lbase + rr]; }
                else { yr = (r0 + rr) * 9 + 8; gt = 1.f; }
                ((LAS float*)(c.lds + G2_GATE))[par * 256 + c.tid] = gt; ((LAS int*)(c.lds + G2_YROW))[par * 256 + c.tid] = yr;
            }
        }
        return true;
    }
};
struct EpiMoeA {
    static constexpr bool HAS_MID = false;
    bf16_t* HID;
    __device__ __forceinline__ void mid(f32x4 (&)[8][4], const G2Unit&, int, int, int, int) const {}
    __device__ __forceinline__ void operator()(f32x4 (&acc)[8][4], const G2Unit& U, int nmi, int wr, int wc, int fr, int fq) const {
#pragma unroll
        for (int mi = 0; mi < 8; ++mi) {
            const int r = 32 * mi + 16 * wr + fr;
            if (mi < nmi && r < U.nrows) {
#pragma unroll
                for (int np = 0; np < 2; ++np) {
                    const f32x4 gt = acc[mi][2 * np], up = acc[mi][2 * np + 1];
                    f32x4 hv;
#pragma unroll
                    for (int j = 0; j < 4; ++j) hv[j] = gt[j] / (1.f + __expf(-gt[j])) * up[j];
                    store_bf4(HID + ((size_t)U.i0 + r) * DEXP + U.i1 * 128 + wc * 32 + np * 16 + fq * 4, hv);
                }
            }
        }
    }
};
struct EpiMoeB {
    static constexpr bool HAS_MID = false;
    bf16_t* Y; const LAS float* gateT; const LAS int* yrowT;
    __device__ __forceinline__ void mid(f32x4 (&)[8][4], const G2Unit&, int, int, int, int) const {}
    __device__ __forceinline__ void operator()(f32x4 (&acc)[8][4], const G2Unit& U, int nmi, int wr, int wc, int fr, int fq) const {
#pragma unroll
        for (int mi = 0; mi < 8; ++mi) {
            if (mi < nmi) {
                const int r = 32 * mi + 16 * wr + fr;
                const float gt = gateT[U.par * 256 + r]; const size_t yrow = (size_t)yrowT[U.par * 256 + r];
                f32x4 v_[4];
#pragma unroll
                for (int ni = 0; ni < 4; ++ni) v_[ni] = acc[mi][ni] * gt;
                store_strip_bf16(Y + yrow * D + U.i1 * 256 + wc * 64, v_, fq, r < U.nrows);
            }
        }
    }
};
__device__ __forceinline__ void phase_moeA(const Params& p, const Ctx& c) {
    MoeSched2 S(p, c, 2, false);
    EpiMoeA E{(bf16_t*)(p.ws + WS_HID)};
    gemm256_stream<BM_F32_GU>(c, S, E);
}
__device__ __forceinline__ void phase_moeB(const Params& p, const Ctx& c) {
    MoeSched2 S(p, c, 4, true);
    EpiMoeB E{(bf16_t*)(p.ws + WS_Y), (const LAS float*)(c.lds + G2_GATE), (const LAS int*)(c.lds + G2_YROW)};
    gemm256_stream<BM_F32>(c, S, E);
}

__device__ __forceinline__ void phase8(const Params& p, const Ctx& c) {
    unsigned char* ws = p.ws;
    const bf16_t* H1 = (const bf16_t*)(ws + WS_H1); const bf16_t* Y = (const bf16_t*)(ws + WS_Y);
    const int gw = c.vcu * NWAVES + c.wave, NGW = c.G * NWAVES, lane = c.lane;
    for (int t = gw; t < NTOK; t += NGW) {
        float v[16];
#pragma unroll
        for (int j = 0; j < 2; ++j) {
            const int col = (lane + 64 * j) * 8;
            const u32x4 w = *(const u32x4*)(H1 + (size_t)t * D + col);
#pragma unroll
            for (int e = 0; e < 4; ++e) { v[j * 8 + 2 * e] = ALPHA * bflo(w[e]); v[j * 8 + 2 * e + 1] = ALPHA * bfhi(w[e]); }
#pragma unroll
            for (int k = 0; k < 9; ++k) {
                const u32x4 y = *(const u32x4*)(Y + ((size_t)t * 9 + k) * D + col);
#pragma unroll
                for (int e = 0; e < 4; ++e) { v[j * 8 + 2 * e] += bflo(y[e]); v[j * 8 + 2 * e + 1] += bfhi(y[e]); }
            }
        }
        float s = 0.f;
#pragma unroll
        for (int e = 0; e < 16; ++e) s += v[e];
        const float mean = wave_sum(s) * (1.f / D);
        float ss = 0.f;
#pragma unroll
        for (int e = 0; e < 16; ++e) { v[e] -= mean; ss += v[e] * v[e]; }
        const float rstd = rsqrtf(wave_sum(ss) * (1.f / D) + 1e-5f);
#pragma unroll
        for (int j = 0; j < 2; ++j) {
            const int col = (lane + 64 * j) * 8;
            f32x4 o0, o1;
#pragma unroll
            for (int e = 0; e < 4; ++e) { o0[e] = v[j * 8 + e] * rstd * p.ln2_g[col + e] + p.ln2_b[col + e]; o1[e] = v[j * 8 + 4 + e] * rstd * p.ln2_g[col + 4 + e] + p.ln2_b[col + 4 + e]; }
            *(f32x4*)(p.out + (size_t)t * D + col) = o0; *(f32x4*)(p.out + (size_t)t * D + col + 4) = o1;
        }
    }
}


#define XB_TMO      128
#define XB_XCNT(j)  (256  + 64 * (j))
#define XB_XSUB(j)  (1280 + 64 * (j))
#define XB_XGEN(j)  (2304 + 64 * (j))
#define XB_TOP      3328
#define XB_TOPGEN   3392
#define XB_SPIN_CAP (1u << 22)
__device__ __forceinline__ unsigned xb_ld(unsigned* p)              { return __hip_atomic_load(p, __ATOMIC_RELAXED, __HIP_MEMORY_SCOPE_AGENT); }
__device__ __forceinline__ unsigned xb_add(unsigned* p, unsigned v) { return __hip_atomic_fetch_add(p, v, __ATOMIC_RELAXED, __HIP_MEMORY_SCOPE_AGENT); }
__device__ __forceinline__ unsigned xb_xcc_id() { return (unsigned)__builtin_amdgcn_s_getreg((3 << 11) | 20) & 0xFu; }
#define XB_SPIN(cond, bar) do { unsigned _sp = 0; while (cond) { __builtin_amdgcn_s_sleep(1); \
    if ((++_sp & 255u) == 0u) { if (xb_ld(&(bar)[XB_TMO])) break; if (_sp > XB_SPIN_CAP) { atomicAdd(&(bar)[XB_TMO], 1u); break; } } } } while (0)
struct XcdBarrier { unsigned* bar; unsigned x; volatile LAS unsigned* st; };
__device__ __forceinline__ XcdBarrier xcd_barrier_post(unsigned* bar, volatile LAS unsigned* st) {
    XcdBarrier b; b.bar = bar; b.x = xb_xcc_id(); b.st = st;
    if (threadIdx.x == 0) (void)xb_add(&bar[XB_XCNT(b.x)], 1u);
    return b;
}
__device__ __forceinline__ void xcd_barrier_complete(unsigned* bar, unsigned x, unsigned& nloc, unsigned& nx) {
    const unsigned G = gridDim.x * gridDim.y * gridDim.z;
    unsigned sum, cnt, mine, sp = 0u;
    for (;;) {
        sum = 0u; cnt = 0u; mine = 0u;
#pragma unroll
        for (unsigned j = 0; j < 16; ++j) { const unsigned c = xb_ld(&bar[XB_XCNT(j)]); sum += c; cnt += (c > 0u) ? 1u : 0u; mine = (j == x) ? c : mine; }
        if (sum == G) break;
        __builtin_amdgcn_s_sleep(1);
        if ((++sp & 255u) == 0u) { if (xb_ld(&bar[XB_TMO])) break; if (sp > XB_SPIN_CAP) { atomicAdd(&bar[XB_TMO], 1u); break; } }
    }
    nloc = mine > 0u ? mine : 1u; nx = cnt > 0u ? cnt : 1u;
}
__device__ __forceinline__ void xcd_barrier(const XcdBarrier& b) {
    asm volatile("s_waitcnt vmcnt(0)" ::: "memory");
    __syncthreads();
    if (threadIdx.x == 0) {
        unsigned* bar = b.bar;
        __builtin_amdgcn_s_waitcnt(0);
        unsigned nloc = b.st[0], nx = b.st[1];
        if (nloc == 0u) { xcd_barrier_complete(bar, b.x, nloc, nx); b.st[0] = nloc; b.st[1] = nx; }
        const unsigned old = xb_add(&bar[XB_XSUB(b.x)], 1u);
        const unsigned gen = old / nloc;
        if (old + 1u == (gen + 1u) * nloc) {
            __builtin_amdgcn_fence(__ATOMIC_RELEASE, "agent");
            asm volatile("s_waitcnt vmcnt(0)" ::: "memory");
            const unsigned og = xb_add(&bar[XB_TOP], 1u);
            const unsigned tg = og / nx;
            if (og + 1u == (tg + 1u) * nx) xb_add(&bar[XB_TOPGEN], 1u);
            else XB_SPIN(xb_ld(&bar[XB_TOPGEN]) == tg, bar);
            __builtin_amdgcn_fence(__ATOMIC_ACQUIRE, "agent");
            xb_add(&bar[XB_XGEN(b.x)], 1u);
            asm volatile("s_waitcnt vmcnt(0)" ::: "memory");
        } else {
            XB_SPIN(xb_ld(&bar[XB_XGEN(b.x)]) == gen, bar);
            __builtin_amdgcn_fence(__ATOMIC_ACQUIRE, "agent");
            asm volatile("s_waitcnt vmcnt(0)" ::: "memory");
        }
    }
    __syncthreads();
}

template <int PH> __device__ __forceinline__ void run_phase(const Params& p, const Ctx& c0) {
    Ctx c = c0;
    { int t = c0.tid; asm volatile("" : "+v"(t)); c.tid = t; c.lane = t & 63; c.wave = __builtin_amdgcn_readfirstlane(t >> 6); }
    if (PH == 0) phase0(p, c);
    if (PH == 1) phase1(p, c);
    if (PH == 2) phase2(p, c);
#if NAIVE_ATTN
    if (PH == 3) phase3_naive(p, c);
#else
    if (PH == 3) phase3(p, c);
#endif
    if (PH == 4) phase4(p, c);
    if (PH == 5) phase5a(p, c);
    if (PH == 6) phase5b(p, c);
    if (PH == 7) phase5c(p, c);
    if (PH == 8) phase_moeA(p, c);
    if (PH == 9) phase_moeB(p, c);
    if (PH == 10) phase8(p, c);
}
constexpr int NPHASES = 11;
__device__ __forceinline__ Ctx make_ctx(unsigned char* lds) {
    Ctx c; c.lds = (LAS unsigned char*)lds; c.tid = threadIdx.x; c.lane = c.tid & 63; c.wave = __builtin_amdgcn_readfirstlane(c.tid >> 6);
    c.G = gridDim.x; const int bx = blockIdx.x; c.vcu = (c.G % 8 == 0) ? (bx % 8) * (c.G / 8) + bx / 8 : bx;
    return c;
}
template <int PH> __global__ void __launch_bounds__(NTHREADS, 2) phase_kernel(Params p) {
    extern __shared__ __attribute__((aligned(16))) unsigned char lds[];
    const Ctx c = make_ctx(lds);
    run_phase<PH>(p, c);
}
#if MEGA
__global__ void __launch_bounds__(NTHREADS, 2) mega_kernel(Params p) {
    extern __shared__ __attribute__((aligned(16))) unsigned char lds[];
    Ctx c = make_ctx(lds);
    cg::grid_group grid = cg::this_grid();
    volatile LAS unsigned* bst = (volatile LAS unsigned*)(c.lds + LDS_BYTES - 64);
    if (c.tid < 4) bst[c.tid] = 0u;
    __syncthreads();
    XcdBarrier bar; bar.bar = (unsigned*)(p.ws + WS_CTL + CT_BAR); bar.x = xb_xcc_id(); bar.st = bst;
    if (c.tid == 0) bst[2] = xb_add(&bar.bar[XB_XCNT(bar.x)], 1u);
    run_phase<0>(p, c); grid.sync();
    if (c.tid == 0) {
        unsigned pre = 0;
        for (unsigned j = 0; j < 16; ++j) { const unsigned n = xb_ld(&bar.bar[XB_XCNT(j)]); if (j < bar.x) pre += n; }
        bst[3] = pre + bst[2];
    }
    __syncthreads();
    c.vcu = (int)bst[3];
    run_phase<1>(p, c); xcd_barrier(bar);
    run_phase<2>(p, c); xcd_barrier(bar);
    run_phase<3>(p, c); xcd_barrier(bar);
    run_phase<4>(p, c); xcd_barrier(bar);
    run_phase<5>(p, c); xcd_barrier(bar);
    run_phase<6>(p, c); xcd_barrier(bar);
    run_phase<7>(p, c); xcd_barrier(bar);
    run_phase<8>(p, c); xcd_barrier(bar);
    run_phase<9>(p, c); xcd_barrier(bar);
    run_phase<10>(p, c);
}

#endif
template <int PH> static void launch_phase(const Params& p, int grid, hipStream_t stream) {
    static bool attr = false;
    if (!attr) { (void)hipFuncSetAttribute((const void*)phase_kernel<PH>, hipFuncAttributeMaxDynamicSharedMemorySize, LDS_BYTES); attr = true; }
    hipLaunchKernelGGL(phase_kernel<PH>, dim3(grid), dim3(NTHREADS), LDS_BYTES, stream, p);
}

extern "C" void kernel_launch(void* const* d_in, const int* in_sizes, int n_in, void* d_out, int out_size, void* d_ws, size_t ws_size, hipStream_t stream) {
    if (n_in != 25 || ws_size < WS_END) { fprintf(stderr, "kernel_launch: unexpected n_in %d or ws_size %zu (need %zu)\n", n_in, ws_size, (size_t)WS_END); return; }
    Params p{};
    const float** pp = (const float**)&p;
    for (int i = 0; i < 25; ++i) pp[i] = (const float*)d_in[i];
    p.out = (float*)d_out; p.ws = (unsigned char*)d_ws;
    (void)hipMemsetAsync((char*)d_ws + WS_CTL, 0, CTL_BYTES, stream);
#if MEGA
    static int grid = 0;
    if (!grid) {
        int dev = 0, cus = 0, per_cu = 0;
        (void)hipGetDevice(&dev);
        (void)hipDeviceGetAttribute(&cus, hipDeviceAttributeMultiprocessorCount, dev);
        (void)hipFuncSetAttribute((const void*)mega_kernel, hipFuncAttributeMaxDynamicSharedMemorySize, LDS_BYTES);
        (void)hipOccupancyMaxActiveBlocksPerMultiprocessor(&per_cu, (const void*)mega_kernel, NTHREADS, LDS_BYTES);
        if (per_cu < 1) per_cu = 1;
        grid = cus;
        (void)per_cu;
    }
    void* args[] = {&p};
    hipError_t e = hipLaunchCooperativeKernel((const void*)mega_kernel, dim3(grid), dim3(NTHREADS), args, LDS_BYTES, stream);
    if (e != hipSuccess) fprintf(stderr, "cooperative launch failed: %s (grid %d)\n", hipGetErrorString(e), grid);
#else
    const int grid = 256;
#define LP(k) do { launch_phase<k>(p, grid, stream); if (REPEAT_PH == k) launch_phase<k>(p, grid, stream); } while (0)
    LP(0); LP(1); LP(2); LP(3); LP(4); LP(5); LP(6); LP(7); LP(8); LP(9); LP(10);
#undef LP
#endif
}
```

```cpp
#include <hip/hip_runtime.h>
#include <hip/hip_cooperative_groups.h>
#include <cstdint>
#include <cstdio>
namespace cg = cooperative_groups;

#ifndef NAIVE_GEMM
#define NAIVE_GEMM 0
#endif
#ifndef NAIVE_ATTN
#define NAIVE_ATTN 0
#endif
#ifndef REPEAT_PH
#define REPEAT_PH -1
#endif
#ifndef MEGA
#define MEGA 1
#endif

#define LAS __attribute__((address_space(3)))
#define GAS __attribute__((address_space(1)))
typedef unsigned short bf16_t;
typedef short bf16x8 __attribute__((ext_vector_type(8)));
typedef float f32x4 __attribute__((ext_vector_type(4)));
typedef unsigned u32x4 __attribute__((ext_vector_type(4)));
typedef unsigned u32x2 __attribute__((ext_vector_type(2)));

constexpr int D = 1024, NBATCH = 8, SEQ = 2048, NMETA = 16, LPOS = SEQ + NMETA;
constexpr int NTOK = NBATCH * SEQ;
constexpr int NROWS = NTOK + NMETA;
constexpr int NROWSP = 16512;
constexpr int NH = 8, DQK = 96, DNOPE = 64, DROPE = 32, DV = 64;
constexpr int QLORA = 384, KVLORA = 256;
constexpr int ZC = 2304;
constexpr int ZQ = 0, ZKV = 384, ZKPE = 640, ZB = 704, ZCG = 1216, ZU = 1728;
constexpr int DIN = 2208;
constexpr int NEXP = 256, DEXP = 256, TOPK = 8, CAP = 16384;
constexpr float ALPHA = 1.189207115002721f;
constexpr float QSCALE = 0.10206207261596577f * 1.4426950408889634f;

constexpr int NTHREADS = 512, NWAVES = 8;
constexpr int LDS_BYTES = 147456;
constexpr int STAGE_BYTES = 49152;
constexpr int LDS_MISC = 2 * STAGE_BYTES;

constexpr size_t MiB = 1u << 20;
constexpr size_t WS_CTL = 0;
constexpr size_t CTL_BYTES = 1 * MiB;
constexpr size_t CT_CNT = 0;
constexpr size_t CT_Q = 1024;
constexpr size_t CT_BAR = 8192;
constexpr size_t CT_SSQ_Q = 32768;
constexpr size_t CT_SSQ_KV = CT_SSQ_Q + 66048;
constexpr size_t CT_SSQ_ATT = CT_SSQ_KV + 66048;
constexpr size_t CT_STATS1 = CT_SSQ_ATT + 65536;
static_assert(CT_STATS1 + 131072 <= CTL_BYTES, "ctl");
constexpr size_t WS_WIN = 1 * MiB;
constexpr size_t WS_WUQ = 6 * MiB;
constexpr size_t WS_WUKV = 7 * MiB;
constexpr size_t WS_WO = 8 * MiB;
constexpr size_t WS_WR = 10 * MiB;
constexpr size_t WS_WSGU = 11 * MiB;
constexpr size_t WS_WSD = 12 * MiB;
constexpr size_t WS_ROPE = 13 * MiB;
constexpr size_t WS_WGU = 14 * MiB;
constexpr size_t WS_WD = 270 * MiB;
constexpr size_t WS_H1 = 398 * MiB;
constexpr size_t WS_HID = 430 * MiB;
constexpr size_t WS_LAID = 502 * MiB;
constexpr size_t WS_LGATE = 518 * MiB;
constexpr size_t WS_Y = 534 * MiB;
constexpr size_t WS_Z = WS_Y;
constexpr size_t WS_H0 = WS_Y + 73 * MiB;
constexpr size_t WS_Q = WS_Y + 106 * MiB;
constexpr size_t WS_K = WS_Y + 130 * MiB;
constexpr size_t WS_V = WS_Y + 155 * MiB;
constexpr size_t WS_ATT = WS_Y + 172 * MiB;
constexpr size_t WS_CONV = WS_Y + 188 * MiB;
constexpr size_t WS_SSQC = WS_Y + 204 * MiB;
constexpr size_t WS_Y1 = WS_Y + 205 * MiB;
constexpr size_t WS_LOG = WS_Y + 237 * MiB;
constexpr size_t WS_PSQ = WS_Y + 253 * MiB;
constexpr size_t WS_PATT = WS_Y + 254 * MiB;
constexpr size_t WS_PST = WS_Y + 255 * MiB;
constexpr size_t WS_END = WS_Y + 288 * MiB;

struct Params {
    const float *x, *meta, *emb_g, *emb_b, *w_in, *q_norm, *w_uq, *kv_norm, *w_ukv, *conv_w, *attn_on, *conv_on, *w_o,
        *ln1_g, *ln1_b, *w_router, *router_bias, *w_gate, *w_up, *w_down, *ws_gate, *ws_up, *ws_down, *ln2_g, *ln2_b;
    float* out;
    unsigned char* ws;
};

__device__ __forceinline__ unsigned f2bf(float f) { unsigned u = __float_as_uint(f); return (u + 0x7fffu + ((u >> 16) & 1u)) >> 16; }
__device__ __forceinline__ unsigned pk2(float lo, float hi) { return f2bf(lo) | (f2bf(hi) << 16); }
__device__ __forceinline__ float bf2f(unsigned b) { return __uint_as_float(b << 16); }
__device__ __forceinline__ float bflo(unsigned w) { return __uint_as_float(w << 16); }
__device__ __forceinline__ float bfhi(unsigned w) { return __uint_as_float(w & 0xffff0000u); }
__device__ __forceinline__ float wave_sum(float v) {
#pragma unroll
    for (int o = 1; o < 64; o <<= 1) v += __shfl_xor(v, o);
    return v;
}
__device__ __forceinline__ float wave_max(float v) {
#pragma unroll
    for (int o = 1; o < 64; o <<= 1) v = fmaxf(v, __shfl_xor(v, o));
    return v;
}

struct Ctx {
    LAS unsigned char* lds;
    int tid, lane, wave, vcu, G;
};

template <class RowPtr>
__device__ __forceinline__ void gemm_kloop(f32x4 (&acc)[4][4], const Ctx& c, const RowPtr& rp, const bf16_t* Bt, long ldb, int K) {
    const int tid = c.tid, lane = c.lane, wid = c.wave, wr = wid >> 2, wc = wid & 3, fr = lane & 15, fq = lane >> 4;
#if NAIVE_GEMM
    const bf16_t* ar[4];
#pragma unroll
    for (int mi = 0; mi < 4; ++mi) ar[mi] = rp(wr * 64 + mi * 16 + fr);
    const bf16_t* br = Bt + (long)(wc * 64 + fq * 4) * ldb;
#pragma nounroll
    for (int k = 0; k < K; k += 2) {
        unsigned av[4];
#pragma unroll
        for (int mi = 0; mi < 4; ++mi) av[mi] = *(const unsigned*)(ar[mi] + k);
#pragma unroll
        for (int ni = 0; ni < 4; ++ni)
#pragma unroll
            for (int j = 0; j < 4; ++j) {
                const unsigned bv = *(const unsigned*)(br + (long)(ni * 16 + j) * ldb + k);
#pragma unroll
                for (int mi = 0; mi < 4; ++mi) acc[mi][ni][j] += bflo(av[mi]) * bflo(bv) + bfhi(av[mi]) * bfhi(bv);
            }
    }
#else
    LAS unsigned char* lds = c.lds;
    const int nt = K >> 6;
    const int srow = tid >> 3, sch = tid & 7;
    const bf16_t* ap0 = rp(srow) + sch * 8;
    const bf16_t* ap1 = rp(srow + 64) + sch * 8;
    const bf16_t* bp = Bt + (long)srow * ldb + sch * 8;
    const long bstep = 64 * ldb;
    const int so = srow * 128 + ((sch ^ ((srow >> 1) & 7)) << 4);
    u32x4 ra0, ra1, rb0, rb1, rb2, rb3;
#define G_LOAD(t) do { const int ko = (t) * 64; ra0 = *(const u32x4*)(ap0 + ko); ra1 = *(const u32x4*)(ap1 + ko); \
        rb0 = *(const u32x4*)(bp + ko); rb1 = *(const u32x4*)(bp + bstep + ko); rb2 = *(const u32x4*)(bp + 2 * bstep + ko); rb3 = *(const u32x4*)(bp + 3 * bstep + ko); } while (0)
#define G_STORE(buf) do { LAS unsigned char* sb = lds + (buf) * STAGE_BYTES; \
        *(LAS u32x4*)(sb + so) = ra0; *(LAS u32x4*)(sb + so + 8192) = ra1; \
        *(LAS u32x4*)(sb + 16384 + so) = rb0; *(LAS u32x4*)(sb + 16384 + so + 8192) = rb1; \
        *(LAS u32x4*)(sb + 16384 + so + 16384) = rb2; *(LAS u32x4*)(sb + 16384 + so + 24576) = rb3; } while (0)
    __syncthreads();
    G_LOAD(0);
    G_STORE(0);
    __syncthreads();
    const int sw0 = ((0 + fq) ^ ((fr >> 1) & 7)) << 4, sw1 = ((4 + fq) ^ ((fr >> 1) & 7)) << 4;
    const int aoff = (wr * 64 + fr) * 128, boff = 16384 + (wc * 64 + fr) * 128;
    for (int t = 0; t < nt; ++t) {
        if (t + 1 < nt) G_LOAD(t + 1);
        const LAS unsigned char* sb = lds + (t & 1) * STAGE_BYTES;
#pragma unroll
        for (int ks = 0; ks < 2; ++ks) {
            const int sw = ks ? sw1 : sw0;
            bf16x8 af[4], bfr[4];
#pragma unroll
            for (int mi = 0; mi < 4; ++mi) af[mi] = *(const LAS bf16x8*)(sb + aoff + mi * 2048 + sw);
#pragma unroll
            for (int ni = 0; ni < 4; ++ni) bfr[ni] = *(const LAS bf16x8*)(sb + boff + ni * 2048 + sw);
#pragma unroll
            for (int mi = 0; mi < 4; ++mi)
#pragma unroll
                for (int ni = 0; ni < 4; ++ni) acc[mi][ni] = __builtin_amdgcn_mfma_f32_16x16x32_bf16(bfr[ni], af[mi], acc[mi][ni], 0, 0, 0);
        }
        if (t + 1 < nt) G_STORE((t + 1) & 1);
        __syncthreads();
    }
#undef G_LOAD
#undef G_STORE
#endif
}
__device__ __forceinline__ void acc_zero(f32x4 (&acc)[4][4]) {
#pragma unroll
    for (int a = 0; a < 4; ++a)
#pragma unroll
        for (int b = 0; b < 4; ++b) acc[a][b] = (f32x4){0.f, 0.f, 0.f, 0.f};
}
__device__ __forceinline__ void store_bf4(bf16_t* p, f32x4 v) { u32x2 w; w.x = pk2(v[0], v[1]); w.y = pk2(v[2], v[3]); *(u32x2*)p = w; }

enum { MAP_ID = 0, MAP_WIN = 1, MAP_GATE = 2, MAP_UP = 3 };
template <int MAP> __device__ __forceinline__ int rowmap(int n) {
    if (MAP == MAP_WIN) return n < 672 ? n : n + 32;
    if (MAP == MAP_GATE) return 32 * (n >> 4) + (n & 15);
    if (MAP == MAP_UP) return 32 * (n >> 4) + 16 + (n & 15);
    return n;
}
template <int MAP>
__device__ __forceinline__ void transpose_item(const float* W, int K, int N, bf16_t* WT, const float* gain, LAS float* scr, int item, int lane) {
    const int nblk = N / 32, kb = item / nblk, nb = item % nblk, k0 = 64 * kb, n0 = 32 * nb;
#pragma unroll 8
    for (int i = 0; i < 32; ++i) {
        const int kk = 2 * i + (lane >> 5);
        float v = W[(size_t)(k0 + kk) * N + n0 + (lane & 31)];
        if (gain) v *= gain[k0 + kk];
        scr[kk * 33 + (lane & 31)] = v;
    }
    asm volatile("s_waitcnt lgkmcnt(0)" ::: "memory");
    const int ch = lane & 7;
#pragma unroll
    for (int j = 0; j < 4; ++j) {
        const int n = (lane >> 3) + 8 * j;
        const LAS float* s = scr + (8 * ch) * 33 + n;
        u32x4 o;
        o.x = pk2(s[0 * 33], s[1 * 33]); o.y = pk2(s[2 * 33], s[3 * 33]); o.z = pk2(s[4 * 33], s[5 * 33]); o.w = pk2(s[6 * 33], s[7 * 33]);
        *(u32x4*)(WT + (size_t)rowmap<MAP>(n0 + n) * K + k0 + 8 * ch) = o;
    }
    asm volatile("s_waitcnt lgkmcnt(0)" ::: "memory");
}
__device__ __forceinline__ void phase0(const Params& p, const Ctx& c) {
    unsigned char* ws = p.ws;
    LAS float* scr = (LAS float*)(c.lds + c.wave * 8704);
    const int gw = c.vcu * NWAVES + c.wave, NGW = c.G * NWAVES, lane = c.lane;
    bf16_t* H0 = (bf16_t*)(ws + WS_H0);
    for (int r = gw; r < NROWSP; r += NGW) {
        u32x2* o = (u32x2*)(H0 + (size_t)r * D) + lane;
        if (r >= NROWS) {
#pragma unroll
            for (int j = 0; j < 4; ++j) o[64 * j] = (u32x2){0u, 0u};
            continue;
        }
        const float* xr = r < NTOK ? p.x + (size_t)r * D : p.meta + (size_t)(r - NTOK) * D;
        f32x4 v[4]; float s = 0.f;
#pragma unroll
        for (int j = 0; j < 4; ++j) { v[j] = *((const f32x4*)xr + lane + 64 * j); s += (v[j][0] + v[j][1]) + (v[j][2] + v[j][3]); }
        const float mean = wave_sum(s) * (1.f / D);
        float s2 = 0.f;
#pragma unroll
        for (int j = 0; j < 4; ++j) { v[j] = v[j] - mean; s2 += (v[j][0] * v[j][0] + v[j][1] * v[j][1]) + (v[j][2] * v[j][2] + v[j][3] * v[j][3]); }
        const float rstd = 1.f / sqrtf(wave_sum(s2) * (1.f / D) + 1e-5f);
#pragma unroll
        for (int j = 0; j < 4; ++j) {
            const f32x4 g = *((const f32x4*)p.emb_g + lane + 64 * j), b = *((const f32x4*)p.emb_b + lane + 64 * j);
            const f32x4 y = v[j] * rstd * g + b;
            u32x2 w; w.x = pk2(y[0], y[1]); w.y = pk2(y[2], y[3]); o[64 * j] = w;
        }
    }
    {
        float* rope = (float*)(ws + WS_ROPE);
        for (int idx = gw * 64 + lane; idx < LPOS * 16; idx += NGW * 64) {
            const int pos = idx >> 4, i = idx & 15;
            const float inv = exp2f(-(float)i * (13.287712379549449f / 16.f));
            const float ang = (float)pos * inv;
            double rev = (double)ang * 0.15915494309189535; rev -= floor(rev);
            const float rf = (float)rev;
            rope[idx * 2 + 0] = __builtin_amdgcn_cosf(rf);
            rope[idx * 2 + 1] = __builtin_amdgcn_sinf(rf);
        }
    }
    {
        bf16_t* WinT = (bf16_t*)(ws + WS_WIN);
        for (int it = gw; it < 96; it += NGW) {
            const int row = it < 32 ? 672 + it : 2240 + (it - 32);
            u32x2* o = (u32x2*)(WinT + (size_t)row * D) + lane;
#pragma unroll
            for (int j = 0; j < 4; ++j) o[64 * j] = (u32x2){0u, 0u};
        }
    }
    constexpr int I_WIN = 16 * 69, I_UQ = 6 * 24, I_UKV = 4 * 32, I_WO = 16 * 32, I_WR = 16 * 8, I_SG = 128, I_SD = 128;
    constexpr int I_SMALL = I_WIN + I_UQ + I_UKV + I_WO + I_WR + 2 * I_SG + I_SD;
    constexpr int I_EXP = NEXP * 128;
    constexpr int NITEMS = I_WIN + I_UQ + I_UKV + I_WO + I_WR;
    for (int it = gw; it < NITEMS; it += NGW) {
        int r = it;
        if (r < I_WIN) { transpose_item<MAP_WIN>(p.w_in, D, DIN, (bf16_t*)(ws + WS_WIN), nullptr, scr, r, lane); continue; } r -= I_WIN;
        if (r < I_UQ) { transpose_item<MAP_ID>(p.w_uq, QLORA, 768, (bf16_t*)(ws + WS_WUQ), p.q_norm, scr, r, lane); continue; } r -= I_UQ;
        if (r < I_UKV) { transpose_item<MAP_ID>(p.w_ukv, KVLORA, 1024, (bf16_t*)(ws + WS_WUKV), p.kv_norm, scr, r, lane); continue; } r -= I_UKV;
        if (r < I_WO) {
            const int kb = r / 32;
            transpose_item<MAP_ID>(p.w_o, D, D, (bf16_t*)(ws + WS_WO), kb < 8 ? p.attn_on : p.conv_on - 512, scr, r, lane); continue; } r -= I_WO;
        if (r < I_WR) { transpose_item<MAP_ID>(p.w_router, D, 256, (bf16_t*)(ws + WS_WR), nullptr, scr, r, lane); continue; } r -= I_WR;
        if (r < I_SG) { transpose_item<MAP_GATE>(p.ws_gate, D, 256, (bf16_t*)(ws + WS_WSGU), nullptr, scr, r, lane); continue; } r -= I_SG;
        if (r < I_SG) { transpose_item<MAP_UP>(p.ws_up, D, 256, (bf16_t*)(ws + WS_WSGU), nullptr, scr, r, lane); continue; } r -= I_SG;
        if (r < I_SD) { transpose_item<MAP_ID>(p.ws_down, DEXP, D, (bf16_t*)(ws + WS_WSD), nullptr, scr, r, lane); continue; } r -= I_SD;
        if (r < I_EXP) { const int e = r >> 7; transpose_item<MAP_GATE>(p.w_gate + (size_t)e * D * DEXP, D, 256, (bf16_t*)(ws + WS_WGU) + (size_t)e * 512 * D, nullptr, scr, r & 127, lane); continue; } r -= I_EXP;
        if (r < I_EXP) { const int e = r >> 7; transpose_item<MAP_UP>(p.w_up + (size_t)e * D * DEXP, D, 256, (bf16_t*)(ws + WS_WGU) + (size_t)e * 512 * D, nullptr, scr, r & 127, lane); continue; } r -= I_EXP;
        { const int e = r >> 7; transpose_item<MAP_ID>(p.w_down + (size_t)e * DEXP * D, DEXP, D, (bf16_t*)(ws + WS_WD) + (size_t)e * D * DEXP, nullptr, scr, r & 127, lane); }
    }
}

__device__ __forceinline__ void phase1(const Params& p, const Ctx& c) {
    unsigned char* ws = p.ws;
    const bf16_t* H0 = (const bf16_t*)(ws + WS_H0); const bf16_t* WinT = (const bf16_t*)(ws + WS_WIN);
    bf16_t* Z = (bf16_t*)(ws + WS_Z);
    float* psq = (float*)(ws + WS_PSQ);
    const int lane = c.lane, wr = c.wave >> 2, wc = c.wave & 3, fr = lane & 15, fq = lane >> 4;
    constexpr int NU = 129 * 9;
    for (int u = c.vcu; u < NU; u += c.G) {
        const int mt = u / 9, nt = u % 9, row0 = mt * 128, n0 = nt * 256;
        f32x4 acc[4][4]; acc_zero(acc);
        auto rp = [&](int r) { return H0 + (size_t)(row0 + r) * D; };
        gemm_kloop(acc, c, rp, WinT + (size_t)n0 * D, D, D);
        const int s0 = n0 + wc * 64;
#pragma unroll
        for (int mi = 0; mi < 4; ++mi) {
            const int row = row0 + wr * 64 + mi * 16 + fr;
            float ss = 0.f;
#pragma unroll
            for (int ni = 0; ni < 4; ++ni) {
                const f32x4 v = acc[mi][ni];
                store_bf4(Z + (size_t)row * ZC + s0 + ni * 16 + fq * 4, v);
                ss += (v[0] * v[0] + v[1] * v[1]) + (v[2] * v[2] + v[3] * v[3]);
            }
            if (s0 < ZKPE) {
                ss += __shfl_xor(ss, 16); ss += __shfl_xor(ss, 32);
                if (fq == 0) psq[(size_t)row * 16 + (s0 >> 6)] = ss;
            }
        }
    }
}

__device__ __forceinline__ void phase2(const Params& p, const Ctx& c) {
    unsigned char* ws = p.ws;
    const bf16_t* Z = (const bf16_t*)(ws + WS_Z);
    const float* psq = (const float*)(ws + WS_PSQ);
    const float* rope = (const float*)(ws + WS_ROPE);
    bf16_t* Q = (bf16_t*)(ws + WS_Q); bf16_t* Kb = (bf16_t*)(ws + WS_K); bf16_t* Vb = (bf16_t*)(ws + WS_V);
    const int lane = c.lane, wr = c.wave >> 2, wc = c.wave & 3, fr = lane & 15, fq = lane >> 4;
    constexpr int NUQ = 128 * 3, NUKV = 129 * 4;
    for (int u = c.vcu; u < NUQ + NUKV; u += c.G) {
        f32x4 acc[4][4]; acc_zero(acc);
        if (u < NUQ) {
            const int mt = u / 3, nt = u % 3, row0 = mt * 128, n0 = nt * 256;
            auto rp = [&](int r) { return Z + (size_t)(row0 + r) * ZC + ZQ; };
            gemm_kloop(acc, c, rp, (const bf16_t*)(ws + WS_WUQ) + (size_t)n0 * QLORA, QLORA, QLORA);
            const int s0 = n0 + wc * 64;
#pragma unroll
            for (int mi = 0; mi < 4; ++mi) {
                const int row = row0 + wr * 64 + mi * 16 + fr;
                const f32x4 pa = *(const f32x4*)(psq + (size_t)row * 16), pb = *(const f32x4*)(psq + (size_t)row * 16 + 4);
                const float rq = rsqrtf((((pa[0] + pa[1]) + (pa[2] + pa[3])) + (pb[0] + pb[1])) * (1.f / QLORA) + 1e-6f) * QSCALE;
                const int pos = NMETA + (row & (SEQ - 1));
#pragma unroll
                for (int np = 0; np < 2; ++np) {
                    const int c0 = s0 + np * 32 + fq * 4;
                    f32x4 a = acc[mi][2 * np] * rq, b = acc[mi][2 * np + 1] * rq;
                    if (((s0 + np * 32) % 96) == 64) {
                        const f32x4 cs0 = *(const f32x4*)(rope + ((size_t)pos * 16 + fq * 4) * 2);
                        const f32x4 cs1 = *(const f32x4*)(rope + ((size_t)pos * 16 + fq * 4 + 2) * 2);
                        const float co[4] = {cs0[0], cs0[2], cs1[0], cs1[2]}, si[4] = {cs0[1], cs0[3], cs1[1], cs1[3]};
                        f32x4 na, nb;
#pragma unroll
                        for (int j = 0; j < 4; ++j) { na[j] = a[j] * co[j] - b[j] * si[j]; nb[j] = b[j] * co[j] + a[j] * si[j]; }
                        a = na; b = nb;
                    }
                    store_bf4(Q + (size_t)row * 768 + c0, a);
                    store_bf4(Q + (size_t)row * 768 + c0 + 16, b);
                }
            }
        } else {
            const int uu = u - NUQ, mt = uu / 4, nt = uu % 4, row0 = mt * 128, n0 = nt * 256;
            auto rp = [&](int r) { return Z + (size_t)(row0 + r) * ZC + ZKV; };
            gemm_kloop(acc, c, rp, (const bf16_t*)(ws + WS_WUKV) + (size_t)n0 * KVLORA, KVLORA, KVLORA);
            const int s0 = n0 + wc * 64;
            const int h = s0 >> 7; const bool isv = (s0 & 64) != 0;
#pragma unroll
            for (int mi = 0; mi < 4; ++mi) {
                const int row = row0 + wr * 64 + mi * 16 + fr;
                if (row >= NROWS) continue;
                const f32x4 pa = *(const f32x4*)(psq + (size_t)row * 16 + 4), pb = *(const f32x4*)(psq + (size_t)row * 16 + 8);
                const float rk = rsqrtf(((pa[2] + pa[3]) + (pb[0] + pb[1])) * (1.f / KVLORA) + 1e-6f);
                const int nb = row < NTOK ? 1 : NBATCH;
                const int b0 = row < NTOK ? (row >> 11) : 0, pos = row < NTOK ? NMETA + (row & (SEQ - 1)) : row - NTOK;
                for (int bb = 0; bb < nb; ++bb) {
                    const size_t prow = (size_t)(b0 + bb) * LPOS + pos;
#pragma unroll
                    for (int ni = 0; ni < 4; ++ni) {
                        const int d = ni * 16 + fq * 4;
                        const f32x4 v = acc[mi][ni] * rk;
                        if (isv) store_bf4(Vb + prow * 512 + h * 64 + d, v);
                        else store_bf4(Kb + prow * 768 + h * 96 + d, v);
                    }
                }
            }
        }
    }
    const int gw = c.vcu * NWAVES + c.wave, NGW = c.G * NWAVES;
    const bf16_t* Zc = Z;
    for (int row = gw; row < NROWS; row += NGW) {
        const int nb = row < NTOK ? 1 : NBATCH;
        const int b0 = row < NTOK ? (row >> 11) : 0, pos = row < NTOK ? NMETA + (row & (SEQ - 1)) : row - NTOK;
        if (lane < 16) {
            const float x1 = bf2f(Zc[(size_t)row * ZC + ZKPE + lane]), x2 = bf2f(Zc[(size_t)row * ZC + ZKPE + 16 + lane]);
            const float co = rope[((size_t)pos * 16 + lane) * 2], si = rope[((size_t)pos * 16 + lane) * 2 + 1];
            const bf16_t o1 = (bf16_t)f2bf(x1 * co - x2 * si), o2 = (bf16_t)f2bf(x2 * co + x1 * si);
            for (int bb = 0; bb < nb; ++bb) {
                bf16_t* kp = Kb + ((size_t)(b0 + bb) * LPOS + pos) * 768;
#pragma unroll
                for (int h = 0; h < NH; ++h) { kp[h * 96 + 64 + lane] = o1; kp[h * 96 + 80 + lane] = o2; }
            }
        }
        if (row < NTOK) {
            const int i = row & (SEQ - 1);
            const int r1 = i >= 1 ? row - 1 : NTOK + 15;
            const int r2 = i >= 2 ? row - 2 : (i == 1 ? NTOK + 15 : NTOK + 14);
            const int ch = lane * 8;
            const u32x4 c0 = *(const u32x4*)(Zc + (size_t)row * ZC + ZCG + ch), u0 = *(const u32x4*)(Zc + (size_t)row * ZC + ZU + ch);
            const u32x4 c1 = *(const u32x4*)(Zc + (size_t)r1 * ZC + ZCG + ch), u1 = *(const u32x4*)(Zc + (size_t)r1 * ZC + ZU + ch);
            const u32x4 c2 = *(const u32x4*)(Zc + (size_t)r2 * ZC + ZCG + ch), u2 = *(const u32x4*)(Zc + (size_t)r2 * ZC + ZU + ch);
            const u32x4 bg = *(const u32x4*)(Zc + (size_t)row * ZC + ZB + ch);
            float y[8]; float ss = 0.f;
#pragma unroll
            for (int e = 0; e < 4; ++e) {
#pragma unroll
                for (int hh = 0; hh < 2; ++hh) {
                    const int cc = ch + e * 2 + hh;
                    const float w0 = p.conv_w[cc], w1 = p.conv_w[512 + cc], w2 = p.conv_w[1024 + cc];
                    const float v0 = hh ? bfhi(c0[e]) * bfhi(u0[e]) : bflo(c0[e]) * bflo(u0[e]);
                    const float v1 = hh ? bfhi(c1[e]) * bfhi(u1[e]) : bflo(c1[e]) * bflo(u1[e]);
                    const float v2 = hh ? bfhi(c2[e]) * bfhi(u2[e]) : bflo(c2[e]) * bflo(u2[e]);
                    const float bgv = hh ? bfhi(bg[e]) : bflo(bg[e]);
                    const float yy = bgv * (w0 * v2 + w1 * v1 + w2 * v0);
                    y[e * 2 + hh] = yy; ss += yy * yy;
                }
            }
            ss = wave_sum(ss);
            u32x4 o; o.x = pk2(y[0], y[1]); o.y = pk2(y[2], y[3]); o.z = pk2(y[4], y[5]); o.w = pk2(y[6], y[7]);
            *(u32x4*)((bf16_t*)(ws + WS_ATT) + (size_t)row * D + 512 + ch) = o;
            if (lane == 0) ((float*)(ws + WS_SSQC))[row] = ss;
        }
    }
}

__device__ __forceinline__ void phase3_naive(const Params& p, const Ctx& c) {
    unsigned char* ws = p.ws;
    const bf16_t* Q = (const bf16_t*)(ws + WS_Q); const bf16_t* Kb = (const bf16_t*)(ws + WS_K); const bf16_t* Vb = (const bf16_t*)(ws + WS_V);
    bf16_t* ATT = (bf16_t*)(ws + WS_ATT); float* patt = (float*)(ws + WS_PATT);
    const int gw = c.vcu * NWAVES + c.wave, NGW = c.G * NWAVES, lane = c.lane;
    for (int it = gw; it < NTOK * NH; it += NGW) {
        const int row = it >> 3, h = it & 7, b = row >> 11, i = row & (SEQ - 1), nkeys = NMETA + i + 1;
        float q[96];
#pragma unroll
        for (int j = 0; j < 12; ++j) {
            const u32x4 w = *(const u32x4*)(Q + (size_t)row * 768 + h * 96 + j * 8);
#pragma unroll
            for (int e = 0; e < 4; ++e) { q[j * 8 + e * 2] = bflo(w[e]); q[j * 8 + e * 2 + 1] = bfhi(w[e]); }
        }
        float m = -INFINITY, l = 0.f; float o[64];
#pragma unroll
        for (int d = 0; d < 64; ++d) o[d] = 0.f;
        for (int kk = lane; kk < nkeys; kk += 64) {
            const bf16_t* kp = Kb + ((size_t)b * LPOS + kk) * 768 + h * 96;
            float s = 0.f;
#pragma unroll
            for (int j = 0; j < 12; ++j) {
                const u32x4 w = *(const u32x4*)(kp + j * 8);
#pragma unroll
                for (int e = 0; e < 4; ++e) { s += q[j * 8 + e * 2] * bflo(w[e]); s += q[j * 8 + e * 2 + 1] * bfhi(w[e]); }
            }
            const float mn = fmaxf(m, s), f = exp2f(m - mn), pe = exp2f(s - mn);
            l = l * f + pe; m = mn;
            const bf16_t* vp = Vb + ((size_t)b * LPOS + kk) * 512 + h * 64;
#pragma unroll
            for (int j = 0; j < 8; ++j) {
                const u32x4 w = *(const u32x4*)(vp + j * 8);
#pragma unroll
                for (int e = 0; e < 4; ++e) { o[j * 8 + e * 2] = o[j * 8 + e * 2] * f + pe * bflo(w[e]); o[j * 8 + e * 2 + 1] = o[j * 8 + e * 2 + 1] * f + pe * bfhi(w[e]); }
            }
        }
        const float M = wave_max(m);
        const float f = (m == -INFINITY) ? 0.f : exp2f(m - M);
        const float lt = wave_sum(l * f);
        float res = 0.f;
#pragma unroll
        for (int d = 0; d < 64; ++d) { const float v = wave_sum(o[d] * f); if (lane == d) res = v; }
        res /= lt;
        ATT[(size_t)row * D + h * 64 + lane] = (bf16_t)f2bf(res);
        const float ss = wave_sum(res * res);
        if (lane == 0) patt[(size_t)row * 8 + h] = ss;
    }
}


typedef float f32x16 __attribute__((ext_vector_type(16)));
typedef short s16x4 __attribute__((ext_vector_type(4)));
constexpr int AK_PITCH = 208, AK_BYTES = 64 * AK_PITCH, AV_BYTES = 8192, ASTAGE = AK_BYTES + AV_BYTES, A_WSF = 2 * ASTAGE;
__device__ __forceinline__ int crow(int r, int hi) { return (r & 3) + 8 * (r >> 2) + 4 * hi; }
__device__ __forceinline__ s16x4 vtr(const LAS unsigned char* p) {
    return __builtin_bit_cast(s16x4, __builtin_amdgcn_ds_read_tr16_b64_v4i16((LAS s16x4*)p));
}
__device__ __forceinline__ void attn_unit(const Params& p, const Ctx& c, int b, int h, int qb) {
    unsigned char* ws = p.ws;
    const bf16_t* Q = (const bf16_t*)(ws + WS_Q); const bf16_t* Kb = (const bf16_t*)(ws + WS_K); const bf16_t* Vb = (const bf16_t*)(ws + WS_V);
    bf16_t* ATT = (bf16_t*)(ws + WS_ATT); float* patt = (float*)(ws + WS_PATT);
    const int tid = c.tid, lane = c.lane, w = c.wave, r32 = lane & 31, hi = lane >> 5;
    LAS unsigned char* lds = c.lds;
    LAS float* wsf = (LAS float*)(lds + A_WSF) + w * 32;
    const int row0 = b * SEQ + qb * 256;
    const int qpos0 = NMETA + qb * 256 + w * 32, myq = qpos0 + r32;
    bf16x8 qf[6];
#pragma unroll
    for (int ds = 0; ds < 6; ++ds) qf[ds] = *(const bf16x8*)(Q + (size_t)(row0 + w * 32 + r32) * 768 + h * 96 + ds * 16 + hi * 8);
    const bf16_t* Kg = Kb + (size_t)b * LPOS * 768 + h * 96;
    const bf16_t* Vg = Vb + (size_t)b * LPOS * 512 + h * 64;
    const int T = 4 * qb + 5;
    const int tl = (qpos0 + 31) >> 6;
    const int k0row = tid / 12, k0ch = tid % 12, k1row = (512 + tid) / 12, k1ch = (512 + tid) % 12;
    const int vrow = tid >> 3, vch = tid & 7;
    const int k0off = k0row * AK_PITCH + k0ch * 16, k1off = k1row * AK_PITCH + k1ch * 16;
    const int voff = AK_BYTES + (vch >> 2) * 4096 + vrow * 64 + (vch & 3) * 16;
    u32x4 rk0, rk1, rv;
#define A_LOAD(t) do { const int kb_ = (t) * 64; \
        rk0 = *(const u32x4*)(Kg + (size_t)min(kb_ + k0row, LPOS - 1) * 768 + k0ch * 8); \
        if (tid < 256) rk1 = *(const u32x4*)(Kg + (size_t)min(kb_ + k1row, LPOS - 1) * 768 + k1ch * 8); \
        rv = *(const u32x4*)(Vg + (size_t)min(kb_ + vrow, LPOS - 1) * 512 + vch * 8); } while (0)
#define A_STORE(buf) do { LAS unsigned char* sb_ = lds + (buf) * ASTAGE; \
        *(LAS u32x4*)(sb_ + k0off) = rk0; if (tid < 256) *(LAS u32x4*)(sb_ + k1off) = rk1; *(LAS u32x4*)(sb_ + voff) = rv; } while (0)
    float m = -INFINITY, l = 0.f;
    f32x16 o0, o1;
#pragma unroll
    for (int r = 0; r < 16; ++r) { o0[r] = 0.f; o1[r] = 0.f; }
    const int kfo = r32 * AK_PITCH + hi * 16;
    const int vfo = AK_BYTES + ((lane >> 4) & 1) * 32 + (lane & 3) * 8 + (4 * hi + ((lane & 15) >> 2)) * 64;
    __syncthreads();
    A_LOAD(0);
    A_STORE(0);
    __syncthreads();
    for (int t = 0; t < T; ++t) {
        if (t + 1 < T) A_LOAD(t + 1);
        if (t <= tl) {
            const LAS unsigned char* sb = lds + (t & 1) * ASTAGE;
            f32x16 p0, p1;
#pragma unroll
            for (int r = 0; r < 16; ++r) { p0[r] = 0.f; p1[r] = 0.f; }
#pragma unroll
            for (int ds = 0; ds < 6; ++ds) {
                const bf16x8 a0 = *(const LAS bf16x8*)(sb + kfo + ds * 32);
                const bf16x8 a1 = *(const LAS bf16x8*)(sb + kfo + 32 * AK_PITCH + ds * 32);
                p0 = __builtin_amdgcn_mfma_f32_32x32x16_bf16(a0, qf[ds], p0, 0, 0, 0);
                p1 = __builtin_amdgcn_mfma_f32_32x32x16_bf16(a1, qf[ds], p1, 0, 0, 0);
            }
            if (t * 64 + 63 > qpos0) {
                const int kb0 = t * 64 + 4 * hi;
#pragma unroll
                for (int r = 0; r < 16; ++r) {
                    const int kv = kb0 + (r & 3) + 8 * (r >> 2);
                    if (kv > myq) p0[r] = -INFINITY;
                    if (kv + 32 > myq) p1[r] = -INFINITY;
                }
            }
            float mx = fmaxf(p0[0], p1[0]);
#pragma unroll
            for (int r = 1; r < 16; ++r) mx = fmaxf(mx, fmaxf(p0[r], p1[r]));
            mx = fmaxf(mx, __shfl_xor(mx, 32));
            if (__any(mx > m)) {
                const float mn = fmaxf(m, mx), alpha = __builtin_amdgcn_exp2f(m - mn);
                m = mn; l *= alpha;
                if (hi == 0) wsf[r32] = alpha;
                asm volatile("s_waitcnt lgkmcnt(0)" ::: "memory");
#pragma unroll
                for (int k = 0; k < 4; ++k) {
                    const f32x4 a = *(const LAS f32x4*)(wsf + 8 * k + 4 * hi);
#pragma unroll
                    for (int j = 0; j < 4; ++j) { o0[4 * k + j] *= a[j]; o1[4 * k + j] *= a[j]; }
                }
                asm volatile("s_waitcnt lgkmcnt(0)" ::: "memory");
            }
            float ls = 0.f;
#pragma unroll
            for (int r = 0; r < 16; ++r) { p0[r] = __builtin_amdgcn_exp2f(p0[r] - m); p1[r] = __builtin_amdgcn_exp2f(p1[r] - m); ls += p0[r] + p1[r]; }
            l += ls;
            bf16x8 pa[4];
#pragma unroll
            for (int s = 0; s < 4; ++s) {
                u32x4 wv;
#pragma unroll
                for (int e = 0; e < 4; ++e) {
                    const int r = 8 * (s & 1) + 2 * e;
                    wv[e] = (s >> 1) ? pk2(p1[r], p1[r + 1]) : pk2(p0[r], p0[r + 1]);
                }
                pa[s] = __builtin_bit_cast(bf16x8, wv);
            }
#pragma unroll
            for (int s = 0; s < 4; ++s) {
                const s16x4 l0 = vtr(sb + vfo + s * 1024), h0 = vtr(sb + vfo + s * 1024 + 512);
                const s16x4 l1 = vtr(sb + vfo + 4096 + s * 1024), h1 = vtr(sb + vfo + 4096 + s * 1024 + 512);
                const bf16x8 v0 = (bf16x8){l0[0], l0[1], l0[2], l0[3], h0[0], h0[1], h0[2], h0[3]};
                const bf16x8 v1 = (bf16x8){l1[0], l1[1], l1[2], l1[3], h1[0], h1[1], h1[2], h1[3]};
                o0 = __builtin_amdgcn_mfma_f32_32x32x16_bf16(pa[s], v0, o0, 0, 0, 0);
                o1 = __builtin_amdgcn_mfma_f32_32x32x16_bf16(pa[s], v1, o1, 0, 0, 0);
            }
        }
        if (t + 1 < T) A_STORE((t + 1) & 1);
        __syncthreads();
    }
#undef A_LOAD
#undef A_STORE
    l += __shfl_xor(l, 32);
    if (hi == 0) wsf[r32] = 1.f / l;
    asm volatile("s_waitcnt lgkmcnt(0)" ::: "memory");
    float sq[16];
#pragma unroll
    for (int k = 0; k < 4; ++k) {
        const f32x4 a = *(const LAS f32x4*)(wsf + 8 * k + 4 * hi);
#pragma unroll
        for (int j = 0; j < 4; ++j) {
            const int r = 4 * k + j;
            const float x0 = o0[r] * a[j], x1 = o1[r] * a[j];
            bf16_t* op = ATT + (size_t)(row0 + w * 32 + crow(r, hi)) * D + h * 64 + r32;
            op[0] = (bf16_t)f2bf(x0); op[32] = (bf16_t)f2bf(x1);
            sq[r] = x0 * x0 + x1 * x1;
        }
    }
#pragma unroll
    for (int r = 0; r < 16; ++r) {
        float v = sq[r];
#pragma unroll
        for (int o = 1; o < 32; o <<= 1) v += __shfl_xor(v, o);
        if (r32 == 0) patt[(size_t)(row0 + w * 32 + crow(r, hi)) * 8 + h] = v;
    }
    asm volatile("s_waitcnt lgkmcnt(0)" ::: "memory");
}
__device__ __forceinline__ void phase3(const Params& p, const Ctx& c) {
    for (int pi = c.vcu; pi < 256; pi += c.G) {
        const int bh = pi >> 2, s = pi & 3;
        attn_unit(p, c, bh >> 3, bh & 7, 7 - s);
        attn_unit(p, c, bh >> 3, bh & 7, s);
    }
}

__device__ __forceinline__ void phase4(const Params& p, const Ctx& c) {
    unsigned char* ws = p.ws;
    const bf16_t* ATT = (const bf16_t*)(ws + WS_ATT); const bf16_t* CONV = (const bf16_t*)(ws + WS_CONV);
    const bf16_t* WoT = (const bf16_t*)(ws + WS_WO); const bf16_t* H0 = (const bf16_t*)(ws + WS_H0);
    const float* patt = (const float*)(ws + WS_PATT); const float* ssq_c = (const float*)(ws + WS_SSQC);
    bf16_t* Y1 = (bf16_t*)(ws + WS_Y1); float* pst = (float*)(ws + WS_PST);
    const int lane = c.lane, wr = c.wave >> 2, wc = c.wave & 3, fr = lane & 15, fq = lane >> 4;
    constexpr int NU = 128 * 4;
    for (int u = c.vcu; u < NU; u += c.G) {
        const int mt = u >> 2, nt = u & 3, row0 = mt * 128, n0 = nt * 256;
        f32x4 acc[4][4]; acc_zero(acc);
        auto rpa = [&](int r) { return ATT + (size_t)(row0 + r) * 512; };
        gemm_kloop(acc, c, rpa, WoT + (size_t)n0 * D, D, 512);
        float rc[4];
#pragma unroll
        for (int mi = 0; mi < 4; ++mi) {
            const int row = row0 + wr * 64 + mi * 16 + fr;
            const f32x4 pa = *(const f32x4*)(patt + (size_t)row * 8), pb = *(const f32x4*)(patt + (size_t)row * 8 + 4);
            const float ra = rsqrtf((((pa[0] + pa[1]) + (pa[2] + pa[3])) + ((pb[0] + pb[1]) + (pb[2] + pb[3]))) * (1.f / 512) + 1e-6f);
            rc[mi] = rsqrtf(ssq_c[row] * (1.f / 512) + 1e-6f);
            const float f = ra / rc[mi];
#pragma unroll
            for (int ni = 0; ni < 4; ++ni) acc[mi][ni] = acc[mi][ni] * f;
        }
        auto rpc = [&](int r) { return CONV + (size_t)(row0 + r) * 512; };
        gemm_kloop(acc, c, rpc, WoT + (size_t)n0 * D + 512, D, 512);
        const int s0 = n0 + wc * 64;
#pragma unroll
        for (int mi = 0; mi < 4; ++mi) {
            const int row = row0 + wr * 64 + mi * 16 + fr;
            float s = 0.f, ss = 0.f;
#pragma unroll
            for (int ni = 0; ni < 4; ++ni) {
                const int col = s0 + ni * 16 + fq * 4;
                const u32x2 hw = *(const u32x2*)(H0 + (size_t)row * D + col);
                f32x4 v = acc[mi][ni] * rc[mi];
                v[0] += ALPHA * bflo(hw.x); v[1] += ALPHA * bfhi(hw.x); v[2] += ALPHA * bflo(hw.y); v[3] += ALPHA * bfhi(hw.y);
                store_bf4(Y1 + (size_t)row * D + col, v);
                s += (v[0] + v[1]) + (v[2] + v[3]);
                ss += (v[0] * v[0] + v[1] * v[1]) + (v[2] * v[2] + v[3] * v[3]);
            }
            s += __shfl_xor(s, 16); s += __shfl_xor(s, 32);
            ss += __shfl_xor(ss, 16); ss += __shfl_xor(ss, 32);
            if (fq == 0) { float* q = pst + ((size_t)row * 16 + nt * 4 + wc) * 2; q[0] = s; q[1] = ss; }
        }
    }
}

__device__ __forceinline__ void phase5a(const Params& p, const Ctx& c) {
    unsigned char* ws = p.ws;
    const bf16_t* Y1 = (const bf16_t*)(ws + WS_Y1); bf16_t* H1 = (bf16_t*)(ws + WS_H1); const float* pst = (const float*)(ws + WS_PST);
    const int gw = c.vcu * NWAVES + c.wave, NGW = c.G * NWAVES, lane = c.lane;
    for (int row = gw; row < NTOK; row += NGW) {
        float s1 = 0.f, s2 = 0.f;
#pragma unroll
        for (int k = 0; k < 16; ++k) { s1 += pst[((size_t)row * 16 + k) * 2]; s2 += pst[((size_t)row * 16 + k) * 2 + 1]; }
        const float mean = s1 * (1.f / D), var = fmaxf(s2 * (1.f / D) - mean * mean, 0.f), rstd = rsqrtf(var + 1e-5f);
#pragma unroll
        for (int j = 0; j < 2; ++j) {
            const int col = (lane + 64 * j) * 8;
            const u32x4 w = *(const u32x4*)(Y1 + (size_t)row * D + col);
            float y[8];
#pragma unroll
            for (int e = 0; e < 4; ++e) { y[2 * e] = bflo(w[e]); y[2 * e + 1] = bfhi(w[e]); }
#pragma unroll
            for (int e = 0; e < 8; ++e) y[e] = (y[e] - mean) * rstd * p.ln1_g[col + e] + p.ln1_b[col + e];
            u32x4 o; o.x = pk2(y[0], y[1]); o.y = pk2(y[2], y[3]); o.z = pk2(y[4], y[5]); o.w = pk2(y[6], y[7]);
            *(u32x4*)(H1 + (size_t)row * D + col) = o;
        }
    }
}
__device__ __forceinline__ void phase5b(const Params& p, const Ctx& c) {
    unsigned char* ws = p.ws;
    const bf16_t* H1 = (const bf16_t*)(ws + WS_H1); float* LOG = (float*)(ws + WS_LOG);
    const int lane = c.lane, wr = c.wave >> 2, wc = c.wave & 3, fr = lane & 15, fq = lane >> 4;
    for (int u = c.vcu; u < 128; u += c.G) {
        const int row0 = u * 128;
        f32x4 acc[4][4]; acc_zero(acc);
        auto rp = [&](int r) { return H1 + (size_t)(row0 + r) * D; };
        gemm_kloop(acc, c, rp, (const bf16_t*)(ws + WS_WR), D, D);
#pragma unroll
        for (int mi = 0; mi < 4; ++mi) {
            const int row = row0 + wr * 64 + mi * 16 + fr;
#pragma unroll
            for (int ni = 0; ni < 4; ++ni) *(f32x4*)(LOG + (size_t)row * 256 + wc * 64 + ni * 16 + fq * 4) = acc[mi][ni];
        }
    }
}
__device__ __forceinline__ void phase5c(const Params& p, const Ctx& c) {
    unsigned char* ws = p.ws;
    const float* LOG = (const float*)(ws + WS_LOG);
    unsigned* cnt = (unsigned*)(ws + WS_CTL + CT_CNT); unsigned* laid = (unsigned*)(ws + WS_LAID); float* lgate = (float*)(ws + WS_LGATE);
    const int gw = c.vcu * NWAVES + c.wave, NGW = c.G * NWAVES, lane = c.lane;
    const f32x4 bias = *((const f32x4*)p.router_bias + lane);
    for (int t = gw; t < NTOK; t += NGW) {
        const f32x4 lg = *((const f32x4*)(LOG + (size_t)t * 256) + lane);
        float s[4], sel[4];
#pragma unroll
        for (int i = 0; i < 4; ++i) { s[i] = 1.f / (1.f + expf(-lg[i])); sel[i] = s[i] + bias[i]; }
        float a = fmaxf(sel[0], sel[1]), b = fminf(sel[0], sel[1]), cc = fmaxf(sel[2], sel[3]), d = fminf(sel[2], sel[3]);
        float t1 = fmaxf(a, cc), t2 = fmaxf(fminf(a, cc), a >= cc ? b : d);
#pragma unroll
        for (int o = 1; o < 8; o <<= 1) {
            const float y1 = __shfl_xor(t1, o), y2 = __shfl_xor(t2, o);
            const float n1 = fmaxf(t1, y1), n2 = fmaxf(fminf(t1, y1), t1 >= y1 ? t2 : y2);
            t1 = n1; t2 = n2;
        }
        const float gs = t1 + t2; const int g = lane >> 3;
        int better = 0;
#pragma unroll
        for (int gg = 0; gg < 8; ++gg) { const float o = __shfl(gs, gg * 8); better += (o > gs || (o == gs && gg < g)) ? 1 : 0; }
        if (better >= 4) { sel[0] = sel[1] = sel[2] = sel[3] = -INFINITY; }
        int ek[8]; float sk[8]; float ssum = 0.f;
#pragma unroll
        for (int k = 0; k < 8; ++k) {
            float bv = sel[0]; int bi = 0;
            if (sel[1] > bv) { bv = sel[1]; bi = 1; }
            if (sel[2] > bv) { bv = sel[2]; bi = 2; }
            if (sel[3] > bv) { bv = sel[3]; bi = 3; }
            const float wm = wave_max(bv);
            const unsigned long long mask = __ballot(bv == wm);
            const int src = __ffsll((long long)mask) - 1;
            const float sb = bi == 0 ? s[0] : bi == 1 ? s[1] : bi == 2 ? s[2] : s[3];
            ek[k] = src * 4 + __shfl(bi, src); sk[k] = __shfl(sb, src); ssum += sk[k];
            if (lane == src) { if (bi == 0) sel[0] = -INFINITY; else if (bi == 1) sel[1] = -INFINITY; else if (bi == 2) sel[2] = -INFINITY; else sel[3] = -INFINITY; }
        }
        int me = ek[0]; float mg = sk[0];
#pragma unroll
        for (int k = 1; k < 8; ++k) if (lane == k) { me = ek[k]; mg = sk[k]; }
        if (lane < 8) {
            const unsigned pos = atomicAdd(cnt + me, 1u);
            laid[(size_t)me * CAP + pos] = (unsigned)(t * 8 + lane);
            lgate[(size_t)me * CAP + pos] = mg / ssum * 2.5f;
        }
    }
}

struct MoeTab { LAS int* tstart; LAS int* roff; LAS int* tok; LAS float* gate; };
__device__ __forceinline__ MoeTab moe_tab_build(const Params& p, const Ctx& c) {
    MoeTab T; T.tstart = (LAS int*)(c.lds + LDS_MISC); T.roff = T.tstart + 260; T.tok = T.roff + 260; T.gate = (LAS float*)(T.tok + 128);
    const unsigned* cnt = (const unsigned*)(p.ws + WS_CTL + CT_CNT);
    __syncthreads();
    if (c.tid < 64) {
        int cv[4], tv[4]; int ls = 0, lt = 0;
#pragma unroll
        for (int i = 0; i < 4; ++i) { cv[i] = (int)cnt[c.tid * 4 + i]; tv[i] = (cv[i] + 127) >> 7; ls += cv[i]; lt += tv[i]; }
        int ps = ls, pt = lt;
#pragma unroll
        for (int o = 1; o < 64; o <<= 1) { const int a = __shfl_up(ps, o), b = __shfl_up(pt, o); if (c.tid >= o) { ps += a; pt += b; } }
        int es = ps - ls, et = pt - lt;
#pragma unroll
        for (int i = 0; i < 4; ++i) { T.roff[c.tid * 4 + i] = es; T.tstart[c.tid * 4 + i] = et; es += cv[i]; et += tv[i]; }
        if (c.tid == 63) { T.roff[256] = es; T.tstart[256] = et; }
    }
    __syncthreads();
    return T;
}
__device__ __forceinline__ int moe_find(const MoeTab& T, int g) {
    int lo = 0, hi = 255;
    while (lo < hi) { const int mid = (lo + hi + 1) >> 1; if (T.tstart[mid] <= g) lo = mid; else hi = mid - 1; }
    return lo;
}

__device__ __forceinline__ void phase6(const Params& p, const Ctx& c) {
    unsigned char* ws = p.ws;
    const bf16_t* H1 = (const bf16_t*)(ws + WS_H1); bf16_t* HID = (bf16_t*)(ws + WS_HID);
    const unsigned* laid = (const unsigned*)(ws + WS_LAID);
    const unsigned* cnt = (const unsigned*)(ws + WS_CTL + CT_CNT);
    const int lane = c.lane, wr = c.wave >> 2, wc = c.wave & 3, fr = lane & 15, fq = lane >> 4;
    const MoeTab T = moe_tab_build(p, c);
    const int tmt = T.tstart[256], NU = (tmt + 128) * 2;
    for (int u = c.vcu; u < NU; u += c.G) {
        const int g = u >> 1, nt = u & 1;
        int e, mt, nrows; size_t hbase;
        __syncthreads();
        if (g < tmt) {
            e = moe_find(T, g); mt = g - T.tstart[e]; nrows = min(128, (int)cnt[e] - mt * 128); hbase = (size_t)T.roff[e] + mt * 128;
            if (c.tid < 128) T.tok[c.tid] = (int)(laid[(size_t)e * CAP + mt * 128 + min(c.tid, nrows - 1)] >> 3);
        } else {
            e = NEXP; mt = g - tmt; nrows = 128; hbase = (size_t)NTOK * 8 + mt * 128;
            if (c.tid < 128) T.tok[c.tid] = mt * 128 + c.tid;
        }
        __syncthreads();
        f32x4 acc[4][4]; acc_zero(acc);
        auto rp = [&](int r) { return H1 + (size_t)T.tok[r] * D; };
        const bf16_t* Bt = (e < NEXP ? (const bf16_t*)(ws + WS_WGU) + (size_t)e * 512 * D : (const bf16_t*)(ws + WS_WSGU)) + (size_t)nt * 256 * D;
        gemm_kloop(acc, c, rp, Bt, D, D);
#pragma unroll
        for (int mi = 0; mi < 4; ++mi) {
            const int r = wr * 64 + mi * 16 + fr;
            if (r >= nrows) continue;
#pragma unroll
            for (int np = 0; np < 2; ++np) {
                const f32x4 gt = acc[mi][2 * np], up = acc[mi][2 * np + 1];
                f32x4 hv;
#pragma unroll
                for (int j = 0; j < 4; ++j) hv[j] = gt[j] / (1.f + __expf(-gt[j])) * up[j];
                store_bf4(HID + (hbase + r) * DEXP + nt * 128 + wc * 32 + np * 16 + fq * 4, hv);
            }
        }
    }
}
__device__ __forceinline__ void phase7(const Params& p, const Ctx& c) {
    unsigned char* ws = p.ws;
    const bf16_t* HID = (const bf16_t*)(ws + WS_HID); bf16_t* Y = (bf16_t*)(ws + WS_Y);
    const unsigned* laid = (const unsigned*)(ws + WS_LAID); const float* lgate = (const float*)(ws + WS_LGATE);
    const unsigned* cnt = (const unsigned*)(ws + WS_CTL + CT_CNT);
    const int lane = c.lane, wr = c.wave >> 2, wc = c.wave & 3, fr = lane & 15, fq = lane >> 4;
    const MoeTab T = moe_tab_build(p, c);
    const int tmt = T.tstart[256], NU = (tmt + 128) * 4;
    for (int u = c.vcu; u < NU; u += c.G) {
        const int g = u >> 2, nt = u & 3;
        int e, mt, nrows; size_t hbase;
        __syncthreads();
        if (g < tmt) {
            e = moe_find(T, g); mt = g - T.tstart[e]; nrows = min(128, (int)cnt[e] - mt * 128); hbase = (size_t)T.roff[e] + mt * 128;
            if (c.tid < 128) {
                const int rr = min(c.tid, nrows - 1);
                const unsigned aid = laid[(size_t)e * CAP + mt * 128 + rr];
                T.tok[c.tid] = (int)((aid >> 3) * 9 + (aid & 7)); T.gate[c.tid] = lgate[(size_t)e * CAP + mt * 128 + rr];
            }
        } else {
            e = NEXP; mt = g - tmt; nrows = 128; hbase = (size_t)NTOK * 8 + mt * 128;
            if (c.tid < 128) { T.tok[c.tid] = (mt * 128 + c.tid) * 9 + 8; T.gate[c.tid] = 1.f; }
        }
        __syncthreads();
        f32x4 acc[4][4]; acc_zero(acc);
        auto rp = [&](int r) { return HID + (hbase + min(r, nrows - 1)) * DEXP; };
        const bf16_t* Bt = (e < NEXP ? (const bf16_t*)(ws + WS_WD) + (size_t)e * D * DEXP : (const bf16_t*)(ws + WS_WSD)) + (size_t)nt * 256 * DEXP;
        gemm_kloop(acc, c, rp, Bt, DEXP, DEXP);
#pragma unroll
        for (int mi = 0; mi < 4; ++mi) {
            const int r = wr * 64 + mi * 16 + fr;
            if (r >= nrows) continue;
            const float gt = T.gate[r]; const size_t yrow = (size_t)T.tok[r];
#pragma unroll
            for (int ni = 0; ni < 4; ++ni) store_bf4(Y + yrow * D + nt * 256 + wc * 64 + ni * 16 + fq * 4, acc[mi][ni] * gt);
        }
    }
}

__device__ __forceinline__ int moe_find_l(const LAS int* tstart, int g) {
    int lo = 0, hi = 255;
    while (lo < hi) { const int mid = (lo + hi + 1) >> 1; if (tstart[mid] <= g) lo = mid; else hi = mid - 1; }
    return lo;
}

typedef float f32x2 __attribute__((ext_vector_type(2)));
typedef __bf16 bf16x2_t __attribute__((ext_vector_type(2)));
__device__ __forceinline__ unsigned cvtpk(float lo, float hi) { f32x2 v = {lo, hi}; bf16x2_t b = __builtin_convertvector(v, bf16x2_t); return __builtin_bit_cast(unsigned, b); }
constexpr int MOE_A = 0, MOE_B = 32768, MOE_H0 = 98304, MOE_H1 = 0, MOE_MISC = 131072;
struct MoeUnit { const float* wg; const float* wu; const float* wd; int nrows; int par; };

__device__ __forceinline__ void phase_moe(const Params& p, const Ctx& c) {
    unsigned char* ws = p.ws;
    const bf16_t* H1 = (const bf16_t*)(ws + WS_H1); bf16_t* Y = (bf16_t*)(ws + WS_Y);
    const unsigned* laid = (const unsigned*)(ws + WS_LAID); const float* lgate = (const float*)(ws + WS_LGATE);
    const unsigned* cnt = (const unsigned*)(ws + WS_CTL + CT_CNT);
    const int tid = c.tid, lane = c.lane, wr = c.wave >> 2, wc = c.wave & 3, fr = lane & 15, fq = lane >> 4;
    LAS unsigned char* lds = c.lds;
    LAS int* tstart = (LAS int*)(lds + MOE_MISC); LAS int* cntl = tstart + 260;
    LAS int* tokT = cntl + 260; LAS int* yrowT = tokT + 256; LAS float* gateT = (LAS float*)(yrowT + 256);
    __syncthreads();
    if (tid < 64) {
        int cv[4], tv[4]; int lt = 0;
#pragma unroll
        for (int i = 0; i < 4; ++i) { cv[i] = (int)cnt[tid * 4 + i]; tv[i] = (cv[i] + 127) >> 7; lt += tv[i]; }
        int pt = lt;
#pragma unroll
        for (int o = 1; o < 64; o <<= 1) { const int b = __shfl_up(pt, o); if (tid >= o) pt += b; }
        int et = pt - lt;
#pragma unroll
        for (int i = 0; i < 4; ++i) { cntl[tid * 4 + i] = cv[i]; tstart[tid * 4 + i] = et; et += tv[i]; }
        if (tid == 63) tstart[256] = et;
    }
    __syncthreads();
    const int tmt = tstart[256], NU = tmt + 128;
    if (c.vcu >= NU) return;

    const int srow = tid >> 3, sch = tid & 7;
    const int soA = srow * 128 + ((sch ^ ((srow >> 1) & 7)) << 4);
    const int kk1 = tid >> 5, n4 = tid & 31;
    const int s1 = (kk1 & 3) | (((kk1 >> 3) & 1) << 2);
    const int soB1g = kk1 * 512 + (((2 * (n4 >> 2)) ^ s1) << 5) + (n4 & 3) * 8;
    const int soB1u = kk1 * 512 + (((2 * (n4 >> 2) + 1) ^ s1) << 5) + (n4 & 3) * 8;
    const int kk2 = tid >> 6, c4 = tid & 63;
    const int soB2e = kk2 * 512 + ((((c4 >> 2)) ^ (kk2 & 3)) << 5) + (c4 & 3) * 8;
    const int soB2o = kk2 * 512 + ((((c4 >> 2)) ^ ((kk2 & 3) | 4)) << 5) + (c4 & 3) * 8;
    const int sw0 = ((0 + fq) ^ ((fr >> 1) & 7)) << 4, sw1 = ((4 + fq) ^ ((fr >> 1) & 7)) << 4;
    const int aoff = (wr * 64 + fr) * 128;
    const int qp = fr >> 2, pp = fr & 3, sB = qp | ((fq & 1) << 2);
    const int brow = (8 * fq + qp) * 512 + pp * 8;
    int bblk[4];
#pragma unroll
    for (int ni = 0; ni < 4; ++ni) bblk[ni] = ((4 * wc + ni) ^ sB) << 5;
    const int hoff = (wr * 64 + fr) * 256;

    const unsigned lo1 = (unsigned)(kk1 * 256 + n4 * 4), lo2 = (unsigned)(kk2 * D + c4 * 4);
    u32x4 ra0, ra1; f32x4 rb[8];
    f32x4 acc[4][4];

#define M_LOAD1(U, nt, kt) do { \
        const int t0_ = tokT[(U).par * 128 + srow], t1_ = tokT[(U).par * 128 + srow + 64]; \
        ra0 = *(const u32x4*)(H1 + (size_t)t0_ * D + (kt) * 64 + sch * 8); ra1 = *(const u32x4*)(H1 + (size_t)t1_ * D + (kt) * 64 + sch * 8); \
        const float* g_ = (U).wg + ((kt) * 64 * 256 + (nt) * 128); const float* u_ = (U).wu + ((kt) * 64 * 256 + (nt) * 128); \
        _Pragma("unroll") for (int j = 0; j < 4; ++j) { rb[j] = *(const f32x4*)(g_ + j * 4096 + lo1); rb[4 + j] = *(const f32x4*)(u_ + j * 4096 + lo1); } } while (0)
#define M_STORE1(buf) do { LAS unsigned char* sa_ = lds + MOE_A + (buf) * 16384; LAS unsigned char* sb_ = lds + MOE_B + (buf) * 32768; \
        *(LAS u32x4*)(sa_ + soA) = ra0; *(LAS u32x4*)(sa_ + soA + 8192) = ra1; \
        _Pragma("unroll") for (int j = 0; j < 4; ++j) { \
            *(LAS u32x2*)(sb_ + soB1g + j * 8192) = (u32x2){cvtpk(rb[j][0], rb[j][1]), cvtpk(rb[j][2], rb[j][3])}; \
            *(LAS u32x2*)(sb_ + soB1u + j * 8192) = (u32x2){cvtpk(rb[4 + j][0], rb[4 + j][1]), cvtpk(rb[4 + j][2], rb[4 + j][3])}; } } while (0)
#define M_LOAD2(U, nt2, ksm) do { \
        const float* d_ = (U).wd + ((ksm) * 64 * D + (nt2) * 256); \
        _Pragma("unroll") for (int j = 0; j < 8; ++j) rb[j] = *(const f32x4*)(d_ + j * 8192 + lo2); } while (0)
#define M_STORE2(buf) do { LAS unsigned char* sb_ = lds + MOE_B + (buf) * 32768; \
        _Pragma("unroll") for (int j = 0; j < 8; ++j) \
            *(LAS u32x2*)(sb_ + ((j & 1) ? soB2o : soB2e) + j * 4096) = (u32x2){cvtpk(rb[j][0], rb[j][1]), cvtpk(rb[j][2], rb[j][3])}; } while (0)
#define M_BFRAG(dst, sbB, ks) do { _Pragma("unroll") for (int ni = 0; ni < 4; ++ni) { \
            const s16x4 lo_ = vtr((sbB) + brow + (ks) * 16384 + bblk[ni]), hi_ = vtr((sbB) + brow + (ks) * 16384 + 2048 + bblk[ni]); \
            dst[ni] = (bf16x8){lo_[0], lo_[1], lo_[2], lo_[3], hi_[0], hi_[1], hi_[2], hi_[3]}; } } while (0)
#define M_COMPUTE1(buf) do { const LAS unsigned char* sa_ = lds + MOE_A + (buf) * 16384; const LAS unsigned char* sbb_ = lds + MOE_B + (buf) * 32768; \
        _Pragma("unroll") for (int ks = 0; ks < 2; ++ks) { bf16x8 af[4], bfr[4]; \
            _Pragma("unroll") for (int mi = 0; mi < 4; ++mi) af[mi] = *(const LAS bf16x8*)(sa_ + aoff + mi * 2048 + (ks ? sw1 : sw0)); \
            M_BFRAG(bfr, sbb_, ks); \
            _Pragma("unroll") for (int mi = 0; mi < 4; ++mi) _Pragma("unroll") for (int ni = 0; ni < 4; ++ni) \
                acc[mi][ni] = __builtin_amdgcn_mfma_f32_16x16x32_bf16(bfr[ni], af[mi], acc[mi][ni], 0, 0, 0); } } while (0)
#define M_COMPUTE2(buf, ksm) do { const LAS unsigned char* sh_ = lds + (((ksm) >> 1) ? MOE_H1 : MOE_H0); const LAS unsigned char* sbb_ = lds + MOE_B + (buf) * 32768; \
        _Pragma("unroll") for (int ks = 0; ks < 2; ++ks) { bf16x8 af[4], bfr[4]; \
            _Pragma("unroll") for (int mi = 0; mi < 4; ++mi) af[mi] = *(const LAS bf16x8*)(sh_ + hoff + mi * 4096 + (((((ksm) & 1) * 8 + ks * 4 + fq) ^ fr) << 4)); \
            M_BFRAG(bfr, sbb_, ks); \
            _Pragma("unroll") for (int mi = 0; mi < 4; ++mi) _Pragma("unroll") for (int ni = 0; ni < 4; ++ni) \
                acc[mi][ni] = __builtin_amdgcn_mfma_f32_16x16x32_bf16(bfr[ni], af[mi], acc[mi][ni], 0, 0, 0); } } while (0)

    auto unit_make = [&](int u, int par, MoeUnit& U, int& e, int& mt) {
        if (u < tmt) { e = moe_find_l(tstart, u); mt = u - tstart[e]; U.nrows = min(128, cntl[e] - mt * 128);
            U.wg = p.w_gate + (size_t)e * D * DEXP; U.wu = p.w_up + (size_t)e * D * DEXP; U.wd = p.w_down + (size_t)e * D * DEXP; }
        else { e = NEXP; mt = u - tmt; U.nrows = 128; U.wg = p.ws_gate; U.wu = p.ws_up; U.wd = p.ws_down; }
        U.par = par;
    };
    auto unit_tables = [&](const MoeUnit& U, int e, int mt) {
        if (tid < 128) {
            int tok, yr; float gt;
            if (e < NEXP) { const int rr = min(tid, U.nrows - 1); const unsigned aid = laid[(size_t)e * CAP + mt * 128 + rr];
                tok = (int)(aid >> 3); yr = tok * 9 + (int)(aid & 7); gt = lgate[(size_t)e * CAP + mt * 128 + rr]; }
            else { tok = mt * 128 + tid; yr = tok * 9 + 8; gt = 1.f; }
            tokT[U.par * 128 + tid] = tok; yrowT[U.par * 128 + tid] = yr; gateT[U.par * 128 + tid] = gt;
        }
    };

    MoeUnit cur, nxt; int e_, mt_;
    unit_make(c.vcu, 0, cur, e_, mt_);
    unit_tables(cur, e_, mt_);
    __syncthreads();
    M_LOAD1(cur, 0, 0);
    M_STORE1(0);
    __syncthreads();
    for (int u = c.vcu, ui = 0; u < NU; u += c.G, ++ui) {
        const bool has_next = (u + c.G) < NU;
#pragma unroll 1
        for (int nt = 0; nt < 2; ++nt) {
            acc_zero(acc);
#pragma unroll 1
            for (int kt = 0; kt < 16; ++kt) {
                const bool last = (kt == 15);
                if (!last) M_LOAD1(cur, nt, kt + 1);
                else if (nt == 0) M_LOAD1(cur, 1, 0);
                else M_LOAD2(cur, 0, 2);
                M_COMPUTE1(kt & 1);
                if (!(last && nt == 1)) M_STORE1((kt + 1) & 1); else M_STORE2(0);
                __syncthreads();
            }
            {
                LAS unsigned char* hb = lds + (nt ? MOE_H1 : MOE_H0);
#pragma unroll
                for (int mi = 0; mi < 4; ++mi) {
                    const int r = wr * 64 + mi * 16 + fr;
#pragma unroll
                    for (int np = 0; np < 2; ++np) {
                        const f32x4 gt = acc[mi][2 * np], up = acc[mi][2 * np + 1];
                        float hv[4];
#pragma unroll
                        for (int j = 0; j < 4; ++j) hv[j] = gt[j] / (1.f + __expf(-gt[j])) * up[j];
                        const int chunk = wc * 4 + np * 2 + (fq >> 1);
                        *(LAS u32x2*)(hb + r * 256 + ((chunk ^ fr) << 4) + (fq & 1) * 8) = (u32x2){cvtpk(hv[0], hv[1]), cvtpk(hv[2], hv[3])};
                    }
                }
            }
            if (nt == 1) __syncthreads();
        }
#pragma unroll 1
        for (int nt2 = 0; nt2 < 4; ++nt2) {
            acc_zero(acc);
            if (nt2 == 0 && has_next) { unit_make(u + c.G, (ui + 1) & 1, nxt, e_, mt_); unit_tables(nxt, e_, mt_); }
#pragma unroll 1
            for (int kq = 0; kq < 4; ++kq) {
                const int ksm = kq ^ 2;
                const bool last = (kq == 3);
                if (!last) M_LOAD2(cur, nt2, (kq + 1) ^ 2);
                else if (nt2 < 3) M_LOAD2(cur, nt2 + 1, 2);
                else if (has_next) M_LOAD1(nxt, 0, 0);
                M_COMPUTE2(kq & 1, ksm);
                if (!(last && nt2 == 3)) M_STORE2((kq + 1) & 1); else if (has_next) M_STORE1(0);
                __syncthreads();
            }
#pragma unroll
            for (int mi = 0; mi < 4; ++mi) {
                const int r = wr * 64 + mi * 16 + fr;
                if (r < cur.nrows) {
                    const float gt = gateT[cur.par * 128 + r]; const size_t yrow = (size_t)yrowT[cur.par * 128 + r];
#pragma unroll
                    for (int ni = 0; ni < 4; ++ni) store_bf4(Y + yrow * D + nt2 * 256 + wc * 64 + ni * 16 + fq * 4, acc[mi][ni] * gt);
                }
            }
        }
        cur = nxt;
    }
#undef M_LOAD1
#undef M_STORE1
#undef M_LOAD2
#undef M_STORE2
#undef M_BFRAG
#undef M_COMPUTE1
#undef M_COMPUTE2
}


__device__ __forceinline__ void store_blk32_bf16(bf16_t* p, const f32x16& v, int hi, bool pred = true) {
#pragma unroll
    for (int pr = 0; pr < 2; ++pr) {
        unsigned ax = cvtpk(v[8 * pr + 0], v[8 * pr + 1]), ay = cvtpk(v[8 * pr + 2], v[8 * pr + 3]);
        unsigned bx = cvtpk(v[8 * pr + 4], v[8 * pr + 5]), by = cvtpk(v[8 * pr + 6], v[8 * pr + 7]);
        { auto r_ = __builtin_amdgcn_permlane32_swap(ax, bx, false, false); ax = r_[0]; bx = r_[1]; }
        { auto r_ = __builtin_amdgcn_permlane32_swap(ay, by, false, false); ay = r_[0]; by = r_[1]; }
        if (pred) *(u32x4*)(p + 16 * pr + (hi ? 8 : 0)) = (u32x4){ax, ay, bx, by};
    }
}

constexpr int G2_A = 0, G2_B = 65536, G2_MISC = 131072;
constexpr int G2_GATE = G2_MISC + 4096, G2_YROW = G2_GATE + 2048, G2_TAB = G2_YROW + 2048;
constexpr int BM_BF16T = 0, BM_F32 = 1, BM_F32_GU = 2;
struct G2Unit { const void* b0; const void* b1; int ldb; int nsteps; int nrows; int par; int i0, i1, i2; int kshift, bsub; };

#define G2_SGB(mask, n) __builtin_amdgcn_sched_group_barrier(mask, n, 0)
#define G2_MFMA_HALF(NMI, KM, kh) do { \
        __builtin_amdgcn_sched_barrier(0); \
        _Pragma("unroll") for (int kq = 0; kq < 2; ++kq) { const int k16_ = 2 * (kh) + kq; bf16x8 bfr[2]; \
            if (KM) { _Pragma("unroll") for (int ni = 0; ni < 2; ++ni) { const int bb_ = ((4 * wc + 2 * ni + bsel) ^ sB2) << 5; \
                const s16x4 lo_ = vtr(sbb_ + brow + k16_ * 8192 + bb_); const s16x4 hi_ = vtr(sbb_ + brow + k16_ * 8192 + 2048 + bb_); \
                bf16x8 t_; t_[0] = lo_[0]; t_[1] = lo_[1]; t_[2] = lo_[2]; t_[3] = lo_[3]; t_[4] = hi_[0]; t_[5] = hi_[1]; t_[6] = hi_[2]; t_[7] = hi_[3]; bfr[ni] = t_; } } \
            else { _Pragma("unroll") for (int ni = 0; ni < 2; ++ni) bfr[ni] = *(const LAS bf16x8*)(sbb_ + boffT + ni * 4096 + (((2 * k16_ + hi) ^ swx) << 4)); } \
            _Pragma("unroll") for (int mi = 0; mi < (NMI); ++mi) { \
                const bf16x8 af_ = *(const LAS bf16x8*)(sa_ + aoff + mi * 8192 + (((2 * k16_ + hi) ^ swx) << 4)); \
                _Pragma("unroll") for (int ni = 0; ni < 2; ++ni) acc[mi][ni] = __builtin_amdgcn_mfma_f32_32x32x16_bf16(bfr[ni], af_, acc[mi][ni], 0, 0, 0); } } \
        if (!(KM)) { _Pragma("unroll") for (int kq = 0; kq < 2; ++kq) { G2_SGB(0x100, 3); \
            _Pragma("unroll") for (int g = 0; g < (NMI) - 1; ++g) { G2_SGB(0x100, 1); G2_SGB(0x008, 2); } \
            G2_SGB(0x008, 2); } } \
        __builtin_amdgcn_sched_barrier(0); \
    } while (0)
#define G2_SEL(off) const int nst_ = st + (off); const bool wrap_ = nst_ >= cur.nsteps, usen_ = wrap_ && has_next; \
        const void* sb0_ = usen_ ? nxt.b0 : cur.b0; const void* sb1_ = usen_ ? nxt.b1 : cur.b1; const int spar_ = usen_ ? nxt.par : cur.par; \
        const int sk0_ = wrap_ ? (has_next ? nst_ - cur.nsteps : cur.nsteps - 1) : nst_; const int ldb_ = cur.ldb; (void)sb1_; \
        const int ssub_ = sk0_ >> cur.kshift, sk_ = sk0_ - (ssub_ << cur.kshift); const int sboff_ = ssub_ * cur.bsub; (void)sboff_

typedef __amdgpu_buffer_rsrc_t rsrc_t;
__device__ __forceinline__ rsrc_t make_rsrc(const void* p) {
    const unsigned long long a = (unsigned long long)(uintptr_t)p;
    const unsigned lo = __builtin_amdgcn_readfirstlane((unsigned)a), hi = __builtin_amdgcn_readfirstlane((unsigned)(a >> 32));
    return __builtin_amdgcn_make_buffer_rsrc((void*)(uintptr_t)(((unsigned long long)hi << 32) | lo), (short)0, 0x7fffffff, 0x00020000);
}
__device__ __forceinline__ u32x4 bload16(rsrc_t r, int voff, int soff) { return __builtin_bit_cast(u32x4, __builtin_amdgcn_raw_buffer_load_b128(r, voff, soff, 0)); }
template <int BMODE, bool FULL, class Sched, class Epi>
__device__ __forceinline__ void gemm256_stream(const Ctx& c, Sched& S, const Epi& E) {
    const int tid = c.tid, lane = c.lane, wr = c.wave >> 2, wc = c.wave & 3, r32 = lane & 31, hi = lane >> 5;
    LAS unsigned char* lds = c.lds;
    const LAS unsigned* rowT = (const LAS unsigned*)(lds + G2_MISC);
    const rsrc_t rsA = make_rsrc(S.abase());
    const int srow = tid >> 3, sch = tid & 7;
    const int soA = srow * 128 + ((sch ^ ((srow >> 1) & 7)) << 4);
    const int kk1 = tid >> 5, n4 = tid & 31;
    const int soB1g = kk1 * 512 + (((2 * (n4 >> 2)) ^ (2 * (kk1 & 3))) << 5) + (n4 & 3) * 8;
    const int soB1u = kk1 * 512 + (((2 * (n4 >> 2) + 1) ^ (2 * (kk1 & 3))) << 5) + (n4 & 3) * 8;
    const int kk2 = tid >> 6, c4 = tid & 63;
    const int soB2 = kk2 * 512 + ((((c4 >> 2)) ^ (2 * (kk2 & 3))) << 5) + (c4 & 3) * 8;
    const int swx = (r32 >> 1) & 7;
    const int aoff = (32 * wr + r32) * 128;
    const int boffT = (wc * 64 + r32) * 128;
    const int qp = (lane & 15) >> 2, pp = lane & 3, bsel = (lane >> 4) & 1, sB2 = 2 * qp;
    const int brow = (8 * hi + qp) * 512 + pp * 8;
    (void)boffT; (void)brow; (void)sB2; (void)bsel; (void)soB1g; (void)soB1u; (void)soB2;
    u32x4 ra[4]; u32x4 rbh[4]; f32x4 rb[8];
    f32x16 acc[4][2];
#define G1_LOAD(b0, b1, par, kst, ldb) do { \
        const LAS unsigned* rt_ = rowT + (par) * 256 + srow; \
        const int ksoff_ = __builtin_amdgcn_readfirstlane((kst) * 128); \
        _Pragma("unroll") for (int j = 0; j < 4; ++j) ra[j] = bload16(rsA, (int)rt_[64 * j] + sch * 16, ksoff_); \
        const rsrc_t rb0_ = make_rsrc(b0); \
        if (BMODE == BM_BF16T) { const int so_ = __builtin_amdgcn_readfirstlane((kst) * 128), js_ = __builtin_amdgcn_readfirstlane(128 * (ldb)); \
            _Pragma("unroll") for (int j = 0; j < 4; ++j) rbh[j] = bload16(rb0_, voB, so_ + j * js_); } \
        else if (BMODE == BM_F32) { const int so_ = __builtin_amdgcn_readfirstlane((kst) * 256 * (ldb)), js_ = __builtin_amdgcn_readfirstlane(32 * (ldb)); \
            _Pragma("unroll") for (int j = 0; j < 8; ++j) rb[j] = __builtin_bit_cast(f32x4, bload16(rb0_, voB, so_ + j * js_)); } \
        else { const rsrc_t rb1_ = make_rsrc(b1); const int so_ = __builtin_amdgcn_readfirstlane((kst) * 256 * (ldb)), js_ = __builtin_amdgcn_readfirstlane(64 * (ldb)); \
            _Pragma("unroll") for (int j = 0; j < 4; ++j) { rb[j] = __builtin_bit_cast(f32x4, bload16(rb0_, voB, so_ + j * js_)); rb[4 + j] = __builtin_bit_cast(f32x4, bload16(rb1_, voB, so_ + j * js_)); } } \
    } while (0)
#define G1_STORE(buf) do { LAS unsigned char* sa_ = lds + G2_A + (buf) * 32768; LAS unsigned char* sb_ = lds + G2_B + (buf) * 32768; \
        _Pragma("unroll") for (int j = 0; j < 4; ++j) *(LAS u32x4*)(sa_ + soA + j * 8192) = ra[j]; \
        if (BMODE == BM_BF16T) { _Pragma("unroll") for (int j = 0; j < 4; ++j) *(LAS u32x4*)(sb_ + soA + j * 8192) = rbh[j]; } \
        else if (BMODE == BM_F32) { _Pragma("unroll") for (int j = 0; j < 8; ++j) \
            *(LAS u32x2*)(sb_ + soB2 + j * 4096) = (u32x2){cvtpk(rb[j][0], rb[j][1]), cvtpk(rb[j][2], rb[j][3])}; } \
        else { _Pragma("unroll") for (int j = 0; j < 4; ++j) { \
            *(LAS u32x2*)(sb_ + soB1g + j * 8192) = (u32x2){cvtpk(rb[j][0], rb[j][1]), cvtpk(rb[j][2], rb[j][3])}; \
            *(LAS u32x2*)(sb_ + soB1u + j * 8192) = (u32x2){cvtpk(rb[4 + j][0], rb[4 + j][1]), cvtpk(rb[4 + j][2], rb[4 + j][3])}; } } \
    } while (0)
    G2Unit cur, nxt;
    if (!S.next(cur, 0)) return;
    nxt = cur;
    const int voB = BMODE == BM_BF16T ? (srow * cur.ldb + sch * 8) * 2 : BMODE == BM_F32 ? (kk2 * cur.ldb + c4 * 4) * 4 : (kk1 * cur.ldb + n4 * 4) * 4;
    __syncthreads();
    G1_LOAD(cur.b0, cur.b1, cur.par, 0, cur.ldb);
    G1_STORE(0);
    G1_LOAD(cur.b0, cur.b1, cur.par, 1, cur.ldb);
    __syncthreads();
    int gs = 0;
    bool has_cur = true;
    while (has_cur) {
#pragma unroll
        for (int a = 0; a < 4; ++a)
#pragma unroll
            for (int b = 0; b < 2; ++b)
#pragma unroll
                for (int r = 0; r < 16; ++r) acc[a][b][r] = 0.f;
        const int nb = (cur.nrows + 31) >> 5, nmi = (nb - wr + 1) >> 1;
        bool has_next = false;
#define G1_UNIT_LOOP(NMI) do { _Pragma("unroll 1") for (int st = 0; st < cur.nsteps; ++st) { \
            if (st == 1) has_next = S.next(nxt, cur.par ^ 1);     \
            if (st == 0) S.issue(); \
            { const LAS unsigned char* sa_ = lds + G2_A + (gs & 1) * 32768; const LAS unsigned char* sbb_ = lds + G2_B + (gs & 1) * 32768; \
              G2_MFMA_HALF(NMI, BMODE != BM_BF16T, 0); \
              G1_STORE((gs + 1) & 1);                             \
              __builtin_amdgcn_sched_barrier(0); \
              { G2_SEL(2); G1_LOAD((BMODE == BM_F32 ? (const void*)((const float*)sb0_ + sboff_) : sb0_), sb1_, spar_, sk_, ldb_); }     \
              G2_MFMA_HALF(NMI, BMODE != BM_BF16T, 1); } \
            if (st == 0) S.commit(); \
            __syncthreads(); \
            ++gs; \
            if (Epi::HAS_MID) E.mid(acc, cur, st, nmi, wr, r32); } } while (0)
        if (FULL || nmi >= 4) G1_UNIT_LOOP(4); else if (nmi == 3) G1_UNIT_LOOP(3); else if (nmi == 2) G1_UNIT_LOOP(2); else G1_UNIT_LOOP(1);
#undef G1_UNIT_LOOP
        E(acc, cur, nmi, wr, wc, r32, hi);
        cur = nxt; has_cur = has_next;
    }
#undef G1_LOAD
#undef G1_STORE
}

struct MoeSched2 {
    const Params& p; const Ctx& c; int NT; bool isB; int tru, NU, i;
    LAS int* tstart; LAS int* roff; LAS int* cntl; LAS int* rpuT; LAS int* qslot; unsigned* qctr; unsigned pend;
    __device__ __forceinline__ const void* abase() const { return isB ? p.ws + WS_HID : p.ws + WS_H1; }
    __device__ __forceinline__ void issue() { if (c.tid == 0) pend = __hip_atomic_fetch_add(qctr, 1u, __ATOMIC_RELAXED, __HIP_MEMORY_SCOPE_AGENT); }
    __device__ __forceinline__ void commit() { if (c.tid == 0) qslot[0] = (int)(32u + pend); }
    __device__ __forceinline__ MoeSched2(const Params& p_, const Ctx& c_, int NT_, bool isB_) : p(p_), c(c_), NT(NT_), isB(isB_), i(0) {
        tstart = (LAS int*)(c.lds + G2_TAB); roff = tstart + 260; cntl = roff + 260; rpuT = cntl + 260; qslot = rpuT + 260; pend = 0;
        qctr = (unsigned*)(p.ws + WS_CTL + CT_Q) + (isB_ ? 8 * 64 : 0) + (c.vcu >> 5) * 64;
        const unsigned* cnt = (const unsigned*)(p.ws + WS_CTL + CT_CNT);
        __syncthreads();
        if (c.tid < 64) {
            int cv[4], tv[4], rp[4]; int ls = 0, lt = 0;
#pragma unroll
            for (int k = 0; k < 4; ++k) { cv[k] = (int)cnt[c.tid * 4 + k]; tv[k] = (cv[k] + 255) >> 8; rp[k] = tv[k] ? ((((cv[k] + tv[k] - 1) / tv[k]) + 31) & ~31) : 0; ls += cv[k]; lt += tv[k]; }
            int ps = ls, pt = lt;
#pragma unroll
            for (int o = 1; o < 64; o <<= 1) { const int a = __shfl_up(ps, o), b = __shfl_up(pt, o); if (c.tid >= o) { ps += a; pt += b; } }
            int es = ps - ls, et = pt - lt;
#pragma unroll
            for (int k = 0; k < 4; ++k) { cntl[c.tid * 4 + k] = cv[k]; rpuT[c.tid * 4 + k] = rp[k]; roff[c.tid * 4 + k] = es; tstart[c.tid * 4 + k] = et; es += cv[k]; et += tv[k]; }
            if (c.tid == 63) { roff[256] = es; tstart[256] = et; }
        }
        __syncthreads();
        tru = tstart[256]; NU = (tru + 64) * NT;
    }
    __device__ __forceinline__ bool next(G2Unit& U, int par) {
        int tid_ = c.tid; asm volatile("" : "+v"(tid_));
        const int NUx = (NU + 7) >> 3, xg = c.vcu >> 5, pos = (i == 0) ? (c.vcu & 31) : qslot[0]; ++i;
        const int idx = xg * NUx + pos;
        if (pos >= NUx || idx >= NU) return false;
        const int g = idx / NT, nt = idx - g * NT;
        int e, r0, nrows; size_t hbase, lbase = 0;
        if (g < tru) { e = moe_find_l(tstart, g); const int ui = g - tstart[e], rpu = rpuT[e]; r0 = ui * rpu; nrows = min(rpu, cntl[e] - r0); hbase = (size_t)roff[e] + r0; lbase = (size_t)e * CAP + r0; }
        else { e = NEXP; r0 = (g - tru) * 256; nrows = 256; hbase = (size_t)NTOK * 8 + r0; }
        U.nrows = nrows; U.par = par; U.i0 = (int)hbase; U.i1 = nt; U.i2 = 0; U.kshift = 30; U.bsub = 0;
        const unsigned* laid = (const unsigned*)(p.ws + WS_LAID); const float* lgate = (const float*)(p.ws + WS_LGATE);
        LAS unsigned* rowT = (LAS unsigned*)(c.lds + G2_MISC) + par * 256;
        if (!isB) {
            U.b0 = (e < NEXP ? p.w_gate + (size_t)e * D * DEXP : p.ws_gate) + nt * 128; U.b1 = (e < NEXP ? p.w_up + (size_t)e * D * DEXP : p.ws_up) + nt * 128;
            U.ldb = DEXP; U.nsteps = D / 64;
            if (tid_ < 256) {
                const int rr = min(tid_, nrows - 1);
                const int tok = e < NEXP ? (int)(laid[lbase + rr] >> 3) : r0 + rr;
                rowT[tid_] = (unsigned)tok * (D * 2);
            }
        } else {
            U.b0 = (e < NEXP ? p.w_down + (size_t)e * DEXP * D : p.ws_down) + nt * 256; U.b1 = nullptr;
            U.ldb = D; U.nsteps = DEXP / 64;
            if (tid_ < 256) {
                const int rr = min(tid_, nrows - 1);
                rowT[tid_] = (unsigned)(hbase + rr) * (DEXP * 2);
                int yr; float gt;
                if (e < NEXP) { const unsigned aid = laid[lbase + rr]; yr = (int)((aid >> 3) * 9 + (aid & 7)); gt = lgate[lbase + rr]; }
                else { yr = (r0 + rr) * 9 + 8; gt = 1.f; }
                ((LAS float*)(c.lds + G2_GATE))[par * 256 + tid_] = gt; ((LAS int*)(c.lds + G2_YROW))[par * 256 + tid_] = yr;
            }
        }
        return true;
    }
};
struct EpiMoeA {
    static constexpr bool HAS_MID = false, HAS_SUB = false;
    bf16_t* HID;
    __device__ __forceinline__ void mid(f32x16 (&)[4][2], const G2Unit&, int, int, int, int) const {}
    __device__ __forceinline__ void operator()(f32x16 (&acc)[4][2], const G2Unit& U, int nmi, int wr, int wc, int r32, int hi) const {
        asm volatile("" : "+v"(r32), "+v"(hi));
#pragma unroll
        for (int mi = 0; mi < 4; ++mi) {
            if (mi < nmi) {
                const int r = 64 * mi + 32 * wr + r32;
#pragma unroll
                for (int ni = 0; ni < 2; ++ni) {
                    float hv[8];
#pragma unroll
                    for (int q = 0; q < 8; ++q) { const float gt = acc[mi][ni][q], up = acc[mi][ni][q + 8]; hv[q] = gt / (1.f + __expf(-gt)) * up; }
                    unsigned ax = cvtpk(hv[0], hv[1]), ay = cvtpk(hv[2], hv[3]), bx = cvtpk(hv[4], hv[5]), by = cvtpk(hv[6], hv[7]);
                    { auto r_ = __builtin_amdgcn_permlane32_swap(ax, bx, false, false); ax = r_[0]; bx = r_[1]; }
                    { auto r_ = __builtin_amdgcn_permlane32_swap(ay, by, false, false); ay = r_[0]; by = r_[1]; }
                    if (r < U.nrows) *(u32x4*)(HID + ((size_t)U.i0 + r) * DEXP + U.i1 * 128 + (2 * wc + ni) * 16 + (hi ? 8 : 0)) = (u32x4){ax, ay, bx, by};
                }
            }
        }
    }
};
struct EpiMoeB {
    static constexpr bool HAS_MID = false, HAS_SUB = false;
    bf16_t* Y; const LAS float* gateT; const LAS int* yrowT;
    __device__ __forceinline__ void mid(f32x16 (&)[4][2], const G2Unit&, int, int, int, int) const {}
    __device__ __forceinline__ void operator()(f32x16 (&acc)[4][2], const G2Unit& U, int nmi, int wr, int wc, int r32, int hi) const {
        asm volatile("" : "+v"(r32), "+v"(hi));
#pragma unroll
        for (int mi = 0; mi < 4; ++mi) {
            if (mi < nmi) {
                const int r = 64 * mi + 32 * wr + r32;
                const float gt = gateT[U.par * 256 + r]; const size_t yrow = (size_t)yrowT[U.par * 256 + r];
#pragma unroll
                for (int ni = 0; ni < 2; ++ni) {
                    f32x16 v_ = acc[mi][ni];
#pragma unroll
                    for (int q = 0; q < 16; ++q) v_[q] *= gt;
                    store_blk32_bf16(Y + yrow * D + U.i1 * 256 + wc * 64 + ni * 32, v_, hi, r < U.nrows);
                }
            }
        }
    }
};
__device__ __forceinline__ void phase_moeA(const Params& p, const Ctx& c) {
    MoeSched2 S(p, c, 2, false);
    EpiMoeA E{(bf16_t*)(p.ws + WS_HID)};
    gemm256_stream<BM_F32_GU, false>(c, S, E);
}
__device__ __forceinline__ void phase_moeB(const Params& p, const Ctx& c) {
    MoeSched2 S(p, c, 4, true);
    EpiMoeB E{(bf16_t*)(p.ws + WS_Y), (const LAS float*)(c.lds + G2_GATE), (const LAS int*)(c.lds + G2_YROW)};
    gemm256_stream<BM_F32, false>(c, S, E);
}


struct Sched1 {
    const Params& p; const Ctx& c; int i;
    __device__ __forceinline__ const void* abase() const { return p.ws + WS_H0; }
    __device__ __forceinline__ void issue() {}
    __device__ __forceinline__ void commit() {}
    static constexpr int MT = 256, NMT = (NROWS + MT - 1) / MT, NU = NMT * 9;
    __device__ __forceinline__ bool next(G2Unit& U, int par) {
        const int idx = c.vcu + i * c.G; ++i;
        if (idx >= NU) return false;
        const int mt = idx / 9, nt = idx - mt * 9, row0 = mt * MT, nrows = min(MT, NROWS - row0);
        U.b0 = (const bf16_t*)(p.ws + WS_WIN) + (size_t)nt * 256 * D; U.b1 = nullptr; U.ldb = D; U.nsteps = D / 64; U.nrows = nrows; U.par = par; U.i0 = row0; U.i1 = nt; U.i2 = 0; U.kshift = 30; U.bsub = 0;
        if (c.tid < 256) ((LAS unsigned*)(c.lds + G2_MISC))[par * 256 + c.tid] = (unsigned)(row0 + min(c.tid, nrows - 1)) * (D * 2);
        return true;
    }
};
struct Epi1 {
    static constexpr bool HAS_MID = false, HAS_SUB = false;
    bf16_t* Z; float* psq;
    __device__ __forceinline__ void mid(f32x16 (&)[4][2], const G2Unit&, int, int, int, int) const {}
    __device__ __forceinline__ void operator()(f32x16 (&acc)[4][2], const G2Unit& U, int nmi, int wr, int wc, int r32, int hi) const {
        asm volatile("" : "+v"(r32), "+v"(hi));
        const int s0 = U.i1 * 256 + wc * 64;
#pragma unroll
        for (int mi = 0; mi < 4; ++mi) {
            if (mi < nmi) {
                const int r = 64 * mi + 32 * wr + r32, row = U.i0 + min(r, U.nrows - 1);
                float ss = 0.f;
#pragma unroll
                for (int ni = 0; ni < 2; ++ni) {
                    store_blk32_bf16(Z + (size_t)row * ZC + s0 + ni * 32, acc[mi][ni], hi, r < U.nrows);
#pragma unroll
                    for (int q = 0; q < 16; ++q) ss += acc[mi][ni][q] * acc[mi][ni][q];
                }
                if (s0 < ZKPE) {
                    ss += __shfl_xor(ss, 32);
                    if (hi == 0 && r < U.nrows) psq[(size_t)row * 16 + (s0 >> 6)] = ss;
                }
            }
        }
    }
};
__device__ __forceinline__ void phase1_g2(const Params& p, const Ctx& c) {
    Sched1 S{p, c, 0};
    Epi1 E{(bf16_t*)(p.ws + WS_Z), (float*)(p.ws + WS_PSQ)};
    gemm256_stream<BM_BF16T, true>(c, S, E);
}

struct Sched4 {
    const Params& p; const Ctx& c; int i;
    __device__ __forceinline__ const void* abase() const { return p.ws + WS_ATT; }
    __device__ __forceinline__ void issue() {}
    __device__ __forceinline__ void commit() {}
    __device__ __forceinline__ bool next(G2Unit& U, int par) {
        const int idx = c.vcu + i * c.G; ++i;
        if (idx >= 256) return false;
        const int mt = idx >> 2, nt = idx & 3, row0 = mt * 256;
        U.b0 = (const bf16_t*)(p.ws + WS_WO) + (size_t)nt * 256 * D; U.b1 = nullptr; U.ldb = D; U.nsteps = D / 64; U.nrows = 256; U.par = par; U.i0 = row0; U.i1 = nt; U.i2 = 0; U.kshift = 30; U.bsub = 0;
        if (c.tid < 256) {
            const int row = row0 + c.tid;
            ((LAS unsigned*)(c.lds + G2_MISC))[par * 256 + c.tid] = (unsigned)row * (D * 2);
            const float* patt = (const float*)(p.ws + WS_PATT);
            const f32x4 pa = *(const f32x4*)(patt + (size_t)row * 8), pb = *(const f32x4*)(patt + (size_t)row * 8 + 4);
            const float ra = rsqrtf((((pa[0] + pa[1]) + (pa[2] + pa[3])) + ((pb[0] + pb[1]) + (pb[2] + pb[3]))) * (1.f / 512) + 1e-6f);
            const float rc = rsqrtf(((const float*)(p.ws + WS_SSQC))[row] * (1.f / 512) + 1e-6f);
            ((LAS float*)(c.lds + G2_GATE))[par * 256 + c.tid] = ra / rc; ((LAS float*)(c.lds + G2_YROW))[par * 256 + c.tid] = rc;
        }
        return true;
    }
};
struct Epi4 {
    static constexpr bool HAS_MID = true, HAS_SUB = false;
    const LAS float* fT; const LAS float* rcT; const bf16_t* H0; bf16_t* Y1; float* pst;
    __device__ __forceinline__ void mid(f32x16 (&acc)[4][2], const G2Unit& U, int st, int nmi, int wr, int r32) const {
        if (st != 7) return;
#pragma unroll
        for (int mi = 0; mi < 4; ++mi) {
            const float f = fT[U.par * 256 + 64 * mi + 32 * wr + r32];
#pragma unroll
            for (int ni = 0; ni < 2; ++ni)
#pragma unroll
                for (int q = 0; q < 16; ++q) acc[mi][ni][q] *= f;
        }
    }
    __device__ __forceinline__ void operator()(f32x16 (&acc)[4][2], const G2Unit& U, int nmi, int wr, int wc, int r32, int hi) const {
        asm volatile("" : "+v"(r32), "+v"(hi));
        const int s0 = U.i1 * 256 + wc * 64;
#pragma unroll
        for (int mi = 0; mi < 4; ++mi) {
            const int r = 64 * mi + 32 * wr + r32, row = U.i0 + r;
            const float rc = rcT[U.par * 256 + r];
            float s = 0.f, ss = 0.f;
#pragma unroll
            for (int ni = 0; ni < 2; ++ni) {
                f32x16 v;
#pragma unroll
                for (int g = 0; g < 4; ++g) {
                    const u32x2 hw = *(const u32x2*)(H0 + (size_t)row * D + s0 + ni * 32 + 8 * g + 4 * hi);
                    v[4 * g + 0] = acc[mi][ni][4 * g + 0] * rc + ALPHA * bflo(hw.x); v[4 * g + 1] = acc[mi][ni][4 * g + 1] * rc + ALPHA * bfhi(hw.x);
                    v[4 * g + 2] = acc[mi][ni][4 * g + 2] * rc + ALPHA * bflo(hw.y); v[4 * g + 3] = acc[mi][ni][4 * g + 3] * rc + ALPHA * bfhi(hw.y);
                }
#pragma unroll
                for (int q = 0; q < 16; ++q) { s += v[q]; ss += v[q] * v[q]; }
                store_blk32_bf16(Y1 + (size_t)row * D + s0 + ni * 32, v, hi);
            }
            s += __shfl_xor(s, 32); ss += __shfl_xor(ss, 32);
            if (hi == 0) { float* q = pst + ((size_t)row * 16 + U.i1 * 4 + wc) * 2; q[0] = s; q[1] = ss; }
        }
    }
};
__device__ __forceinline__ void phase4_g2(const Params& p, const Ctx& c) {
    Sched4 S{p, c, 0};
    Epi4 E{(const LAS float*)(c.lds + G2_GATE), (const LAS float*)(c.lds + G2_YROW), (const bf16_t*)(p.ws + WS_H0), (bf16_t*)(p.ws + WS_Y1), (float*)(p.ws + WS_PST)};
    gemm256_stream<BM_BF16T, true>(c, S, E);
}

__device__ __forceinline__ void phase8(const Params& p, const Ctx& c) {
    unsigned char* ws = p.ws;
    const bf16_t* H1 = (const bf16_t*)(ws + WS_H1); const bf16_t* Y = (const bf16_t*)(ws + WS_Y);
    const int gw = c.vcu * NWAVES + c.wave, NGW = c.G * NWAVES, lane = c.lane;
    for (int t = gw; t < NTOK; t += NGW) {
        float v[16];
#pragma unroll
        for (int j = 0; j < 2; ++j) {
            const int col = (lane + 64 * j) * 8;
            const u32x4 w = *(const u32x4*)(H1 + (size_t)t * D + col);
#pragma unroll
            for (int e = 0; e < 4; ++e) { v[j * 8 + 2 * e] = ALPHA * bflo(w[e]); v[j * 8 + 2 * e + 1] = ALPHA * bfhi(w[e]); }
#pragma unroll
            for (int k = 0; k < 9; ++k) {
                const u32x4 y = *(const u32x4*)(Y + ((size_t)t * 9 + k) * D + col);
#pragma unroll
                for (int e = 0; e < 4; ++e) { v[j * 8 + 2 * e] += bflo(y[e]); v[j * 8 + 2 * e + 1] += bfhi(y[e]); }
            }
        }
        float s = 0.f;
#pragma unroll
        for (int e = 0; e < 16; ++e) s += v[e];
        const float mean = wave_sum(s) * (1.f / D);
        float ss = 0.f;
#pragma unroll
        for (int e = 0; e < 16; ++e) { v[e] -= mean; ss += v[e] * v[e]; }
        const float rstd = rsqrtf(wave_sum(ss) * (1.f / D) + 1e-5f);
#pragma unroll
        for (int j = 0; j < 2; ++j) {
            const int col = (lane + 64 * j) * 8;
            f32x4 o0, o1;
#pragma unroll
            for (int e = 0; e < 4; ++e) { o0[e] = v[j * 8 + e] * rstd * p.ln2_g[col + e] + p.ln2_b[col + e]; o1[e] = v[j * 8 + 4 + e] * rstd * p.ln2_g[col + 4 + e] + p.ln2_b[col + 4 + e]; }
            *(f32x4*)(p.out + (size_t)t * D + col) = o0; *(f32x4*)(p.out + (size_t)t * D + col + 4) = o1;
        }
    }
}


#define XB_TMO      128
#define XB_XCNT(j)  (256  + 64 * (j))
#define XB_XSUB(j)  (1280 + 64 * (j))
#define XB_XGEN(j)  (2304 + 64 * (j))
#define XB_TOP      3328
#define XB_TOPGEN   3392
#define XB_SPIN_CAP (1u << 22)
__device__ __forceinline__ unsigned xb_ld(unsigned* p)              { return __hip_atomic_load(p, __ATOMIC_RELAXED, __HIP_MEMORY_SCOPE_AGENT); }
__device__ __forceinline__ unsigned xb_add(unsigned* p, unsigned v) { return __hip_atomic_fetch_add(p, v, __ATOMIC_RELAXED, __HIP_MEMORY_SCOPE_AGENT); }
__device__ __forceinline__ unsigned xb_xcc_id() { return (unsigned)__builtin_amdgcn_s_getreg((3 << 11) | 20) & 0xFu; }
#define XB_SPIN(cond, bar) do { unsigned _sp = 0; while (cond) { __builtin_amdgcn_s_sleep(1); \
    if ((++_sp & 255u) == 0u) { if (xb_ld(&(bar)[XB_TMO])) break; if (_sp > XB_SPIN_CAP) { atomicAdd(&(bar)[XB_TMO], 1u); break; } } } } while (0)
struct XcdBarrier { unsigned* bar; unsigned x; volatile LAS unsigned* st; };
__device__ __forceinline__ XcdBarrier xcd_barrier_post(unsigned* bar, volatile LAS unsigned* st) {
    XcdBarrier b; b.bar = bar; b.x = xb_xcc_id(); b.st = st;
    if (threadIdx.x == 0) (void)xb_add(&bar[XB_XCNT(b.x)], 1u);
    return b;
}
__device__ __forceinline__ void xcd_barrier_complete(unsigned* bar, unsigned x, unsigned& nloc, unsigned& nx) {
    const unsigned G = gridDim.x * gridDim.y * gridDim.z;
    unsigned sum, cnt, mine, sp = 0u;
    for (;;) {
        sum = 0u; cnt = 0u; mine = 0u;
#pragma unroll
        for (unsigned j = 0; j < 16; ++j) { const unsigned c = xb_ld(&bar[XB_XCNT(j)]); sum += c; cnt += (c > 0u) ? 1u : 0u; mine = (j == x) ? c : mine; }
        if (sum == G) break;
        __builtin_amdgcn_s_sleep(1);
        if ((++sp & 255u) == 0u) { if (xb_ld(&bar[XB_TMO])) break; if (sp > XB_SPIN_CAP) { atomicAdd(&bar[XB_TMO], 1u); break; } }
    }
    nloc = mine > 0u ? mine : 1u; nx = cnt > 0u ? cnt : 1u;
}
__device__ __forceinline__ void xcd_barrier(const XcdBarrier& b) {
    asm volatile("s_waitcnt vmcnt(0)" ::: "memory");
    __syncthreads();
    if (threadIdx.x == 0) {
        unsigned* bar = b.bar;
        __builtin_amdgcn_s_waitcnt(0);
        unsigned nloc = b.st[0], nx = b.st[1];
        if (nloc == 0u) { xcd_barrier_complete(bar, b.x, nloc, nx); b.st[0] = nloc; b.st[1] = nx; }
        const unsigned old = xb_add(&bar[XB_XSUB(b.x)], 1u);
        const unsigned gen = old / nloc;
        if (old + 1u == (gen + 1u) * nloc) {
            __builtin_amdgcn_fence(__ATOMIC_RELEASE, "agent");
            asm volatile("s_waitcnt vmcnt(0)" ::: "memory");
            const unsigned og = xb_add(&bar[XB_TOP], 1u);
            const unsigned tg = og / nx;
            if (og + 1u == (tg + 1u) * nx) xb_add(&bar[XB_TOPGEN], 1u);
            else XB_SPIN(xb_ld(&bar[XB_TOPGEN]) == tg, bar);
            __builtin_amdgcn_fence(__ATOMIC_ACQUIRE, "agent");
            xb_add(&bar[XB_XGEN(b.x)], 1u);
            asm volatile("s_waitcnt vmcnt(0)" ::: "memory");
        } else {
            XB_SPIN(xb_ld(&bar[XB_XGEN(b.x)]) == gen, bar);
            __builtin_amdgcn_fence(__ATOMIC_ACQUIRE, "agent");
            asm volatile("s_waitcnt vmcnt(0)" ::: "memory");
        }
    }
    __syncthreads();
}

template <int PH> __device__ __forceinline__ void run_phase(const Params& p, const Ctx& c0) {
    Ctx c = c0;
    { int l; asm volatile("v_mbcnt_lo_u32_b32 %0, -1, 0\n\tv_mbcnt_hi_u32_b32 %0, -1, %0" : "=v"(l)); c.lane = l; c.tid = c0.wave * 64 + l; c.wave = c0.wave; }
    if (PH == 0) phase0(p, c);
    if (PH == 1) phase1_g2(p, c);
    if (PH == 2) phase2(p, c);
#if NAIVE_ATTN
    if (PH == 3) phase3_naive(p, c);
#else
    if (PH == 3) phase3(p, c);
#endif
    if (PH == 4) phase4_g2(p, c);
    if (PH == 5) phase5a(p, c);
    if (PH == 6) phase5b(p, c);
    if (PH == 7) phase5c(p, c);
    if (PH == 8) phase_moeA(p, c);
    if (PH == 9) phase_moeB(p, c);
    if (PH == 10) phase8(p, c);
}
constexpr int NPHASES = 11;
__device__ __forceinline__ Ctx make_ctx(unsigned char* lds) {
    Ctx c; c.lds = (LAS unsigned char*)lds; c.tid = threadIdx.x; c.lane = c.tid & 63; c.wave = __builtin_amdgcn_readfirstlane(c.tid >> 6);
    c.G = gridDim.x; const int bx = blockIdx.x; c.vcu = (c.G % 8 == 0) ? (bx % 8) * (c.G / 8) + bx / 8 : bx;
    return c;
}
template <int PH> __global__ void __launch_bounds__(NTHREADS, 2) phase_kernel(Params p) {
    extern __shared__ __attribute__((aligned(16))) unsigned char lds[];
    const Ctx c = make_ctx(lds);
    run_phase<PH>(p, c);
}
#if MEGA
__global__ void __launch_bounds__(NTHREADS, 2) mega_kernel(Params p) {
    extern __shared__ __attribute__((aligned(16))) unsigned char lds[];
    Ctx c = make_ctx(lds);
    cg::grid_group grid = cg::this_grid();
    volatile LAS unsigned* bst = (volatile LAS unsigned*)(c.lds + LDS_BYTES - 64);
    if (c.tid < 4) bst[c.tid] = 0u;
    __syncthreads();
    XcdBarrier bar; bar.bar = (unsigned*)(p.ws + WS_CTL + CT_BAR); bar.x = xb_xcc_id(); bar.st = bst;
    if (c.tid == 0) bst[2] = xb_add(&bar.bar[XB_XCNT(bar.x)], 1u);
    if (p.out == nullptr) grid.sync();
    run_phase<0>(p, c); xcd_barrier(bar);
    if (c.tid == 0) {
        unsigned pre = 0;
        for (unsigned j = 0; j < 16; ++j) { const unsigned n = xb_ld(&bar.bar[XB_XCNT(j)]); if (j < bar.x) pre += n; }
        bst[3] = pre + bst[2];
    }
    __syncthreads();
    c.vcu = (int)bst[3];
    run_phase<1>(p, c); xcd_barrier(bar);
    run_phase<2>(p, c); xcd_barrier(bar);
    run_phase<3>(p, c); xcd_barrier(bar);
    run_phase<4>(p, c); xcd_barrier(bar);
    run_phase<5>(p, c); xcd_barrier(bar);
    run_phase<6>(p, c); xcd_barrier(bar);
    run_phase<7>(p, c); xcd_barrier(bar);
    run_phase<8>(p, c); xcd_barrier(bar);
    run_phase<9>(p, c); xcd_barrier(bar);
    run_phase<10>(p, c);
}

#endif
template <int PH> static void launch_phase(const Params& p, int grid, hipStream_t stream) {
    static bool attr = false;
    if (!attr) { (void)hipFuncSetAttribute((const void*)phase_kernel<PH>, hipFuncAttributeMaxDynamicSharedMemorySize, LDS_BYTES); attr = true; }
    hipLaunchKernelGGL(phase_kernel<PH>, dim3(grid), dim3(NTHREADS), LDS_BYTES, stream, p);
}

extern "C" void kernel_launch(void* const* d_in, const int* in_sizes, int n_in, void* d_out, int out_size, void* d_ws, size_t ws_size, hipStream_t stream) {
    if (n_in != 25 || ws_size < WS_END) { fprintf(stderr, "kernel_launch: unexpected n_in %d or ws_size %zu (need %zu)\n", n_in, ws_size, (size_t)WS_END); return; }
    Params p{};
    const float** pp = (const float**)&p;
    for (int i = 0; i < 25; ++i) pp[i] = (const float*)d_in[i];
    p.out = (float*)d_out; p.ws = (unsigned char*)d_ws;
    (void)hipMemsetAsync((char*)d_ws + WS_CTL, 0, CTL_BYTES, stream);
#if MEGA
    static int grid = 0;
    if (!grid) {
        int dev = 0, cus = 0, per_cu = 0;
        (void)hipGetDevice(&dev);
        (void)hipDeviceGetAttribute(&cus, hipDeviceAttributeMultiprocessorCount, dev);
        (void)hipFuncSetAttribute((const void*)mega_kernel, hipFuncAttributeMaxDynamicSharedMemorySize, LDS_BYTES);
        (void)hipOccupancyMaxActiveBlocksPerMultiprocessor(&per_cu, (const void*)mega_kernel, NTHREADS, LDS_BYTES);
        if (per_cu < 1) per_cu = 1;
        grid = cus;
        (void)per_cu;
    }
    void* args[] = {&p};
    hipError_t e = hipLaunchCooperativeKernel((const void*)mega_kernel, dim3(grid), dim3(NTHREADS), args, LDS_BYTES, stream);
    if (e != hipSuccess) fprintf(stderr, "cooperative launch failed: %s (grid %d)\n", hipGetErrorString(e), grid);
#else
    const int grid = 256;
#define LP(k) do { launch_phase<k>(p, grid, stream); if (REPEAT_PH == k) launch_phase<k>(p, grid, stream); } while (0)
    LP(0); LP(1); LP(2); LP(3); LP(4); LP(5); LP(6); LP(7); LP(8); LP(9); LP(10);
#undef LP
#endif
}
```

```cpp
#include <hip/hip_runtime.h>
#include <hip/hip_cooperative_groups.h>
#include <cstdint>
#include <cstdio>
namespace cg = cooperative_groups;

#ifndef NAIVE_GEMM
#define NAIVE_GEMM 0
#endif
#ifndef NAIVE_ATTN
#define NAIVE_ATTN 0
#endif
#ifndef REPEAT_PH
#define REPEAT_PH -1
#endif
#ifndef MEGA
#define MEGA 1
#endif

#define LAS __attribute__((address_space(3)))
#define GAS __attribute__((address_space(1)))
typedef unsigned short bf16_t;
typedef short bf16x8 __attribute__((ext_vector_type(8)));
typedef float f32x4 __attribute__((ext_vector_type(4)));
typedef unsigned u32x4 __attribute__((ext_vector_type(4)));
typedef unsigned u32x2 __attribute__((ext_vector_type(2)));

constexpr int D = 1024, NBATCH = 8, SEQ = 2048, NMETA = 16, LPOS = SEQ + NMETA;
constexpr int NTOK = NBATCH * SEQ;
constexpr int NROWS = NTOK + NMETA;
constexpr int NROWSP = 16512;
constexpr int NH = 8, DQK = 96, DNOPE = 64, DROPE = 32, DV = 64;
constexpr int QLORA = 384, KVLORA = 256;
constexpr int ZC = 2304;
constexpr int ZQ = 0, ZKV = 384, ZKPE = 640, ZB = 704, ZCG = 1216, ZU = 1728;
constexpr int DIN = 2208;
constexpr int NEXP = 256, DEXP = 256, TOPK = 8, CAP = 16384;
constexpr float ALPHA = 1.189207115002721f;
constexpr float QSCALE = 0.10206207261596577f * 1.4426950408889634f;

constexpr int NTHREADS = 512, NWAVES = 8;
constexpr int LDS_BYTES = 147456;
constexpr int STAGE_BYTES = 49152;
constexpr int LDS_MISC = 2 * STAGE_BYTES;

constexpr size_t MiB = 1u << 20;
constexpr size_t WS_CTL = 0;
constexpr size_t CTL_BYTES = 1 * MiB;
constexpr size_t CT_CNT = 0;
constexpr size_t CT_Q = 1024;
constexpr size_t CT_BAR = 8192;
constexpr size_t CT_SSQ_Q = 32768;
constexpr size_t CT_SSQ_KV = CT_SSQ_Q + 66048;
constexpr size_t CT_SSQ_ATT = CT_SSQ_KV + 66048;
constexpr size_t CT_STATS1 = CT_SSQ_ATT + 65536;
static_assert(CT_STATS1 + 131072 <= CTL_BYTES, "ctl");
constexpr size_t WS_WIN = 1 * MiB;
constexpr size_t WS_WUQ = 6 * MiB;
constexpr size_t WS_WUKV = 7 * MiB;
constexpr size_t WS_WO = 8 * MiB;
constexpr size_t WS_WR = 10 * MiB;
constexpr size_t WS_WSGU = 11 * MiB;
constexpr size_t WS_WSD = 12 * MiB;
constexpr size_t WS_ROPE = 13 * MiB;
constexpr size_t WS_WGU = 14 * MiB;
constexpr size_t WS_WD = 270 * MiB;
constexpr size_t WS_H1 = 398 * MiB;
constexpr size_t WS_HID = 430 * MiB;
constexpr size_t WS_LAID = 502 * MiB;
constexpr size_t WS_LGATE = 518 * MiB;
constexpr size_t WS_Y = 534 * MiB;
constexpr size_t WS_Z = WS_Y;
constexpr size_t WS_H0 = WS_Y + 73 * MiB;
constexpr size_t WS_Q = WS_Y + 106 * MiB;
constexpr size_t WS_K = WS_Y + 130 * MiB;
constexpr size_t WS_V = WS_Y + 155 * MiB;
constexpr size_t WS_ATT = WS_Y + 172 * MiB;
constexpr size_t WS_CONV = WS_Y + 188 * MiB;
constexpr size_t WS_SSQC = WS_Y + 204 * MiB;
constexpr size_t WS_Y1 = WS_Y + 205 * MiB;
constexpr size_t WS_LOG = WS_Y + 237 * MiB;
constexpr size_t WS_PSQ = WS_Y + 253 * MiB;
constexpr size_t WS_PATT = WS_Y + 254 * MiB;
constexpr size_t WS_PST = WS_Y + 255 * MiB;
constexpr size_t WS_END = WS_Y + 288 * MiB;

struct Params {
    const float *x, *meta, *emb_g, *emb_b, *w_in, *q_norm, *w_uq, *kv_norm, *w_ukv, *conv_w, *attn_on, *conv_on, *w_o,
        *ln1_g, *ln1_b, *w_router, *router_bias, *w_gate, *w_up, *w_down, *ws_gate, *ws_up, *ws_down, *ln2_g, *ln2_b;
    float* out;
    unsigned char* ws;
};

__device__ __forceinline__ unsigned f2bf(float f) { unsigned u = __float_as_uint(f); return (u + 0x7fffu + ((u >> 16) & 1u)) >> 16; }
typedef float f32x2 __attribute__((ext_vector_type(2)));
typedef __bf16 bf16x2_t __attribute__((ext_vector_type(2)));
__device__ __forceinline__ unsigned cvtpk(float lo, float hi) { f32x2 v = {lo, hi}; bf16x2_t b = __builtin_convertvector(v, bf16x2_t); return __builtin_bit_cast(unsigned, b); }
__device__ __forceinline__ unsigned pk2(float lo, float hi) { return cvtpk(lo, hi); }
__device__ __forceinline__ float bf2f(unsigned b) { return __uint_as_float(b << 16); }
__device__ __forceinline__ float bflo(unsigned w) { return __uint_as_float(w << 16); }
__device__ __forceinline__ float bfhi(unsigned w) { return __uint_as_float(w & 0xffff0000u); }
__device__ __forceinline__ float wave_sum(float v) {
#pragma unroll
    for (int o = 1; o < 64; o <<= 1) v += __shfl_xor(v, o);
    return v;
}
__device__ __forceinline__ float wave_max(float v) {
#pragma unroll
    for (int o = 1; o < 64; o <<= 1) v = fmaxf(v, __shfl_xor(v, o));
    return v;
}

struct Ctx {
    LAS unsigned char* lds;
    int tid, lane, wave, vcu, G;
};

template <class RowPtr>
__device__ __forceinline__ void gemm_kloop(f32x4 (&acc)[4][4], const Ctx& c, const RowPtr& rp, const bf16_t* Bt, long ldb, int K) {
    const int tid = c.tid, lane = c.lane, wid = c.wave, wr = wid >> 2, wc = wid & 3, fr = lane & 15, fq = lane >> 4;
#if NAIVE_GEMM
    const bf16_t* ar[4];
#pragma unroll
    for (int mi = 0; mi < 4; ++mi) ar[mi] = rp(wr * 64 + mi * 16 + fr);
    const bf16_t* br = Bt + (long)(wc * 64 + fq * 4) * ldb;
#pragma nounroll
    for (int k = 0; k < K; k += 2) {
        unsigned av[4];
#pragma unroll
        for (int mi = 0; mi < 4; ++mi) av[mi] = *(const unsigned*)(ar[mi] + k);
#pragma unroll
        for (int ni = 0; ni < 4; ++ni)
#pragma unroll
            for (int j = 0; j < 4; ++j) {
                const unsigned bv = *(const unsigned*)(br + (long)(ni * 16 + j) * ldb + k);
#pragma unroll
                for (int mi = 0; mi < 4; ++mi) acc[mi][ni][j] += bflo(av[mi]) * bflo(bv) + bfhi(av[mi]) * bfhi(bv);
            }
    }
#else
    LAS unsigned char* lds = c.lds;
    const int nt = K >> 6;
    const int srow = tid >> 3, sch = tid & 7;
    const bf16_t* ap0 = rp(srow) + sch * 8;
    const bf16_t* ap1 = rp(srow + 64) + sch * 8;
    const bf16_t* bp = Bt + (long)srow * ldb + sch * 8;
    const long bstep = 64 * ldb;
    const int so = srow * 128 + ((sch ^ ((srow >> 1) & 7)) << 4);
    u32x4 ra0, ra1, rb0, rb1, rb2, rb3;
#define G_LOAD(t) do { const int ko = (t) * 64; ra0 = *(const u32x4*)(ap0 + ko); ra1 = *(const u32x4*)(ap1 + ko); \
        rb0 = *(const u32x4*)(bp + ko); rb1 = *(const u32x4*)(bp + bstep + ko); rb2 = *(const u32x4*)(bp + 2 * bstep + ko); rb3 = *(const u32x4*)(bp + 3 * bstep + ko); } while (0)
#define G_STORE(buf) do { LAS unsigned char* sb = lds + (buf) * STAGE_BYTES; \
        *(LAS u32x4*)(sb + so) = ra0; *(LAS u32x4*)(sb + so + 8192) = ra1; \
        *(LAS u32x4*)(sb + 16384 + so) = rb0; *(LAS u32x4*)(sb + 16384 + so + 8192) = rb1; \
        *(LAS u32x4*)(sb + 16384 + so + 16384) = rb2; *(LAS u32x4*)(sb + 16384 + so + 24576) = rb3; } while (0)
    __syncthreads();
    G_LOAD(0);
    G_STORE(0);
    __syncthreads();
    const int sw0 = ((0 + fq) ^ ((fr >> 1) & 7)) << 4, sw1 = ((4 + fq) ^ ((fr >> 1) & 7)) << 4;
    const int aoff = (wr * 64 + fr) * 128, boff = 16384 + (wc * 64 + fr) * 128;
    for (int t = 0; t < nt; ++t) {
        if (t + 1 < nt) G_LOAD(t + 1);
        const LAS unsigned char* sb = lds + (t & 1) * STAGE_BYTES;
#pragma unroll
        for (int ks = 0; ks < 2; ++ks) {
            const int sw = ks ? sw1 : sw0;
            bf16x8 af[4], bfr[4];
#pragma unroll
            for (int mi = 0; mi < 4; ++mi) af[mi] = *(const LAS bf16x8*)(sb + aoff + mi * 2048 + sw);
#pragma unroll
            for (int ni = 0; ni < 4; ++ni) bfr[ni] = *(const LAS bf16x8*)(sb + boff + ni * 2048 + sw);
#pragma unroll
            for (int mi = 0; mi < 4; ++mi)
#pragma unroll
                for (int ni = 0; ni < 4; ++ni) acc[mi][ni] = __builtin_amdgcn_mfma_f32_16x16x32_bf16(bfr[ni], af[mi], acc[mi][ni], 0, 0, 0);
        }
        if (t + 1 < nt) G_STORE((t + 1) & 1);
        __syncthreads();
    }
#undef G_LOAD
#undef G_STORE
#endif
}
__device__ __forceinline__ void acc_zero(f32x4 (&acc)[4][4]) {
#pragma unroll
    for (int a = 0; a < 4; ++a)
#pragma unroll
        for (int b = 0; b < 4; ++b) acc[a][b] = (f32x4){0.f, 0.f, 0.f, 0.f};
}
__device__ __forceinline__ void store_bf4(bf16_t* p, f32x4 v) { u32x2 w; w.x = pk2(v[0], v[1]); w.y = pk2(v[2], v[3]); *(u32x2*)p = w; }

enum { MAP_ID = 0, MAP_WIN = 1, MAP_GATE = 2, MAP_UP = 3 };
template <int MAP> __device__ __forceinline__ int rowmap(int n) {
    if (MAP == MAP_WIN) return n < 672 ? n : n + 32;
    if (MAP == MAP_GATE) return 32 * (n >> 4) + (n & 15);
    if (MAP == MAP_UP) return 32 * (n >> 4) + 16 + (n & 15);
    return n;
}
template <int MAP>
__device__ __forceinline__ void transpose_item(const float* W, int K, int N, bf16_t* WT, const float* gain, LAS float* scr, int item, int lane) {
    const int nblk = N / 32, kb = item / nblk, nb = item % nblk, k0 = 64 * kb, n0 = 32 * nb;
#pragma unroll 8
    for (int i = 0; i < 32; ++i) {
        const int kk = 2 * i + (lane >> 5);
        float v = W[(size_t)(k0 + kk) * N + n0 + (lane & 31)];
        if (gain) v *= gain[k0 + kk];
        scr[kk * 33 + (lane & 31)] = v;
    }
    asm volatile("s_waitcnt lgkmcnt(0)" ::: "memory");
    const int ch = lane & 7;
#pragma unroll
    for (int j = 0; j < 4; ++j) {
        const int n = (lane >> 3) + 8 * j;
        const LAS float* s = scr + (8 * ch) * 33 + n;
        u32x4 o;
        o.x = pk2(s[0 * 33], s[1 * 33]); o.y = pk2(s[2 * 33], s[3 * 33]); o.z = pk2(s[4 * 33], s[5 * 33]); o.w = pk2(s[6 * 33], s[7 * 33]);
        *(u32x4*)(WT + (size_t)rowmap<MAP>(n0 + n) * K + k0 + 8 * ch) = o;
    }
    asm volatile("s_waitcnt lgkmcnt(0)" ::: "memory");
}
__device__ __forceinline__ void phase0(const Params& p, const Ctx& c) {
    unsigned char* ws = p.ws;
    LAS float* scr = (LAS float*)(c.lds + c.wave * 8704);
    const int gw = c.vcu * NWAVES + c.wave, NGW = c.G * NWAVES, lane = c.lane;
    bf16_t* H0 = (bf16_t*)(ws + WS_H0);
    for (int r = gw; r < NROWSP; r += NGW) {
        u32x2* o = (u32x2*)(H0 + (size_t)r * D) + lane;
        if (r >= NROWS) {
#pragma unroll
            for (int j = 0; j < 4; ++j) o[64 * j] = (u32x2){0u, 0u};
            continue;
        }
        const float* xr = r < NTOK ? p.x + (size_t)r * D : p.meta + (size_t)(r - NTOK) * D;
        f32x4 v[4]; float s = 0.f;
#pragma unroll
        for (int j = 0; j < 4; ++j) { v[j] = *((const f32x4*)xr + lane + 64 * j); s += (v[j][0] + v[j][1]) + (v[j][2] + v[j][3]); }
        const float mean = wave_sum(s) * (1.f / D);
        float s2 = 0.f;
#pragma unroll
        for (int j = 0; j < 4; ++j) { v[j] = v[j] - mean; s2 += (v[j][0] * v[j][0] + v[j][1] * v[j][1]) + (v[j][2] * v[j][2] + v[j][3] * v[j][3]); }
        const float rstd = 1.f / sqrtf(wave_sum(s2) * (1.f / D) + 1e-5f);
#pragma unroll
        for (int j = 0; j < 4; ++j) {
            const f32x4 g = *((const f32x4*)p.emb_g + lane + 64 * j), b = *((const f32x4*)p.emb_b + lane + 64 * j);
            const f32x4 y = v[j] * rstd * g + b;
            u32x2 w; w.x = pk2(y[0], y[1]); w.y = pk2(y[2], y[3]); o[64 * j] = w;
        }
    }
    {
        float* rope = (float*)(ws + WS_ROPE);
        for (int idx = gw * 64 + lane; idx < LPOS * 16; idx += NGW * 64) {
            const int pos = idx >> 4, i = idx & 15;
            const float inv = exp2f(-(float)i * (13.287712379549449f / 16.f));
            const float ang = (float)pos * inv;
            double rev = (double)ang * 0.15915494309189535; rev -= floor(rev);
            const float rf = (float)rev;
            rope[idx * 2 + 0] = __builtin_amdgcn_cosf(rf);
            rope[idx * 2 + 1] = __builtin_amdgcn_sinf(rf);
        }
    }
    {
        bf16_t* WinT = (bf16_t*)(ws + WS_WIN);
        for (int it = gw; it < 96; it += NGW) {
            const int row = it < 32 ? 672 + it : 2240 + (it - 32);
            u32x2* o = (u32x2*)(WinT + (size_t)row * D) + lane;
#pragma unroll
            for (int j = 0; j < 4; ++j) o[64 * j] = (u32x2){0u, 0u};
        }
    }
    constexpr int I_WIN = 16 * 69, I_UQ = 6 * 24, I_UKV = 4 * 32, I_WO = 16 * 32, I_WR = 16 * 8, I_SG = 128, I_SD = 128;
    constexpr int I_SMALL = I_WIN + I_UQ + I_UKV + I_WO + I_WR + 2 * I_SG + I_SD;
    constexpr int I_EXP = NEXP * 128;
    constexpr int NITEMS = I_WIN + I_UQ + I_UKV + I_WO + I_WR;
    for (int it = gw; it < NITEMS; it += NGW) {
        int r = it;
        if (r < I_WIN) { transpose_item<MAP_WIN>(p.w_in, D, DIN, (bf16_t*)(ws + WS_WIN), nullptr, scr, r, lane); continue; } r -= I_WIN;
        if (r < I_UQ) { transpose_item<MAP_ID>(p.w_uq, QLORA, 768, (bf16_t*)(ws + WS_WUQ), p.q_norm, scr, r, lane); continue; } r -= I_UQ;
        if (r < I_UKV) { transpose_item<MAP_ID>(p.w_ukv, KVLORA, 1024, (bf16_t*)(ws + WS_WUKV), p.kv_norm, scr, r, lane); continue; } r -= I_UKV;
        if (r < I_WO) {
            const int kb = r / 32;
            transpose_item<MAP_ID>(p.w_o, D, D, (bf16_t*)(ws + WS_WO), kb < 8 ? p.attn_on : p.conv_on - 512, scr, r, lane); continue; } r -= I_WO;
        if (r < I_WR) { transpose_item<MAP_ID>(p.w_router, D, 256, (bf16_t*)(ws + WS_WR), nullptr, scr, r, lane); continue; } r -= I_WR;
        if (r < I_SG) { transpose_item<MAP_GATE>(p.ws_gate, D, 256, (bf16_t*)(ws + WS_WSGU), nullptr, scr, r, lane); continue; } r -= I_SG;
        if (r < I_SG) { transpose_item<MAP_UP>(p.ws_up, D, 256, (bf16_t*)(ws + WS_WSGU), nullptr, scr, r, lane); continue; } r -= I_SG;
        if (r < I_SD) { transpose_item<MAP_ID>(p.ws_down, DEXP, D, (bf16_t*)(ws + WS_WSD), nullptr, scr, r, lane); continue; } r -= I_SD;
        if (r < I_EXP) { const int e = r >> 7; transpose_item<MAP_GATE>(p.w_gate + (size_t)e * D * DEXP, D, 256, (bf16_t*)(ws + WS_WGU) + (size_t)e * 512 * D, nullptr, scr, r & 127, lane); continue; } r -= I_EXP;
        if (r < I_EXP) { const int e = r >> 7; transpose_item<MAP_UP>(p.w_up + (size_t)e * D * DEXP, D, 256, (bf16_t*)(ws + WS_WGU) + (size_t)e * 512 * D, nullptr, scr, r & 127, lane); continue; } r -= I_EXP;
        { const int e = r >> 7; transpose_item<MAP_ID>(p.w_down + (size_t)e * DEXP * D, DEXP, D, (bf16_t*)(ws + WS_WD) + (size_t)e * D * DEXP, nullptr, scr, r & 127, lane); }
    }
}

__device__ __forceinline__ void phase1(const Params& p, const Ctx& c) {
    unsigned char* ws = p.ws;
    const bf16_t* H0 = (const bf16_t*)(ws + WS_H0); const bf16_t* WinT = (const bf16_t*)(ws + WS_WIN);
    bf16_t* Z = (bf16_t*)(ws + WS_Z);
    float* psq = (float*)(ws + WS_PSQ);
    const int lane = c.lane, wr = c.wave >> 2, wc = c.wave & 3, fr = lane & 15, fq = lane >> 4;
    constexpr int NU = 129 * 9;
    for (int u = c.vcu; u < NU; u += c.G) {
        const int mt = u / 9, nt = u % 9, row0 = mt * 128, n0 = nt * 256;
        f32x4 acc[4][4]; acc_zero(acc);
        auto rp = [&](int r) { return H0 + (size_t)(row0 + r) * D; };
        gemm_kloop(acc, c, rp, WinT + (size_t)n0 * D, D, D);
        const int s0 = n0 + wc * 64;
#pragma unroll
        for (int mi = 0; mi < 4; ++mi) {
            const int row = row0 + wr * 64 + mi * 16 + fr;
            float ss = 0.f;
#pragma unroll
            for (int ni = 0; ni < 4; ++ni) {
                const f32x4 v = acc[mi][ni];
                store_bf4(Z + (size_t)row * ZC + s0 + ni * 16 + fq * 4, v);
                ss += (v[0] * v[0] + v[1] * v[1]) + (v[2] * v[2] + v[3] * v[3]);
            }
            if (s0 < ZKPE) {
                ss += __shfl_xor(ss, 16); ss += __shfl_xor(ss, 32);
                if (fq == 0) psq[(size_t)row * 16 + (s0 >> 6)] = ss;
            }
        }
    }
}

__device__ __forceinline__ void phase2_gemms(const Params& p, const Ctx& c);
__device__ __forceinline__ void phase2(const Params& p, const Ctx& c) {
    unsigned char* ws = p.ws;
    const bf16_t* Z = (const bf16_t*)(ws + WS_Z);
    const float* psq = (const float*)(ws + WS_PSQ);
    const float* rope = (const float*)(ws + WS_ROPE);
    bf16_t* Q = (bf16_t*)(ws + WS_Q); bf16_t* Kb = (bf16_t*)(ws + WS_K); bf16_t* Vb = (bf16_t*)(ws + WS_V);
    const int lane = c.lane, wr = c.wave >> 2, wc = c.wave & 3, fr = lane & 15, fq = lane >> 4;
    phase2_gemms(p, c);
    __syncthreads();
    const int gw = c.vcu * NWAVES + c.wave, NGW = c.G * NWAVES;
    const bf16_t* Zc = Z;
    for (int row = gw; row < NROWS; row += NGW) {
        const int nb = row < NTOK ? 1 : NBATCH;
        const int b0 = row < NTOK ? (row >> 11) : 0, pos = row < NTOK ? NMETA + (row & (SEQ - 1)) : row - NTOK;
        if (lane < 16) {
            const float x1 = bf2f(Zc[(size_t)row * ZC + ZKPE + lane]), x2 = bf2f(Zc[(size_t)row * ZC + ZKPE + 16 + lane]);
            const float co = rope[((size_t)pos * 16 + lane) * 2], si = rope[((size_t)pos * 16 + lane) * 2 + 1];
            const bf16_t o1 = (bf16_t)f2bf(x1 * co - x2 * si), o2 = (bf16_t)f2bf(x2 * co + x1 * si);
            for (int bb = 0; bb < nb; ++bb) {
                bf16_t* kp = Kb + ((size_t)(b0 + bb) * LPOS + pos) * 768;
#pragma unroll
                for (int h = 0; h < NH; ++h) { kp[h * 96 + 64 + lane] = o1; kp[h * 96 + 80 + lane] = o2; }
            }
        }
        if (row < NTOK) {
            const int i = row & (SEQ - 1);
            const int r1 = i >= 1 ? row - 1 : NTOK + 15;
            const int r2 = i >= 2 ? row - 2 : (i == 1 ? NTOK + 15 : NTOK + 14);
            const int ch = lane * 8;
            const u32x4 c0 = *(const u32x4*)(Zc + (size_t)row * ZC + ZCG + ch), u0 = *(const u32x4*)(Zc + (size_t)row * ZC + ZU + ch);
            const u32x4 c1 = *(const u32x4*)(Zc + (size_t)r1 * ZC + ZCG + ch), u1 = *(const u32x4*)(Zc + (size_t)r1 * ZC + ZU + ch);
            const u32x4 c2 = *(const u32x4*)(Zc + (size_t)r2 * ZC + ZCG + ch), u2 = *(const u32x4*)(Zc + (size_t)r2 * ZC + ZU + ch);
            const u32x4 bg = *(const u32x4*)(Zc + (size_t)row * ZC + ZB + ch);
            float y[8]; float ss = 0.f;
#pragma unroll
            for (int e = 0; e < 4; ++e) {
#pragma unroll
                for (int hh = 0; hh < 2; ++hh) {
                    const int cc = ch + e * 2 + hh;
                    const float w0 = p.conv_w[cc], w1 = p.conv_w[512 + cc], w2 = p.conv_w[1024 + cc];
                    const float v0 = hh ? bfhi(c0[e]) * bfhi(u0[e]) : bflo(c0[e]) * bflo(u0[e]);
                    const float v1 = hh ? bfhi(c1[e]) * bfhi(u1[e]) : bflo(c1[e]) * bflo(u1[e]);
                    const float v2 = hh ? bfhi(c2[e]) * bfhi(u2[e]) : bflo(c2[e]) * bflo(u2[e]);
                    const float bgv = hh ? bfhi(bg[e]) : bflo(bg[e]);
                    const float yy = bgv * (w0 * v2 + w1 * v1 + w2 * v0);
                    y[e * 2 + hh] = yy; ss += yy * yy;
                }
            }
            ss = wave_sum(ss);
            u32x4 o; o.x = pk2(y[0], y[1]); o.y = pk2(y[2], y[3]); o.z = pk2(y[4], y[5]); o.w = pk2(y[6], y[7]);
            *(u32x4*)((bf16_t*)(ws + WS_ATT) + (size_t)row * D + 512 + ch) = o;
            if (lane == 0) ((float*)(ws + WS_SSQC))[row] = ss;
        }
    }
}

__device__ __forceinline__ void phase3_naive(const Params& p, const Ctx& c) {
    unsigned char* ws = p.ws;
    const bf16_t* Q = (const bf16_t*)(ws + WS_Q); const bf16_t* Kb = (const bf16_t*)(ws + WS_K); const bf16_t* Vb = (const bf16_t*)(ws + WS_V);
    bf16_t* ATT = (bf16_t*)(ws + WS_ATT); float* patt = (float*)(ws + WS_PATT);
    const int gw = c.vcu * NWAVES + c.wave, NGW = c.G * NWAVES, lane = c.lane;
    for (int it = gw; it < NTOK * NH; it += NGW) {
        const int row = it >> 3, h = it & 7, b = row >> 11, i = row & (SEQ - 1), nkeys = NMETA + i + 1;
        float q[96];
#pragma unroll
        for (int j = 0; j < 12; ++j) {
            const u32x4 w = *(const u32x4*)(Q + (size_t)row * 768 + h * 96 + j * 8);
#pragma unroll
            for (int e = 0; e < 4; ++e) { q[j * 8 + e * 2] = bflo(w[e]); q[j * 8 + e * 2 + 1] = bfhi(w[e]); }
        }
        float m = -INFINITY, l = 0.f; float o[64];
#pragma unroll
        for (int d = 0; d < 64; ++d) o[d] = 0.f;
        for (int kk = lane; kk < nkeys; kk += 64) {
            const bf16_t* kp = Kb + ((size_t)b * LPOS + kk) * 768 + h * 96;
            float s = 0.f;
#pragma unroll
            for (int j = 0; j < 12; ++j) {
                const u32x4 w = *(const u32x4*)(kp + j * 8);
#pragma unroll
                for (int e = 0; e < 4; ++e) { s += q[j * 8 + e * 2] * bflo(w[e]); s += q[j * 8 + e * 2 + 1] * bfhi(w[e]); }
            }
            const float mn = fmaxf(m, s), f = exp2f(m - mn), pe = exp2f(s - mn);
            l = l * f + pe; m = mn;
            const bf16_t* vp = Vb + ((size_t)b * LPOS + kk) * 512 + h * 64;
#pragma unroll
            for (int j = 0; j < 8; ++j) {
                const u32x4 w = *(const u32x4*)(vp + j * 8);
#pragma unroll
                for (int e = 0; e < 4; ++e) { o[j * 8 + e * 2] = o[j * 8 + e * 2] * f + pe * bflo(w[e]); o[j * 8 + e * 2 + 1] = o[j * 8 + e * 2 + 1] * f + pe * bfhi(w[e]); }
            }
        }
        const float M = wave_max(m);
        const float f = (m == -INFINITY) ? 0.f : exp2f(m - M);
        const float lt = wave_sum(l * f);
        float res = 0.f;
#pragma unroll
        for (int d = 0; d < 64; ++d) { const float v = wave_sum(o[d] * f); if (lane == d) res = v; }
        res /= lt;
        ATT[(size_t)row * D + h * 64 + lane] = (bf16_t)f2bf(res);
        const float ss = wave_sum(res * res);
        if (lane == 0) patt[(size_t)row * 8 + h] = ss;
    }
}


typedef float f32x16 __attribute__((ext_vector_type(16)));
typedef short s16x4 __attribute__((ext_vector_type(4)));
constexpr int AK_PITCH = 208, AK_BYTES = 64 * AK_PITCH, AV_BYTES = 8192, ASTAGE = AK_BYTES + AV_BYTES, A_WSF = 2 * ASTAGE;
__device__ __forceinline__ int crow(int r, int hi) { return (r & 3) + 8 * (r >> 2) + 4 * hi; }
__device__ __forceinline__ s16x4 vtr(const LAS unsigned char* p) {
    return __builtin_bit_cast(s16x4, __builtin_amdgcn_ds_read_tr16_b64_v4i16((LAS s16x4*)p));
}
__device__ __forceinline__ void attn_unit(const Params& p, const Ctx& c, int b, int h, int qb) {
    unsigned char* ws = p.ws;
    const bf16_t* Q = (const bf16_t*)(ws + WS_Q); const bf16_t* Kb = (const bf16_t*)(ws + WS_K); const bf16_t* Vb = (const bf16_t*)(ws + WS_V);
    bf16_t* ATT = (bf16_t*)(ws + WS_ATT); float* patt = (float*)(ws + WS_PATT);
    const int tid = c.tid, lane = c.lane, w = c.wave, r32 = lane & 31, hi = lane >> 5;
    LAS unsigned char* lds = c.lds;
    LAS float* wsf = (LAS float*)(lds + A_WSF) + w * 32;
    const int row0 = b * SEQ + qb * 256;
    const int qpos0 = NMETA + qb * 256 + w * 32, myq = qpos0 + r32;
    bf16x8 qf[6];
#pragma unroll
    for (int ds = 0; ds < 6; ++ds) qf[ds] = *(const bf16x8*)(Q + (size_t)(row0 + w * 32 + r32) * 768 + h * 96 + ds * 16 + hi * 8);
    const bf16_t* Kg = Kb + (size_t)b * LPOS * 768 + h * 96;
    const bf16_t* Vg = Vb + (size_t)b * LPOS * 512 + h * 64;
    const int T = 4 * qb + 5;
    const int tl = (qpos0 + 31) >> 6;
    const int vrow = tid >> 3, vch = tid & 7;
    const int voff = AK_BYTES + (vch >> 2) * 4096 + vrow * 64 + (vch & 3) * 16;
    const int k1c = 512 + (tid & 255);
    const int k0row = tid / 12, k0ch = tid % 12, k1row = k1c / 12, k1ch = k1c % 12;
    const int k0off = k0row * AK_PITCH + k0ch * 16, k1off = k1row * AK_PITCH + k1ch * 16;
    u32x4 rkA0, rkA1, rvA, rkB0, rkB1, rvB;
#define A_LOAD(k0, k1, v, t) do { const int kb_ = min((t), T - 1) * 64; \
        k0 = *(const u32x4*)(Kg + (size_t)min(kb_ + k0row, LPOS - 1) * 768 + k0ch * 8); \
        k1 = *(const u32x4*)(Kg + (size_t)min(kb_ + k1row, LPOS - 1) * 768 + k1ch * 8); \
        v = *(const u32x4*)(Vg + (size_t)min(kb_ + vrow, LPOS - 1) * 512 + vch * 8); } while (0)
#define A_STORE(k0, k1, v, buf) do { LAS unsigned char* sb_ = lds + (buf) * ASTAGE; \
        *(LAS u32x4*)(sb_ + k0off) = k0; *(LAS u32x4*)(sb_ + k1off) = k1; *(LAS u32x4*)(sb_ + voff) = v; } while (0)
    float m = -INFINITY, l = 0.f;
    f32x16 o0, o1;
#pragma unroll
    for (int r = 0; r < 16; ++r) { o0[r] = 0.f; o1[r] = 0.f; }
    const int kfo = r32 * AK_PITCH + hi * 16;
    const int vfo = AK_BYTES + ((lane >> 4) & 1) * 32 + (lane & 3) * 8 + (4 * hi + ((lane & 15) >> 2)) * 64;
    __syncthreads();
    A_LOAD(rkA0, rkA1, rvA, 0);
    A_LOAD(rkB0, rkB1, rvB, 1);
    A_STORE(rkA0, rkA1, rvA, 0);
    __syncthreads();
    auto compute_tile = [&](int t) __attribute__((always_inline)) {
        if (t <= tl) {
            const LAS unsigned char* sb = lds + (t & 1) * ASTAGE;
            f32x16 p0, p1;
#pragma unroll
            for (int r = 0; r < 16; ++r) { p0[r] = 0.f; p1[r] = 0.f; }
#pragma unroll
            for (int ds = 0; ds < 6; ++ds) {
                const bf16x8 a0 = *(const LAS bf16x8*)(sb + kfo + ds * 32);
                const bf16x8 a1 = *(const LAS bf16x8*)(sb + kfo + 32 * AK_PITCH + ds * 32);
                p0 = __builtin_amdgcn_mfma_f32_32x32x16_bf16(a0, qf[ds], p0, 0, 0, 0);
                p1 = __builtin_amdgcn_mfma_f32_32x32x16_bf16(a1, qf[ds], p1, 0, 0, 0);
            }
            if (t * 64 + 63 > qpos0) {
                const int kb0 = t * 64 + 4 * hi;
#pragma unroll
                for (int r = 0; r < 16; ++r) {
                    const int kv = kb0 + (r & 3) + 8 * (r >> 2);
                    if (kv > myq) p0[r] = -INFINITY;
                    if (kv + 32 > myq) p1[r] = -INFINITY;
                }
            }
            float mx = fmaxf(p0[0], p1[0]);
#pragma unroll
            for (int r = 1; r < 16; ++r) mx = fmaxf(mx, fmaxf(p0[r], p1[r]));
            mx = fmaxf(mx, __shfl_xor(mx, 32));
            if (__any(mx > m)) {
                const float mn = fmaxf(m, mx), alpha = __builtin_amdgcn_exp2f(m - mn);
                m = mn; l *= alpha;
                if (hi == 0) wsf[r32] = alpha;
                asm volatile("s_waitcnt lgkmcnt(0)" ::: "memory");
#pragma unroll
                for (int k = 0; k < 4; ++k) {
                    const f32x4 a = *(const LAS f32x4*)(wsf + 8 * k + 4 * hi);
#pragma unroll
                    for (int j = 0; j < 4; ++j) { o0[4 * k + j] *= a[j]; o1[4 * k + j] *= a[j]; }
                }
                asm volatile("s_waitcnt lgkmcnt(0)" ::: "memory");
            }
            float ls = 0.f;
#pragma unroll
            for (int r = 0; r < 16; ++r) { p0[r] = __builtin_amdgcn_exp2f(p0[r] - m); p1[r] = __builtin_amdgcn_exp2f(p1[r] - m); ls += p0[r] + p1[r]; }
            l += ls;
            bf16x8 pa[4];
#pragma unroll
            for (int s = 0; s < 4; ++s) {
                u32x4 wv;
#pragma unroll
                for (int e = 0; e < 4; ++e) {
                    const int r = 8 * (s & 1) + 2 * e;
                    wv[e] = (s >> 1) ? pk2(p1[r], p1[r + 1]) : pk2(p0[r], p0[r + 1]);
                }
                pa[s] = __builtin_bit_cast(bf16x8, wv);
            }
#pragma unroll
            for (int s = 0; s < 4; ++s) {
                const s16x4 l0 = vtr(sb + vfo + s * 1024), h0 = vtr(sb + vfo + s * 1024 + 512);
                const s16x4 l1 = vtr(sb + vfo + 4096 + s * 1024), h1 = vtr(sb + vfo + 4096 + s * 1024 + 512);
                const bf16x8 v0 = (bf16x8){l0[0], l0[1], l0[2], l0[3], h0[0], h0[1], h0[2], h0[3]};
                const bf16x8 v1 = (bf16x8){l1[0], l1[1], l1[2], l1[3], h1[0], h1[1], h1[2], h1[3]};
                o0 = __builtin_amdgcn_mfma_f32_32x32x16_bf16(pa[s], v0, o0, 0, 0, 0);
                o1 = __builtin_amdgcn_mfma_f32_32x32x16_bf16(pa[s], v1, o1, 0, 0, 0);
            }
        }
    };
#pragma unroll 1
    for (int t = 0; t < T; t += 2) {
        A_LOAD(rkA0, rkA1, rvA, t + 2);
        compute_tile(t);
        A_STORE(rkB0, rkB1, rvB, 1);
        __syncthreads();
        if (t + 1 >= T) break;
        A_LOAD(rkB0, rkB1, rvB, t + 3);
        compute_tile(t + 1);
        A_STORE(rkA0, rkA1, rvA, 0);
        __syncthreads();
    }
#undef A_LOAD
#undef A_STORE
    l += __shfl_xor(l, 32);
    if (hi == 0) wsf[r32] = 1.f / l;
    asm volatile("s_waitcnt lgkmcnt(0)" ::: "memory");
    float sq[16];
#pragma unroll
    for (int k = 0; k < 4; ++k) {
        const f32x4 a = *(const LAS f32x4*)(wsf + 8 * k + 4 * hi);
#pragma unroll
        for (int j = 0; j < 4; ++j) {
            const int r = 4 * k + j;
            const float x0 = o0[r] * a[j], x1 = o1[r] * a[j];
            bf16_t* op = ATT + (size_t)(row0 + w * 32 + crow(r, hi)) * D + h * 64 + r32;
            op[0] = (bf16_t)f2bf(x0); op[32] = (bf16_t)f2bf(x1);
            sq[r] = x0 * x0 + x1 * x1;
        }
    }
#pragma unroll
    for (int r = 0; r < 16; ++r) {
        float v = sq[r];
#pragma unroll
        for (int o = 1; o < 32; o <<= 1) v += __shfl_xor(v, o);
        if (r32 == 0) patt[(size_t)(row0 + w * 32 + crow(r, hi)) * 8 + h] = v;
    }
    asm volatile("s_waitcnt lgkmcnt(0)" ::: "memory");
}
__device__ __forceinline__ void phase3(const Params& p, const Ctx& c) {
    for (int pi = c.vcu; pi < 256; pi += c.G) {
        const int bh = pi >> 2, s = pi & 3;
        attn_unit(p, c, bh >> 3, bh & 7, 7 - s);
        attn_unit(p, c, bh >> 3, bh & 7, s);
    }
}

__device__ __forceinline__ void phase4(const Params& p, const Ctx& c) {
    unsigned char* ws = p.ws;
    const bf16_t* ATT = (const bf16_t*)(ws + WS_ATT); const bf16_t* CONV = (const bf16_t*)(ws + WS_CONV);
    const bf16_t* WoT = (const bf16_t*)(ws + WS_WO); const bf16_t* H0 = (const bf16_t*)(ws + WS_H0);
    const float* patt = (const float*)(ws + WS_PATT); const float* ssq_c = (const float*)(ws + WS_SSQC);
    bf16_t* Y1 = (bf16_t*)(ws + WS_Y1); float* pst = (float*)(ws + WS_PST);
    const int lane = c.lane, wr = c.wave >> 2, wc = c.wave & 3, fr = lane & 15, fq = lane >> 4;
    constexpr int NU = 128 * 4;
    for (int u = c.vcu; u < NU; u += c.G) {
        const int mt = u >> 2, nt = u & 3, row0 = mt * 128, n0 = nt * 256;
        f32x4 acc[4][4]; acc_zero(acc);
        auto rpa = [&](int r) { return ATT + (size_t)(row0 + r) * 512; };
        gemm_kloop(acc, c, rpa, WoT + (size_t)n0 * D, D, 512);
        float rc[4];
#pragma unroll
        for (int mi = 0; mi < 4; ++mi) {
            const int row = row0 + wr * 64 + mi * 16 + fr;
            const f32x4 pa = *(const f32x4*)(patt + (size_t)row * 8), pb = *(const f32x4*)(patt + (size_t)row * 8 + 4);
            const float ra = rsqrtf((((pa[0] + pa[1]) + (pa[2] + pa[3])) + ((pb[0] + pb[1]) + (pb[2] + pb[3]))) * (1.f / 512) + 1e-6f);
            rc[mi] = rsqrtf(ssq_c[row] * (1.f / 512) + 1e-6f);
            const float f = ra / rc[mi];
#pragma unroll
            for (int ni = 0; ni < 4; ++ni) acc[mi][ni] = acc[mi][ni] * f;
        }
        auto rpc = [&](int r) { return CONV + (size_t)(row0 + r) * 512; };
        gemm_kloop(acc, c, rpc, WoT + (size_t)n0 * D + 512, D, 512);
        const int s0 = n0 + wc * 64;
#pragma unroll
        for (int mi = 0; mi < 4; ++mi) {
            const int row = row0 + wr * 64 + mi * 16 + fr;
            float s = 0.f, ss = 0.f;
#pragma unroll
            for (int ni = 0; ni < 4; ++ni) {
                const int col = s0 + ni * 16 + fq * 4;
                const u32x2 hw = *(const u32x2*)(H0 + (size_t)row * D + col);
                f32x4 v = acc[mi][ni] * rc[mi];
                v[0] += ALPHA * bflo(hw.x); v[1] += ALPHA * bfhi(hw.x); v[2] += ALPHA * bflo(hw.y); v[3] += ALPHA * bfhi(hw.y);
                store_bf4(Y1 + (size_t)row * D + col, v);
                s += (v[0] + v[1]) + (v[2] + v[3]);
                ss += (v[0] * v[0] + v[1] * v[1]) + (v[2] * v[2] + v[3] * v[3]);
            }
            s += __shfl_xor(s, 16); s += __shfl_xor(s, 32);
            ss += __shfl_xor(ss, 16); ss += __shfl_xor(ss, 32);
            if (fq == 0) { float* q = pst + ((size_t)row * 16 + nt * 4 + wc) * 2; q[0] = s; q[1] = ss; }
        }
    }
}

__device__ __forceinline__ void phase5a(const Params& p, const Ctx& c) {
    unsigned char* ws = p.ws;
    const bf16_t* Y1 = (const bf16_t*)(ws + WS_Y1); bf16_t* H1 = (bf16_t*)(ws + WS_H1); const float* pst = (const float*)(ws + WS_PST);
    const int gw = c.vcu * NWAVES + c.wave, NGW = c.G * NWAVES, lane = c.lane;
    for (int row = gw; row < NTOK; row += NGW) {
        float s1 = 0.f, s2 = 0.f;
#pragma unroll
        for (int k = 0; k < 16; ++k) { s1 += pst[((size_t)row * 16 + k) * 2]; s2 += pst[((size_t)row * 16 + k) * 2 + 1]; }
        const float mean = s1 * (1.f / D), var = fmaxf(s2 * (1.f / D) - mean * mean, 0.f), rstd = rsqrtf(var + 1e-5f);
#pragma unroll
        for (int j = 0; j < 2; ++j) {
            const int col = (lane + 64 * j) * 8;
            const u32x4 w = *(const u32x4*)(Y1 + (size_t)row * D + col);
            float y[8];
#pragma unroll
            for (int e = 0; e < 4; ++e) { y[2 * e] = bflo(w[e]); y[2 * e + 1] = bfhi(w[e]); }
#pragma unroll
            for (int e = 0; e < 8; ++e) y[e] = (y[e] - mean) * rstd * p.ln1_g[col + e] + p.ln1_b[col + e];
            u32x4 o; o.x = pk2(y[0], y[1]); o.y = pk2(y[2], y[3]); o.z = pk2(y[4], y[5]); o.w = pk2(y[6], y[7]);
            *(u32x4*)(H1 + (size_t)row * D + col) = o;
        }
    }
}
__device__ __forceinline__ void phase5b(const Params& p, const Ctx& c) {
    unsigned char* ws = p.ws;
    const bf16_t* H1 = (const bf16_t*)(ws + WS_H1); float* LOG = (float*)(ws + WS_LOG);
    const int lane = c.lane, wr = c.wave >> 2, wc = c.wave & 3, fr = lane & 15, fq = lane >> 4;
    for (int u = c.vcu; u < 128; u += c.G) {
        const int row0 = u * 128;
        f32x4 acc[4][4]; acc_zero(acc);
        auto rp = [&](int r) { return H1 + (size_t)(row0 + r) * D; };
        gemm_kloop(acc, c, rp, (const bf16_t*)(ws + WS_WR), D, D);
#pragma unroll
        for (int mi = 0; mi < 4; ++mi) {
            const int row = row0 + wr * 64 + mi * 16 + fr;
#pragma unroll
            for (int ni = 0; ni < 4; ++ni) *(f32x4*)(LOG + (size_t)row * 256 + wc * 64 + ni * 16 + fq * 4) = acc[mi][ni];
        }
    }
}
__device__ __forceinline__ void phase5c(const Params& p, const Ctx& c) {
    unsigned char* ws = p.ws;
    const float* LOG = (const float*)(ws + WS_LOG);
    unsigned* cnt = (unsigned*)(ws + WS_CTL + CT_CNT); unsigned* laid = (unsigned*)(ws + WS_LAID); float* lgate = (float*)(ws + WS_LGATE);
    const int gw = c.vcu * NWAVES + c.wave, NGW = c.G * NWAVES, lane = c.lane;
    const f32x4 bias = *((const f32x4*)p.router_bias + lane);
    for (int t = gw; t < NTOK; t += NGW) {
        const f32x4 lg = *((const f32x4*)(LOG + (size_t)t * 256) + lane);
        float s[4], sel[4];
#pragma unroll
        for (int i = 0; i < 4; ++i) { s[i] = 1.f / (1.f + expf(-lg[i])); sel[i] = s[i] + bias[i]; }
        float a = fmaxf(sel[0], sel[1]), b = fminf(sel[0], sel[1]), cc = fmaxf(sel[2], sel[3]), d = fminf(sel[2], sel[3]);
        float t1 = fmaxf(a, cc), t2 = fmaxf(fminf(a, cc), a >= cc ? b : d);
#pragma unroll
        for (int o = 1; o < 8; o <<= 1) {
            const float y1 = __shfl_xor(t1, o), y2 = __shfl_xor(t2, o);
            const float n1 = fmaxf(t1, y1), n2 = fmaxf(fminf(t1, y1), t1 >= y1 ? t2 : y2);
            t1 = n1; t2 = n2;
        }
        const float gs = t1 + t2; const int g = lane >> 3;
        int better = 0;
#pragma unroll
        for (int gg = 0; gg < 8; ++gg) { const float o = __shfl(gs, gg * 8); better += (o > gs || (o == gs && gg < g)) ? 1 : 0; }
        if (better >= 4) { sel[0] = sel[1] = sel[2] = sel[3] = -INFINITY; }
        int ek[8]; float sk[8]; float ssum = 0.f;
#pragma unroll
        for (int k = 0; k < 8; ++k) {
            float bv = sel[0]; int bi = 0;
            if (sel[1] > bv) { bv = sel[1]; bi = 1; }
            if (sel[2] > bv) { bv = sel[2]; bi = 2; }
            if (sel[3] > bv) { bv = sel[3]; bi = 3; }
            const float wm = wave_max(bv);
            const unsigned long long mask = __ballot(bv == wm);
            const int src = __ffsll((long long)mask) - 1;
            const float sb = bi == 0 ? s[0] : bi == 1 ? s[1] : bi == 2 ? s[2] : s[3];
            ek[k] = src * 4 + __shfl(bi, src); sk[k] = __shfl(sb, src); ssum += sk[k];
            if (lane == src) { if (bi == 0) sel[0] = -INFINITY; else if (bi == 1) sel[1] = -INFINITY; else if (bi == 2) sel[2] = -INFINITY; else sel[3] = -INFINITY; }
        }
        int me = ek[0]; float mg = sk[0];
#pragma unroll
        for (int k = 1; k < 8; ++k) if (lane == k) { me = ek[k]; mg = sk[k]; }
        if (lane < 8) {
            const unsigned pos = atomicAdd(cnt + me, 1u);
            laid[(size_t)me * CAP + pos] = (unsigned)(t * 8 + lane);
            lgate[(size_t)me * CAP + pos] = mg / ssum * 2.5f;
        }
    }
}


__device__ __forceinline__ void route_token(const Params& p, int t, const f32x4 lg, const f32x4 bias, int lane, unsigned* cnt, unsigned* laid, float* lgate) {
    float s[4], sel[4];
#pragma unroll
    for (int i = 0; i < 4; ++i) { s[i] = 1.f / (1.f + expf(-lg[i])); sel[i] = s[i] + bias[i]; }
    float a = fmaxf(sel[0], sel[1]), b = fminf(sel[0], sel[1]), cc = fmaxf(sel[2], sel[3]), d = fminf(sel[2], sel[3]);
    float t1 = fmaxf(a, cc), t2 = fmaxf(fminf(a, cc), a >= cc ? b : d);
#pragma unroll
    for (int o = 1; o < 8; o <<= 1) {
        const float y1 = __shfl_xor(t1, o), y2 = __shfl_xor(t2, o);
        const float n1 = fmaxf(t1, y1), n2 = fmaxf(fminf(t1, y1), t1 >= y1 ? t2 : y2);
        t1 = n1; t2 = n2;
    }
    const float gs = t1 + t2; const int g = lane >> 3;
    int better = 0;
#pragma unroll
    for (int gg = 0; gg < 8; ++gg) { const float o = __shfl(gs, gg * 8); better += (o > gs || (o == gs && gg < g)) ? 1 : 0; }
    if (better >= 4) { sel[0] = sel[1] = sel[2] = sel[3] = -INFINITY; }
    int ek[8]; float sk[8]; float ssum = 0.f;
#pragma unroll
    for (int k = 0; k < 8; ++k) {
        float bv = sel[0]; int bi = 0;
        if (sel[1] > bv) { bv = sel[1]; bi = 1; }
        if (sel[2] > bv) { bv = sel[2]; bi = 2; }
        if (sel[3] > bv) { bv = sel[3]; bi = 3; }
        const float wm = wave_max(bv);
        const unsigned long long mask = __ballot(bv == wm);
        const int src = __ffsll((long long)mask) - 1;
        const float sb = bi == 0 ? s[0] : bi == 1 ? s[1] : bi == 2 ? s[2] : s[3];
        ek[k] = src * 4 + __shfl(bi, src); sk[k] = __shfl(sb, src); ssum += sk[k];
        if (lane == src) { if (bi == 0) sel[0] = -INFINITY; else if (bi == 1) sel[1] = -INFINITY; else if (bi == 2) sel[2] = -INFINITY; else sel[3] = -INFINITY; }
    }
    int me = ek[0]; float mg = sk[0];
#pragma unroll
    for (int k = 1; k < 8; ++k) if (lane == k) { me = ek[k]; mg = sk[k]; }
    if (lane < 8) {
        const unsigned pos = atomicAdd(cnt + me, 1u);
        laid[(size_t)me * CAP + pos] = (unsigned)(t * 8 + lane);
        lgate[(size_t)me * CAP + pos] = mg / ssum * 2.5f;
    }
}
__device__ __forceinline__ void phase5_fused(const Params& p, const Ctx& c) {
    unsigned char* ws = p.ws;
    const bf16_t* Y1 = (const bf16_t*)(ws + WS_Y1); bf16_t* H1 = (bf16_t*)(ws + WS_H1); const float* pst = (const float*)(ws + WS_PST);
    const bf16_t* WrT = (const bf16_t*)(ws + WS_WR);
    unsigned* cnt = (unsigned*)(ws + WS_CTL + CT_CNT); unsigned* laid = (unsigned*)(ws + WS_LAID); float* lgate = (float*)(ws + WS_LGATE);
    const int lane = c.lane, w = c.wave, r32 = lane & 31, hi = lane >> 5;
    LAS unsigned char* lds = c.lds;
    const f32x4 bias = *((const f32x4*)p.router_bias + lane);
    for (int u = c.vcu; u < NTOK / 64; u += c.G) {
        const int row0 = u * 64;
        __syncthreads();
        {
            float gg[16], bb[16];
#pragma unroll
            for (int j = 0; j < 2; ++j) {
                const int col = (lane + 64 * j) * 8;
#pragma unroll
                for (int e = 0; e < 2; ++e) { const f32x4 g4 = *(const f32x4*)(p.ln1_g + col + 4 * e), b4 = *(const f32x4*)(p.ln1_b + col + 4 * e);
#pragma unroll
                    for (int q = 0; q < 4; ++q) { gg[j * 8 + e * 4 + q] = g4[q]; bb[j * 8 + e * 4 + q] = b4[q]; } }
            }
#pragma unroll 2
            for (int rr = 0; rr < 8; ++rr) {
                const int lr = w * 8 + rr, row = row0 + lr;
                float s1 = 0.f, s2 = 0.f;
                if (lane < 16) { const float* q = pst + ((size_t)row * 16 + lane) * 2; s1 = q[0]; s2 = q[1]; }
#pragma unroll
                for (int o = 1; o < 16; o <<= 1) { s1 += __shfl_xor(s1, o); s2 += __shfl_xor(s2, o); }
                s1 = __shfl(s1, 0); s2 = __shfl(s2, 0);
                const float mean = s1 * (1.f / D), var = fmaxf(s2 * (1.f / D) - mean * mean, 0.f), rstd = rsqrtf(var + 1e-5f);
#pragma unroll
                for (int j = 0; j < 2; ++j) {
                    const int ch = lane + 64 * j, col = ch * 8;
                    const u32x4 wv = *(const u32x4*)(Y1 + (size_t)row * D + col);
                    float y[8];
#pragma unroll
                    for (int e = 0; e < 4; ++e) { y[2 * e] = bflo(wv[e]); y[2 * e + 1] = bfhi(wv[e]); }
#pragma unroll
                    for (int e = 0; e < 8; ++e) y[e] = (y[e] - mean) * rstd * gg[j * 8 + e] + bb[j * 8 + e];
                    u32x4 o; o.x = cvtpk(y[0], y[1]); o.y = cvtpk(y[2], y[3]); o.z = cvtpk(y[4], y[5]); o.w = cvtpk(y[6], y[7]);
                    *(u32x4*)(H1 + (size_t)row * D + col) = o;
                    *(LAS u32x4*)(lds + lr * 2048 + ((ch ^ (lr & 15)) << 4)) = o;
                }
            }
        }
        __syncthreads();
        f32x16 acc0, acc1;
#pragma unroll
        for (int r = 0; r < 16; ++r) { acc0[r] = 0.f; acc1[r] = 0.f; }
        {
            const bf16_t* bp = WrT + (size_t)(w * 32 + r32) * D + hi * 8;
            const LAS unsigned char* a0 = lds + r32 * 2048, * a1 = lds + (32 + r32) * 2048;
            const int sx = r32 & 15;
#pragma unroll 1
            for (int kb = 0; kb < 64; kb += 8) {
                bf16x8 bf[8];
#pragma unroll
                for (int q = 0; q < 8; ++q) bf[q] = *(const bf16x8*)(bp + (kb + q) * 16);
#pragma unroll
                for (int q = 0; q < 8; ++q) {
                    const int ch = 2 * (kb + q) + hi;
                    const bf16x8 f0 = *(const LAS bf16x8*)(a0 + ((ch ^ sx) << 4)), f1 = *(const LAS bf16x8*)(a1 + ((ch ^ sx) << 4));
                    acc0 = __builtin_amdgcn_mfma_f32_32x32x16_bf16(bf[q], f0, acc0, 0, 0, 0);
                    acc1 = __builtin_amdgcn_mfma_f32_32x32x16_bf16(bf[q], f1, acc1, 0, 0, 0);
                }
            }
        }
        __syncthreads();
#pragma unroll
        for (int g = 0; g < 4; ++g) {
            *(LAS f32x4*)(lds + (size_t)r32 * 1024 + (w * 32 + 8 * g + 4 * hi) * 4) = (f32x4){acc0[4 * g], acc0[4 * g + 1], acc0[4 * g + 2], acc0[4 * g + 3]};
            *(LAS f32x4*)(lds + (size_t)(32 + r32) * 1024 + (w * 32 + 8 * g + 4 * hi) * 4) = (f32x4){acc1[4 * g], acc1[4 * g + 1], acc1[4 * g + 2], acc1[4 * g + 3]};
        }
        __syncthreads();
#pragma unroll 1
        for (int rr = 0; rr < 8; ++rr) {
            const int lr = w * 8 + rr;
            const f32x4 lg = *(const LAS f32x4*)(lds + lr * 1024 + lane * 16);
            route_token(p, row0 + lr, lg, bias, lane, cnt, laid, lgate);
        }
    }
}

struct MoeTab { LAS int* tstart; LAS int* roff; LAS int* tok; LAS float* gate; };
__device__ __forceinline__ MoeTab moe_tab_build(const Params& p, const Ctx& c) {
    MoeTab T; T.tstart = (LAS int*)(c.lds + LDS_MISC); T.roff = T.tstart + 260; T.tok = T.roff + 260; T.gate = (LAS float*)(T.tok + 128);
    const unsigned* cnt = (const unsigned*)(p.ws + WS_CTL + CT_CNT);
    __syncthreads();
    if (c.tid < 64) {
        int cv[4], tv[4]; int ls = 0, lt = 0;
#pragma unroll
        for (int i = 0; i < 4; ++i) { cv[i] = (int)cnt[c.tid * 4 + i]; tv[i] = (cv[i] + 127) >> 7; ls += cv[i]; lt += tv[i]; }
        int ps = ls, pt = lt;
#pragma unroll
        for (int o = 1; o < 64; o <<= 1) { const int a = __shfl_up(ps, o), b = __shfl_up(pt, o); if (c.tid >= o) { ps += a; pt += b; } }
        int es = ps - ls, et = pt - lt;
#pragma unroll
        for (int i = 0; i < 4; ++i) { T.roff[c.tid * 4 + i] = es; T.tstart[c.tid * 4 + i] = et; es += cv[i]; et += tv[i]; }
        if (c.tid == 63) { T.roff[256] = es; T.tstart[256] = et; }
    }
    __syncthreads();
    return T;
}
__device__ __forceinline__ int moe_find(const MoeTab& T, int g) {
    int lo = 0, hi = 255;
    while (lo < hi) { const int mid = (lo + hi + 1) >> 1; if (T.tstart[mid] <= g) lo = mid; else hi = mid - 1; }
    return lo;
}

__device__ __forceinline__ void phase6(const Params& p, const Ctx& c) {
    unsigned char* ws = p.ws;
    const bf16_t* H1 = (const bf16_t*)(ws + WS_H1); bf16_t* HID = (bf16_t*)(ws + WS_HID);
    const unsigned* laid = (const unsigned*)(ws + WS_LAID);
    const unsigned* cnt = (const unsigned*)(ws + WS_CTL + CT_CNT);
    const int lane = c.lane, wr = c.wave >> 2, wc = c.wave & 3, fr = lane & 15, fq = lane >> 4;
    const MoeTab T = moe_tab_build(p, c);
    const int tmt = T.tstart[256], NU = (tmt + 128) * 2;
    for (int u = c.vcu; u < NU; u += c.G) {
        const int g = u >> 1, nt = u & 1;
        int e, mt, nrows; size_t hbase;
        __syncthreads();
        if (g < tmt) {
            e = moe_find(T, g); mt = g - T.tstart[e]; nrows = min(128, (int)cnt[e] - mt * 128); hbase = (size_t)T.roff[e] + mt * 128;
            if (c.tid < 128) T.tok[c.tid] = (int)(laid[(size_t)e * CAP + mt * 128 + min(c.tid, nrows - 1)] >> 3);
        } else {
            e = NEXP; mt = g - tmt; nrows = 128; hbase = (size_t)NTOK * 8 + mt * 128;
            if (c.tid < 128) T.tok[c.tid] = mt * 128 + c.tid;
        }
        __syncthreads();
        f32x4 acc[4][4]; acc_zero(acc);
        auto rp = [&](int r) { return H1 + (size_t)T.tok[r] * D; };
        const bf16_t* Bt = (e < NEXP ? (const bf16_t*)(ws + WS_WGU) + (size_t)e * 512 * D : (const bf16_t*)(ws + WS_WSGU)) + (size_t)nt * 256 * D;
        gemm_kloop(acc, c, rp, Bt, D, D);
#pragma unroll
        for (int mi = 0; mi < 4; ++mi) {
            const int r = wr * 64 + mi * 16 + fr;
            if (r >= nrows) continue;
#pragma unroll
            for (int np = 0; np < 2; ++np) {
                const f32x4 gt = acc[mi][2 * np], up = acc[mi][2 * np + 1];
                f32x4 hv;
#pragma unroll
                for (int j = 0; j < 4; ++j) hv[j] = gt[j] / (1.f + __expf(-gt[j])) * up[j];
                store_bf4(HID + (hbase + r) * DEXP + nt * 128 + wc * 32 + np * 16 + fq * 4, hv);
            }
        }
    }
}
__device__ __forceinline__ void phase7(const Params& p, const Ctx& c) {
    unsigned char* ws = p.ws;
    const bf16_t* HID = (const bf16_t*)(ws + WS_HID); bf16_t* Y = (bf16_t*)(ws + WS_Y);
    const unsigned* laid = (const unsigned*)(ws + WS_LAID); const float* lgate = (const float*)(ws + WS_LGATE);
    const unsigned* cnt = (const unsigned*)(ws + WS_CTL + CT_CNT);
    const int lane = c.lane, wr = c.wave >> 2, wc = c.wave & 3, fr = lane & 15, fq = lane >> 4;
    const MoeTab T = moe_tab_build(p, c);
    const int tmt = T.tstart[256], NU = (tmt + 128) * 4;
    for (int u = c.vcu; u < NU; u += c.G) {
        const int g = u >> 2, nt = u & 3;
        int e, mt, nrows; size_t hbase;
        __syncthreads();
        if (g < tmt) {
            e = moe_find(T, g); mt = g - T.tstart[e]; nrows = min(128, (int)cnt[e] - mt * 128); hbase = (size_t)T.roff[e] + mt * 128;
            if (c.tid < 128) {
                const int rr = min(c.tid, nrows - 1);
                const unsigned aid = laid[(size_t)e * CAP + mt * 128 + rr];
                T.tok[c.tid] = (int)((aid >> 3) * 9 + (aid & 7)); T.gate[c.tid] = lgate[(size_t)e * CAP + mt * 128 + rr];
            }
        } else {
            e = NEXP; mt = g - tmt; nrows = 128; hbase = (size_t)NTOK * 8 + mt * 128;
            if (c.tid < 128) { T.tok[c.tid] = (mt * 128 + c.tid) * 9 + 8; T.gate[c.tid] = 1.f; }
        }
        __syncthreads();
        f32x4 acc[4][4]; acc_zero(acc);
        auto rp = [&](int r) { return HID + (hbase + min(r, nrows - 1)) * DEXP; };
        const bf16_t* Bt = (e < NEXP ? (const bf16_t*)(ws + WS_WD) + (size_t)e * D * DEXP : (const bf16_t*)(ws + WS_WSD)) + (size_t)nt * 256 * DEXP;
        gemm_kloop(acc, c, rp, Bt, DEXP, DEXP);
#pragma unroll
        for (int mi = 0; mi < 4; ++mi) {
            const int r = wr * 64 + mi * 16 + fr;
            if (r >= nrows) continue;
            const float gt = T.gate[r]; const size_t yrow = (size_t)T.tok[r];
#pragma unroll
            for (int ni = 0; ni < 4; ++ni) store_bf4(Y + yrow * D + nt * 256 + wc * 64 + ni * 16 + fq * 4, acc[mi][ni] * gt);
        }
    }
}

__device__ __forceinline__ int moe_find_l(const LAS int* tstart, int g) {
    int lo = 0, hi = 255;
    while (lo < hi) { const int mid = (lo + hi + 1) >> 1; if (tstart[mid] <= g) lo = mid; else hi = mid - 1; }
    return lo;
}

constexpr int MOE_A = 0, MOE_B = 32768, MOE_H0 = 98304, MOE_H1 = 0, MOE_MISC = 131072;
struct MoeUnit { const float* wg; const float* wu; const float* wd; int nrows; int par; };

__device__ __forceinline__ void phase_moe(const Params& p, const Ctx& c) {
    unsigned char* ws = p.ws;
    const bf16_t* H1 = (const bf16_t*)(ws + WS_H1); bf16_t* Y = (bf16_t*)(ws + WS_Y);
    const unsigned* laid = (const unsigned*)(ws + WS_LAID); const float* lgate = (const float*)(ws + WS_LGATE);
    const unsigned* cnt = (const unsigned*)(ws + WS_CTL + CT_CNT);
    const int tid = c.tid, lane = c.lane, wr = c.wave >> 2, wc = c.wave & 3, fr = lane & 15, fq = lane >> 4;
    LAS unsigned char* lds = c.lds;
    LAS int* tstart = (LAS int*)(lds + MOE_MISC); LAS int* cntl = tstart + 260;
    LAS int* tokT = cntl + 260; LAS int* yrowT = tokT + 256; LAS float* gateT = (LAS float*)(yrowT + 256);
    __syncthreads();
    if (tid < 64) {
        int cv[4], tv[4]; int lt = 0;
#pragma unroll
        for (int i = 0; i < 4; ++i) { cv[i] = (int)cnt[tid * 4 + i]; tv[i] = (cv[i] + 127) >> 7; lt += tv[i]; }
        int pt = lt;
#pragma unroll
        for (int o = 1; o < 64; o <<= 1) { const int b = __shfl_up(pt, o); if (tid >= o) pt += b; }
        int et = pt - lt;
#pragma unroll
        for (int i = 0; i < 4; ++i) { cntl[tid * 4 + i] = cv[i]; tstart[tid * 4 + i] = et; et += tv[i]; }
        if (tid == 63) tstart[256] = et;
    }
    __syncthreads();
    const int tmt = tstart[256], NU = tmt + 128;
    if (c.vcu >= NU) return;

    const int srow = tid >> 3, sch = tid & 7;
    const int soA = srow * 128 + ((sch ^ ((srow >> 1) & 7)) << 4);
    const int kk1 = tid >> 5, n4 = tid & 31;
    const int s1 = (kk1 & 3) | (((kk1 >> 3) & 1) << 2);
    const int soB1g = kk1 * 512 + (((2 * (n4 >> 2)) ^ s1) << 5) + (n4 & 3) * 8;
    const int soB1u = kk1 * 512 + (((2 * (n4 >> 2) + 1) ^ s1) << 5) + (n4 & 3) * 8;
    const int kk2 = tid >> 6, c4 = tid & 63;
    const int soB2e = kk2 * 512 + ((((c4 >> 2)) ^ (kk2 & 3)) << 5) + (c4 & 3) * 8;
    const int soB2o = kk2 * 512 + ((((c4 >> 2)) ^ ((kk2 & 3) | 4)) << 5) + (c4 & 3) * 8;
    const int sw0 = ((0 + fq) ^ ((fr >> 1) & 7)) << 4, sw1 = ((4 + fq) ^ ((fr >> 1) & 7)) << 4;
    const int aoff = (wr * 64 + fr) * 128;
    const int qp = fr >> 2, pp = fr & 3, sB = qp | ((fq & 1) << 2);
    const int brow = (8 * fq + qp) * 512 + pp * 8;
    int bblk[4];
#pragma unroll
    for (int ni = 0; ni < 4; ++ni) bblk[ni] = ((4 * wc + ni) ^ sB) << 5;
    const int hoff = (wr * 64 + fr) * 256;

    const unsigned lo1 = (unsigned)(kk1 * 256 + n4 * 4), lo2 = (unsigned)(kk2 * D + c4 * 4);
    u32x4 ra0, ra1; f32x4 rb[8];
    f32x4 acc[4][4];

#define M_LOAD1(U, nt, kt) do { \
        const int t0_ = tokT[(U).par * 128 + srow], t1_ = tokT[(U).par * 128 + srow + 64]; \
        ra0 = *(const u32x4*)(H1 + (size_t)t0_ * D + (kt) * 64 + sch * 8); ra1 = *(const u32x4*)(H1 + (size_t)t1_ * D + (kt) * 64 + sch * 8); \
        const float* g_ = (U).wg + ((kt) * 64 * 256 + (nt) * 128); const float* u_ = (U).wu + ((kt) * 64 * 256 + (nt) * 128); \
        _Pragma("unroll") for (int j = 0; j < 4; ++j) { rb[j] = *(const f32x4*)(g_ + j * 4096 + lo1); rb[4 + j] = *(const f32x4*)(u_ + j * 4096 + lo1); } } while (0)
#define M_STORE1(buf) do { LAS unsigned char* sa_ = lds + MOE_A + (buf) * 16384; LAS unsigned char* sb_ = lds + MOE_B + (buf) * 32768; \
        *(LAS u32x4*)(sa_ + soA) = ra0; *(LAS u32x4*)(sa_ + soA + 8192) = ra1; \
        _Pragma("unroll") for (int j = 0; j < 4; ++j) { \
            *(LAS u32x2*)(sb_ + soB1g + j * 8192) = (u32x2){cvtpk(rb[j][0], rb[j][1]), cvtpk(rb[j][2], rb[j][3])}; \
            *(LAS u32x2*)(sb_ + soB1u + j * 8192) = (u32x2){cvtpk(rb[4 + j][0], rb[4 + j][1]), cvtpk(rb[4 + j][2], rb[4 + j][3])}; } } while (0)
#define M_LOAD2(U, nt2, ksm) do { \
        const float* d_ = (U).wd + ((ksm) * 64 * D + (nt2) * 256); \
        _Pragma("unroll") for (int j = 0; j < 8; ++j) rb[j] = *(const f32x4*)(d_ + j * 8192 + lo2); } while (0)
#define M_STORE2(buf) do { LAS unsigned char* sb_ = lds + MOE_B + (buf) * 32768; \
        _Pragma("unroll") for (int j = 0; j < 8; ++j) \
            *(LAS u32x2*)(sb_ + ((j & 1) ? soB2o : soB2e) + j * 4096) = (u32x2){cvtpk(rb[j][0], rb[j][1]), cvtpk(rb[j][2], rb[j][3])}; } while (0)
#define M_BFRAG(dst, sbB, ks) do { _Pragma("unroll") for (int ni = 0; ni < 4; ++ni) { \
            const s16x4 lo_ = vtr((sbB) + brow + (ks) * 16384 + bblk[ni]), hi_ = vtr((sbB) + brow + (ks) * 16384 + 2048 + bblk[ni]); \
            dst[ni] = (bf16x8){lo_[0], lo_[1], lo_[2], lo_[3], hi_[0], hi_[1], hi_[2], hi_[3]}; } } while (0)
#define M_COMPUTE1(buf) do { const LAS unsigned char* sa_ = lds + MOE_A + (buf) * 16384; const LAS unsigned char* sbb_ = lds + MOE_B + (buf) * 32768; \
        _Pragma("unroll") for (int ks = 0; ks < 2; ++ks) { bf16x8 af[4], bfr[4]; \
            _Pragma("unroll") for (int mi = 0; mi < 4; ++mi) af[mi] = *(const LAS bf16x8*)(sa_ + aoff + mi * 2048 + (ks ? sw1 : sw0)); \
            M_BFRAG(bfr, sbb_, ks); \
            _Pragma("unroll") for (int mi = 0; mi < 4; ++mi) _Pragma("unroll") for (int ni = 0; ni < 4; ++ni) \
                acc[mi][ni] = __builtin_amdgcn_mfma_f32_16x16x32_bf16(bfr[ni], af[mi], acc[mi][ni], 0, 0, 0); } } while (0)
#define M_COMPUTE2(buf, ksm) do { const LAS unsigned char* sh_ = lds + (((ksm) >> 1) ? MOE_H1 : MOE_H0); const LAS unsigned char* sbb_ = lds + MOE_B + (buf) * 32768; \
        _Pragma("unroll") for (int ks = 0; ks < 2; ++ks) { bf16x8 af[4], bfr[4]; \
            _Pragma("unroll") for (int mi = 0; mi < 4; ++mi) af[mi] = *(const LAS bf16x8*)(sh_ + hoff + mi * 4096 + (((((ksm) & 1) * 8 + ks * 4 + fq) ^ fr) << 4)); \
            M_BFRAG(bfr, sbb_, ks); \
            _Pragma("unroll") for (int mi = 0; mi < 4; ++mi) _Pragma("unroll") for (int ni = 0; ni < 4; ++ni) \
                acc[mi][ni] = __builtin_amdgcn_mfma_f32_16x16x32_bf16(bfr[ni], af[mi], acc[mi][ni], 0, 0, 0); } } while (0)

    auto unit_make = [&](int u, int par, MoeUnit& U, int& e, int& mt) {
        if (u < tmt) { e = moe_find_l(tstart, u); mt = u - tstart[e]; U.nrows = min(128, cntl[e] - mt * 128);
            U.wg = p.w_gate + (size_t)e * D * DEXP; U.wu = p.w_up + (size_t)e * D * DEXP; U.wd = p.w_down + (size_t)e * D * DEXP; }
        else { e = NEXP; mt = u - tmt; U.nrows = 128; U.wg = p.ws_gate; U.wu = p.ws_up; U.wd = p.ws_down; }
        U.par = par;
    };
    auto unit_tables = [&](const MoeUnit& U, int e, int mt) {
        if (tid < 128) {
            int tok, yr; float gt;
            if (e < NEXP) { const int rr = min(tid, U.nrows - 1); const unsigned aid = laid[(size_t)e * CAP + mt * 128 + rr];
                tok = (int)(aid >> 3); yr = tok * 9 + (int)(aid & 7); gt = lgate[(size_t)e * CAP + mt * 128 + rr]; }
            else { tok = mt * 128 + tid; yr = tok * 9 + 8; gt = 1.f; }
            tokT[U.par * 128 + tid] = tok; yrowT[U.par * 128 + tid] = yr; gateT[U.par * 128 + tid] = gt;
        }
    };

    MoeUnit cur, nxt; int e_, mt_;
    unit_make(c.vcu, 0, cur, e_, mt_);
    unit_tables(cur, e_, mt_);
    __syncthreads();
    M_LOAD1(cur, 0, 0);
    M_STORE1(0);
    __syncthreads();
    for (int u = c.vcu, ui = 0; u < NU; u += c.G, ++ui) {
        const bool has_next = (u + c.G) < NU;
#pragma unroll 1
        for (int nt = 0; nt < 2; ++nt) {
            acc_zero(acc);
#pragma unroll 1
            for (int kt = 0; kt < 16; ++kt) {
                const bool last = (kt == 15);
                if (!last) M_LOAD1(cur, nt, kt + 1);
                else if (nt == 0) M_LOAD1(cur, 1, 0);
                else M_LOAD2(cur, 0, 2);
                M_COMPUTE1(kt & 1);
                if (!(last && nt == 1)) M_STORE1((kt + 1) & 1); else M_STORE2(0);
                __syncthreads();
            }
            {
                LAS unsigned char* hb = lds + (nt ? MOE_H1 : MOE_H0);
#pragma unroll
                for (int mi = 0; mi < 4; ++mi) {
                    const int r = wr * 64 + mi * 16 + fr;
#pragma unroll
                    for (int np = 0; np < 2; ++np) {
                        const f32x4 gt = acc[mi][2 * np], up = acc[mi][2 * np + 1];
                        float hv[4];
#pragma unroll
                        for (int j = 0; j < 4; ++j) hv[j] = gt[j] / (1.f + __expf(-gt[j])) * up[j];
                        const int chunk = wc * 4 + np * 2 + (fq >> 1);
                        *(LAS u32x2*)(hb + r * 256 + ((chunk ^ fr) << 4) + (fq & 1) * 8) = (u32x2){cvtpk(hv[0], hv[1]), cvtpk(hv[2], hv[3])};
                    }
                }
            }
            if (nt == 1) __syncthreads();
        }
#pragma unroll 1
        for (int nt2 = 0; nt2 < 4; ++nt2) {
            acc_zero(acc);
            if (nt2 == 0 && has_next) { unit_make(u + c.G, (ui + 1) & 1, nxt, e_, mt_); unit_tables(nxt, e_, mt_); }
#pragma unroll 1
            for (int kq = 0; kq < 4; ++kq) {
                const int ksm = kq ^ 2;
                const bool last = (kq == 3);
                if (!last) M_LOAD2(cur, nt2, (kq + 1) ^ 2);
                else if (nt2 < 3) M_LOAD2(cur, nt2 + 1, 2);
                else if (has_next) M_LOAD1(nxt, 0, 0);
                M_COMPUTE2(kq & 1, ksm);
                if (!(last && nt2 == 3)) M_STORE2((kq + 1) & 1); else if (has_next) M_STORE1(0);
                __syncthreads();
            }
#pragma unroll
            for (int mi = 0; mi < 4; ++mi) {
                const int r = wr * 64 + mi * 16 + fr;
                if (r < cur.nrows) {
                    const float gt = gateT[cur.par * 128 + r]; const size_t yrow = (size_t)yrowT[cur.par * 128 + r];
#pragma unroll
                    for (int ni = 0; ni < 4; ++ni) store_bf4(Y + yrow * D + nt2 * 256 + wc * 64 + ni * 16 + fq * 4, acc[mi][ni] * gt);
                }
            }
        }
        cur = nxt;
    }
#undef M_LOAD1
#undef M_STORE1
#undef M_LOAD2
#undef M_STORE2
#undef M_BFRAG
#undef M_COMPUTE1
#undef M_COMPUTE2
}


__device__ __forceinline__ void store_blk32_bf16(bf16_t* p, const f32x16& v, int hi, bool pred = true) {
#pragma unroll
    for (int pr = 0; pr < 2; ++pr) {
        unsigned ax = cvtpk(v[8 * pr + 0], v[8 * pr + 1]), ay = cvtpk(v[8 * pr + 2], v[8 * pr + 3]);
        unsigned bx = cvtpk(v[8 * pr + 4], v[8 * pr + 5]), by = cvtpk(v[8 * pr + 6], v[8 * pr + 7]);
        { auto r_ = __builtin_amdgcn_permlane32_swap(ax, bx, false, false); ax = r_[0]; bx = r_[1]; }
        { auto r_ = __builtin_amdgcn_permlane32_swap(ay, by, false, false); ay = r_[0]; by = r_[1]; }
        if (pred) *(u32x4*)(p + 16 * pr + (hi ? 8 : 0)) = (u32x4){ax, ay, bx, by};
    }
}

constexpr int G2_A = 0, G2_B = 65536, G2_MISC = 131072;
constexpr int G2_GATE = G2_MISC + 4096, G2_YROW = G2_GATE + 2048, G2_TAB = G2_YROW + 2048;
constexpr int BM_BF16T = 0, BM_F32 = 1, BM_F32_GU = 2;
struct G2Unit { const void* b0; const void* b1; int ldb; int nsteps; int nrows; int par; int i0, i1, i2; int kshift, bsub; };

#define G2_SGB(mask, n) __builtin_amdgcn_sched_group_barrier(mask, n, 0)
#define G2_MFMA_HALF(NMI, KM, kh) do { \
        __builtin_amdgcn_sched_barrier(0); \
        _Pragma("unroll") for (int kq = 0; kq < 2; ++kq) { const int k16_ = 2 * (kh) + kq; bf16x8 bfr[2]; \
            if (KM) { _Pragma("unroll") for (int ni = 0; ni < 2; ++ni) { const int bb_ = ((4 * wc + 2 * ni + bsel) ^ sB2) << 5; \
                const s16x4 lo_ = vtr(sbb_ + brow + k16_ * 8192 + bb_); const s16x4 hi_ = vtr(sbb_ + brow + k16_ * 8192 + 2048 + bb_); \
                bf16x8 t_; t_[0] = lo_[0]; t_[1] = lo_[1]; t_[2] = lo_[2]; t_[3] = lo_[3]; t_[4] = hi_[0]; t_[5] = hi_[1]; t_[6] = hi_[2]; t_[7] = hi_[3]; bfr[ni] = t_; } } \
            else { _Pragma("unroll") for (int ni = 0; ni < 2; ++ni) bfr[ni] = *(const LAS bf16x8*)(sbb_ + boffT + ni * 4096 + (((2 * k16_ + hi) ^ swx) << 4)); } \
            _Pragma("unroll") for (int mi = 0; mi < (NMI); ++mi) { \
                const bf16x8 af_ = *(const LAS bf16x8*)(sa_ + aoff + mi * 8192 + (((2 * k16_ + hi) ^ swx) << 4)); \
                _Pragma("unroll") for (int ni = 0; ni < 2; ++ni) acc[mi][ni] = __builtin_amdgcn_mfma_f32_32x32x16_bf16(bfr[ni], af_, acc[mi][ni], 0, 0, 0); } } \
        if (!(KM)) { _Pragma("unroll") for (int kq = 0; kq < 2; ++kq) { G2_SGB(0x100, 3); \
            _Pragma("unroll") for (int g = 0; g < (NMI) - 1; ++g) { G2_SGB(0x100, 1); G2_SGB(0x008, 2); } \
            G2_SGB(0x008, 2); } } \
        __builtin_amdgcn_sched_barrier(0); \
    } while (0)
#define G2_SEL(off) const int nst_ = st + (off); const bool wrap_ = nst_ >= cur.nsteps, usen_ = wrap_ && has_next; \
        const void* sb0_ = usen_ ? nxt.b0 : cur.b0; const void* sb1_ = usen_ ? nxt.b1 : cur.b1; const int spar_ = usen_ ? nxt.par : cur.par; \
        const int sk0_ = wrap_ ? (has_next ? nst_ - cur.nsteps : cur.nsteps - 1) : nst_; const int ldb_ = cur.ldb; (void)sb1_; \
        const int ssub_ = sk0_ >> cur.kshift, sk_ = sk0_ - (ssub_ << cur.kshift); const int sboff_ = ssub_ * cur.bsub; (void)sboff_

typedef __amdgpu_buffer_rsrc_t rsrc_t;
__device__ __forceinline__ rsrc_t make_rsrc(const void* p) {
    const unsigned long long a = (unsigned long long)(uintptr_t)p;
    const unsigned lo = __builtin_amdgcn_readfirstlane((unsigned)a), hi = __builtin_amdgcn_readfirstlane((unsigned)(a >> 32));
    return __builtin_amdgcn_make_buffer_rsrc((void*)(uintptr_t)(((unsigned long long)hi << 32) | lo), (short)0, 0x7fffffff, 0x00020000);
}
__device__ __forceinline__ u32x4 bload16(rsrc_t r, int voff, int soff) { return __builtin_bit_cast(u32x4, __builtin_amdgcn_raw_buffer_load_b128(r, voff, soff, 0)); }
template <int BMODE, bool FULL, class Sched, class Epi>
__device__ __forceinline__ void gemm256_stream(const Ctx& c, Sched& S, const Epi& E) {
    const int tid = c.tid, lane = c.lane, wr = c.wave >> 2, wc = c.wave & 3, r32 = lane & 31, hi = lane >> 5;
    LAS unsigned char* lds = c.lds;
    const LAS unsigned* rowT = (const LAS unsigned*)(lds + G2_MISC);
    const rsrc_t rsA = make_rsrc(S.abase());
    const int srow = tid >> 3, sch = tid & 7;
    const int soA = srow * 128 + ((sch ^ ((srow >> 1) & 7)) << 4);
    const int kk1 = tid >> 5, n4 = tid & 31;
    const int soB1g = kk1 * 512 + (((2 * (n4 >> 2)) ^ (2 * (kk1 & 3))) << 5) + (n4 & 3) * 8;
    const int soB1u = kk1 * 512 + (((2 * (n4 >> 2) + 1) ^ (2 * (kk1 & 3))) << 5) + (n4 & 3) * 8;
    const int kk2 = tid >> 6, c4 = tid & 63;
    const int soB2 = kk2 * 512 + ((((c4 >> 2)) ^ (2 * (kk2 & 3))) << 5) + (c4 & 3) * 8;
    const int swx = (r32 >> 1) & 7;
    const int aoff = (32 * wr + r32) * 128;
    const int boffT = (wc * 64 + r32) * 128;
    const int qp = (lane & 15) >> 2, pp = lane & 3, bsel = (lane >> 4) & 1, sB2 = 2 * qp;
    const int brow = (8 * hi + qp) * 512 + pp * 8;
    (void)boffT; (void)brow; (void)sB2; (void)bsel; (void)soB1g; (void)soB1u; (void)soB2;
    u32x4 ra[4]; u32x4 rbh[4]; f32x4 rb[8];
    f32x16 acc[4][2];
#define G1_LOAD(b0, b1, par, kst, ldb) do { \
        const LAS unsigned* rt_ = rowT + (par) * 256 + srow; \
        const int ksoff_ = __builtin_amdgcn_readfirstlane((kst) * 128); \
        _Pragma("unroll") for (int j = 0; j < 4; ++j) ra[j] = bload16(rsA, (int)rt_[64 * j] + sch * 16, ksoff_); \
        const rsrc_t rb0_ = make_rsrc(b0); \
        if (BMODE == BM_BF16T) { const int so_ = __builtin_amdgcn_readfirstlane((kst) * 128), js_ = __builtin_amdgcn_readfirstlane(128 * (ldb)); \
            _Pragma("unroll") for (int j = 0; j < 4; ++j) rbh[j] = bload16(rb0_, voB, so_ + j * js_); } \
        else if (BMODE == BM_F32) { const int so_ = __builtin_amdgcn_readfirstlane((kst) * 256 * (ldb)), js_ = __builtin_amdgcn_readfirstlane(32 * (ldb)); \
            _Pragma("unroll") for (int j = 0; j < 8; ++j) rb[j] = __builtin_bit_cast(f32x4, bload16(rb0_, voB, so_ + j * js_)); } \
        else { const rsrc_t rb1_ = make_rsrc(b1); const int so_ = __builtin_amdgcn_readfirstlane((kst) * 256 * (ldb)), js_ = __builtin_amdgcn_readfirstlane(64 * (ldb)); \
            _Pragma("unroll") for (int j = 0; j < 4; ++j) { rb[j] = __builtin_bit_cast(f32x4, bload16(rb0_, voB, so_ + j * js_)); rb[4 + j] = __builtin_bit_cast(f32x4, bload16(rb1_, voB, so_ + j * js_)); } } \
    } while (0)
#define G1_STORE(buf) do { LAS unsigned char* sa_ = lds + G2_A + (buf) * 32768; LAS unsigned char* sb_ = lds + G2_B + (buf) * 32768; \
        _Pragma("unroll") for (int j = 0; j < 4; ++j) *(LAS u32x4*)(sa_ + soA + j * 8192) = ra[j]; \
        if (BMODE == BM_BF16T) { _Pragma("unroll") for (int j = 0; j < 4; ++j) *(LAS u32x4*)(sb_ + soA + j * 8192) = rbh[j]; } \
        else if (BMODE == BM_F32) { _Pragma("unroll") for (int j = 0; j < 8; ++j) \
            *(LAS u32x2*)(sb_ + soB2 + j * 4096) = (u32x2){cvtpk(rb[j][0], rb[j][1]), cvtpk(rb[j][2], rb[j][3])}; } \
        else { _Pragma("unroll") for (int j = 0; j < 4; ++j) { \
            *(LAS u32x2*)(sb_ + soB1g + j * 8192) = (u32x2){cvtpk(rb[j][0], rb[j][1]), cvtpk(rb[j][2], rb[j][3])}; \
            *(LAS u32x2*)(sb_ + soB1u + j * 8192) = (u32x2){cvtpk(rb[4 + j][0], rb[4 + j][1]), cvtpk(rb[4 + j][2], rb[4 + j][3])}; } } \
    } while (0)
    G2Unit cur, nxt;
    if (!S.next(cur, 0)) return;
    nxt = cur;
    const int voB = BMODE == BM_BF16T ? (srow * cur.ldb + sch * 8) * 2 : BMODE == BM_F32 ? (kk2 * cur.ldb + c4 * 4) * 4 : (kk1 * cur.ldb + n4 * 4) * 4;
    __syncthreads();
    G1_LOAD(cur.b0, cur.b1, cur.par, 0, cur.ldb);
    G1_STORE(0);
    G1_LOAD(cur.b0, cur.b1, cur.par, 1, cur.ldb);
    __syncthreads();
    int gs = 0;
    bool has_cur = true;
    while (has_cur) {
#pragma unroll
        for (int a = 0; a < 4; ++a)
#pragma unroll
            for (int b = 0; b < 2; ++b)
#pragma unroll
                for (int r = 0; r < 16; ++r) acc[a][b][r] = 0.f;
        const int nb = (cur.nrows + 31) >> 5, nmi = (nb - wr + 1) >> 1;
        bool has_next = false;
#define G1_UNIT_LOOP(NMI) do { _Pragma("unroll 1") for (int st = 0; st < cur.nsteps; ++st) { \
            if (st == 1) has_next = S.next(nxt, cur.par ^ 1);     \
            if (st == 0) S.issue(); \
            { const LAS unsigned char* sa_ = lds + G2_A + (gs & 1) * 32768; const LAS unsigned char* sbb_ = lds + G2_B + (gs & 1) * 32768; \
              G2_MFMA_HALF(NMI, BMODE != BM_BF16T, 0); \
              G1_STORE((gs + 1) & 1);                             \
              __builtin_amdgcn_sched_barrier(0); \
              { G2_SEL(2); G1_LOAD((BMODE == BM_F32 ? (const void*)((const float*)sb0_ + sboff_) : sb0_), sb1_, spar_, sk_, ldb_); }     \
              G2_MFMA_HALF(NMI, BMODE != BM_BF16T, 1); } \
            if (st == 0) S.commit(); \
            __syncthreads(); \
            ++gs; \
            if (Epi::HAS_MID) E.mid(acc, cur, st, nmi, wr, r32); } } while (0)
        if (FULL || nmi >= 4) G1_UNIT_LOOP(4); else if (nmi == 3) G1_UNIT_LOOP(3); else if (nmi == 2) G1_UNIT_LOOP(2); else G1_UNIT_LOOP(1);
#undef G1_UNIT_LOOP
        E(acc, cur, nmi, wr, wc, r32, hi);
        cur = nxt; has_cur = has_next;
    }
#undef G1_LOAD
#undef G1_STORE
}

struct MoeSched2 {
    const Params& p; const Ctx& c; int NT; bool isB; int tru, NU, i;
    LAS int* tstart; LAS int* roff; LAS int* cntl; LAS int* rpuT; LAS int* qslot; unsigned* qctr; unsigned pend;
    __device__ __forceinline__ const void* abase() const { return isB ? p.ws + WS_HID : p.ws + WS_H1; }
    __device__ __forceinline__ void issue() { if (c.tid == 0) pend = __hip_atomic_fetch_add(qctr, 1u, __ATOMIC_RELAXED, __HIP_MEMORY_SCOPE_AGENT); }
    __device__ __forceinline__ void commit() { if (c.tid == 0) qslot[0] = (int)(32u + pend); }
    __device__ __forceinline__ MoeSched2(const Params& p_, const Ctx& c_, int NT_, bool isB_) : p(p_), c(c_), NT(NT_), isB(isB_), i(0) {
        tstart = (LAS int*)(c.lds + G2_TAB); roff = tstart + 260; cntl = roff + 260; rpuT = cntl + 260; qslot = rpuT + 260; pend = 0;
        qctr = (unsigned*)(p.ws + WS_CTL + CT_Q) + (isB_ ? 8 * 64 : 0) + (c.vcu >> 5) * 64;
        const unsigned* cnt = (const unsigned*)(p.ws + WS_CTL + CT_CNT);
        __syncthreads();
        if (c.tid < 64) {
            int cv[4], tv[4], rp[4]; int ls = 0, lt = 0;
#pragma unroll
            for (int k = 0; k < 4; ++k) { cv[k] = (int)cnt[c.tid * 4 + k]; tv[k] = (cv[k] + 255) >> 8; rp[k] = tv[k] ? ((((cv[k] + tv[k] - 1) / tv[k]) + 31) & ~31) : 0; ls += cv[k]; lt += tv[k]; }
            int ps = ls, pt = lt;
#pragma unroll
            for (int o = 1; o < 64; o <<= 1) { const int a = __shfl_up(ps, o), b = __shfl_up(pt, o); if (c.tid >= o) { ps += a; pt += b; } }
            int es = ps - ls, et = pt - lt;
#pragma unroll
            for (int k = 0; k < 4; ++k) { cntl[c.tid * 4 + k] = cv[k]; rpuT[c.tid * 4 + k] = rp[k]; roff[c.tid * 4 + k] = es; tstart[c.tid * 4 + k] = et; es += cv[k]; et += tv[k]; }
            if (c.tid == 63) { roff[256] = es; tstart[256] = et; }
        }
        __syncthreads();
        tru = tstart[256]; NU = (tru + 64) * NT;
    }
    __device__ __forceinline__ bool next(G2Unit& U, int par) {
        int tid_ = c.tid; asm volatile("" : "+v"(tid_));
        const int NUx = (NU + 7) >> 3, xg = c.vcu >> 5, pos = (i == 0) ? (c.vcu & 31) : qslot[0]; ++i;
        const int idx = xg * NUx + pos;
        if (pos >= NUx || idx >= NU) return false;
        const int g = idx / NT, nt = idx - g * NT;
        int e, r0, nrows; size_t hbase, lbase = 0;
        if (g < tru) { e = moe_find_l(tstart, g); const int ui = g - tstart[e], rpu = rpuT[e]; r0 = ui * rpu; nrows = min(rpu, cntl[e] - r0); hbase = (size_t)roff[e] + r0; lbase = (size_t)e * CAP + r0; }
        else { e = NEXP; r0 = (g - tru) * 256; nrows = 256; hbase = (size_t)NTOK * 8 + r0; }
        U.nrows = nrows; U.par = par; U.i0 = (int)hbase; U.i1 = nt; U.i2 = 0; U.kshift = 30; U.bsub = 0;
        const unsigned* laid = (const unsigned*)(p.ws + WS_LAID); const float* lgate = (const float*)(p.ws + WS_LGATE);
        LAS unsigned* rowT = (LAS unsigned*)(c.lds + G2_MISC) + par * 256;
        if (!isB) {
            U.b0 = (e < NEXP ? p.w_gate + (size_t)e * D * DEXP : p.ws_gate) + nt * 128; U.b1 = (e < NEXP ? p.w_up + (size_t)e * D * DEXP : p.ws_up) + nt * 128;
            U.ldb = DEXP; U.nsteps = D / 64;
            if (tid_ < 256) {
                const int rr = min(tid_, nrows - 1);
                const int tok = e < NEXP ? (int)(laid[lbase + rr] >> 3) : r0 + rr;
                rowT[tid_] = (unsigned)tok * (D * 2);
            }
        } else {
            U.b0 = (e < NEXP ? p.w_down + (size_t)e * DEXP * D : p.ws_down) + nt * 256; U.b1 = nullptr;
            U.ldb = D; U.nsteps = DEXP / 64;
            if (tid_ < 256) {
                const int rr = min(tid_, nrows - 1);
                rowT[tid_] = (unsigned)(hbase + rr) * (DEXP * 2);
                int yr; float gt;
                if (e < NEXP) { const unsigned aid = laid[lbase + rr]; yr = (int)((aid >> 3) * 9 + (aid & 7)); gt = lgate[lbase + rr]; }
                else { yr = (r0 + rr) * 9 + 8; gt = 1.f; }
                ((LAS float*)(c.lds + G2_GATE))[par * 256 + tid_] = gt; ((LAS int*)(c.lds + G2_YROW))[par * 256 + tid_] = yr;
            }
        }
        return true;
    }
};
struct EpiMoeA {
    static constexpr bool HAS_MID = false, HAS_SUB = false;
    bf16_t* HID;
    __device__ __forceinline__ void mid(f32x16 (&)[4][2], const G2Unit&, int, int, int, int) const {}
    __device__ __forceinline__ void operator()(f32x16 (&acc)[4][2], const G2Unit& U, int nmi, int wr, int wc, int r32, int hi) const {
        asm volatile("" : "+v"(r32), "+v"(hi));
#pragma unroll
        for (int mi = 0; mi < 4; ++mi) {
            if (mi < nmi) {
                const int r = 64 * mi + 32 * wr + r32;
#pragma unroll
                for (int ni = 0; ni < 2; ++ni) {
                    float hv[8];
#pragma unroll
                    for (int q = 0; q < 8; ++q) { const float gt = acc[mi][ni][q], up = acc[mi][ni][q + 8]; hv[q] = gt / (1.f + __expf(-gt)) * up; }
                    unsigned ax = cvtpk(hv[0], hv[1]), ay = cvtpk(hv[2], hv[3]), bx = cvtpk(hv[4], hv[5]), by = cvtpk(hv[6], hv[7]);
                    { auto r_ = __builtin_amdgcn_permlane32_swap(ax, bx, false, false); ax = r_[0]; bx = r_[1]; }
                    { auto r_ = __builtin_amdgcn_permlane32_swap(ay, by, false, false); ay = r_[0]; by = r_[1]; }
                    if (r < U.nrows) *(u32x4*)(HID + ((size_t)U.i0 + r) * DEXP + U.i1 * 128 + (2 * wc + ni) * 16 + (hi ? 8 : 0)) = (u32x4){ax, ay, bx, by};
                }
            }
        }
    }
};
struct EpiMoeB {
    static constexpr bool HAS_MID = false, HAS_SUB = false;
    bf16_t* Y; const LAS float* gateT; const LAS int* yrowT;
    __device__ __forceinline__ void mid(f32x16 (&)[4][2], const G2Unit&, int, int, int, int) const {}
    __device__ __forceinline__ void operator()(f32x16 (&acc)[4][2], const G2Unit& U, int nmi, int wr, int wc, int r32, int hi) const {
        asm volatile("" : "+v"(r32), "+v"(hi));
#pragma unroll
        for (int mi = 0; mi < 4; ++mi) {
            if (mi < nmi) {
                const int r = 64 * mi + 32 * wr + r32;
                const float gt = gateT[U.par * 256 + r]; const size_t yrow = (size_t)yrowT[U.par * 256 + r];
#pragma unroll
                for (int ni = 0; ni < 2; ++ni) {
                    f32x16 v_ = acc[mi][ni];
#pragma unroll
                    for (int q = 0; q < 16; ++q) v_[q] *= gt;
                    store_blk32_bf16(Y + yrow * D + U.i1 * 256 + wc * 64 + ni * 32, v_, hi, r < U.nrows);
                }
            }
        }
    }
};
__device__ __forceinline__ void phase_moeA(const Params& p, const Ctx& c) {
    MoeSched2 S(p, c, 2, false);
    EpiMoeA E{(bf16_t*)(p.ws + WS_HID)};
    gemm256_stream<BM_F32_GU, false>(c, S, E);
}
__device__ __forceinline__ void phase_moeB(const Params& p, const Ctx& c) {
    MoeSched2 S(p, c, 4, true);
    EpiMoeB E{(bf16_t*)(p.ws + WS_Y), (const LAS float*)(c.lds + G2_GATE), (const LAS int*)(c.lds + G2_YROW)};
    gemm256_stream<BM_F32, false>(c, S, E);
}


struct Sched1 {
    const Params& p; const Ctx& c; int i;
    __device__ __forceinline__ const void* abase() const { return p.ws + WS_H0; }
    __device__ __forceinline__ void issue() {}
    __device__ __forceinline__ void commit() {}
    static constexpr int MT = 256, NMT = (NROWS + MT - 1) / MT, NU = NMT * 9;
    __device__ __forceinline__ bool next(G2Unit& U, int par) {
        const int idx = c.vcu + i * c.G; ++i;
        if (idx >= NU) return false;
        const int mt = idx / 9, nt = idx - mt * 9, row0 = mt * MT, nrows = min(MT, NROWS - row0);
        U.b0 = (const bf16_t*)(p.ws + WS_WIN) + (size_t)nt * 256 * D; U.b1 = nullptr; U.ldb = D; U.nsteps = D / 64; U.nrows = nrows; U.par = par; U.i0 = row0; U.i1 = nt; U.i2 = 0; U.kshift = 30; U.bsub = 0;
        if (c.tid < 256) ((LAS unsigned*)(c.lds + G2_MISC))[par * 256 + c.tid] = (unsigned)(row0 + min(c.tid, nrows - 1)) * (D * 2);
        return true;
    }
};
struct Epi1 {
    static constexpr bool HAS_MID = false, HAS_SUB = false;
    bf16_t* Z; float* psq;
    __device__ __forceinline__ void mid(f32x16 (&)[4][2], const G2Unit&, int, int, int, int) const {}
    __device__ __forceinline__ void operator()(f32x16 (&acc)[4][2], const G2Unit& U, int nmi, int wr, int wc, int r32, int hi) const {
        asm volatile("" : "+v"(r32), "+v"(hi));
        const int s0 = U.i1 * 256 + wc * 64;
#pragma unroll
        for (int mi = 0; mi < 4; ++mi) {
            if (mi < nmi) {
                const int r = 64 * mi + 32 * wr + r32, row = U.i0 + min(r, U.nrows - 1);
                float ss = 0.f;
#pragma unroll
                for (int ni = 0; ni < 2; ++ni) {
                    store_blk32_bf16(Z + (size_t)row * ZC + s0 + ni * 32, acc[mi][ni], hi, r < U.nrows);
#pragma unroll
                    for (int q = 0; q < 16; ++q) ss += acc[mi][ni][q] * acc[mi][ni][q];
                }
                if (s0 < ZKPE) {
                    ss += __shfl_xor(ss, 32);
                    if (hi == 0 && r < U.nrows) psq[(size_t)row * 16 + (s0 >> 6)] = ss;
                }
            }
        }
    }
};
__device__ __forceinline__ void phase1_g2(const Params& p, const Ctx& c) {
    Sched1 S{p, c, 0};
    Epi1 E{(bf16_t*)(p.ws + WS_Z), (float*)(p.ws + WS_PSQ)};
    gemm256_stream<BM_BF16T, true>(c, S, E);
}

struct Sched4 {
    const Params& p; const Ctx& c; int i;
    __device__ __forceinline__ const void* abase() const { return p.ws + WS_ATT; }
    __device__ __forceinline__ void issue() {}
    __device__ __forceinline__ void commit() {}
    __device__ __forceinline__ bool next(G2Unit& U, int par) {
        const int idx = c.vcu + i * c.G; ++i;
        if (idx >= 256) return false;
        const int mt = idx >> 2, nt = idx & 3, row0 = mt * 256;
        U.b0 = (const bf16_t*)(p.ws + WS_WO) + (size_t)nt * 256 * D; U.b1 = nullptr; U.ldb = D; U.nsteps = D / 64; U.nrows = 256; U.par = par; U.i0 = row0; U.i1 = nt; U.i2 = 0; U.kshift = 30; U.bsub = 0;
        if (c.tid < 256) {
            const int row = row0 + c.tid;
            ((LAS unsigned*)(c.lds + G2_MISC))[par * 256 + c.tid] = (unsigned)row * (D * 2);
            const float* patt = (const float*)(p.ws + WS_PATT);
            const f32x4 pa = *(const f32x4*)(patt + (size_t)row * 8), pb = *(const f32x4*)(patt + (size_t)row * 8 + 4);
            const float ra = rsqrtf((((pa[0] + pa[1]) + (pa[2] + pa[3])) + ((pb[0] + pb[1]) + (pb[2] + pb[3]))) * (1.f / 512) + 1e-6f);
            const float rc = rsqrtf(((const float*)(p.ws + WS_SSQC))[row] * (1.f / 512) + 1e-6f);
            ((LAS float*)(c.lds + G2_GATE))[par * 256 + c.tid] = ra / rc; ((LAS float*)(c.lds + G2_YROW))[par * 256 + c.tid] = rc;
        }
        return true;
    }
};
struct Epi4 {
    static constexpr bool HAS_MID = true, HAS_SUB = false;
    const LAS float* fT; const LAS float* rcT; const bf16_t* H0; bf16_t* Y1; float* pst;
    __device__ __forceinline__ void mid(f32x16 (&acc)[4][2], const G2Unit& U, int st, int nmi, int wr, int r32) const {
        if (st != 7) return;
#pragma unroll
        for (int mi = 0; mi < 4; ++mi) {
            const float f = fT[U.par * 256 + 64 * mi + 32 * wr + r32];
#pragma unroll
            for (int ni = 0; ni < 2; ++ni)
#pragma unroll
                for (int q = 0; q < 16; ++q) acc[mi][ni][q] *= f;
        }
    }
    __device__ __forceinline__ void operator()(f32x16 (&acc)[4][2], const G2Unit& U, int nmi, int wr, int wc, int r32, int hi) const {
        asm volatile("" : "+v"(r32), "+v"(hi));
        const int s0 = U.i1 * 256 + wc * 64;
#pragma unroll
        for (int mi = 0; mi < 4; ++mi) {
            const int r = 64 * mi + 32 * wr + r32, row = U.i0 + r;
            const float rc = rcT[U.par * 256 + r];
            float s = 0.f, ss = 0.f;
#pragma unroll
            for (int ni = 0; ni < 2; ++ni) {
                f32x16 v;
#pragma unroll
                for (int g = 0; g < 4; ++g) {
                    const u32x2 hw = *(const u32x2*)(H0 + (size_t)row * D + s0 + ni * 32 + 8 * g + 4 * hi);
                    v[4 * g + 0] = acc[mi][ni][4 * g + 0] * rc + ALPHA * bflo(hw.x); v[4 * g + 1] = acc[mi][ni][4 * g + 1] * rc + ALPHA * bfhi(hw.x);
                    v[4 * g + 2] = acc[mi][ni][4 * g + 2] * rc + ALPHA * bflo(hw.y); v[4 * g + 3] = acc[mi][ni][4 * g + 3] * rc + ALPHA * bfhi(hw.y);
                }
#pragma unroll
                for (int q = 0; q < 16; ++q) { s += v[q]; ss += v[q] * v[q]; }
                store_blk32_bf16(Y1 + (size_t)row * D + s0 + ni * 32, v, hi);
            }
            s += __shfl_xor(s, 32); ss += __shfl_xor(ss, 32);
            if (hi == 0) { float* q = pst + ((size_t)row * 16 + U.i1 * 4 + wc) * 2; q[0] = s; q[1] = ss; }
        }
    }
};
__device__ __forceinline__ void phase4_g2(const Params& p, const Ctx& c) {
    Sched4 S{p, c, 0};
    Epi4 E{(const LAS float*)(c.lds + G2_GATE), (const LAS float*)(c.lds + G2_YROW), (const bf16_t*)(p.ws + WS_H0), (bf16_t*)(p.ws + WS_Y1), (float*)(p.ws + WS_PST)};
    gemm256_stream<BM_BF16T, true>(c, S, E);
}


struct Sched2 {
    const Params& p; const Ctx& c; int i; bool kv;
    __device__ __forceinline__ const void* abase() const { return p.ws + WS_Z; }
    __device__ __forceinline__ void issue() {}
    __device__ __forceinline__ void commit() {}
    __device__ __forceinline__ bool next(G2Unit& U, int par) {
        const int NT = kv ? 4 : 3, NU = kv ? 65 * 4 : 64 * 3;
        const int idx = (kv ? ((c.vcu + 64) & 255) : c.vcu) + i * 256; ++i;
        if (idx >= NU) return false;
        const int mt = idx / NT, nt = idx - mt * NT, row0 = mt * 256, nrows = min(256, (kv ? NROWS : NTOK) - row0);
        const int K = kv ? KVLORA : QLORA;
        U.b0 = (const bf16_t*)(p.ws + (kv ? WS_WUKV : WS_WUQ)) + (size_t)nt * 256 * K; U.b1 = nullptr; U.ldb = K; U.nsteps = K / 64; U.nrows = nrows; U.par = par;
        U.i0 = row0; U.i1 = nt; U.i2 = 0; U.kshift = 30; U.bsub = 0;
        if (c.tid < 256) ((LAS unsigned*)(c.lds + G2_MISC))[par * 256 + c.tid] = (unsigned)(row0 + min(c.tid, nrows - 1)) * (ZC * 2) + (kv ? ZKV : ZQ) * 2;
        return true;
    }
};
struct Epi2q {
    static constexpr bool HAS_MID = false, HAS_SUB = false;
    const float* psq; const float* rope; bf16_t* Q;
    __device__ __forceinline__ void mid(f32x16 (&)[4][2], const G2Unit&, int, int, int, int) const {}
    __device__ __forceinline__ void operator()(f32x16 (&acc)[4][2], const G2Unit& U, int nmi, int wr, int wc, int r32, int hi) const {
        asm volatile("" : "+v"(r32), "+v"(hi));
#pragma unroll
        for (int mi = 0; mi < 4; ++mi) {
            const int row = U.i0 + 64 * mi + 32 * wr + r32;
            const f32x4 pa = *(const f32x4*)(psq + (size_t)row * 16), pb = *(const f32x4*)(psq + (size_t)row * 16 + 4);
            const float rq = rsqrtf((((pa[0] + pa[1]) + (pa[2] + pa[3])) + (pb[0] + pb[1])) * (1.f / QLORA) + 1e-6f) * QSCALE;
            const int pos = NMETA + (row & (SEQ - 1));
#pragma unroll
            for (int ni = 0; ni < 2; ++ni) {
                const int c0 = U.i1 * 256 + wc * 64 + ni * 32;
                f32x16 v = acc[mi][ni];
#pragma unroll
                for (int q = 0; q < 16; ++q) v[q] *= rq;
                if ((c0 % 96) == 64) {
#pragma unroll
                    for (int g = 0; g < 2; ++g) {
                        const float* rp = rope + ((size_t)pos * 16 + 8 * g + 4 * hi) * 2;
                        const f32x4 cs0 = *(const f32x4*)rp, cs1 = *(const f32x4*)(rp + 4);
                        const float co[4] = {cs0[0], cs0[2], cs1[0], cs1[2]}, si[4] = {cs0[1], cs0[3], cs1[1], cs1[3]};
#pragma unroll
                        for (int j = 0; j < 4; ++j) { const float x1 = v[4 * g + j], x2 = v[4 * g + j + 8]; v[4 * g + j] = x1 * co[j] - x2 * si[j]; v[4 * g + j + 8] = x2 * co[j] + x1 * si[j]; }
                    }
                }
                store_blk32_bf16(Q + (size_t)row * 768 + c0, v, hi);
            }
        }
    }
};
struct Epi2kv {
    static constexpr bool HAS_MID = false, HAS_SUB = false;
    const float* psq; bf16_t* Kb; bf16_t* Vb;
    __device__ __forceinline__ void mid(f32x16 (&)[4][2], const G2Unit&, int, int, int, int) const {}
    __device__ __forceinline__ void operator()(f32x16 (&acc)[4][2], const G2Unit& U, int nmi, int wr, int wc, int r32, int hi) const {
        asm volatile("" : "+v"(r32), "+v"(hi));
        const int s0 = U.i1 * 256 + wc * 64, h = s0 >> 7; const bool isv = (s0 & 64) != 0;
#pragma unroll
        for (int mi = 0; mi < 4; ++mi) {
            if (mi < nmi) {
                const int r = 64 * mi + 32 * wr + r32, row = U.i0 + min(r, U.nrows - 1);
                const f32x4 pa = *(const f32x4*)(psq + (size_t)row * 16 + 4), pb = *(const f32x4*)(psq + (size_t)row * 16 + 8);
                const float rk = rsqrtf(((pa[2] + pa[3]) + (pb[0] + pb[1])) * (1.f / KVLORA) + 1e-6f);
                const bool meta = U.i0 >= NTOK;
                const int ncopy = meta ? NBATCH : 1;
                const int pos = meta ? row - NTOK : NMETA + (row & (SEQ - 1));
#pragma unroll
                for (int ni = 0; ni < 2; ++ni) {
                    f32x16 v = acc[mi][ni];
#pragma unroll
                    for (int q = 0; q < 16; ++q) v[q] *= rk;
                    for (int bb = 0; bb < ncopy; ++bb) {
                        const size_t prow = (size_t)(meta ? bb : (row >> 11)) * LPOS + pos;
                        bf16_t* dst = isv ? Vb + prow * 512 + h * 64 + ni * 32 : Kb + prow * 768 + h * 96 + ni * 32;
                        store_blk32_bf16(dst, v, hi, r < U.nrows);
                    }
                }
            }
        }
    }
};

__device__ __forceinline__ void phase2_gemms(const Params& p, const Ctx& c) {
    { Sched2 S{p, c, 0, false}; Epi2q E{(const float*)(p.ws + WS_PSQ), (const float*)(p.ws + WS_ROPE), (bf16_t*)(p.ws + WS_Q)}; gemm256_stream<BM_BF16T, true>(c, S, E); }
    __syncthreads();
    { Sched2 S{p, c, 0, true}; Epi2kv E{(const float*)(p.ws + WS_PSQ), (bf16_t*)(p.ws + WS_K), (bf16_t*)(p.ws + WS_V)}; gemm256_stream<BM_BF16T, false>(c, S, E); }
}

__device__ __forceinline__ void phase8(const Params& p, const Ctx& c) {
    unsigned char* ws = p.ws;
    const bf16_t* H1 = (const bf16_t*)(ws + WS_H1); const bf16_t* Y = (const bf16_t*)(ws + WS_Y);
    const int gw = c.vcu * NWAVES + c.wave, NGW = c.G * NWAVES, lane = c.lane;
    for (int t = gw; t < NTOK; t += NGW) {
        float v[16];
#pragma unroll
        for (int j = 0; j < 2; ++j) {
            const int col = (lane + 64 * j) * 8;
            const u32x4 w = *(const u32x4*)(H1 + (size_t)t * D + col);
#pragma unroll
            for (int e = 0; e < 4; ++e) { v[j * 8 + 2 * e] = ALPHA * bflo(w[e]); v[j * 8 + 2 * e + 1] = ALPHA * bfhi(w[e]); }
#pragma unroll
            for (int k = 0; k < 9; ++k) {
                const u32x4 y = *(const u32x4*)(Y + ((size_t)t * 9 + k) * D + col);
#pragma unroll
                for (int e = 0; e < 4; ++e) { v[j * 8 + 2 * e] += bflo(y[e]); v[j * 8 + 2 * e + 1] += bfhi(y[e]); }
            }
        }
        float s = 0.f;
#pragma unroll
        for (int e = 0; e < 16; ++e) s += v[e];
        const float mean = wave_sum(s) * (1.f / D);
        float ss = 0.f;
#pragma unroll
        for (int e = 0; e < 16; ++e) { v[e] -= mean; ss += v[e] * v[e]; }
        const float rstd = rsqrtf(wave_sum(ss) * (1.f / D) + 1e-5f);
#pragma unroll
        for (int j = 0; j < 2; ++j) {
            const int col = (lane + 64 * j) * 8;
            f32x4 o0, o1;
#pragma unroll
            for (int e = 0; e < 4; ++e) { o0[e] = v[j * 8 + e] * rstd * p.ln2_g[col + e] + p.ln2_b[col + e]; o1[e] = v[j * 8 + 4 + e] * rstd * p.ln2_g[col + 4 + e] + p.ln2_b[col + 4 + e]; }
            *(f32x4*)(p.out + (size_t)t * D + col) = o0; *(f32x4*)(p.out + (size_t)t * D + col + 4) = o1;
        }
    }
}


#define XB_TMO      128
#define XB_XCNT(j)  (256  + 64 * (j))
#define XB_XSUB(j)  (1280 + 64 * (j))
#define XB_XGEN(j)  (2304 + 64 * (j))
#define XB_TOP      3328
#define XB_TOPGEN   3392
#define XB_SPIN_CAP (1u << 22)
__device__ __forceinline__ unsigned xb_ld(unsigned* p)              { return __hip_atomic_load(p, __ATOMIC_RELAXED, __HIP_MEMORY_SCOPE_AGENT); }
__device__ __forceinline__ unsigned xb_add(unsigned* p, unsigned v) { return __hip_atomic_fetch_add(p, v, __ATOMIC_RELAXED, __HIP_MEMORY_SCOPE_AGENT); }
__device__ __forceinline__ unsigned xb_xcc_id() { return (unsigned)__builtin_amdgcn_s_getreg((3 << 11) | 20) & 0xFu; }
#define XB_SPIN(cond, bar) do { unsigned _sp = 0; while (cond) { __builtin_amdgcn_s_sleep(1); \
    if ((++_sp & 255u) == 0u) { if (xb_ld(&(bar)[XB_TMO])) break; if (_sp > XB_SPIN_CAP) { atomicAdd(&(bar)[XB_TMO], 1u); break; } } } } while (0)
struct XcdBarrier { unsigned* bar; unsigned x; volatile LAS unsigned* st; };
__device__ __forceinline__ XcdBarrier xcd_barrier_post(unsigned* bar, volatile LAS unsigned* st) {
    XcdBarrier b; b.bar = bar; b.x = xb_xcc_id(); b.st = st;
    if (threadIdx.x == 0) (void)xb_add(&bar[XB_XCNT(b.x)], 1u);
    return b;
}
__device__ __forceinline__ void xcd_barrier_complete(unsigned* bar, unsigned x, unsigned& nloc, unsigned& nx) {
    const unsigned G = gridDim.x * gridDim.y * gridDim.z;
    unsigned sum, cnt, mine, sp = 0u;
    for (;;) {
        sum = 0u; cnt = 0u; mine = 0u;
#pragma unroll
        for (unsigned j = 0; j < 16; ++j) { const unsigned c = xb_ld(&bar[XB_XCNT(j)]); sum += c; cnt += (c > 0u) ? 1u : 0u; mine = (j == x) ? c : mine; }
        if (sum == G) break;
        __builtin_amdgcn_s_sleep(1);
        if ((++sp & 255u) == 0u) { if (xb_ld(&bar[XB_TMO])) break; if (sp > XB_SPIN_CAP) { atomicAdd(&bar[XB_TMO], 1u); break; } }
    }
    nloc = mine > 0u ? mine : 1u; nx = cnt > 0u ? cnt : 1u;
}
__device__ __forceinline__ void xcd_barrier(const XcdBarrier& b) {
    asm volatile("s_waitcnt vmcnt(0)" ::: "memory");
    __syncthreads();
    if (threadIdx.x == 0) {
        unsigned* bar = b.bar;
        __builtin_amdgcn_s_waitcnt(0);
        unsigned nloc = b.st[0], nx = b.st[1];
        if (nloc == 0u) { xcd_barrier_complete(bar, b.x, nloc, nx); b.st[0] = nloc; b.st[1] = nx; }
        const unsigned old = xb_add(&bar[XB_XSUB(b.x)], 1u);
        const unsigned gen = old / nloc;
        if (old + 1u == (gen + 1u) * nloc) {
            __builtin_amdgcn_fence(__ATOMIC_RELEASE, "agent");
            asm volatile("s_waitcnt vmcnt(0)" ::: "memory");
            const unsigned og = xb_add(&bar[XB_TOP], 1u);
            const unsigned tg = og / nx;
            if (og + 1u == (tg + 1u) * nx) xb_add(&bar[XB_TOPGEN], 1u);
            else XB_SPIN(xb_ld(&bar[XB_TOPGEN]) == tg, bar);
            __builtin_amdgcn_fence(__ATOMIC_ACQUIRE, "agent");
            xb_add(&bar[XB_XGEN(b.x)], 1u);
            asm volatile("s_waitcnt vmcnt(0)" ::: "memory");
        } else {
            XB_SPIN(xb_ld(&bar[XB_XGEN(b.x)]) == gen, bar);
            __builtin_amdgcn_fence(__ATOMIC_ACQUIRE, "agent");
            asm volatile("s_waitcnt vmcnt(0)" ::: "memory");
        }
    }
    __syncthreads();
}

template <int PH> __device__ __forceinline__ void run_phase(const Params& p, const Ctx& c0) {
    Ctx c = c0;
    { int l; asm volatile("v_mbcnt_lo_u32_b32 %0, -1, 0\n\tv_mbcnt_hi_u32_b32 %0, -1, %0" : "=v"(l)); c.lane = l; c.tid = c0.wave * 64 + l; c.wave = c0.wave; }
    if (PH == 0) phase0(p, c);
    if (PH == 1) phase1_g2(p, c);
    if (PH == 2) phase2(p, c);
#if NAIVE_ATTN
    if (PH == 3) phase3_naive(p, c);
#else
    if (PH == 3) phase3(p, c);
#endif
    if (PH == 4) phase4_g2(p, c);
    if (PH == 5) phase5_fused(p, c);
    if (PH == 8) phase_moeA(p, c);
    if (PH == 9) phase_moeB(p, c);
    if (PH == 10) phase8(p, c);
}
constexpr int NPHASES = 11;
__device__ __forceinline__ Ctx make_ctx(unsigned char* lds) {
    Ctx c; c.lds = (LAS unsigned char*)lds; c.tid = threadIdx.x; c.lane = c.tid & 63; c.wave = __builtin_amdgcn_readfirstlane(c.tid >> 6);
    c.G = gridDim.x; const int bx = blockIdx.x; c.vcu = (c.G % 8 == 0) ? (bx % 8) * (c.G / 8) + bx / 8 : bx;
    return c;
}
template <int PH> __global__ void __launch_bounds__(NTHREADS, 2) phase_kernel(Params p) {
    extern __shared__ __attribute__((aligned(16))) unsigned char lds[];
    const Ctx c = make_ctx(lds);
    run_phase<PH>(p, c);
}
#if MEGA
__global__ void __launch_bounds__(NTHREADS, 2) mega_kernel(Params p) {
    extern __shared__ __attribute__((aligned(16))) unsigned char lds[];
    Ctx c = make_ctx(lds);
    cg::grid_group grid = cg::this_grid();
    volatile LAS unsigned* bst = (volatile LAS unsigned*)(c.lds + LDS_BYTES - 64);
    if (c.tid < 4) bst[c.tid] = 0u;
    __syncthreads();
    XcdBarrier bar; bar.bar = (unsigned*)(p.ws + WS_CTL + CT_BAR); bar.x = xb_xcc_id(); bar.st = bst;
    if (c.tid == 0) bst[2] = xb_add(&bar.bar[XB_XCNT(bar.x)], 1u);
    if (p.out == nullptr) grid.sync();
    run_phase<0>(p, c); xcd_barrier(bar);
    if (c.tid == 0) {
        unsigned pre = 0;
        for (unsigned j = 0; j < 16; ++j) { const unsigned n = xb_ld(&bar.bar[XB_XCNT(j)]); if (j < bar.x) pre += n; }
        bst[3] = pre + bst[2];
    }
    __syncthreads();
    c.vcu = (int)bst[3];
    run_phase<1>(p, c); xcd_barrier(bar);
    run_phase<2>(p, c); xcd_barrier(bar);
    run_phase<3>(p, c); xcd_barrier(bar);
    run_phase<4>(p, c); xcd_barrier(bar);
    run_phase<5>(p, c); xcd_barrier(bar);
    run_phase<8>(p, c); xcd_barrier(bar);
    run_phase<9>(p, c); xcd_barrier(bar);
    run_phase<10>(p, c);
}

#endif
template <int PH> static void launch_phase(const Params& p, int grid, hipStream_t stream) {
    static bool attr = false;
    if (!attr) { (void)hipFuncSetAttribute((const void*)phase_kernel<PH>, hipFuncAttributeMaxDynamicSharedMemorySize, LDS_BYTES); attr = true; }
    hipLaunchKernelGGL(phase_kernel<PH>, dim3(grid), dim3(NTHREADS), LDS_BYTES, stream, p);
}

extern "C" void kernel_launch(void* const* d_in, const int* in_sizes, int n_in, void* d_out, int out_size, void* d_ws, size_t ws_size, hipStream_t stream) {
    if (n_in != 25 || ws_size < WS_END) { fprintf(stderr, "kernel_launch: unexpected n_in %d or ws_size %zu (need %zu)\n", n_in, ws_size, (size_t)WS_END); return; }
    Params p{};
    const float** pp = (const float**)&p;
    for (int i = 0; i < 25; ++i) pp[i] = (const float*)d_in[i];
    p.out = (float*)d_out; p.ws = (unsigned char*)d_ws;
    (void)hipMemsetAsync((char*)d_ws + WS_CTL, 0, CTL_BYTES, stream);
#if MEGA
    static int grid = 0;
    if (!grid) {
        int dev = 0, cus = 0, per_cu = 0;
        (void)hipGetDevice(&dev);
        (void)hipDeviceGetAttribute(&cus, hipDeviceAttributeMultiprocessorCount, dev);
        (void)hipFuncSetAttribute((const void*)mega_kernel, hipFuncAttributeMaxDynamicSharedMemorySize, LDS_BYTES);
        (void)hipOccupancyMaxActiveBlocksPerMultiprocessor(&per_cu, (const void*)mega_kernel, NTHREADS, LDS_BYTES);
        if (per_cu < 1) per_cu = 1;
        grid = cus;
        (void)per_cu;
    }
    void* args[] = {&p};
    hipError_t e = hipLaunchCooperativeKernel((const void*)mega_kernel, dim3(grid), dim3(NTHREADS), args, LDS_BYTES, stream);
    if (e != hipSuccess) fprintf(stderr, "cooperative launch failed: %s (grid %d)\n", hipGetErrorString(e), grid);
#else
    const int grid = 256;
#define LP(k) do { launch_phase<k>(p, grid, stream); if (REPEAT_PH == k) launch_phase<k>(p, grid, stream); } while (0)
    LP(0); LP(1); LP(2); LP(3); LP(4); LP(5); LP(8); LP(9); LP(10);
#undef LP
#endif
}
```

```cpp
#include <hip/hip_runtime.h>
#include <hip/hip_cooperative_groups.h>
#include <cstdint>
#include <cstdio>
namespace cg = cooperative_groups;

#ifndef NAIVE_GEMM
#define NAIVE_GEMM 0
#endif
#ifndef NAIVE_ATTN
#define NAIVE_ATTN 0
#endif
#ifndef REPEAT_PH
#define REPEAT_PH -1
#endif
#ifndef MEGA
#define MEGA 1
#endif

#define LAS __attribute__((address_space(3)))
#define GAS __attribute__((address_space(1)))
typedef unsigned short bf16_t;
typedef short bf16x8 __attribute__((ext_vector_type(8)));
typedef float f32x4 __attribute__((ext_vector_type(4)));
typedef unsigned u32x4 __attribute__((ext_vector_type(4)));
typedef unsigned u32x2 __attribute__((ext_vector_type(2)));

constexpr int D = 1024, NBATCH = 8, SEQ = 2048, NMETA = 16, LPOS = SEQ + NMETA;
constexpr int NTOK = NBATCH * SEQ;
constexpr int NROWS = NTOK + NMETA;
constexpr int NROWSP = 16512;
constexpr int NH = 8, DQK = 96, DNOPE = 64, DROPE = 32, DV = 64;
constexpr int QLORA = 384, KVLORA = 256;
constexpr int ZC = 2304;
constexpr int ZQ = 0, ZKV = 384, ZKPE = 640, ZB = 704, ZCG = 1216, ZU = 1728;
constexpr int DIN = 2208;
constexpr int NEXP = 256, DEXP = 256, TOPK = 8, CAP = 16384;
constexpr float ALPHA = 1.189207115002721f;
constexpr float QSCALE = 0.10206207261596577f * 1.4426950408889634f;

constexpr int NTHREADS = 512, NWAVES = 8;
constexpr int LDS_BYTES = 147456;
constexpr int STAGE_BYTES = 49152;
constexpr int LDS_MISC = 2 * STAGE_BYTES;

constexpr size_t MiB = 1u << 20;
constexpr size_t WS_CTL = 0;
constexpr size_t CTL_BYTES = 1 * MiB;
constexpr size_t CT_CNT = 0;
constexpr size_t CT_Q = 1024;
constexpr size_t CT_BAR = 8192;
constexpr size_t CT_SSQ_Q = 32768;
constexpr size_t CT_SSQ_KV = CT_SSQ_Q + 66048;
constexpr size_t CT_SSQ_ATT = CT_SSQ_KV + 66048;
constexpr size_t CT_STATS1 = CT_SSQ_ATT + 65536;
static_assert(CT_STATS1 + 131072 <= CTL_BYTES, "ctl");
constexpr size_t WS_WIN = 1 * MiB;
constexpr size_t WS_WUQ = 6 * MiB;
constexpr size_t WS_WUKV = 7 * MiB;
constexpr size_t WS_WO = 8 * MiB;
constexpr size_t WS_WR = 10 * MiB;
constexpr size_t WS_WSGU = 11 * MiB;
constexpr size_t WS_WSD = 12 * MiB;
constexpr size_t WS_ROPE = 13 * MiB;
constexpr size_t WS_WGU = 14 * MiB;
constexpr size_t WS_WD = 270 * MiB;
constexpr size_t WS_H1 = 398 * MiB;
constexpr size_t WS_HID = 430 * MiB;
constexpr size_t WS_LAID = 502 * MiB;
constexpr size_t WS_LGATE = 518 * MiB;
constexpr size_t WS_Y = 534 * MiB;
constexpr size_t WS_Z = WS_Y;
constexpr size_t WS_H0 = WS_Y + 73 * MiB;
constexpr size_t WS_Q = WS_Y + 106 * MiB;
constexpr size_t WS_K = WS_Y + 130 * MiB;
constexpr size_t WS_V = WS_Y + 155 * MiB;
constexpr size_t WS_ATT = WS_Y + 172 * MiB;
constexpr size_t WS_CONV = WS_Y + 188 * MiB;
constexpr size_t WS_SSQC = WS_Y + 204 * MiB;
constexpr size_t WS_Y1 = WS_Y + 205 * MiB;
constexpr size_t WS_LOG = WS_Y + 237 * MiB;
constexpr size_t WS_PSQ = WS_Y + 253 * MiB;
constexpr size_t WS_PATT = WS_Y + 254 * MiB;
constexpr size_t WS_PST = WS_Y + 255 * MiB;
constexpr size_t WS_END = WS_Y + 288 * MiB;

struct Params {
    const float *x, *meta, *emb_g, *emb_b, *w_in, *q_norm, *w_uq, *kv_norm, *w_ukv, *conv_w, *attn_on, *conv_on, *w_o,
        *ln1_g, *ln1_b, *w_router, *router_bias, *w_gate, *w_up, *w_down, *ws_gate, *ws_up, *ws_down, *ln2_g, *ln2_b;
    float* out;
    unsigned char* ws;
};

__device__ __forceinline__ unsigned f2bf(float f) { unsigned u = __float_as_uint(f); return (u + 0x7fffu + ((u >> 16) & 1u)) >> 16; }
typedef float f32x2 __attribute__((ext_vector_type(2)));
typedef __bf16 bf16x2_t __attribute__((ext_vector_type(2)));
__device__ __forceinline__ unsigned cvtpk(float lo, float hi) { f32x2 v = {lo, hi}; bf16x2_t b = __builtin_convertvector(v, bf16x2_t); return __builtin_bit_cast(unsigned, b); }
__device__ __forceinline__ unsigned pk2(float lo, float hi) { return cvtpk(lo, hi); }
__device__ __forceinline__ float bf2f(unsigned b) { return __uint_as_float(b << 16); }
__device__ __forceinline__ float bflo(unsigned w) { return __uint_as_float(w << 16); }
__device__ __forceinline__ float bfhi(unsigned w) { return __uint_as_float(w & 0xffff0000u); }
__device__ __forceinline__ float wave_sum(float v) {
#pragma unroll
    for (int o = 1; o < 64; o <<= 1) v += __shfl_xor(v, o);
    return v;
}
__device__ __forceinline__ float wave_max(float v) {
#pragma unroll
    for (int o = 1; o < 64; o <<= 1) v = fmaxf(v, __shfl_xor(v, o));
    return v;
}

struct Ctx {
    LAS unsigned char* lds;
    int tid, lane, wave, vcu, G;
};

template <class RowPtr>
__device__ __forceinline__ void gemm_kloop(f32x4 (&acc)[4][4], const Ctx& c, const RowPtr& rp, const bf16_t* Bt, long ldb, int K) {
    const int tid = c.tid, lane = c.lane, wid = c.wave, wr = wid >> 2, wc = wid & 3, fr = lane & 15, fq = lane >> 4;
#if NAIVE_GEMM
    const bf16_t* ar[4];
#pragma unroll
    for (int mi = 0; mi < 4; ++mi) ar[mi] = rp(wr * 64 + mi * 16 + fr);
    const bf16_t* br = Bt + (long)(wc * 64 + fq * 4) * ldb;
#pragma nounroll
    for (int k = 0; k < K; k += 2) {
        unsigned av[4];
#pragma unroll
        for (int mi = 0; mi < 4; ++mi) av[mi] = *(const unsigned*)(ar[mi] + k);
#pragma unroll
        for (int ni = 0; ni < 4; ++ni)
#pragma unroll
            for (int j = 0; j < 4; ++j) {
                const unsigned bv = *(const unsigned*)(br + (long)(ni * 16 + j) * ldb + k);
#pragma unroll
                for (int mi = 0; mi < 4; ++mi) acc[mi][ni][j] += bflo(av[mi]) * bflo(bv) + bfhi(av[mi]) * bfhi(bv);
            }
    }
#else
    LAS unsigned char* lds = c.lds;
    const int nt = K >> 6;
    const int srow = tid >> 3, sch = tid & 7;
    const bf16_t* ap0 = rp(srow) + sch * 8;
    const bf16_t* ap1 = rp(srow + 64) + sch * 8;
    const bf16_t* bp = Bt + (long)srow * ldb + sch * 8;
    const long bstep = 64 * ldb;
    const int so = srow * 128 + ((sch ^ ((srow >> 1) & 7)) << 4);
    u32x4 ra0, ra1, rb0, rb1, rb2, rb3;
#define G_LOAD(t) do { const int ko = (t) * 64; ra0 = *(const u32x4*)(ap0 + ko); ra1 = *(const u32x4*)(ap1 + ko); \
        rb0 = *(const u32x4*)(bp + ko); rb1 = *(const u32x4*)(bp + bstep + ko); rb2 = *(const u32x4*)(bp + 2 * bstep + ko); rb3 = *(const u32x4*)(bp + 3 * bstep + ko); } while (0)
#define G_STORE(buf) do { LAS unsigned char* sb = lds + (buf) * STAGE_BYTES; \
        *(LAS u32x4*)(sb + so) = ra0; *(LAS u32x4*)(sb + so + 8192) = ra1; \
        *(LAS u32x4*)(sb + 16384 + so) = rb0; *(LAS u32x4*)(sb + 16384 + so + 8192) = rb1; \
        *(LAS u32x4*)(sb + 16384 + so + 16384) = rb2; *(LAS u32x4*)(sb + 16384 + so + 24576) = rb3; } while (0)
    __syncthreads();
    G_LOAD(0);
    G_STORE(0);
    __syncthreads();
    const int sw0 = ((0 + fq) ^ ((fr >> 1) & 7)) << 4, sw1 = ((4 + fq) ^ ((fr >> 1) & 7)) << 4;
    const int aoff = (wr * 64 + fr) * 128, boff = 16384 + (wc * 64 + fr) * 128;
    for (int t = 0; t < nt; ++t) {
        if (t + 1 < nt) G_LOAD(t + 1);
        const LAS unsigned char* sb = lds + (t & 1) * STAGE_BYTES;
#pragma unroll
        for (int ks = 0; ks < 2; ++ks) {
            const int sw = ks ? sw1 : sw0;
            bf16x8 af[4], bfr[4];
#pragma unroll
            for (int mi = 0; mi < 4; ++mi) af[mi] = *(const LAS bf16x8*)(sb + aoff + mi * 2048 + sw);
#pragma unroll
            for (int ni = 0; ni < 4; ++ni) bfr[ni] = *(const LAS bf16x8*)(sb + boff + ni * 2048 + sw);
#pragma unroll
            for (int mi = 0; mi < 4; ++mi)
#pragma unroll
                for (int ni = 0; ni < 4; ++ni) acc[mi][ni] = __builtin_amdgcn_mfma_f32_16x16x32_bf16(bfr[ni], af[mi], acc[mi][ni], 0, 0, 0);
        }
        if (t + 1 < nt) G_STORE((t + 1) & 1);
        __syncthreads();
    }
#undef G_LOAD
#undef G_STORE
#endif
}
__device__ __forceinline__ void acc_zero(f32x4 (&acc)[4][4]) {
#pragma unroll
    for (int a = 0; a < 4; ++a)
#pragma unroll
        for (int b = 0; b < 4; ++b) acc[a][b] = (f32x4){0.f, 0.f, 0.f, 0.f};
}
__device__ __forceinline__ void store_bf4(bf16_t* p, f32x4 v) { u32x2 w; w.x = pk2(v[0], v[1]); w.y = pk2(v[2], v[3]); *(u32x2*)p = w; }

enum { MAP_ID = 0, MAP_WIN = 1, MAP_GATE = 2, MAP_UP = 3 };
template <int MAP> __device__ __forceinline__ int rowmap(int n) {
    if (MAP == MAP_WIN) return n < 672 ? n : n + 32;
    if (MAP == MAP_GATE) return 32 * (n >> 4) + (n & 15);
    if (MAP == MAP_UP) return 32 * (n >> 4) + 16 + (n & 15);
    return n;
}
template <int MAP>
__device__ __forceinline__ void transpose_item(const float* W, int K, int N, bf16_t* WT, const float* gain, LAS float* scr, int item, int lane) {
    const int nblk = N / 32, kb = item / nblk, nb = item % nblk, k0 = 64 * kb, n0 = 32 * nb;
#pragma unroll 8
    for (int i = 0; i < 32; ++i) {
        const int kk = 2 * i + (lane >> 5);
        float v = W[(size_t)(k0 + kk) * N + n0 + (lane & 31)];
        if (gain) v *= gain[k0 + kk];
        scr[kk * 33 + (lane & 31)] = v;
    }
    asm volatile("s_waitcnt lgkmcnt(0)" ::: "memory");
    const int ch = lane & 7;
#pragma unroll
    for (int j = 0; j < 4; ++j) {
        const int n = (lane >> 3) + 8 * j;
        const LAS float* s = scr + (8 * ch) * 33 + n;
        u32x4 o;
        o.x = pk2(s[0 * 33], s[1 * 33]); o.y = pk2(s[2 * 33], s[3 * 33]); o.z = pk2(s[4 * 33], s[5 * 33]); o.w = pk2(s[6 * 33], s[7 * 33]);
        *(u32x4*)(WT + (size_t)rowmap<MAP>(n0 + n) * K + k0 + 8 * ch) = o;
    }
    asm volatile("s_waitcnt lgkmcnt(0)" ::: "memory");
}
__device__ __forceinline__ void phase0(const Params& p, const Ctx& c) {
    unsigned char* ws = p.ws;
    LAS float* scr = (LAS float*)(c.lds + c.wave * 8704);
    const int gw = c.vcu * NWAVES + c.wave, NGW = c.G * NWAVES, lane = c.lane;
    bf16_t* H0 = (bf16_t*)(ws + WS_H0);
    for (int r = gw; r < NROWSP; r += NGW) {
        u32x2* o = (u32x2*)(H0 + (size_t)r * D) + lane;
        if (r >= NROWS) {
#pragma unroll
            for (int j = 0; j < 4; ++j) o[64 * j] = (u32x2){0u, 0u};
            continue;
        }
        const float* xr = r < NTOK ? p.x + (size_t)r * D : p.meta + (size_t)(r - NTOK) * D;
        f32x4 v[4]; float s = 0.f;
#pragma unroll
        for (int j = 0; j < 4; ++j) { v[j] = *((const f32x4*)xr + lane + 64 * j); s += (v[j][0] + v[j][1]) + (v[j][2] + v[j][3]); }
        const float mean = wave_sum(s) * (1.f / D);
        float s2 = 0.f;
#pragma unroll
        for (int j = 0; j < 4; ++j) { v[j] = v[j] - mean; s2 += (v[j][0] * v[j][0] + v[j][1] * v[j][1]) + (v[j][2] * v[j][2] + v[j][3] * v[j][3]); }
        const float rstd = 1.f / sqrtf(wave_sum(s2) * (1.f / D) + 1e-5f);
#pragma unroll
        for (int j = 0; j < 4; ++j) {
            const f32x4 g = *((const f32x4*)p.emb_g + lane + 64 * j), b = *((const f32x4*)p.emb_b + lane + 64 * j);
            const f32x4 y = v[j] * rstd * g + b;
            u32x2 w; w.x = pk2(y[0], y[1]); w.y = pk2(y[2], y[3]); o[64 * j] = w;
        }
    }
    {
        float* rope = (float*)(ws + WS_ROPE);
        for (int idx = gw * 64 + lane; idx < LPOS * 16; idx += NGW * 64) {
            const int pos = idx >> 4, i = idx & 15;
            const float inv = exp2f(-(float)i * (13.287712379549449f / 16.f));
            const float ang = (float)pos * inv;
            double rev = (double)ang * 0.15915494309189535; rev -= floor(rev);
            const float rf = (float)rev;
            rope[idx * 2 + 0] = __builtin_amdgcn_cosf(rf);
            rope[idx * 2 + 1] = __builtin_amdgcn_sinf(rf);
        }
    }
    {
        bf16_t* WinT = (bf16_t*)(ws + WS_WIN);
        for (int it = gw; it < 96; it += NGW) {
            const int row = it < 32 ? 672 + it : 2240 + (it - 32);
            u32x2* o = (u32x2*)(WinT + (size_t)row * D) + lane;
#pragma unroll
            for (int j = 0; j < 4; ++j) o[64 * j] = (u32x2){0u, 0u};
        }
    }
    constexpr int I_WIN = 16 * 69, I_UQ = 6 * 24, I_UKV = 4 * 32, I_WO = 16 * 32, I_WR = 16 * 8, I_SG = 128, I_SD = 128;
    constexpr int I_SMALL = I_WIN + I_UQ + I_UKV + I_WO + I_WR + 2 * I_SG + I_SD;
    constexpr int I_EXP = NEXP * 128;
    constexpr int NITEMS = I_WIN + I_UQ + I_UKV + I_WO + I_WR;
    for (int it = gw; it < NITEMS; it += NGW) {
        int r = it;
        if (r < I_WIN) { transpose_item<MAP_WIN>(p.w_in, D, DIN, (bf16_t*)(ws + WS_WIN), nullptr, scr, r, lane); continue; } r -= I_WIN;
        if (r < I_UQ) { transpose_item<MAP_ID>(p.w_uq, QLORA, 768, (bf16_t*)(ws + WS_WUQ), p.q_norm, scr, r, lane); continue; } r -= I_UQ;
        if (r < I_UKV) { transpose_item<MAP_ID>(p.w_ukv, KVLORA, 1024, (bf16_t*)(ws + WS_WUKV), p.kv_norm, scr, r, lane); continue; } r -= I_UKV;
        if (r < I_WO) {
            const int kb = r / 32;
            transpose_item<MAP_ID>(p.w_o, D, D, (bf16_t*)(ws + WS_WO), kb < 8 ? p.attn_on : p.conv_on - 512, scr, r, lane); continue; } r -= I_WO;
        if (r < I_WR) { transpose_item<MAP_ID>(p.w_router, D, 256, (bf16_t*)(ws + WS_WR), nullptr, scr, r, lane); continue; } r -= I_WR;
        if (r < I_SG) { transpose_item<MAP_GATE>(p.ws_gate, D, 256, (bf16_t*)(ws + WS_WSGU), nullptr, scr, r, lane); continue; } r -= I_SG;
        if (r < I_SG) { transpose_item<MAP_UP>(p.ws_up, D, 256, (bf16_t*)(ws + WS_WSGU), nullptr, scr, r, lane); continue; } r -= I_SG;
        if (r < I_SD) { transpose_item<MAP_ID>(p.ws_down, DEXP, D, (bf16_t*)(ws + WS_WSD), nullptr, scr, r, lane); continue; } r -= I_SD;
        if (r < I_EXP) { const int e = r >> 7; transpose_item<MAP_GATE>(p.w_gate + (size_t)e * D * DEXP, D, 256, (bf16_t*)(ws + WS_WGU) + (size_t)e * 512 * D, nullptr, scr, r & 127, lane); continue; } r -= I_EXP;
        if (r < I_EXP) { const int e = r >> 7; transpose_item<MAP_UP>(p.w_up + (size_t)e * D * DEXP, D, 256, (bf16_t*)(ws + WS_WGU) + (size_t)e * 512 * D, nullptr, scr, r & 127, lane); continue; } r -= I_EXP;
        { const int e = r >> 7; transpose_item<MAP_ID>(p.w_down + (size_t)e * DEXP * D, DEXP, D, (bf16_t*)(ws + WS_WD) + (size_t)e * D * DEXP, nullptr, scr, r & 127, lane); }
    }
}

__device__ __forceinline__ void phase1(const Params& p, const Ctx& c) {
    unsigned char* ws = p.ws;
    const bf16_t* H0 = (const bf16_t*)(ws + WS_H0); const bf16_t* WinT = (const bf16_t*)(ws + WS_WIN);
    bf16_t* Z = (bf16_t*)(ws + WS_Z);
    float* psq = (float*)(ws + WS_PSQ);
    const int lane = c.lane, wr = c.wave >> 2, wc = c.wave & 3, fr = lane & 15, fq = lane >> 4;
    constexpr int NU = 129 * 9;
    for (int u = c.vcu; u < NU; u += c.G) {
        const int mt = u / 9, nt = u % 9, row0 = mt * 128, n0 = nt * 256;
        f32x4 acc[4][4]; acc_zero(acc);
        auto rp = [&](int r) { return H0 + (size_t)(row0 + r) * D; };
        gemm_kloop(acc, c, rp, WinT + (size_t)n0 * D, D, D);
        const int s0 = n0 + wc * 64;
#pragma unroll
        for (int mi = 0; mi < 4; ++mi) {
            const int row = row0 + wr * 64 + mi * 16 + fr;
            float ss = 0.f;
#pragma unroll
            for (int ni = 0; ni < 4; ++ni) {
                const f32x4 v = acc[mi][ni];
                store_bf4(Z + (size_t)row * ZC + s0 + ni * 16 + fq * 4, v);
                ss += (v[0] * v[0] + v[1] * v[1]) + (v[2] * v[2] + v[3] * v[3]);
            }
            if (s0 < ZKPE) {
                ss += __shfl_xor(ss, 16); ss += __shfl_xor(ss, 32);
                if (fq == 0) psq[(size_t)row * 16 + (s0 >> 6)] = ss;
            }
        }
    }
}

__device__ __forceinline__ void phase2_gemms(const Params& p, const Ctx& c);
__device__ __forceinline__ void phase2(const Params& p, const Ctx& c) {
    unsigned char* ws = p.ws;
    const bf16_t* Z = (const bf16_t*)(ws + WS_Z);
    const float* psq = (const float*)(ws + WS_PSQ);
    const float* rope = (const float*)(ws + WS_ROPE);
    bf16_t* Q = (bf16_t*)(ws + WS_Q); bf16_t* Kb = (bf16_t*)(ws + WS_K); bf16_t* Vb = (bf16_t*)(ws + WS_V);
    const int lane = c.lane, wr = c.wave >> 2, wc = c.wave & 3, fr = lane & 15, fq = lane >> 4;
    phase2_gemms(p, c);
    __syncthreads();
    const int gw = c.vcu * NWAVES + c.wave, NGW = c.G * NWAVES;
    const bf16_t* Zc = Z;
    for (int row = gw; row < NROWS; row += NGW) {
        const int nb = row < NTOK ? 1 : NBATCH;
        const int b0 = row < NTOK ? (row >> 11) : 0, pos = row < NTOK ? NMETA + (row & (SEQ - 1)) : row - NTOK;
        if (lane < 16) {
            const float x1 = bf2f(Zc[(size_t)row * ZC + ZKPE + lane]), x2 = bf2f(Zc[(size_t)row * ZC + ZKPE + 16 + lane]);
            const float co = rope[((size_t)pos * 16 + lane) * 2], si = rope[((size_t)pos * 16 + lane) * 2 + 1];
            const bf16_t o1 = (bf16_t)f2bf(x1 * co - x2 * si), o2 = (bf16_t)f2bf(x2 * co + x1 * si);
            for (int bb = 0; bb < nb; ++bb) {
                bf16_t* kp = Kb + ((size_t)(b0 + bb) * LPOS + pos) * 768;
#pragma unroll
                for (int h = 0; h < NH; ++h) { kp[h * 96 + 64 + lane] = o1; kp[h * 96 + 80 + lane] = o2; }
            }
        }
        if (row < NTOK) {
            const int i = row & (SEQ - 1);
            const int r1 = i >= 1 ? row - 1 : NTOK + 15;
            const int r2 = i >= 2 ? row - 2 : (i == 1 ? NTOK + 15 : NTOK + 14);
            const int ch = lane * 8;
            const u32x4 c0 = *(const u32x4*)(Zc + (size_t)row * ZC + ZCG + ch), u0 = *(const u32x4*)(Zc + (size_t)row * ZC + ZU + ch);
            const u32x4 c1 = *(const u32x4*)(Zc + (size_t)r1 * ZC + ZCG + ch), u1 = *(const u32x4*)(Zc + (size_t)r1 * ZC + ZU + ch);
            const u32x4 c2 = *(const u32x4*)(Zc + (size_t)r2 * ZC + ZCG + ch), u2 = *(const u32x4*)(Zc + (size_t)r2 * ZC + ZU + ch);
            const u32x4 bg = *(const u32x4*)(Zc + (size_t)row * ZC + ZB + ch);
            float y[8]; float ss = 0.f;
#pragma unroll
            for (int e = 0; e < 4; ++e) {
#pragma unroll
                for (int hh = 0; hh < 2; ++hh) {
                    const int cc = ch + e * 2 + hh;
                    const float w0 = p.conv_w[cc], w1 = p.conv_w[512 + cc], w2 = p.conv_w[1024 + cc];
                    const float v0 = hh ? bfhi(c0[e]) * bfhi(u0[e]) : bflo(c0[e]) * bflo(u0[e]);
                    const float v1 = hh ? bfhi(c1[e]) * bfhi(u1[e]) : bflo(c1[e]) * bflo(u1[e]);
                    const float v2 = hh ? bfhi(c2[e]) * bfhi(u2[e]) : bflo(c2[e]) * bflo(u2[e]);
                    const float bgv = hh ? bfhi(bg[e]) : bflo(bg[e]);
                    const float yy = bgv * (w0 * v2 + w1 * v1 + w2 * v0);
                    y[e * 2 + hh] = yy; ss += yy * yy;
                }
            }
            ss = wave_sum(ss);
            u32x4 o; o.x = pk2(y[0], y[1]); o.y = pk2(y[2], y[3]); o.z = pk2(y[4], y[5]); o.w = pk2(y[6], y[7]);
            *(u32x4*)((bf16_t*)(ws + WS_ATT) + (size_t)row * D + 512 + ch) = o;
            if (lane == 0) ((float*)(ws + WS_SSQC))[row] = ss;
        }
    }
}

__device__ __forceinline__ void phase3_naive(const Params& p, const Ctx& c) {
    unsigned char* ws = p.ws;
    const bf16_t* Q = (const bf16_t*)(ws + WS_Q); const bf16_t* Kb = (const bf16_t*)(ws + WS_K); const bf16_t* Vb = (const bf16_t*)(ws + WS_V);
    bf16_t* ATT = (bf16_t*)(ws + WS_ATT); float* patt = (float*)(ws + WS_PATT);
    const int gw = c.vcu * NWAVES + c.wave, NGW = c.G * NWAVES, lane = c.lane;
    for (int it = gw; it < NTOK * NH; it += NGW) {
        const int row = it >> 3, h = it & 7, b = row >> 11, i = row & (SEQ - 1), nkeys = NMETA + i + 1;
        float q[96];
#pragma unroll
        for (int j = 0; j < 12; ++j) {
            const u32x4 w = *(const u32x4*)(Q + (size_t)row * 768 + h * 96 + j * 8);
#pragma unroll
            for (int e = 0; e < 4; ++e) { q[j * 8 + e * 2] = bflo(w[e]); q[j * 8 + e * 2 + 1] = bfhi(w[e]); }
        }
        float m = -INFINITY, l = 0.f; float o[64];
#pragma unroll
        for (int d = 0; d < 64; ++d) o[d] = 0.f;
        for (int kk = lane; kk < nkeys; kk += 64) {
            const bf16_t* kp = Kb + ((size_t)b * LPOS + kk) * 768 + h * 96;
            float s = 0.f;
#pragma unroll
            for (int j = 0; j < 12; ++j) {
                const u32x4 w = *(const u32x4*)(kp + j * 8);
#pragma unroll
                for (int e = 0; e < 4; ++e) { s += q[j * 8 + e * 2] * bflo(w[e]); s += q[j * 8 + e * 2 + 1] * bfhi(w[e]); }
            }
            const float mn = fmaxf(m, s), f = exp2f(m - mn), pe = exp2f(s - mn);
            l = l * f + pe; m = mn;
            const bf16_t* vp = Vb + ((size_t)b * LPOS + kk) * 512 + h * 64;
#pragma unroll
            for (int j = 0; j < 8; ++j) {
                const u32x4 w = *(const u32x4*)(vp + j * 8);
#pragma unroll
                for (int e = 0; e < 4; ++e) { o[j * 8 + e * 2] = o[j * 8 + e * 2] * f + pe * bflo(w[e]); o[j * 8 + e * 2 + 1] = o[j * 8 + e * 2 + 1] * f + pe * bfhi(w[e]); }
            }
        }
        const float M = wave_max(m);
        const float f = (m == -INFINITY) ? 0.f : exp2f(m - M);
        const float lt = wave_sum(l * f);
        float res = 0.f;
#pragma unroll
        for (int d = 0; d < 64; ++d) { const float v = wave_sum(o[d] * f); if (lane == d) res = v; }
        res /= lt;
        ATT[(size_t)row * D + h * 64 + lane] = (bf16_t)f2bf(res);
        const float ss = wave_sum(res * res);
        if (lane == 0) patt[(size_t)row * 8 + h] = ss;
    }
}


typedef float f32x16 __attribute__((ext_vector_type(16)));
typedef short s16x4 __attribute__((ext_vector_type(4)));
constexpr int AK_PITCH = 208, AK_BYTES = 64 * AK_PITCH, AV_BYTES = 8192, ASTAGE = AK_BYTES + AV_BYTES, A_WSF = 4 * ASTAGE;
__device__ __forceinline__ int crow(int r, int hi) { return (r & 3) + 8 * (r >> 2) + 4 * hi; }
__device__ __forceinline__ s16x4 vtr(const LAS unsigned char* p) {
    return __builtin_bit_cast(s16x4, __builtin_amdgcn_ds_read_tr16_b64_v4i16((LAS s16x4*)p));
}
__device__ __forceinline__ void attn_unit(const Params& p, const Ctx& c, int b, int h, int qb) {
    unsigned char* ws = p.ws;
    const bf16_t* Q = (const bf16_t*)(ws + WS_Q); const bf16_t* Kb = (const bf16_t*)(ws + WS_K); const bf16_t* Vb = (const bf16_t*)(ws + WS_V);
    bf16_t* ATT = (bf16_t*)(ws + WS_ATT); float* patt = (float*)(ws + WS_PATT);
    const int tid = c.tid, lane = c.lane, w = c.wave, r32 = lane & 31, hi = lane >> 5;
    LAS unsigned char* lds = c.lds;
    LAS float* wsf = (LAS float*)(lds + A_WSF) + w * 32;
    const int row0 = b * SEQ + qb * 256;
    const int qpos0 = NMETA + qb * 256 + w * 32, myq = qpos0 + r32;
    bf16x8 qf[6];
#pragma unroll
    for (int ds = 0; ds < 6; ++ds) qf[ds] = *(const bf16x8*)(Q + (size_t)(row0 + w * 32 + r32) * 768 + h * 96 + ds * 16 + hi * 8);
    const bf16_t* Kg = Kb + (size_t)b * LPOS * 768 + h * 96;
    const bf16_t* Vg = Vb + (size_t)b * LPOS * 512 + h * 64;
    const int T = 4 * qb + 5;
    const int tl = (qpos0 + 31) >> 6;
    const int vrow = tid >> 3, vch = tid & 7;
    const int voff = AK_BYTES + (vch >> 2) * 4096 + vrow * 64 + (vch & 3) * 16;
    const int k1c = 512 + (tid & 255);
    const int k0row = tid / 12, k0ch = tid % 12, k1row = k1c / 12, k1ch = k1c % 12;
    const int k0off = k0row * AK_PITCH + k0ch * 16, k1off = k1row * AK_PITCH + k1ch * 16;
    u32x4 rkA0, rkA1, rvA, rkA2, rkA3, rvA2;
#define A_LOAD1(k0, k1, v, t) do { const int kb_ = min((t), T - 1) * 64; \
        k0 = *(const u32x4*)(Kg + (size_t)min(kb_ + k0row, LPOS - 1) * 768 + k0ch * 8); \
        k1 = *(const u32x4*)(Kg + (size_t)min(kb_ + k1row, LPOS - 1) * 768 + k1ch * 8); \
        v = *(const u32x4*)(Vg + (size_t)min(kb_ + vrow, LPOS - 1) * 512 + vch * 8); } while (0)
#define A_STORE1(k0, k1, v, off) do { LAS unsigned char* sb_ = lds + (off); \
        *(LAS u32x4*)(sb_ + k0off) = k0; *(LAS u32x4*)(sb_ + k1off) = k1; *(LAS u32x4*)(sb_ + voff) = v; } while (0)
#define A_LOAD_A(t2) do { A_LOAD1(rkA0, rkA1, rvA, 2 * (t2)); A_LOAD1(rkA2, rkA3, rvA2, 2 * (t2) + 1); } while (0)
#define A_STORE_A(buf) do { A_STORE1(rkA0, rkA1, rvA, (buf) * 2 * ASTAGE); A_STORE1(rkA2, rkA3, rvA2, (buf) * 2 * ASTAGE + ASTAGE); } while (0)
    float m = -INFINITY, l = 0.f;
    f32x16 o0, o1;
#pragma unroll
    for (int r = 0; r < 16; ++r) { o0[r] = 0.f; o1[r] = 0.f; }
    const int kfo = r32 * AK_PITCH + hi * 16;
    const int vfo = AK_BYTES + ((lane >> 4) & 1) * 32 + (lane & 3) * 8 + (4 * hi + ((lane & 15) >> 2)) * 64;
    const int T2 = (T + 1) >> 1;
    __syncthreads();
    A_LOAD_A(0);
    A_STORE_A(0);
    __syncthreads();
    auto compute_tile = [&](int t) __attribute__((always_inline)) {
        if (t <= tl) {
            const LAS unsigned char* sb = lds + ((t >> 1) & 1) * 2 * ASTAGE + (t & 1) * ASTAGE;
            f32x16 p0, p1;
#pragma unroll
            for (int r = 0; r < 16; ++r) { p0[r] = 0.f; p1[r] = 0.f; }
#pragma unroll
            for (int ds = 0; ds < 6; ++ds) {
                const bf16x8 a0 = *(const LAS bf16x8*)(sb + kfo + ds * 32);
                const bf16x8 a1 = *(const LAS bf16x8*)(sb + kfo + 32 * AK_PITCH + ds * 32);
                p0 = __builtin_amdgcn_mfma_f32_32x32x16_bf16(a0, qf[ds], p0, 0, 0, 0);
                p1 = __builtin_amdgcn_mfma_f32_32x32x16_bf16(a1, qf[ds], p1, 0, 0, 0);
            }
            if (t * 64 + 63 > qpos0) {
                const int kb0 = t * 64 + 4 * hi;
#pragma unroll
                for (int r = 0; r < 16; ++r) {
                    const int kv = kb0 + (r & 3) + 8 * (r >> 2);
                    if (kv > myq) p0[r] = -INFINITY;
                    if (kv + 32 > myq) p1[r] = -INFINITY;
                }
            }
            float mx = fmaxf(p0[0], p1[0]);
#pragma unroll
            for (int r = 1; r < 16; ++r) mx = fmaxf(mx, fmaxf(p0[r], p1[r]));
            mx = fmaxf(mx, __shfl_xor(mx, 32));
            if (__any(mx > m)) {
                const float mn = fmaxf(m, mx), alpha = __builtin_amdgcn_exp2f(m - mn);
                m = mn; l *= alpha;
                if (hi == 0) wsf[r32] = alpha;
                asm volatile("s_waitcnt lgkmcnt(0)" ::: "memory");
#pragma unroll
                for (int k = 0; k < 4; ++k) {
                    const f32x4 a = *(const LAS f32x4*)(wsf + 8 * k + 4 * hi);
#pragma unroll
                    for (int j = 0; j < 4; ++j) { o0[4 * k + j] *= a[j]; o1[4 * k + j] *= a[j]; }
                }
                asm volatile("s_waitcnt lgkmcnt(0)" ::: "memory");
            }
            float ls = 0.f;
#pragma unroll
            for (int r = 0; r < 16; ++r) { p0[r] = __builtin_amdgcn_exp2f(p0[r] - m); p1[r] = __builtin_amdgcn_exp2f(p1[r] - m); ls += p0[r] + p1[r]; }
            l += ls;
            bf16x8 pa[4];
#pragma unroll
            for (int s = 0; s < 4; ++s) {
                u32x4 wv;
#pragma unroll
                for (int e = 0; e < 4; ++e) {
                    const int r = 8 * (s & 1) + 2 * e;
                    wv[e] = (s >> 1) ? pk2(p1[r], p1[r + 1]) : pk2(p0[r], p0[r + 1]);
                }
                pa[s] = __builtin_bit_cast(bf16x8, wv);
            }
#pragma unroll
            for (int s = 0; s < 4; ++s) {
                const s16x4 l0 = vtr(sb + vfo + s * 1024), h0 = vtr(sb + vfo + s * 1024 + 512);
                const s16x4 l1 = vtr(sb + vfo + 4096 + s * 1024), h1 = vtr(sb + vfo + 4096 + s * 1024 + 512);
                const bf16x8 v0 = (bf16x8){l0[0], l0[1], l0[2], l0[3], h0[0], h0[1], h0[2], h0[3]};
                const bf16x8 v1 = (bf16x8){l1[0], l1[1], l1[2], l1[3], h1[0], h1[1], h1[2], h1[3]};
                o0 = __builtin_amdgcn_mfma_f32_32x32x16_bf16(pa[s], v0, o0, 0, 0, 0);
                o1 = __builtin_amdgcn_mfma_f32_32x32x16_bf16(pa[s], v1, o1, 0, 0, 0);
            }
        }
    };
#pragma unroll 1
    for (int t2 = 0; t2 < T2; ++t2) {
        A_LOAD_A(t2 + 1);
        compute_tile(2 * t2); compute_tile(2 * t2 + 1);
        A_STORE_A((t2 + 1) & 1);
        __syncthreads();
    }
#undef A_LOAD1
#undef A_STORE1
#undef A_LOAD_A
#undef A_STORE_A
    l += __shfl_xor(l, 32);
    if (hi == 0) wsf[r32] = 1.f / l;
    asm volatile("s_waitcnt lgkmcnt(0)" ::: "memory");
    float sq[16];
#pragma unroll
    for (int k = 0; k < 4; ++k) {
        const f32x4 a = *(const LAS f32x4*)(wsf + 8 * k + 4 * hi);
#pragma unroll
        for (int j = 0; j < 4; ++j) {
            const int r = 4 * k + j;
            const float x0 = o0[r] * a[j], x1 = o1[r] * a[j];
            bf16_t* op = ATT + (size_t)(row0 + w * 32 + crow(r, hi)) * D + h * 64 + r32;
            op[0] = (bf16_t)f2bf(x0); op[32] = (bf16_t)f2bf(x1);
            sq[r] = x0 * x0 + x1 * x1;
        }
    }
#pragma unroll
    for (int r = 0; r < 16; ++r) {
        float v = sq[r];
#pragma unroll
        for (int o = 1; o < 32; o <<= 1) v += __shfl_xor(v, o);
        if (r32 == 0) patt[(size_t)(row0 + w * 32 + crow(r, hi)) * 8 + h] = v;
    }
    asm volatile("s_waitcnt lgkmcnt(0)" ::: "memory");
}
__device__ __forceinline__ void phase3(const Params& p, const Ctx& c) {
    for (int pi = c.vcu; pi < 256; pi += c.G) {
        const int bh = pi >> 2, s = pi & 3;
        attn_unit(p, c, bh >> 3, bh & 7, 7 - s);
        attn_unit(p, c, bh >> 3, bh & 7, s);
    }
}

__device__ __forceinline__ void phase4(const Params& p, const Ctx& c) {
    unsigned char* ws = p.ws;
    const bf16_t* ATT = (const bf16_t*)(ws + WS_ATT); const bf16_t* CONV = (const bf16_t*)(ws + WS_CONV);
    const bf16_t* WoT = (const bf16_t*)(ws + WS_WO); const bf16_t* H0 = (const bf16_t*)(ws + WS_H0);
    const float* patt = (const float*)(ws + WS_PATT); const float* ssq_c = (const float*)(ws + WS_SSQC);
    bf16_t* Y1 = (bf16_t*)(ws + WS_Y1); float* pst = (float*)(ws + WS_PST);
    const int lane = c.lane, wr = c.wave >> 2, wc = c.wave & 3, fr = lane & 15, fq = lane >> 4;
    constexpr int NU = 128 * 4;
    for (int u = c.vcu; u < NU; u += c.G) {
        const int mt = u >> 2, nt = u & 3, row0 = mt * 128, n0 = nt * 256;
        f32x4 acc[4][4]; acc_zero(acc);
        auto rpa = [&](int r) { return ATT + (size_t)(row0 + r) * 512; };
        gemm_kloop(acc, c, rpa, WoT + (size_t)n0 * D, D, 512);
        float rc[4];
#pragma unroll
        for (int mi = 0; mi < 4; ++mi) {
            const int row = row0 + wr * 64 + mi * 16 + fr;
            const f32x4 pa = *(const f32x4*)(patt + (size_t)row * 8), pb = *(const f32x4*)(patt + (size_t)row * 8 + 4);
            const float ra = rsqrtf((((pa[0] + pa[1]) + (pa[2] + pa[3])) + ((pb[0] + pb[1]) + (pb[2] + pb[3]))) * (1.f / 512) + 1e-6f);
            rc[mi] = rsqrtf(ssq_c[row] * (1.f / 512) + 1e-6f);
            const float f = ra / rc[mi];
#pragma unroll
            for (int ni = 0; ni < 4; ++ni) acc[mi][ni] = acc[mi][ni] * f;
        }
        auto rpc = [&](int r) { return CONV + (size_t)(row0 + r) * 512; };
        gemm_kloop(acc, c, rpc, WoT + (size_t)n0 * D + 512, D, 512);
        const int s0 = n0 + wc * 64;
#pragma unroll
        for (int mi = 0; mi < 4; ++mi) {
            const int row = row0 + wr * 64 + mi * 16 + fr;
            float s = 0.f, ss = 0.f;
#pragma unroll
            for (int ni = 0; ni < 4; ++ni) {
                const int col = s0 + ni * 16 + fq * 4;
                const u32x2 hw = *(const u32x2*)(H0 + (size_t)row * D + col);
                f32x4 v = acc[mi][ni] * rc[mi];
                v[0] += ALPHA * bflo(hw.x); v[1] += ALPHA * bfhi(hw.x); v[2] += ALPHA * bflo(hw.y); v[3] += ALPHA * bfhi(hw.y);
                store_bf4(Y1 + (size_t)row * D + col, v);
                s += (v[0] + v[1]) + (v[2] + v[3]);
                ss += (v[0] * v[0] + v[1] * v[1]) + (v[2] * v[2] + v[3] * v[3]);
            }
            s += __shfl_xor(s, 16); s += __shfl_xor(s, 32);
            ss += __shfl_xor(ss, 16); ss += __shfl_xor(ss, 32);
            if (fq == 0) { float* q = pst + ((size_t)row * 16 + nt * 4 + wc) * 2; q[0] = s; q[1] = ss; }
        }
    }
}

__device__ __forceinline__ void phase5a(const Params& p, const Ctx& c) {
    unsigned char* ws = p.ws;
    const bf16_t* Y1 = (const bf16_t*)(ws + WS_Y1); bf16_t* H1 = (bf16_t*)(ws + WS_H1); const float* pst = (const float*)(ws + WS_PST);
    const int gw = c.vcu * NWAVES + c.wave, NGW = c.G * NWAVES, lane = c.lane;
    for (int row = gw; row < NTOK; row += NGW) {
        float s1 = 0.f, s2 = 0.f;
#pragma unroll
        for (int k = 0; k < 16; ++k) { s1 += pst[((size_t)row * 16 + k) * 2]; s2 += pst[((size_t)row * 16 + k) * 2 + 1]; }
        const float mean = s1 * (1.f / D), var = fmaxf(s2 * (1.f / D) - mean * mean, 0.f), rstd = rsqrtf(var + 1e-5f);
#pragma unroll
        for (int j = 0; j < 2; ++j) {
            const int col = (lane + 64 * j) * 8;
            const u32x4 w = *(const u32x4*)(Y1 + (size_t)row * D + col);
            float y[8];
#pragma unroll
            for (int e = 0; e < 4; ++e) { y[2 * e] = bflo(w[e]); y[2 * e + 1] = bfhi(w[e]); }
#pragma unroll
            for (int e = 0; e < 8; ++e) y[e] = (y[e] - mean) * rstd * p.ln1_g[col + e] + p.ln1_b[col + e];
            u32x4 o; o.x = pk2(y[0], y[1]); o.y = pk2(y[2], y[3]); o.z = pk2(y[4], y[5]); o.w = pk2(y[6], y[7]);
            *(u32x4*)(H1 + (size_t)row * D + col) = o;
        }
    }
}
__device__ __forceinline__ void phase5b(const Params& p, const Ctx& c) {
    unsigned char* ws = p.ws;
    const bf16_t* H1 = (const bf16_t*)(ws + WS_H1); float* LOG = (float*)(ws + WS_LOG);
    const int lane = c.lane, wr = c.wave >> 2, wc = c.wave & 3, fr = lane & 15, fq = lane >> 4;
    for (int u = c.vcu; u < 128; u += c.G) {
        const int row0 = u * 128;
        f32x4 acc[4][4]; acc_zero(acc);
        auto rp = [&](int r) { return H1 + (size_t)(row0 + r) * D; };
        gemm_kloop(acc, c, rp, (const bf16_t*)(ws + WS_WR), D, D);
#pragma unroll
        for (int mi = 0; mi < 4; ++mi) {
            const int row = row0 + wr * 64 + mi * 16 + fr;
#pragma unroll
            for (int ni = 0; ni < 4; ++ni) *(f32x4*)(LOG + (size_t)row * 256 + wc * 64 + ni * 16 + fq * 4) = acc[mi][ni];
        }
    }
}
__device__ __forceinline__ void phase5c(const Params& p, const Ctx& c) {
    unsigned char* ws = p.ws;
    const float* LOG = (const float*)(ws + WS_LOG);
    unsigned* cnt = (unsigned*)(ws + WS_CTL + CT_CNT); unsigned* laid = (unsigned*)(ws + WS_LAID); float* lgate = (float*)(ws + WS_LGATE);
    const int gw = c.vcu * NWAVES + c.wave, NGW = c.G * NWAVES, lane = c.lane;
    const f32x4 bias = *((const f32x4*)p.router_bias + lane);
    for (int t = gw; t < NTOK; t += NGW) {
        const f32x4 lg = *((const f32x4*)(LOG + (size_t)t * 256) + lane);
        float s[4], sel[4];
#pragma unroll
        for (int i = 0; i < 4; ++i) { s[i] = 1.f / (1.f + expf(-lg[i])); sel[i] = s[i] + bias[i]; }
        float a = fmaxf(sel[0], sel[1]), b = fminf(sel[0], sel[1]), cc = fmaxf(sel[2], sel[3]), d = fminf(sel[2], sel[3]);
        float t1 = fmaxf(a, cc), t2 = fmaxf(fminf(a, cc), a >= cc ? b : d);
#pragma unroll
        for (int o = 1; o < 8; o <<= 1) {
            const float y1 = __shfl_xor(t1, o), y2 = __shfl_xor(t2, o);
            const float n1 = fmaxf(t1, y1), n2 = fmaxf(fminf(t1, y1), t1 >= y1 ? t2 : y2);
            t1 = n1; t2 = n2;
        }
        const float gs = t1 + t2; const int g = lane >> 3;
        int better = 0;
#pragma unroll
        for (int gg = 0; gg < 8; ++gg) { const float o = __shfl(gs, gg * 8); better += (o > gs || (o == gs && gg < g)) ? 1 : 0; }
        if (better >= 4) { sel[0] = sel[1] = sel[2] = sel[3] = -INFINITY; }
        int ek[8]; float sk[8]; float ssum = 0.f;
#pragma unroll
        for (int k = 0; k < 8; ++k) {
            float bv = sel[0]; int bi = 0;
            if (sel[1] > bv) { bv = sel[1]; bi = 1; }
            if (sel[2] > bv) { bv = sel[2]; bi = 2; }
            if (sel[3] > bv) { bv = sel[3]; bi = 3; }
            const float wm = wave_max(bv);
            const unsigned long long mask = __ballot(bv == wm);
            const int src = __ffsll((long long)mask) - 1;
            const float sb = bi == 0 ? s[0] : bi == 1 ? s[1] : bi == 2 ? s[2] : s[3];
            ek[k] = src * 4 + __shfl(bi, src); sk[k] = __shfl(sb, src); ssum += sk[k];
            if (lane == src) { if (bi == 0) sel[0] = -INFINITY; else if (bi == 1) sel[1] = -INFINITY; else if (bi == 2) sel[2] = -INFINITY; else sel[3] = -INFINITY; }
        }
        int me = ek[0]; float mg = sk[0];
#pragma unroll
        for (int k = 1; k < 8; ++k) if (lane == k) { me = ek[k]; mg = sk[k]; }
        if (lane < 8) {
            const unsigned pos = atomicAdd(cnt + me, 1u);
            laid[(size_t)me * CAP + pos] = (unsigned)(t * 8 + lane);
            lgate[(size_t)me * CAP + pos] = mg / ssum * 2.5f;
        }
    }
}


__device__ __forceinline__ void route_token(const Params& p, int t, const f32x4 lg, const f32x4 bias, int lane, unsigned* cnt, unsigned* laid, float* lgate) {
    float s[4], sel[4];
#pragma unroll
    for (int i = 0; i < 4; ++i) { s[i] = 1.f / (1.f + expf(-lg[i])); sel[i] = s[i] + bias[i]; }
    float a = fmaxf(sel[0], sel[1]), b = fminf(sel[0], sel[1]), cc = fmaxf(sel[2], sel[3]), d = fminf(sel[2], sel[3]);
    float t1 = fmaxf(a, cc), t2 = fmaxf(fminf(a, cc), a >= cc ? b : d);
#pragma unroll
    for (int o = 1; o < 8; o <<= 1) {
        const float y1 = __shfl_xor(t1, o), y2 = __shfl_xor(t2, o);
        const float n1 = fmaxf(t1, y1), n2 = fmaxf(fminf(t1, y1), t1 >= y1 ? t2 : y2);
        t1 = n1; t2 = n2;
    }
    const float gs = t1 + t2; const int g = lane >> 3;
    int better = 0;
#pragma unroll
    for (int gg = 0; gg < 8; ++gg) { const float o = __shfl(gs, gg * 8); better += (o > gs || (o == gs && gg < g)) ? 1 : 0; }
    if (better >= 4) { sel[0] = sel[1] = sel[2] = sel[3] = -INFINITY; }
    int ek[8]; float sk[8]; float ssum = 0.f;
#pragma unroll
    for (int k = 0; k < 8; ++k) {
        float bv = sel[0]; int bi = 0;
        if (sel[1] > bv) { bv = sel[1]; bi = 1; }
        if (sel[2] > bv) { bv = sel[2]; bi = 2; }
        if (sel[3] > bv) { bv = sel[3]; bi = 3; }
        const float wm = wave_max(bv);
        const unsigned long long mask = __ballot(bv == wm);
        const int src = __ffsll((long long)mask) - 1;
        const float sb = bi == 0 ? s[0] : bi == 1 ? s[1] : bi == 2 ? s[2] : s[3];
        ek[k] = src * 4 + __shfl(bi, src); sk[k] = __shfl(sb, src); ssum += sk[k];
        if (lane == src) { if (bi == 0) sel[0] = -INFINITY; else if (bi == 1) sel[1] = -INFINITY; else if (bi == 2) sel[2] = -INFINITY; else sel[3] = -INFINITY; }
    }
    int me = ek[0]; float mg = sk[0];
#pragma unroll
    for (int k = 1; k < 8; ++k) if (lane == k) { me = ek[k]; mg = sk[k]; }
    if (lane < 8) {
        const unsigned pos = atomicAdd(cnt + me, 1u);
        laid[(size_t)me * CAP + pos] = (unsigned)(t * 8 + lane);
        lgate[(size_t)me * CAP + pos] = mg / ssum * 2.5f;
    }
}
__device__ __forceinline__ void phase5_fused(const Params& p, const Ctx& c) {
    unsigned char* ws = p.ws;
    const bf16_t* Y1 = (const bf16_t*)(ws + WS_Y1); bf16_t* H1 = (bf16_t*)(ws + WS_H1); const float* pst = (const float*)(ws + WS_PST);
    const bf16_t* WrT = (const bf16_t*)(ws + WS_WR);
    unsigned* cnt = (unsigned*)(ws + WS_CTL + CT_CNT); unsigned* laid = (unsigned*)(ws + WS_LAID); float* lgate = (float*)(ws + WS_LGATE);
    const int lane = c.lane, w = c.wave, r32 = lane & 31, hi = lane >> 5;
    LAS unsigned char* lds = c.lds;
    const f32x4 bias = *((const f32x4*)p.router_bias + lane);
    for (int u = c.vcu; u < NTOK / 64; u += c.G) {
        const int row0 = u * 64;
        __syncthreads();
        {
            float gg[16], bb[16];
#pragma unroll
            for (int j = 0; j < 2; ++j) {
                const int col = (lane + 64 * j) * 8;
#pragma unroll
                for (int e = 0; e < 2; ++e) { const f32x4 g4 = *(const f32x4*)(p.ln1_g + col + 4 * e), b4 = *(const f32x4*)(p.ln1_b + col + 4 * e);
#pragma unroll
                    for (int q = 0; q < 4; ++q) { gg[j * 8 + e * 4 + q] = g4[q]; bb[j * 8 + e * 4 + q] = b4[q]; } }
            }
#pragma unroll 2
            for (int rr = 0; rr < 8; ++rr) {
                const int lr = w * 8 + rr, row = row0 + lr;
                float s1 = 0.f, s2 = 0.f;
                if (lane < 16) { const float* q = pst + ((size_t)row * 16 + lane) * 2; s1 = q[0]; s2 = q[1]; }
#pragma unroll
                for (int o = 1; o < 16; o <<= 1) { s1 += __shfl_xor(s1, o); s2 += __shfl_xor(s2, o); }
                s1 = __shfl(s1, 0); s2 = __shfl(s2, 0);
                const float mean = s1 * (1.f / D), var = fmaxf(s2 * (1.f / D) - mean * mean, 0.f), rstd = rsqrtf(var + 1e-5f);
#pragma unroll
                for (int j = 0; j < 2; ++j) {
                    const int ch = lane + 64 * j, col = ch * 8;
                    const u32x4 wv = *(const u32x4*)(Y1 + (size_t)row * D + col);
                    float y[8];
#pragma unroll
                    for (int e = 0; e < 4; ++e) { y[2 * e] = bflo(wv[e]); y[2 * e + 1] = bfhi(wv[e]); }
#pragma unroll
                    for (int e = 0; e < 8; ++e) y[e] = (y[e] - mean) * rstd * gg[j * 8 + e] + bb[j * 8 + e];
                    u32x4 o; o.x = cvtpk(y[0], y[1]); o.y = cvtpk(y[2], y[3]); o.z = cvtpk(y[4], y[5]); o.w = cvtpk(y[6], y[7]);
                    *(u32x4*)(H1 + (size_t)row * D + col) = o;
                    *(LAS u32x4*)(lds + lr * 2048 + ((ch ^ (lr & 15)) << 4)) = o;
                }
            }
        }
        __syncthreads();
        f32x16 acc0, acc1;
#pragma unroll
        for (int r = 0; r < 16; ++r) { acc0[r] = 0.f; acc1[r] = 0.f; }
        {
            const bf16_t* bp = WrT + (size_t)(w * 32 + r32) * D + hi * 8;
            const LAS unsigned char* a0 = lds + r32 * 2048, * a1 = lds + (32 + r32) * 2048;
            const int sx = r32 & 15;
#pragma unroll 1
            for (int kb = 0; kb < 64; kb += 8) {
                bf16x8 bf[8];
#pragma unroll
                for (int q = 0; q < 8; ++q) bf[q] = *(const bf16x8*)(bp + (kb + q) * 16);
#pragma unroll
                for (int q = 0; q < 8; ++q) {
                    const int ch = 2 * (kb + q) + hi;
                    const bf16x8 f0 = *(const LAS bf16x8*)(a0 + ((ch ^ sx) << 4)), f1 = *(const LAS bf16x8*)(a1 + ((ch ^ sx) << 4));
                    acc0 = __builtin_amdgcn_mfma_f32_32x32x16_bf16(bf[q], f0, acc0, 0, 0, 0);
                    acc1 = __builtin_amdgcn_mfma_f32_32x32x16_bf16(bf[q], f1, acc1, 0, 0, 0);
                }
            }
        }
        __syncthreads();
#pragma unroll
        for (int g = 0; g < 4; ++g) {
            *(LAS f32x4*)(lds + (size_t)r32 * 1024 + (w * 32 + 8 * g + 4 * hi) * 4) = (f32x4){acc0[4 * g], acc0[4 * g + 1], acc0[4 * g + 2], acc0[4 * g + 3]};
            *(LAS f32x4*)(lds + (size_t)(32 + r32) * 1024 + (w * 32 + 8 * g + 4 * hi) * 4) = (f32x4){acc1[4 * g], acc1[4 * g + 1], acc1[4 * g + 2], acc1[4 * g + 3]};
        }
        __syncthreads();
#pragma unroll 1
        for (int rr = 0; rr < 8; ++rr) {
            const int lr = w * 8 + rr;
            const f32x4 lg = *(const LAS f32x4*)(lds + lr * 1024 + lane * 16);
            route_token(p, row0 + lr, lg, bias, lane, cnt, laid, lgate);
        }
    }
}

struct MoeTab { LAS int* tstart; LAS int* roff; LAS int* tok; LAS float* gate; };
__device__ __forceinline__ MoeTab moe_tab_build(const Params& p, const Ctx& c) {
    MoeTab T; T.tstart = (LAS int*)(c.lds + LDS_MISC); T.roff = T.tstart + 260; T.tok = T.roff + 260; T.gate = (LAS float*)(T.tok + 128);
    const unsigned* cnt = (const unsigned*)(p.ws + WS_CTL + CT_CNT);
    __syncthreads();
    if (c.tid < 64) {
        int cv[4], tv[4]; int ls = 0, lt = 0;
#pragma unroll
        for (int i = 0; i < 4; ++i) { cv[i] = (int)cnt[c.tid * 4 + i]; tv[i] = (cv[i] + 127) >> 7; ls += cv[i]; lt += tv[i]; }
        int ps = ls, pt = lt;
#pragma unroll
        for (int o = 1; o < 64; o <<= 1) { const int a = __shfl_up(ps, o), b = __shfl_up(pt, o); if (c.tid >= o) { ps += a; pt += b; } }
        int es = ps - ls, et = pt - lt;
#pragma unroll
        for (int i = 0; i < 4; ++i) { T.roff[c.tid * 4 + i] = es; T.tstart[c.tid * 4 + i] = et; es += cv[i]; et += tv[i]; }
        if (c.tid == 63) { T.roff[256] = es; T.tstart[256] = et; }
    }
    __syncthreads();
    return T;
}
__device__ __forceinline__ int moe_find(const MoeTab& T, int g) {
    int lo = 0, hi = 255;
    while (lo < hi) { const int mid = (lo + hi + 1) >> 1; if (T.tstart[mid] <= g) lo = mid; else hi = mid - 1; }
    return lo;
}

__device__ __forceinline__ void phase6(const Params& p, const Ctx& c) {
    unsigned char* ws = p.ws;
    const bf16_t* H1 = (const bf16_t*)(ws + WS_H1); bf16_t* HID = (bf16_t*)(ws + WS_HID);
    const unsigned* laid = (const unsigned*)(ws + WS_LAID);
    const unsigned* cnt = (const unsigned*)(ws + WS_CTL + CT_CNT);
    const int lane = c.lane, wr = c.wave >> 2, wc = c.wave & 3, fr = lane & 15, fq = lane >> 4;
    const MoeTab T = moe_tab_build(p, c);
    const int tmt = T.tstart[256], NU = (tmt + 128) * 2;
    for (int u = c.vcu; u < NU; u += c.G) {
        const int g = u >> 1, nt = u & 1;
        int e, mt, nrows; size_t hbase;
        __syncthreads();
        if (g < tmt) {
            e = moe_find(T, g); mt = g - T.tstart[e]; nrows = min(128, (int)cnt[e] - mt * 128); hbase = (size_t)T.roff[e] + mt * 128;
            if (c.tid < 128) T.tok[c.tid] = (int)(laid[(size_t)e * CAP + mt * 128 + min(c.tid, nrows - 1)] >> 3);
        } else {
            e = NEXP; mt = g - tmt; nrows = 128; hbase = (size_t)NTOK * 8 + mt * 128;
            if (c.tid < 128) T.tok[c.tid] = mt * 128 + c.tid;
        }
        __syncthreads();
        f32x4 acc[4][4]; acc_zero(acc);
        auto rp = [&](int r) { return H1 + (size_t)T.tok[r] * D; };
        const bf16_t* Bt = (e < NEXP ? (const bf16_t*)(ws + WS_WGU) + (size_t)e * 512 * D : (const bf16_t*)(ws + WS_WSGU)) + (size_t)nt * 256 * D;
        gemm_kloop(acc, c, rp, Bt, D, D);
#pragma unroll
        for (int mi = 0; mi < 4; ++mi) {
            const int r = wr * 64 + mi * 16 + fr;
            if (r >= nrows) continue;
#pragma unroll
            for (int np = 0; np < 2; ++np) {
                const f32x4 gt = acc[mi][2 * np], up = acc[mi][2 * np + 1];
                f32x4 hv;
#pragma unroll
                for (int j = 0; j < 4; ++j) hv[j] = gt[j] / (1.f + __expf(-gt[j])) * up[j];
                store_bf4(HID + (hbase + r) * DEXP + nt * 128 + wc * 32 + np * 16 + fq * 4, hv);
            }
        }
    }
}
__device__ __forceinline__ void phase7(const Params& p, const Ctx& c) {
    unsigned char* ws = p.ws;
    const bf16_t* HID = (const bf16_t*)(ws + WS_HID); bf16_t* Y = (bf16_t*)(ws + WS_Y);
    const unsigned* laid = (const unsigned*)(ws + WS_LAID); const float* lgate = (const float*)(ws + WS_LGATE);
    const unsigned* cnt = (const unsigned*)(ws + WS_CTL + CT_CNT);
    const int lane = c.lane, wr = c.wave >> 2, wc = c.wave & 3, fr = lane & 15, fq = lane >> 4;
    const MoeTab T = moe_tab_build(p, c);
    const int tmt = T.tstart[256], NU = (tmt + 128) * 4;
    for (int u = c.vcu; u < NU; u += c.G) {
        const int g = u >> 2, nt = u & 3;
        int e, mt, nrows; size_t hbase;
        __syncthreads();
        if (g < tmt) {
            e = moe_find(T, g); mt = g - T.tstart[e]; nrows = min(128, (int)cnt[e] - mt * 128); hbase = (size_t)T.roff[e] + mt * 128;
            if (c.tid < 128) {
                const int rr = min(c.tid, nrows - 1);
                const unsigned aid = laid[(size_t)e * CAP + mt * 128 + rr];
                T.tok[c.tid] = (int)((aid >> 3) * 9 + (aid & 7)); T.gate[c.tid] = lgate[(size_t)e * CAP + mt * 128 + rr];
            }
        } else {
            e = NEXP; mt = g - tmt; nrows = 128; hbase = (size_t)NTOK * 8 + mt * 128;
            if (c.tid < 128) { T.tok[c.tid] = (mt * 128 + c.tid) * 9 + 8; T.gate[c.tid] = 1.f; }
        }
        __syncthreads();
        f32x4 acc[4][4]; acc_zero(acc);
        auto rp = [&](int r) { return HID + (hbase + min(r, nrows - 1)) * DEXP; };
        const bf16_t* Bt = (e < NEXP ? (const bf16_t*)(ws + WS_WD) + (size_t)e * D * DEXP : (const bf16_t*)(ws + WS_WSD)) + (size_t)nt * 256 * DEXP;
        gemm_kloop(acc, c, rp, Bt, DEXP, DEXP);
#pragma unroll
        for (int mi = 0; mi < 4; ++mi) {
            const int r = wr * 64 + mi * 16 + fr;
            if (r >= nrows) continue;
            const float gt = T.gate[r]; const size_t yrow = (size_t)T.tok[r];
#pragma unroll
            for (int ni = 0; ni < 4; ++ni) store_bf4(Y + yrow * D + nt * 256 + wc * 64 + ni * 16 + fq * 4, acc[mi][ni] * gt);
        }
    }
}

__device__ __forceinline__ int moe_find_l(const LAS int* tstart, int g) {
    int lo = 0, hi = 255;
    while (lo < hi) { const int mid = (lo + hi + 1) >> 1; if (tstart[mid] <= g) lo = mid; else hi = mid - 1; }
    return lo;
}

constexpr int MOE_A = 0, MOE_B = 32768, MOE_H0 = 98304, MOE_H1 = 0, MOE_MISC = 131072;
struct MoeUnit { const float* wg; const float* wu; const float* wd; int nrows; int par; };

__device__ __forceinline__ void phase_moe(const Params& p, const Ctx& c) {
    unsigned char* ws = p.ws;
    const bf16_t* H1 = (const bf16_t*)(ws + WS_H1); bf16_t* Y = (bf16_t*)(ws + WS_Y);
    const unsigned* laid = (const unsigned*)(ws + WS_LAID); const float* lgate = (const float*)(ws + WS_LGATE);
    const unsigned* cnt = (const unsigned*)(ws + WS_CTL + CT_CNT);
    const int tid = c.tid, lane = c.lane, wr = c.wave >> 2, wc = c.wave & 3, fr = lane & 15, fq = lane >> 4;
    LAS unsigned char* lds = c.lds;
    LAS int* tstart = (LAS int*)(lds + MOE_MISC); LAS int* cntl = tstart + 260;
    LAS int* tokT = cntl + 260; LAS int* yrowT = tokT + 256; LAS float* gateT = (LAS float*)(yrowT + 256);
    __syncthreads();
    if (tid < 64) {
        int cv[4], tv[4]; int lt = 0;
#pragma unroll
        for (int i = 0; i < 4; ++i) { cv[i] = (int)cnt[tid * 4 + i]; tv[i] = (cv[i] + 127) >> 7; lt += tv[i]; }
        int pt = lt;
#pragma unroll
        for (int o = 1; o < 64; o <<= 1) { const int b = __shfl_up(pt, o); if (tid >= o) pt += b; }
        int et = pt - lt;
#pragma unroll
        for (int i = 0; i < 4; ++i) { cntl[tid * 4 + i] = cv[i]; tstart[tid * 4 + i] = et; et += tv[i]; }
        if (tid == 63) tstart[256] = et;
    }
    __syncthreads();
    const int tmt = tstart[256], NU = tmt + 128;
    if (c.vcu >= NU) return;

    const int srow = tid >> 3, sch = tid & 7;
    const int soA = srow * 128 + ((sch ^ ((srow >> 1) & 7)) << 4);
    const int kk1 = tid >> 5, n4 = tid & 31;
    const int s1 = (kk1 & 3) | (((kk1 >> 3) & 1) << 2);
    const int soB1g = kk1 * 512 + (((2 * (n4 >> 2)) ^ s1) << 5) + (n4 & 3) * 8;
    const int soB1u = kk1 * 512 + (((2 * (n4 >> 2) + 1) ^ s1) << 5) + (n4 & 3) * 8;
    const int kk2 = tid >> 6, c4 = tid & 63;
    const int soB2e = kk2 * 512 + ((((c4 >> 2)) ^ (kk2 & 3)) << 5) + (c4 & 3) * 8;
    const int soB2o = kk2 * 512 + ((((c4 >> 2)) ^ ((kk2 & 3) | 4)) << 5) + (c4 & 3) * 8;
    const int sw0 = ((0 + fq) ^ ((fr >> 1) & 7)) << 4, sw1 = ((4 + fq) ^ ((fr >> 1) & 7)) << 4;
    const int aoff = (wr * 64 + fr) * 128;
    const int qp = fr >> 2, pp = fr & 3, sB = qp | ((fq & 1) << 2);
    const int brow = (8 * fq + qp) * 512 + pp * 8;
    int bblk[4];
#pragma unroll
    for (int ni = 0; ni < 4; ++ni) bblk[ni] = ((4 * wc + ni) ^ sB) << 5;
    const int hoff = (wr * 64 + fr) * 256;

    const unsigned lo1 = (unsigned)(kk1 * 256 + n4 * 4), lo2 = (unsigned)(kk2 * D + c4 * 4);
    u32x4 ra0, ra1; f32x4 rb[8];
    f32x4 acc[4][4];

#define M_LOAD1(U, nt, kt) do { \
        const int t0_ = tokT[(U).par * 128 + srow], t1_ = tokT[(U).par * 128 + srow + 64]; \
        ra0 = *(const u32x4*)(H1 + (size_t)t0_ * D + (kt) * 64 + sch * 8); ra1 = *(const u32x4*)(H1 + (size_t)t1_ * D + (kt) * 64 + sch * 8); \
        const float* g_ = (U).wg + ((kt) * 64 * 256 + (nt) * 128); const float* u_ = (U).wu + ((kt) * 64 * 256 + (nt) * 128); \
        _Pragma("unroll") for (int j = 0; j < 4; ++j) { rb[j] = *(const f32x4*)(g_ + j * 4096 + lo1); rb[4 + j] = *(const f32x4*)(u_ + j * 4096 + lo1); } } while (0)
#define M_STORE1(buf) do { LAS unsigned char* sa_ = lds + MOE_A + (buf) * 16384; LAS unsigned char* sb_ = lds + MOE_B + (buf) * 32768; \
        *(LAS u32x4*)(sa_ + soA) = ra0; *(LAS u32x4*)(sa_ + soA + 8192) = ra1; \
        _Pragma("unroll") for (int j = 0; j < 4; ++j) { \
            *(LAS u32x2*)(sb_ + soB1g + j * 8192) = (u32x2){cvtpk(rb[j][0], rb[j][1]), cvtpk(rb[j][2], rb[j][3])}; \
            *(LAS u32x2*)(sb_ + soB1u + j * 8192) = (u32x2){cvtpk(rb[4 + j][0], rb[4 + j][1]), cvtpk(rb[4 + j][2], rb[4 + j][3])}; } } while (0)
#define M_LOAD2(U, nt2, ksm) do { \
        const float* d_ = (U).wd + ((ksm) * 64 * D + (nt2) * 256); \
        _Pragma("unroll") for (int j = 0; j < 8; ++j) rb[j] = *(const f32x4*)(d_ + j * 8192 + lo2); } while (0)
#define M_STORE2(buf) do { LAS unsigned char* sb_ = lds + MOE_B + (buf) * 32768; \
        _Pragma("unroll") for (int j = 0; j < 8; ++j) \
            *(LAS u32x2*)(sb_ + ((j & 1) ? soB2o : soB2e) + j * 4096) = (u32x2){cvtpk(rb[j][0], rb[j][1]), cvtpk(rb[j][2], rb[j][3])}; } while (0)
#define M_BFRAG(dst, sbB, ks) do { _Pragma("unroll") for (int ni = 0; ni < 4; ++ni) { \
            const s16x4 lo_ = vtr((sbB) + brow + (ks) * 16384 + bblk[ni]), hi_ = vtr((sbB) + brow + (ks) * 16384 + 2048 + bblk[ni]); \
            dst[ni] = (bf16x8){lo_[0], lo_[1], lo_[2], lo_[3], hi_[0], hi_[1], hi_[2], hi_[3]}; } } while (0)
#define M_COMPUTE1(buf) do { const LAS unsigned char* sa_ = lds + MOE_A + (buf) * 16384; const LAS unsigned char* sbb_ = lds + MOE_B + (buf) * 32768; \
        _Pragma("unroll") for (int ks = 0; ks < 2; ++ks) { bf16x8 af[4], bfr[4]; \
            _Pragma("unroll") for (int mi = 0; mi < 4; ++mi) af[mi] = *(const LAS bf16x8*)(sa_ + aoff + mi * 2048 + (ks ? sw1 : sw0)); \
            M_BFRAG(bfr, sbb_, ks); \
            _Pragma("unroll") for (int mi = 0; mi < 4; ++mi) _Pragma("unroll") for (int ni = 0; ni < 4; ++ni) \
                acc[mi][ni] = __builtin_amdgcn_mfma_f32_16x16x32_bf16(bfr[ni], af[mi], acc[mi][ni], 0, 0, 0); } } while (0)
#define M_COMPUTE2(buf, ksm) do { const LAS unsigned char* sh_ = lds + (((ksm) >> 1) ? MOE_H1 : MOE_H0); const LAS unsigned char* sbb_ = lds + MOE_B + (buf) * 32768; \
        _Pragma("unroll") for (int ks = 0; ks < 2; ++ks) { bf16x8 af[4], bfr[4]; \
            _Pragma("unroll") for (int mi = 0; mi < 4; ++mi) af[mi] = *(const LAS bf16x8*)(sh_ + hoff + mi * 4096 + (((((ksm) & 1) * 8 + ks * 4 + fq) ^ fr) << 4)); \
            M_BFRAG(bfr, sbb_, ks); \
            _Pragma("unroll") for (int mi = 0; mi < 4; ++mi) _Pragma("unroll") for (int ni = 0; ni < 4; ++ni) \
                acc[mi][ni] = __builtin_amdgcn_mfma_f32_16x16x32_bf16(bfr[ni], af[mi], acc[mi][ni], 0, 0, 0); } } while (0)

    auto unit_make = [&](int u, int par, MoeUnit& U, int& e, int& mt) {
        if (u < tmt) { e = moe_find_l(tstart, u); mt = u - tstart[e]; U.nrows = min(128, cntl[e] - mt * 128);
            U.wg = p.w_gate + (size_t)e * D * DEXP; U.wu = p.w_up + (size_t)e * D * DEXP; U.wd = p.w_down + (size_t)e * D * DEXP; }
        else { e = NEXP; mt = u - tmt; U.nrows = 128; U.wg = p.ws_gate; U.wu = p.ws_up; U.wd = p.ws_down; }
        U.par = par;
    };
    auto unit_tables = [&](const MoeUnit& U, int e, int mt) {
        if (tid < 128) {
            int tok, yr; float gt;
            if (e < NEXP) { const int rr = min(tid, U.nrows - 1); const unsigned aid = laid[(size_t)e * CAP + mt * 128 + rr];
                tok = (int)(aid >> 3); yr = tok * 9 + (int)(aid & 7); gt = lgate[(size_t)e * CAP + mt * 128 + rr]; }
            else { tok = mt * 128 + tid; yr = tok * 9 + 8; gt = 1.f; }
            tokT[U.par * 128 + tid] = tok; yrowT[U.par * 128 + tid] = yr; gateT[U.par * 128 + tid] = gt;
        }
    };

    MoeUnit cur, nxt; int e_, mt_;
    unit_make(c.vcu, 0, cur, e_, mt_);
    unit_tables(cur, e_, mt_);
    __syncthreads();
    M_LOAD1(cur, 0, 0);
    M_STORE1(0);
    __syncthreads();
    for (int u = c.vcu, ui = 0; u < NU; u += c.G, ++ui) {
        const bool has_next = (u + c.G) < NU;
#pragma unroll 1
        for (int nt = 0; nt < 2; ++nt) {
            acc_zero(acc);
#pragma unroll 1
            for (int kt = 0; kt < 16; ++kt) {
                const bool last = (kt == 15);
                if (!last) M_LOAD1(cur, nt, kt + 1);
                else if (nt == 0) M_LOAD1(cur, 1, 0);
                else M_LOAD2(cur, 0, 2);
                M_COMPUTE1(kt & 1);
                if (!(last && nt == 1)) M_STORE1((kt + 1) & 1); else M_STORE2(0);
                __syncthreads();
            }
            {
                LAS unsigned char* hb = lds + (nt ? MOE_H1 : MOE_H0);
#pragma unroll
                for (int mi = 0; mi < 4; ++mi) {
                    const int r = wr * 64 + mi * 16 + fr;
#pragma unroll
                    for (int np = 0; np < 2; ++np) {
                        const f32x4 gt = acc[mi][2 * np], up = acc[mi][2 * np + 1];
                        float hv[4];
#pragma unroll
                        for (int j = 0; j < 4; ++j) hv[j] = gt[j] / (1.f + __expf(-gt[j])) * up[j];
                        const int chunk = wc * 4 + np * 2 + (fq >> 1);
                        *(LAS u32x2*)(hb + r * 256 + ((chunk ^ fr) << 4) + (fq & 1) * 8) = (u32x2){cvtpk(hv[0], hv[1]), cvtpk(hv[2], hv[3])};
                    }
                }
            }
            if (nt == 1) __syncthreads();
        }
#pragma unroll 1
        for (int nt2 = 0; nt2 < 4; ++nt2) {
            acc_zero(acc);
            if (nt2 == 0 && has_next) { unit_make(u + c.G, (ui + 1) & 1, nxt, e_, mt_); unit_tables(nxt, e_, mt_); }
#pragma unroll 1
            for (int kq = 0; kq < 4; ++kq) {
                const int ksm = kq ^ 2;
                const bool last = (kq == 3);
                if (!last) M_LOAD2(cur, nt2, (kq + 1) ^ 2);
                else if (nt2 < 3) M_LOAD2(cur, nt2 + 1, 2);
                else if (has_next) M_LOAD1(nxt, 0, 0);
                M_COMPUTE2(kq & 1, ksm);
                if (!(last && nt2 == 3)) M_STORE2((kq + 1) & 1); else if (has_next) M_STORE1(0);
                __syncthreads();
            }
#pragma unroll
            for (int mi = 0; mi < 4; ++mi) {
                const int r = wr * 64 + mi * 16 + fr;
                if (r < cur.nrows) {
                    const float gt = gateT[cur.par * 128 + r]; const size_t yrow = (size_t)yrowT[cur.par * 128 + r];
#pragma unroll
                    for (int ni = 0; ni < 4; ++ni) store_bf4(Y + yrow * D + nt2 * 256 + wc * 64 + ni * 16 + fq * 4, acc[mi][ni] * gt);
                }
            }
        }
        cur = nxt;
    }
#undef M_LOAD1
#undef M_STORE1
#undef M_LOAD2
#undef M_STORE2
#undef M_BFRAG
#undef M_COMPUTE1
#undef M_COMPUTE2
}


__device__ __forceinline__ void store_blk32_bf16(bf16_t* p, const f32x16& v, int hi, bool pred = true) {
#pragma unroll
    for (int pr = 0; pr < 2; ++pr) {
        unsigned ax = cvtpk(v[8 * pr + 0], v[8 * pr + 1]), ay = cvtpk(v[8 * pr + 2], v[8 * pr + 3]);
        unsigned bx = cvtpk(v[8 * pr + 4], v[8 * pr + 5]), by = cvtpk(v[8 * pr + 6], v[8 * pr + 7]);
        { auto r_ = __builtin_amdgcn_permlane32_swap(ax, bx, false, false); ax = r_[0]; bx = r_[1]; }
        { auto r_ = __builtin_amdgcn_permlane32_swap(ay, by, false, false); ay = r_[0]; by = r_[1]; }
        if (pred) *(u32x4*)(p + 16 * pr + (hi ? 8 : 0)) = (u32x4){ax, ay, bx, by};
    }
}

constexpr int G2_A = 0, G2_B = 65536, G2_MISC = 131072;
constexpr int G2_GATE = G2_MISC + 4096, G2_YROW = G2_GATE + 2048, G2_TAB = G2_YROW + 2048;
constexpr int BM_BF16T = 0, BM_F32 = 1, BM_F32_GU = 2;
struct G2Unit { const void* b0; const void* b1; int ldb; int nsteps; int nrows; int par; int i0, i1, i2; int kshift, bsub; };

#define G2_SGB(mask, n) __builtin_amdgcn_sched_group_barrier(mask, n, 0)
#define G2_MFMA_HALF(NMI, KM, kh) do { \
        __builtin_amdgcn_sched_barrier(0); \
        _Pragma("unroll") for (int kq = 0; kq < 2; ++kq) { const int k16_ = 2 * (kh) + kq; bf16x8 bfr[2]; \
            if (KM) { _Pragma("unroll") for (int ni = 0; ni < 2; ++ni) { const int bb_ = ((4 * wc + 2 * ni + bsel) ^ sB2) << 5; \
                const s16x4 lo_ = vtr(sbb_ + brow + k16_ * 8192 + bb_); const s16x4 hi_ = vtr(sbb_ + brow + k16_ * 8192 + 2048 + bb_); \
                bf16x8 t_; t_[0] = lo_[0]; t_[1] = lo_[1]; t_[2] = lo_[2]; t_[3] = lo_[3]; t_[4] = hi_[0]; t_[5] = hi_[1]; t_[6] = hi_[2]; t_[7] = hi_[3]; bfr[ni] = t_; } } \
            else { _Pragma("unroll") for (int ni = 0; ni < 2; ++ni) bfr[ni] = *(const LAS bf16x8*)(sbb_ + boffT + ni * 4096 + (((2 * k16_ + hi) ^ swx) << 4)); } \
            _Pragma("unroll") for (int mi = 0; mi < (NMI); ++mi) { \
                const bf16x8 af_ = *(const LAS bf16x8*)(sa_ + aoff + mi * 8192 + (((2 * k16_ + hi) ^ swx) << 4)); \
                _Pragma("unroll") for (int ni = 0; ni < 2; ++ni) acc[mi][ni] = __builtin_amdgcn_mfma_f32_32x32x16_bf16(bfr[ni], af_, acc[mi][ni], 0, 0, 0); } } \
        if (!(KM)) { _Pragma("unroll") for (int kq = 0; kq < 2; ++kq) { G2_SGB(0x100, 3); \
            _Pragma("unroll") for (int g = 0; g < (NMI) - 1; ++g) { G2_SGB(0x100, 1); G2_SGB(0x008, 2); } \
            G2_SGB(0x008, 2); } } \
        __builtin_amdgcn_sched_barrier(0); \
    } while (0)
#define G2_SEL(off) const int nst_ = st + (off); const bool wrap_ = nst_ >= cur.nsteps, usen_ = wrap_ && has_next; \
        const void* sb0_ = usen_ ? nxt.b0 : cur.b0; const void* sb1_ = usen_ ? nxt.b1 : cur.b1; const int spar_ = usen_ ? nxt.par : cur.par; \
        const int sk0_ = wrap_ ? (has_next ? nst_ - cur.nsteps : cur.nsteps - 1) : nst_; const int ldb_ = cur.ldb; (void)sb1_; \
        const int ssub_ = sk0_ >> cur.kshift, sk_ = sk0_ - (ssub_ << cur.kshift); const int sboff_ = ssub_ * cur.bsub; (void)sboff_

typedef __amdgpu_buffer_rsrc_t rsrc_t;
__device__ __forceinline__ rsrc_t make_rsrc(const void* p) {
    const unsigned long long a = (unsigned long long)(uintptr_t)p;
    const unsigned lo = __builtin_amdgcn_readfirstlane((unsigned)a), hi = __builtin_amdgcn_readfirstlane((unsigned)(a >> 32));
    return __builtin_amdgcn_make_buffer_rsrc((void*)(uintptr_t)(((unsigned long long)hi << 32) | lo), (short)0, 0x7fffffff, 0x00020000);
}
__device__ __forceinline__ u32x4 bload16(rsrc_t r, int voff, int soff) { return __builtin_bit_cast(u32x4, __builtin_amdgcn_raw_buffer_load_b128(r, voff, soff, 0)); }
template <int BMODE, bool FULL, class Sched, class Epi>
__device__ __forceinline__ void gemm256_stream(const Ctx& c, Sched& S, const Epi& E) {
    const int tid = c.tid, lane = c.lane, wr = c.wave >> 2, wc = c.wave & 3, r32 = lane & 31, hi = lane >> 5;
    LAS unsigned char* lds = c.lds;
    const LAS unsigned* rowT = (const LAS unsigned*)(lds + G2_MISC);
    const rsrc_t rsA = make_rsrc(S.abase());
    const int srow = tid >> 3, sch = tid & 7;
    const int soA = srow * 128 + ((sch ^ ((srow >> 1) & 7)) << 4);
    const int kk1 = tid >> 5, n4 = tid & 31;
    const int soB1g = kk1 * 512 + (((2 * (n4 >> 2)) ^ (2 * (kk1 & 3))) << 5) + (n4 & 3) * 8;
    const int soB1u = kk1 * 512 + (((2 * (n4 >> 2) + 1) ^ (2 * (kk1 & 3))) << 5) + (n4 & 3) * 8;
    const int kk2 = tid >> 6, c4 = tid & 63;
    const int soB2 = kk2 * 512 + ((((c4 >> 2)) ^ (2 * (kk2 & 3))) << 5) + (c4 & 3) * 8;
    const int swx = (r32 >> 1) & 7;
    const int aoff = (32 * wr + r32) * 128;
    const int boffT = (wc * 64 + r32) * 128;
    const int qp = (lane & 15) >> 2, pp = lane & 3, bsel = (lane >> 4) & 1, sB2 = 2 * qp;
    const int brow = (8 * hi + qp) * 512 + pp * 8;
    (void)boffT; (void)brow; (void)sB2; (void)bsel; (void)soB1g; (void)soB1u; (void)soB2;
    u32x4 ra[4]; u32x4 rbh[4]; f32x4 rb[8];
    f32x16 acc[4][2];
#define G1_LOAD(b0, b1, par, kst, ldb) do { \
        const LAS unsigned* rt_ = rowT + (par) * 256 + srow; \
        const int ksoff_ = __builtin_amdgcn_readfirstlane((kst) * 128); \
        _Pragma("unroll") for (int j = 0; j < 4; ++j) ra[j] = bload16(rsA, (int)rt_[64 * j] + sch * 16, ksoff_); \
        const rsrc_t rb0_ = make_rsrc(b0); \
        if (BMODE == BM_BF16T) { const int so_ = __builtin_amdgcn_readfirstlane((kst) * 128), js_ = __builtin_amdgcn_readfirstlane(128 * (ldb)); \
            _Pragma("unroll") for (int j = 0; j < 4; ++j) rbh[j] = bload16(rb0_, voB, so_ + j * js_); } \
        else if (BMODE == BM_F32) { const int so_ = __builtin_amdgcn_readfirstlane((kst) * 256 * (ldb)), js_ = __builtin_amdgcn_readfirstlane(32 * (ldb)); \
            _Pragma("unroll") for (int j = 0; j < 8; ++j) rb[j] = __builtin_bit_cast(f32x4, bload16(rb0_, voB, so_ + j * js_)); } \
        else { const rsrc_t rb1_ = make_rsrc(b1); const int so_ = __builtin_amdgcn_readfirstlane((kst) * 256 * (ldb)), js_ = __builtin_amdgcn_readfirstlane(64 * (ldb)); \
            _Pragma("unroll") for (int j = 0; j < 4; ++j) { rb[j] = __builtin_bit_cast(f32x4, bload16(rb0_, voB, so_ + j * js_)); rb[4 + j] = __builtin_bit_cast(f32x4, bload16(rb1_, voB, so_ + j * js_)); } } \
    } while (0)
#define G1_STORE(buf) do { LAS unsigned char* sa_ = lds + G2_A + (buf) * 32768; LAS unsigned char* sb_ = lds + G2_B + (buf) * 32768; \
        _Pragma("unroll") for (int j = 0; j < 4; ++j) *(LAS u32x4*)(sa_ + soA + j * 8192) = ra[j]; \
        if (BMODE == BM_BF16T) { _Pragma("unroll") for (int j = 0; j < 4; ++j) *(LAS u32x4*)(sb_ + soA + j * 8192) = rbh[j]; } \
        else if (BMODE == BM_F32) { _Pragma("unroll") for (int j = 0; j < 8; ++j) \
            *(LAS u32x2*)(sb_ + soB2 + j * 4096) = (u32x2){cvtpk(rb[j][0], rb[j][1]), cvtpk(rb[j][2], rb[j][3])}; } \
        else { _Pragma("unroll") for (int j = 0; j < 4; ++j) { \
            *(LAS u32x2*)(sb_ + soB1g + j * 8192) = (u32x2){cvtpk(rb[j][0], rb[j][1]), cvtpk(rb[j][2], rb[j][3])}; \
            *(LAS u32x2*)(sb_ + soB1u + j * 8192) = (u32x2){cvtpk(rb[4 + j][0], rb[4 + j][1]), cvtpk(rb[4 + j][2], rb[4 + j][3])}; } } \
    } while (0)
    G2Unit cur, nxt;
    if (!S.next(cur, 0)) return;
    nxt = cur;
    const int voB = BMODE == BM_BF16T ? (srow * cur.ldb + sch * 8) * 2 : BMODE == BM_F32 ? (kk2 * cur.ldb + c4 * 4) * 4 : (kk1 * cur.ldb + n4 * 4) * 4;
    __syncthreads();
    G1_LOAD(cur.b0, cur.b1, cur.par, 0, cur.ldb);
    G1_STORE(0);
    G1_LOAD(cur.b0, cur.b1, cur.par, 1, cur.ldb);
    __syncthreads();
    int gs = 0;
    bool has_cur = true;
    while (has_cur) {
#pragma unroll
        for (int a = 0; a < 4; ++a)
#pragma unroll
            for (int b = 0; b < 2; ++b)
#pragma unroll
                for (int r = 0; r < 16; ++r) acc[a][b][r] = 0.f;
        const int nb = (cur.nrows + 31) >> 5, nmi = (nb - wr + 1) >> 1;
        bool has_next = false;
#define G1_UNIT_LOOP(NMI) do { _Pragma("unroll 1") for (int st = 0; st < cur.nsteps; ++st) { \
            if (st == 1) has_next = S.next(nxt, cur.par ^ 1);     \
            if (st == 0) S.issue(); \
            { const LAS unsigned char* sa_ = lds + G2_A + (gs & 1) * 32768; const LAS unsigned char* sbb_ = lds + G2_B + (gs & 1) * 32768; \
              G2_MFMA_HALF(NMI, BMODE != BM_BF16T, 0); \
              G1_STORE((gs + 1) & 1);                             \
              __builtin_amdgcn_sched_barrier(0); \
              { G2_SEL(2); G1_LOAD((BMODE == BM_F32 ? (const void*)((const float*)sb0_ + sboff_) : sb0_), sb1_, spar_, sk_, ldb_); }     \
              G2_MFMA_HALF(NMI, BMODE != BM_BF16T, 1); } \
            if (st == 0) S.commit(); \
            __syncthreads(); \
            ++gs; \
            if (Epi::HAS_MID) E.mid(acc, cur, st, nmi, wr, r32); } } while (0)
        if (FULL || nmi >= 4) G1_UNIT_LOOP(4); else if (nmi == 3) G1_UNIT_LOOP(3); else if (nmi == 2) G1_UNIT_LOOP(2); else G1_UNIT_LOOP(1);
#undef G1_UNIT_LOOP
        E(acc, cur, nmi, wr, wc, r32, hi);
        cur = nxt; has_cur = has_next;
    }
#undef G1_LOAD
#undef G1_STORE
}

struct MoeSched2 {
    const Params& p; const Ctx& c; int NT; bool isB; int tru, NU, i;
    LAS int* tstart; LAS int* roff; LAS int* cntl; LAS int* rpuT; LAS int* qslot; unsigned* qctr; unsigned pend;
    __device__ __forceinline__ const void* abase() const { return isB ? p.ws + WS_HID : p.ws + WS_H1; }
    __device__ __forceinline__ void issue() { if (c.tid == 0) pend = __hip_atomic_fetch_add(qctr, 1u, __ATOMIC_RELAXED, __HIP_MEMORY_SCOPE_AGENT); }
    __device__ __forceinline__ void commit() { if (c.tid == 0) qslot[0] = (int)(32u + pend); }
    __device__ __forceinline__ MoeSched2(const Params& p_, const Ctx& c_, int NT_, bool isB_) : p(p_), c(c_), NT(NT_), isB(isB_), i(0) {
        tstart = (LAS int*)(c.lds + G2_TAB); roff = tstart + 260; cntl = roff + 260; rpuT = cntl + 260; qslot = rpuT + 260; pend = 0;
        qctr = (unsigned*)(p.ws + WS_CTL + CT_Q) + (isB_ ? 8 * 64 : 0) + (c.vcu >> 5) * 64;
        const unsigned* cnt = (const unsigned*)(p.ws + WS_CTL + CT_CNT);
        __syncthreads();
        if (c.tid < 64) {
            int cv[4], tv[4], rp[4]; int ls = 0, lt = 0;
#pragma unroll
            for (int k = 0; k < 4; ++k) { cv[k] = (int)cnt[c.tid * 4 + k]; tv[k] = (cv[k] + 255) >> 8; rp[k] = tv[k] ? ((((cv[k] + tv[k] - 1) / tv[k]) + 31) & ~31) : 0; ls += cv[k]; lt += tv[k]; }
            int ps = ls, pt = lt;
#pragma unroll
            for (int o = 1; o < 64; o <<= 1) { const int a = __shfl_up(ps, o), b = __shfl_up(pt, o); if (c.tid >= o) { ps += a; pt += b; } }
            int es = ps - ls, et = pt - lt;
#pragma unroll
            for (int k = 0; k < 4; ++k) { cntl[c.tid * 4 + k] = cv[k]; rpuT[c.tid * 4 + k] = rp[k]; roff[c.tid * 4 + k] = es; tstart[c.tid * 4 + k] = et; es += cv[k]; et += tv[k]; }
            if (c.tid == 63) { roff[256] = es; tstart[256] = et; }
        }
        __syncthreads();
        tru = tstart[256]; NU = (tru + 64) * NT;
    }
    __device__ __forceinline__ bool next(G2Unit& U, int par) {
        int tid_ = c.tid; asm volatile("" : "+v"(tid_));
        const int NUx = (NU + 7) >> 3, xg = c.vcu >> 5, pos = (i == 0) ? (c.vcu & 31) : qslot[0]; ++i;
        const int idx = xg * NUx + pos;
        if (pos >= NUx || idx >= NU) return false;
        const int g = idx / NT, nt = idx - g * NT;
        int e, r0, nrows; size_t hbase, lbase = 0;
        if (g < tru) { e = moe_find_l(tstart, g); const int ui = g - tstart[e], rpu = rpuT[e]; r0 = ui * rpu; nrows = min(rpu, cntl[e] - r0); hbase = (size_t)roff[e] + r0; lbase = (size_t)e * CAP + r0; }
        else { e = NEXP; r0 = (g - tru) * 256; nrows = 256; hbase = (size_t)NTOK * 8 + r0; }
        U.nrows = nrows; U.par = par; U.i0 = (int)hbase; U.i1 = nt; U.i2 = 0; U.kshift = 30; U.bsub = 0;
        const unsigned* laid = (const unsigned*)(p.ws + WS_LAID); const float* lgate = (const float*)(p.ws + WS_LGATE);
        LAS unsigned* rowT = (LAS unsigned*)(c.lds + G2_MISC) + par * 256;
        if (!isB) {
            U.b0 = (e < NEXP ? p.w_gate + (size_t)e * D * DEXP : p.ws_gate) + nt * 128; U.b1 = (e < NEXP ? p.w_up + (size_t)e * D * DEXP : p.ws_up) + nt * 128;
            U.ldb = DEXP; U.nsteps = D / 64;
            if (tid_ < 256) {
                const int rr = min(tid_, nrows - 1);
                const int tok = e < NEXP ? (int)(laid[lbase + rr] >> 3) : r0 + rr;
                rowT[tid_] = (unsigned)tok * (D * 2);
            }
        } else {
            U.b0 = (e < NEXP ? p.w_down + (size_t)e * DEXP * D : p.ws_down) + nt * 256; U.b1 = nullptr;
            U.ldb = D; U.nsteps = DEXP / 64;
            if (tid_ < 256) {
                const int rr = min(tid_, nrows - 1);
                rowT[tid_] = (unsigned)(hbase + rr) * (DEXP * 2);
                int yr; float gt;
                if (e < NEXP) { const unsigned aid = laid[lbase + rr]; yr = (int)((aid >> 3) * 9 + (aid & 7)); gt = lgate[lbase + rr]; }
                else { yr = (r0 + rr) * 9 + 8; gt = 1.f; }
                ((LAS float*)(c.lds + G2_GATE))[par * 256 + tid_] = gt; ((LAS int*)(c.lds + G2_YROW))[par * 256 + tid_] = yr;
            }
        }
        return true;
    }
};
struct EpiMoeA {
    static constexpr bool HAS_MID = false, HAS_SUB = false;
    bf16_t* HID;
    __device__ __forceinline__ void mid(f32x16 (&)[4][2], const G2Unit&, int, int, int, int) const {}
    __device__ __forceinline__ void operator()(f32x16 (&acc)[4][2], const G2Unit& U, int nmi, int wr, int wc, int r32, int hi) const {
        asm volatile("" : "+v"(r32), "+v"(hi));
#pragma unroll
        for (int mi = 0; mi < 4; ++mi) {
            if (mi < nmi) {
                const int r = 64 * mi + 32 * wr + r32;
#pragma unroll
                for (int ni = 0; ni < 2; ++ni) {
                    float hv[8];
#pragma unroll
                    for (int q = 0; q < 8; ++q) { const float gt = acc[mi][ni][q], up = acc[mi][ni][q + 8]; hv[q] = gt / (1.f + __expf(-gt)) * up; }
                    unsigned ax = cvtpk(hv[0], hv[1]), ay = cvtpk(hv[2], hv[3]), bx = cvtpk(hv[4], hv[5]), by = cvtpk(hv[6], hv[7]);
                    { auto r_ = __builtin_amdgcn_permlane32_swap(ax, bx, false, false); ax = r_[0]; bx = r_[1]; }
                    { auto r_ = __builtin_amdgcn_permlane32_swap(ay, by, false, false); ay = r_[0]; by = r_[1]; }
                    if (r < U.nrows) *(u32x4*)(HID + ((size_t)U.i0 + r) * DEXP + U.i1 * 128 + (2 * wc + ni) * 16 + (hi ? 8 : 0)) = (u32x4){ax, ay, bx, by};
                }
            }
        }
    }
};
constexpr float Y8_SCALE = 64.f;
struct EpiMoeB {
    static constexpr bool HAS_MID = false, HAS_SUB = false;
    unsigned char* Y8; const LAS float* gateT; const LAS int* yrowT;
    __device__ __forceinline__ void mid(f32x16 (&)[4][2], const G2Unit&, int, int, int, int) const {}
    __device__ __forceinline__ void operator()(f32x16 (&acc)[4][2], const G2Unit& U, int nmi, int wr, int wc, int r32, int hi) const {
        asm volatile("" : "+v"(r32), "+v"(hi));
#pragma unroll
        for (int mi = 0; mi < 4; ++mi) {
            if (mi < nmi) {
                const int r = 64 * mi + 32 * wr + r32;
                const float gt = gateT[U.par * 256 + r] * Y8_SCALE; const size_t yrow = (size_t)yrowT[U.par * 256 + r];
#pragma unroll
                for (int ni = 0; ni < 2; ++ni) {
                    unsigned d[4];
#pragma unroll
                    for (int g = 0; g < 4; ++g) {
                        int wv = __builtin_amdgcn_cvt_pk_fp8_f32(acc[mi][ni][4 * g] * gt, acc[mi][ni][4 * g + 1] * gt, 0, false);
                        wv = __builtin_amdgcn_cvt_pk_fp8_f32(acc[mi][ni][4 * g + 2] * gt, acc[mi][ni][4 * g + 3] * gt, wv, true);
                        d[g] = (unsigned)wv;
                    }
                    { auto r_ = __builtin_amdgcn_permlane32_swap(d[0], d[1], false, false); d[0] = r_[0]; d[1] = r_[1]; }
                    { auto r_ = __builtin_amdgcn_permlane32_swap(d[2], d[3], false, false); d[2] = r_[0]; d[3] = r_[1]; }
                    { auto r_ = __builtin_amdgcn_permlane32_swap(d[0], d[2], false, false); d[0] = r_[0]; d[2] = r_[1]; }
                    { auto r_ = __builtin_amdgcn_permlane32_swap(d[1], d[3], false, false); d[1] = r_[0]; d[3] = r_[1]; }
                    if (r < U.nrows) *(u32x4*)(Y8 + yrow * D + U.i1 * 256 + wc * 64 + ni * 32 + (hi ? 16 : 0)) = (u32x4){d[0], d[1], d[2], d[3]};
                }
            }
        }
    }
};
__device__ __forceinline__ void phase_moeA(const Params& p, const Ctx& c) {
    MoeSched2 S(p, c, 2, false);
    EpiMoeA E{(bf16_t*)(p.ws + WS_HID)};
    gemm256_stream<BM_F32_GU, false>(c, S, E);
}
__device__ __forceinline__ void phase_moeB(const Params& p, const Ctx& c) {
    MoeSched2 S(p, c, 4, true);
    EpiMoeB E{(unsigned char*)(p.ws + WS_Y), (const LAS float*)(c.lds + G2_GATE), (const LAS int*)(c.lds + G2_YROW)};
    gemm256_stream<BM_F32, false>(c, S, E);
}


struct Sched1 {
    const Params& p; const Ctx& c; int i;
    __device__ __forceinline__ const void* abase() const { return p.ws + WS_H0; }
    __device__ __forceinline__ void issue() {}
    __device__ __forceinline__ void commit() {}
    static constexpr int MT = 256, NMT = (NROWS + MT - 1) / MT, NU = NMT * 9;
    __device__ __forceinline__ bool next(G2Unit& U, int par) {
        const int idx = c.vcu + i * c.G; ++i;
        if (idx >= NU) return false;
        const int mt = idx / 9, nt = idx - mt * 9, row0 = mt * MT, nrows = min(MT, NROWS - row0);
        U.b0 = (const bf16_t*)(p.ws + WS_WIN) + (size_t)nt * 256 * D; U.b1 = nullptr; U.ldb = D; U.nsteps = D / 64; U.nrows = nrows; U.par = par; U.i0 = row0; U.i1 = nt; U.i2 = 0; U.kshift = 30; U.bsub = 0;
        if (c.tid < 256) ((LAS unsigned*)(c.lds + G2_MISC))[par * 256 + c.tid] = (unsigned)(row0 + min(c.tid, nrows - 1)) * (D * 2);
        return true;
    }
};
struct Epi1 {
    static constexpr bool HAS_MID = false, HAS_SUB = false;
    bf16_t* Z; float* psq;
    __device__ __forceinline__ void mid(f32x16 (&)[4][2], const G2Unit&, int, int, int, int) const {}
    __device__ __forceinline__ void operator()(f32x16 (&acc)[4][2], const G2Unit& U, int nmi, int wr, int wc, int r32, int hi) const {
        asm volatile("" : "+v"(r32), "+v"(hi));
        const int s0 = U.i1 * 256 + wc * 64;
#pragma unroll
        for (int mi = 0; mi < 4; ++mi) {
            if (mi < nmi) {
                const int r = 64 * mi + 32 * wr + r32, row = U.i0 + min(r, U.nrows - 1);
                float ss = 0.f;
#pragma unroll
                for (int ni = 0; ni < 2; ++ni) {
                    store_blk32_bf16(Z + (size_t)row * ZC + s0 + ni * 32, acc[mi][ni], hi, r < U.nrows);
#pragma unroll
                    for (int q = 0; q < 16; ++q) ss += acc[mi][ni][q] * acc[mi][ni][q];
                }
                if (s0 < ZKPE) {
                    ss += __shfl_xor(ss, 32);
                    if (hi == 0 && r < U.nrows) psq[(size_t)row * 16 + (s0 >> 6)] = ss;
                }
            }
        }
    }
};
__device__ __forceinline__ void phase1_g2(const Params& p, const Ctx& c) {
    Sched1 S{p, c, 0};
    Epi1 E{(bf16_t*)(p.ws + WS_Z), (float*)(p.ws + WS_PSQ)};
    gemm256_stream<BM_BF16T, true>(c, S, E);
}

struct Sched4 {
    const Params& p; const Ctx& c; int i;
    __device__ __forceinline__ const void* abase() const { return p.ws + WS_ATT; }
    __device__ __forceinline__ void issue() {}
    __device__ __forceinline__ void commit() {}
    __device__ __forceinline__ bool next(G2Unit& U, int par) {
        const int idx = c.vcu + i * c.G; ++i;
        if (idx >= 256) return false;
        const int mt = idx >> 2, nt = idx & 3, row0 = mt * 256;
        U.b0 = (const bf16_t*)(p.ws + WS_WO) + (size_t)nt * 256 * D; U.b1 = nullptr; U.ldb = D; U.nsteps = D / 64; U.nrows = 256; U.par = par; U.i0 = row0; U.i1 = nt; U.i2 = 0; U.kshift = 30; U.bsub = 0;
        if (c.tid < 256) {
            const int row = row0 + c.tid;
            ((LAS unsigned*)(c.lds + G2_MISC))[par * 256 + c.tid] = (unsigned)row * (D * 2);
            const float* patt = (const float*)(p.ws + WS_PATT);
            const f32x4 pa = *(const f32x4*)(patt + (size_t)row * 8), pb = *(const f32x4*)(patt + (size_t)row * 8 + 4);
            const float ra = rsqrtf((((pa[0] + pa[1]) + (pa[2] + pa[3])) + ((pb[0] + pb[1]) + (pb[2] + pb[3]))) * (1.f / 512) + 1e-6f);
            const float rc = rsqrtf(((const float*)(p.ws + WS_SSQC))[row] * (1.f / 512) + 1e-6f);
            ((LAS float*)(c.lds + G2_GATE))[par * 256 + c.tid] = ra / rc; ((LAS float*)(c.lds + G2_YROW))[par * 256 + c.tid] = rc;
        }
        return true;
    }
};
struct Epi4 {
    static constexpr bool HAS_MID = true, HAS_SUB = false;
    const LAS float* fT; const LAS float* rcT; const bf16_t* H0; bf16_t* Y1; float* pst;
    __device__ __forceinline__ void mid(f32x16 (&acc)[4][2], const G2Unit& U, int st, int nmi, int wr, int r32) const {
        if (st != 7) return;
#pragma unroll
        for (int mi = 0; mi < 4; ++mi) {
            const float f = fT[U.par * 256 + 64 * mi + 32 * wr + r32];
#pragma unroll
            for (int ni = 0; ni < 2; ++ni)
#pragma unroll
                for (int q = 0; q < 16; ++q) acc[mi][ni][q] *= f;
        }
    }
    __device__ __forceinline__ void operator()(f32x16 (&acc)[4][2], const G2Unit& U, int nmi, int wr, int wc, int r32, int hi) const {
        asm volatile("" : "+v"(r32), "+v"(hi));
        const int s0 = U.i1 * 256 + wc * 64;
#pragma unroll
        for (int mi = 0; mi < 4; ++mi) {
            const int r = 64 * mi + 32 * wr + r32, row = U.i0 + r;
            const float rc = rcT[U.par * 256 + r];
            float s = 0.f, ss = 0.f;
#pragma unroll
            for (int ni = 0; ni < 2; ++ni) {
                f32x16 v;
#pragma unroll
                for (int g = 0; g < 4; ++g) {
                    const u32x2 hw = *(const u32x2*)(H0 + (size_t)row * D + s0 + ni * 32 + 8 * g + 4 * hi);
                    v[4 * g + 0] = acc[mi][ni][4 * g + 0] * rc + ALPHA * bflo(hw.x); v[4 * g + 1] = acc[mi][ni][4 * g + 1] * rc + ALPHA * bfhi(hw.x);
                    v[4 * g + 2] = acc[mi][ni][4 * g + 2] * rc + ALPHA * bflo(hw.y); v[4 * g + 3] = acc[mi][ni][4 * g + 3] * rc + ALPHA * bfhi(hw.y);
                }
#pragma unroll
                for (int q = 0; q < 16; ++q) { s += v[q]; ss += v[q] * v[q]; }
                store_blk32_bf16(Y1 + (size_t)row * D + s0 + ni * 32, v, hi);
            }
            s += __shfl_xor(s, 32); ss += __shfl_xor(ss, 32);
            if (hi == 0) { float* q = pst + ((size_t)row * 16 + U.i1 * 4 + wc) * 2; q[0] = s; q[1] = ss; }
        }
    }
};
__device__ __forceinline__ void phase4_g2(const Params& p, const Ctx& c) {
    Sched4 S{p, c, 0};
    Epi4 E{(const LAS float*)(c.lds + G2_GATE), (const LAS float*)(c.lds + G2_YROW), (const bf16_t*)(p.ws + WS_H0), (bf16_t*)(p.ws + WS_Y1), (float*)(p.ws + WS_PST)};
    gemm256_stream<BM_BF16T, true>(c, S, E);
}


struct Sched2 {
    const Params& p; const Ctx& c; int i; bool kv;
    __device__ __forceinline__ const void* abase() const { return p.ws + WS_Z; }
    __device__ __forceinline__ void issue() {}
    __device__ __forceinline__ void commit() {}
    __device__ __forceinline__ bool next(G2Unit& U, int par) {
        const int NT = kv ? 4 : 3, NU = kv ? 65 * 4 : 64 * 3;
        const int idx = (kv ? ((c.vcu + 64) & 255) : c.vcu) + i * 256; ++i;
        if (idx >= NU) return false;
        const int mt = idx / NT, nt = idx - mt * NT, row0 = mt * 256, nrows = min(256, (kv ? NROWS : NTOK) - row0);
        const int K = kv ? KVLORA : QLORA;
        U.b0 = (const bf16_t*)(p.ws + (kv ? WS_WUKV : WS_WUQ)) + (size_t)nt * 256 * K; U.b1 = nullptr; U.ldb = K; U.nsteps = K / 64; U.nrows = nrows; U.par = par;
        U.i0 = row0; U.i1 = nt; U.i2 = 0; U.kshift = 30; U.bsub = 0;
        if (c.tid < 256) ((LAS unsigned*)(c.lds + G2_MISC))[par * 256 + c.tid] = (unsigned)(row0 + min(c.tid, nrows - 1)) * (ZC * 2) + (kv ? ZKV : ZQ) * 2;
        return true;
    }
};
struct Epi2q {
    static constexpr bool HAS_MID = false, HAS_SUB = false;
    const float* psq; const float* rope; bf16_t* Q;
    __device__ __forceinline__ void mid(f32x16 (&)[4][2], const G2Unit&, int, int, int, int) const {}
    __device__ __forceinline__ void operator()(f32x16 (&acc)[4][2], const G2Unit& U, int nmi, int wr, int wc, int r32, int hi) const {
        asm volatile("" : "+v"(r32), "+v"(hi));
#pragma unroll
        for (int mi = 0; mi < 4; ++mi) {
            const int row = U.i0 + 64 * mi + 32 * wr + r32;
            const f32x4 pa = *(const f32x4*)(psq + (size_t)row * 16), pb = *(const f32x4*)(psq + (size_t)row * 16 + 4);
            const float rq = rsqrtf((((pa[0] + pa[1]) + (pa[2] + pa[3])) + (pb[0] + pb[1])) * (1.f / QLORA) + 1e-6f) * QSCALE;
            const int pos = NMETA + (row & (SEQ - 1));
#pragma unroll
            for (int ni = 0; ni < 2; ++ni) {
                const int c0 = U.i1 * 256 + wc * 64 + ni * 32;
                f32x16 v = acc[mi][ni];
#pragma unroll
                for (int q = 0; q < 16; ++q) v[q] *= rq;
                if ((c0 % 96) == 64) {
#pragma unroll
                    for (int g = 0; g < 2; ++g) {
                        const float* rp = rope + ((size_t)pos * 16 + 8 * g + 4 * hi) * 2;
                        const f32x4 cs0 = *(const f32x4*)rp, cs1 = *(const f32x4*)(rp + 4);
                        const float co[4] = {cs0[0], cs0[2], cs1[0], cs1[2]}, si[4] = {cs0[1], cs0[3], cs1[1], cs1[3]};
#pragma unroll
                        for (int j = 0; j < 4; ++j) { const float x1 = v[4 * g + j], x2 = v[4 * g + j + 8]; v[4 * g + j] = x1 * co[j] - x2 * si[j]; v[4 * g + j + 8] = x2 * co[j] + x1 * si[j]; }
                    }
                }
                store_blk32_bf16(Q + (size_t)row * 768 + c0, v, hi);
            }
        }
    }
};
struct Epi2kv {
    static constexpr bool HAS_MID = false, HAS_SUB = false;
    const float* psq; bf16_t* Kb; bf16_t* Vb;
    __device__ __forceinline__ void mid(f32x16 (&)[4][2], const G2Unit&, int, int, int, int) const {}
    __device__ __forceinline__ void operator()(f32x16 (&acc)[4][2], const G2Unit& U, int nmi, int wr, int wc, int r32, int hi) const {
        asm volatile("" : "+v"(r32), "+v"(hi));
        const int s0 = U.i1 * 256 + wc * 64, h = s0 >> 7; const bool isv = (s0 & 64) != 0;
#pragma unroll
        for (int mi = 0; mi < 4; ++mi) {
            if (mi < nmi) {
                const int r = 64 * mi + 32 * wr + r32, row = U.i0 + min(r, U.nrows - 1);
                const f32x4 pa = *(const f32x4*)(psq + (size_t)row * 16 + 4), pb = *(const f32x4*)(psq + (size_t)row * 16 + 8);
                const float rk = rsqrtf(((pa[2] + pa[3]) + (pb[0] + pb[1])) * (1.f / KVLORA) + 1e-6f);
                const bool meta = U.i0 >= NTOK;
                const int ncopy = meta ? NBATCH : 1;
                const int pos = meta ? row - NTOK : NMETA + (row & (SEQ - 1));
#pragma unroll
                for (int ni = 0; ni < 2; ++ni) {
                    f32x16 v = acc[mi][ni];
#pragma unroll
                    for (int q = 0; q < 16; ++q) v[q] *= rk;
                    for (int bb = 0; bb < ncopy; ++bb) {
                        const size_t prow = (size_t)(meta ? bb : (row >> 11)) * LPOS + pos;
                        bf16_t* dst = isv ? Vb + prow * 512 + h * 64 + ni * 32 : Kb + prow * 768 + h * 96 + ni * 32;
                        store_blk32_bf16(dst, v, hi, r < U.nrows);
                    }
                }
            }
        }
    }
};

__device__ __forceinline__ void phase2_gemms(const Params& p, const Ctx& c) {
    { Sched2 S{p, c, 0, false}; Epi2q E{(const float*)(p.ws + WS_PSQ), (const float*)(p.ws + WS_ROPE), (bf16_t*)(p.ws + WS_Q)}; gemm256_stream<BM_BF16T, true>(c, S, E); }
    __syncthreads();
    { Sched2 S{p, c, 0, true}; Epi2kv E{(const float*)(p.ws + WS_PSQ), (bf16_t*)(p.ws + WS_K), (bf16_t*)(p.ws + WS_V)}; gemm256_stream<BM_BF16T, false>(c, S, E); }
}

__device__ __forceinline__ void phase8(const Params& p, const Ctx& c) {
    unsigned char* ws = p.ws;
    const bf16_t* H1 = (const bf16_t*)(ws + WS_H1); const unsigned char* Y8 = (const unsigned char*)(ws + WS_Y);
    const int gw = c.vcu * NWAVES + c.wave, NGW = c.G * NWAVES, lane = c.lane;
    const int col = lane * 16;
    float gg[16], bb[16];
#pragma unroll
    for (int e = 0; e < 4; ++e) { const f32x4 g4 = *(const f32x4*)(p.ln2_g + col + 4 * e), b4 = *(const f32x4*)(p.ln2_b + col + 4 * e);
#pragma unroll
        for (int q = 0; q < 4; ++q) { gg[4 * e + q] = g4[q]; bb[4 * e + q] = b4[q]; } }
    for (int t = gw; t < NTOK; t += NGW) {
        float v[16], y[16];
        const u32x4 w0 = *(const u32x4*)(H1 + (size_t)t * D + col), w1 = *(const u32x4*)(H1 + (size_t)t * D + col + 8);
#pragma unroll
        for (int e = 0; e < 4; ++e) { v[2 * e] = ALPHA * bflo(w0[e]); v[2 * e + 1] = ALPHA * bfhi(w0[e]); v[8 + 2 * e] = ALPHA * bflo(w1[e]); v[8 + 2 * e + 1] = ALPHA * bfhi(w1[e]); }
#pragma unroll
        for (int e = 0; e < 16; ++e) y[e] = 0.f;
#pragma unroll
        for (int k = 0; k < 9; ++k) {
            const u32x4 yw = *(const u32x4*)(Y8 + ((size_t)t * 9 + k) * D + col);
#pragma unroll
            for (int e = 0; e < 4; ++e) {
                const f32x2 lo = __builtin_amdgcn_cvt_pk_f32_fp8((int)yw[e], false), hi2 = __builtin_amdgcn_cvt_pk_f32_fp8((int)yw[e], true);
                y[4 * e] += lo[0]; y[4 * e + 1] += lo[1]; y[4 * e + 2] += hi2[0]; y[4 * e + 3] += hi2[1];
            }
        }
        float s = 0.f;
#pragma unroll
        for (int e = 0; e < 16; ++e) { v[e] += y[e] * (1.f / Y8_SCALE); s += v[e]; }
        const float mean = wave_sum(s) * (1.f / D);
        float ss = 0.f;
#pragma unroll
        for (int e = 0; e < 16; ++e) { v[e] -= mean; ss += v[e] * v[e]; }
        const float rstd = rsqrtf(wave_sum(ss) * (1.f / D) + 1e-5f);
#pragma unroll
        for (int e = 0; e < 4; ++e) {
            f32x4 o;
#pragma unroll
            for (int q = 0; q < 4; ++q) o[q] = v[4 * e + q] * rstd * gg[4 * e + q] + bb[4 * e + q];
            *(f32x4*)(p.out + (size_t)t * D + col + 4 * e) = o;
        }
    }
}


#define XB_TMO      128
#define XB_XCNT(j)  (256  + 64 * (j))
#define XB_XSUB(j)  (1280 + 64 * (j))
#define XB_XGEN(j)  (2304 + 64 * (j))
#define XB_TOP      3328
#define XB_TOPGEN   3392
#define XB_SPIN_CAP (1u << 22)
__device__ __forceinline__ unsigned xb_ld(unsigned* p)              { return __hip_atomic_load(p, __ATOMIC_RELAXED, __HIP_MEMORY_SCOPE_AGENT); }
__device__ __forceinline__ unsigned xb_add(unsigned* p, unsigned v) { return __hip_atomic_fetch_add(p, v, __ATOMIC_RELAXED, __HIP_MEMORY_SCOPE_AGENT); }
__device__ __forceinline__ unsigned xb_xcc_id() { return (unsigned)__builtin_amdgcn_s_getreg((3 << 11) | 20) & 0xFu; }
#define XB_SPIN(cond, bar) do { unsigned _sp = 0; while (cond) { __builtin_amdgcn_s_sleep(1); \
    if ((++_sp & 255u) == 0u) { if (xb_ld(&(bar)[XB_TMO])) break; if (_sp > XB_SPIN_CAP) { atomicAdd(&(bar)[XB_TMO], 1u); break; } } } } while (0)
struct XcdBarrier { unsigned* bar; unsigned x; volatile LAS unsigned* st; };
__device__ __forceinline__ XcdBarrier xcd_barrier_post(unsigned* bar, volatile LAS unsigned* st) {
    XcdBarrier b; b.bar = bar; b.x = xb_xcc_id(); b.st = st;
    if (threadIdx.x == 0) (void)xb_add(&bar[XB_XCNT(b.x)], 1u);
    return b;
}
__device__ __forceinline__ void xcd_barrier_complete(unsigned* bar, unsigned x, unsigned& nloc, unsigned& nx) {
    const unsigned G = gridDim.x * gridDim.y * gridDim.z;
    unsigned sum, cnt, mine, sp = 0u;
    for (;;) {
        sum = 0u; cnt = 0u; mine = 0u;
#pragma unroll
        for (unsigned j = 0; j < 16; ++j) { const unsigned c = xb_ld(&bar[XB_XCNT(j)]); sum += c; cnt += (c > 0u) ? 1u : 0u; mine = (j == x) ? c : mine; }
        if (sum == G) break;
        __builtin_amdgcn_s_sleep(1);
        if ((++sp & 255u) == 0u) { if (xb_ld(&bar[XB_TMO])) break; if (sp > XB_SPIN_CAP) { atomicAdd(&bar[XB_TMO], 1u); break; } }
    }
    nloc = mine > 0u ? mine : 1u; nx = cnt > 0u ? cnt : 1u;
}
__device__ __forceinline__ void xcd_barrier(const XcdBarrier& b) {
    asm volatile("s_waitcnt vmcnt(0)" ::: "memory");
    __syncthreads();
    if (threadIdx.x == 0) {
        unsigned* bar = b.bar;
        __builtin_amdgcn_s_waitcnt(0);
        unsigned nloc = b.st[0], nx = b.st[1];
        if (nloc == 0u) { xcd_barrier_complete(bar, b.x, nloc, nx); b.st[0] = nloc; b.st[1] = nx; }
        const unsigned old = xb_add(&bar[XB_XSUB(b.x)], 1u);
        const unsigned gen = old / nloc;
        if (old + 1u == (gen + 1u) * nloc) {
            __builtin_amdgcn_fence(__ATOMIC_RELEASE, "agent");
            asm volatile("s_waitcnt vmcnt(0)" ::: "memory");
            const unsigned og = xb_add(&bar[XB_TOP], 1u);
            const unsigned tg = og / nx;
            if (og + 1u == (tg + 1u) * nx) xb_add(&bar[XB_TOPGEN], 1u);
            else XB_SPIN(xb_ld(&bar[XB_TOPGEN]) == tg, bar);
            __builtin_amdgcn_fence(__ATOMIC_ACQUIRE, "agent");
            xb_add(&bar[XB_XGEN(b.x)], 1u);
            asm volatile("s_waitcnt vmcnt(0)" ::: "memory");
        } else {
            XB_SPIN(xb_ld(&bar[XB_XGEN(b.x)]) == gen, bar);
            __builtin_amdgcn_fence(__ATOMIC_ACQUIRE, "agent");
            asm volatile("s_waitcnt vmcnt(0)" ::: "memory");
        }
    }
    __syncthreads();
}

template <int PH> __device__ __forceinline__ void run_phase(const Params& p, const Ctx& c0) {
    Ctx c = c0;
    { int l; asm volatile("v_mbcnt_lo_u32_b32 %0, -1, 0\n\tv_mbcnt_hi_u32_b32 %0, -1, %0" : "=v"(l)); c.lane = l; c.tid = c0.wave * 64 + l; c.wave = c0.wave; }
    if (PH == 0) phase0(p, c);
    if (PH == 1) phase1_g2(p, c);
    if (PH == 2) phase2(p, c);
#if NAIVE_ATTN
    if (PH == 3) phase3_naive(p, c);
#else
    if (PH == 3) phase3(p, c);
#endif
    if (PH == 4) phase4_g2(p, c);
    if (PH == 5) phase5_fused(p, c);
    if (PH == 8) phase_moeA(p, c);
    if (PH == 9) phase_moeB(p, c);
    if (PH == 10) phase8(p, c);
}
constexpr int NPHASES = 11;
__device__ __forceinline__ Ctx make_ctx(unsigned char* lds) {
    Ctx c; c.lds = (LAS unsigned char*)lds; c.tid = threadIdx.x; c.lane = c.tid & 63; c.wave = __builtin_amdgcn_readfirstlane(c.tid >> 6);
    c.G = gridDim.x; const int bx = blockIdx.x; c.vcu = (c.G % 8 == 0) ? (bx % 8) * (c.G / 8) + bx / 8 : bx;
    return c;
}
template <int PH> __global__ void __launch_bounds__(NTHREADS, 2) phase_kernel(Params p) {
    extern __shared__ __attribute__((aligned(16))) unsigned char lds[];
    const Ctx c = make_ctx(lds);
    run_phase<PH>(p, c);
}
#if MEGA
__global__ void __launch_bounds__(NTHREADS, 2) mega_kernel(Params p) {
    extern __shared__ __attribute__((aligned(16))) unsigned char lds[];
    Ctx c = make_ctx(lds);
    cg::grid_group grid = cg::this_grid();
    volatile LAS unsigned* bst = (volatile LAS unsigned*)(c.lds + LDS_BYTES - 64);
    if (c.tid < 4) bst[c.tid] = 0u;
    __syncthreads();
    XcdBarrier bar; bar.bar = (unsigned*)(p.ws + WS_CTL + CT_BAR); bar.x = xb_xcc_id(); bar.st = bst;
    if (c.tid == 0) bst[2] = xb_add(&bar.bar[XB_XCNT(bar.x)], 1u);
    if (p.out == nullptr) grid.sync();
    run_phase<0>(p, c); xcd_barrier(bar);
    if (c.tid == 0) {
        unsigned pre = 0;
        for (unsigned j = 0; j < 16; ++j) { const unsigned n = xb_ld(&bar.bar[XB_XCNT(j)]); if (j < bar.x) pre += n; }
        bst[3] = pre + bst[2];
    }
    __syncthreads();
    c.vcu = (int)bst[3];
    run_phase<1>(p, c); xcd_barrier(bar);
    run_phase<2>(p, c); xcd_barrier(bar);
    run_phase<3>(p, c); xcd_barrier(bar);
    run_phase<4>(p, c); xcd_barrier(bar);
    run_phase<5>(p, c); xcd_barrier(bar);
    run_phase<8>(p, c); xcd_barrier(bar);
    run_phase<9>(p, c); xcd_barrier(bar);
    run_phase<10>(p, c);
}

#endif
template <int PH> static void launch_phase(const Params& p, int grid, hipStream_t stream) {
    static bool attr = false;
    if (!attr) { (void)hipFuncSetAttribute((const void*)phase_kernel<PH>, hipFuncAttributeMaxDynamicSharedMemorySize, LDS_BYTES); attr = true; }
    hipLaunchKernelGGL(phase_kernel<PH>, dim3(grid), dim3(NTHREADS), LDS_BYTES, stream, p);
}

extern "C" void kernel_launch(void* const* d_in, const int* in_sizes, int n_in, void* d_out, int out_size, void* d_ws, size_t ws_size, hipStream_t stream) {
    if (n_in != 25 || ws_size < WS_END) { fprintf(stderr, "kernel_launch: unexpected n_in %d or ws_size %zu (need %zu)\n", n_in, ws_size, (size_t)WS_END); return; }
    Params p{};
    const float** pp = (const float**)&p;
    for (int i = 0; i < 25; ++i) pp[i] = (const float*)d_in[i];
    p.out = (float*)d_out; p.ws = (unsigned char*)d_ws;
    (void)hipMemsetAsync((char*)d_ws + WS_CTL, 0, CTL_BYTES, stream);
#if MEGA
    static int grid = 0;
    if (!grid) {
        int dev = 0, cus = 0, per_cu = 0;
        (void)hipGetDevice(&dev);
        (void)hipDeviceGetAttribute(&cus, hipDeviceAttributeMultiprocessorCount, dev);
        (void)hipFuncSetAttribute((const void*)mega_kernel, hipFuncAttributeMaxDynamicSharedMemorySize, LDS_BYTES);
        (void)hipOccupancyMaxActiveBlocksPerMultiprocessor(&per_cu, (const void*)mega_kernel, NTHREADS, LDS_BYTES);
        if (per_cu < 1) per_cu = 1;
        grid = cus;
        (void)per_cu;
    }
    void* args[] = {&p};
    hipError_t e = hipLaunchCooperativeKernel((const void*)mega_kernel, dim3(grid), dim3(NTHREADS), args, LDS_BYTES, stream);
    if (e != hipSuccess) fprintf(stderr, "cooperative launch failed: %s (grid %d)\n", hipGetErrorString(e), grid);
#else
    const int grid = 256;
#define LP(k) do { launch_phase<k>(p, grid, stream); if (REPEAT_PH == k) launch_phase<k>(p, grid, stream); } while (0)
    LP(0); LP(1); LP(2); LP(3); LP(4); LP(5); LP(8); LP(9); LP(10);
#undef LP
#endif
}
```

```cpp
#include <hip/hip_runtime.h>
#include <hip/hip_cooperative_groups.h>
#include <cstdint>
#include <cstdio>
namespace cg = cooperative_groups;

#ifndef NAIVE_GEMM
#define NAIVE_GEMM 0
#endif
#ifndef NAIVE_ATTN
#define NAIVE_ATTN 0
#endif
#ifndef REPEAT_PH
#define REPEAT_PH -1
#endif
#ifndef MEGA
#define MEGA 1
#endif

#define LAS __attribute__((address_space(3)))
#define GAS __attribute__((address_space(1)))
typedef unsigned short bf16_t;
typedef short bf16x8 __attribute__((ext_vector_type(8)));
typedef float f32x4 __attribute__((ext_vector_type(4)));
typedef unsigned u32x4 __attribute__((ext_vector_type(4)));
typedef unsigned u32x2 __attribute__((ext_vector_type(2)));

constexpr int D = 1024, NBATCH = 8, SEQ = 2048, NMETA = 16, LPOS = SEQ + NMETA;
constexpr int NTOK = NBATCH * SEQ;
constexpr int NROWS = NTOK + NMETA;
constexpr int NROWSP = 16512;
constexpr int NH = 8, DQK = 96, DNOPE = 64, DROPE = 32, DV = 64;
constexpr int QLORA = 384, KVLORA = 256;
constexpr int ZC = 2304;
constexpr int ZQ = 0, ZKV = 384, ZKPE = 640, ZB = 704, ZCG = 1216, ZU = 1728;
constexpr int DIN = 2208;
constexpr int NEXP = 256, DEXP = 256, TOPK = 8, CAP = 16384;
constexpr float ALPHA = 1.189207115002721f;
constexpr float QSCALE = 0.10206207261596577f * 1.4426950408889634f;

constexpr int NTHREADS = 512, NWAVES = 8;
constexpr int LDS_BYTES = 147456;
constexpr int STAGE_BYTES = 49152;
constexpr int LDS_MISC = 2 * STAGE_BYTES;

constexpr size_t MiB = 1u << 20;
constexpr size_t WS_CTL = 0;
constexpr size_t CTL_BYTES = 1 * MiB;
constexpr size_t CT_CNT = 0;
constexpr size_t CT_Q = 1024;
constexpr size_t CT_BAR = 8192;
constexpr size_t CT_SSQ_Q = 32768;
constexpr size_t CT_SSQ_KV = CT_SSQ_Q + 66048;
constexpr size_t CT_SSQ_ATT = CT_SSQ_KV + 66048;
constexpr size_t CT_STATS1 = CT_SSQ_ATT + 65536;
static_assert(CT_STATS1 + 131072 <= CTL_BYTES, "ctl");
constexpr size_t WS_WIN = 1 * MiB;
constexpr size_t WS_WUQ = 6 * MiB;
constexpr size_t WS_WUKV = 7 * MiB;
constexpr size_t WS_WO = 8 * MiB;
constexpr size_t WS_WR = 10 * MiB;
constexpr size_t WS_WSGU = 11 * MiB;
constexpr size_t WS_WSD = 12 * MiB;
constexpr size_t WS_ROPE = 13 * MiB;
constexpr size_t WS_WGU = 14 * MiB;
constexpr size_t WS_WD = 270 * MiB;
constexpr size_t WS_H1 = 398 * MiB;
constexpr size_t WS_HID = 430 * MiB;
constexpr size_t WS_LAID = 502 * MiB;
constexpr size_t WS_LGATE = 518 * MiB;
constexpr size_t WS_Y = 534 * MiB;
constexpr size_t WS_Z = WS_Y;
constexpr size_t WS_H0 = WS_Y + 73 * MiB;
constexpr size_t WS_Q = WS_Y + 106 * MiB;
constexpr size_t WS_K = WS_Y + 130 * MiB;
constexpr size_t WS_V = WS_Y + 155 * MiB;
constexpr size_t WS_ATT = WS_Y + 172 * MiB;
constexpr size_t WS_CONV = WS_Y + 188 * MiB;
constexpr size_t WS_SSQC = WS_Y + 204 * MiB;
constexpr size_t WS_Y1 = WS_Y + 205 * MiB;
constexpr size_t WS_LOG = WS_Y + 237 * MiB;
constexpr size_t WS_PSQ = WS_Y + 253 * MiB;
constexpr size_t WS_PATT = WS_Y + 254 * MiB;
constexpr size_t WS_PST = WS_Y + 255 * MiB;
constexpr size_t WS_END = WS_Y + 288 * MiB;

struct Params {
    const float *x, *meta, *emb_g, *emb_b, *w_in, *q_norm, *w_uq, *kv_norm, *w_ukv, *conv_w, *attn_on, *conv_on, *w_o,
        *ln1_g, *ln1_b, *w_router, *router_bias, *w_gate, *w_up, *w_down, *ws_gate, *ws_up, *ws_down, *ln2_g, *ln2_b;
    float* out;
    unsigned char* ws;
};

__device__ __forceinline__ unsigned f2bf(float f) { unsigned u = __float_as_uint(f); return (u + 0x7fffu + ((u >> 16) & 1u)) >> 16; }
typedef float f32x2 __attribute__((ext_vector_type(2)));
typedef __bf16 bf16x2_t __attribute__((ext_vector_type(2)));
__device__ __forceinline__ unsigned cvtpk(float lo, float hi) { f32x2 v = {lo, hi}; bf16x2_t b = __builtin_convertvector(v, bf16x2_t); return __builtin_bit_cast(unsigned, b); }
__device__ __forceinline__ unsigned pk2(float lo, float hi) { return cvtpk(lo, hi); }
__device__ __forceinline__ float bf2f(unsigned b) { return __uint_as_float(b << 16); }
__device__ __forceinline__ float bflo(unsigned w) { return __uint_as_float(w << 16); }
__device__ __forceinline__ float bfhi(unsigned w) { return __uint_as_float(w & 0xffff0000u); }
__device__ __forceinline__ float wave_sum(float v) {
#pragma unroll
    for (int o = 1; o < 64; o <<= 1) v += __shfl_xor(v, o);
    return v;
}
__device__ __forceinline__ float wave_max(float v) {
#pragma unroll
    for (int o = 1; o < 64; o <<= 1) v = fmaxf(v, __shfl_xor(v, o));
    return v;
}

struct Ctx {
    LAS unsigned char* lds;
    int tid, lane, wave, vcu, G;
};

template <class RowPtr>
__device__ __forceinline__ void gemm_kloop(f32x4 (&acc)[4][4], const Ctx& c, const RowPtr& rp, const bf16_t* Bt, long ldb, int K) {
    const int tid = c.tid, lane = c.lane, wid = c.wave, wr = wid >> 2, wc = wid & 3, fr = lane & 15, fq = lane >> 4;
#if NAIVE_GEMM
    const bf16_t* ar[4];
#pragma unroll
    for (int mi = 0; mi < 4; ++mi) ar[mi] = rp(wr * 64 + mi * 16 + fr);
    const bf16_t* br = Bt + (long)(wc * 64 + fq * 4) * ldb;
#pragma nounroll
    for (int k = 0; k < K; k += 2) {
        unsigned av[4];
#pragma unroll
        for (int mi = 0; mi < 4; ++mi) av[mi] = *(const unsigned*)(ar[mi] + k);
#pragma unroll
        for (int ni = 0; ni < 4; ++ni)
#pragma unroll
            for (int j = 0; j < 4; ++j) {
                const unsigned bv = *(const unsigned*)(br + (long)(ni * 16 + j) * ldb + k);
#pragma unroll
                for (int mi = 0; mi < 4; ++mi) acc[mi][ni][j] += bflo(av[mi]) * bflo(bv) + bfhi(av[mi]) * bfhi(bv);
            }
    }
#else
    LAS unsigned char* lds = c.lds;
    const int nt = K >> 6;
    const int srow = tid >> 3, sch = tid & 7;
    const bf16_t* ap0 = rp(srow) + sch * 8;
    const bf16_t* ap1 = rp(srow + 64) + sch * 8;
    const bf16_t* bp = Bt + (long)srow * ldb + sch * 8;
    const long bstep = 64 * ldb;
    const int so = srow * 128 + ((sch ^ ((srow >> 1) & 7)) << 4);
    u32x4 ra0, ra1, rb0, rb1, rb2, rb3;
#define G_LOAD(t) do { const int ko = (t) * 64; ra0 = *(const u32x4*)(ap0 + ko); ra1 = *(const u32x4*)(ap1 + ko); \
        rb0 = *(const u32x4*)(bp + ko); rb1 = *(const u32x4*)(bp + bstep + ko); rb2 = *(const u32x4*)(bp + 2 * bstep + ko); rb3 = *(const u32x4*)(bp + 3 * bstep + ko); } while (0)
#define G_STORE(buf) do { LAS unsigned char* sb = lds + (buf) * STAGE_BYTES; \
        *(LAS u32x4*)(sb + so) = ra0; *(LAS u32x4*)(sb + so + 8192) = ra1; \
        *(LAS u32x4*)(sb + 16384 + so) = rb0; *(LAS u32x4*)(sb + 16384 + so + 8192) = rb1; \
        *(LAS u32x4*)(sb + 16384 + so + 16384) = rb2; *(LAS u32x4*)(sb + 16384 + so + 24576) = rb3; } while (0)
    __syncthreads();
    G_LOAD(0);
    G_STORE(0);
    __syncthreads();
    const int sw0 = ((0 + fq) ^ ((fr >> 1) & 7)) << 4, sw1 = ((4 + fq) ^ ((fr >> 1) & 7)) << 4;
    const int aoff = (wr * 64 + fr) * 128, boff = 16384 + (wc * 64 + fr) * 128;
    for (int t = 0; t < nt; ++t) {
        if (t + 1 < nt) G_LOAD(t + 1);
        const LAS unsigned char* sb = lds + (t & 1) * STAGE_BYTES;
#pragma unroll
        for (int ks = 0; ks < 2; ++ks) {
            const int sw = ks ? sw1 : sw0;
            bf16x8 af[4], bfr[4];
#pragma unroll
            for (int mi = 0; mi < 4; ++mi) af[mi] = *(const LAS bf16x8*)(sb + aoff + mi * 2048 + sw);
#pragma unroll
            for (int ni = 0; ni < 4; ++ni) bfr[ni] = *(const LAS bf16x8*)(sb + boff + ni * 2048 + sw);
#pragma unroll
            for (int mi = 0; mi < 4; ++mi)
#pragma unroll
                for (int ni = 0; ni < 4; ++ni) acc[mi][ni] = __builtin_amdgcn_mfma_f32_16x16x32_bf16(bfr[ni], af[mi], acc[mi][ni], 0, 0, 0);
        }
        if (t + 1 < nt) G_STORE((t + 1) & 1);
        __syncthreads();
    }
#undef G_LOAD
#undef G_STORE
#endif
}
__device__ __forceinline__ void acc_zero(f32x4 (&acc)[4][4]) {
#pragma unroll
    for (int a = 0; a < 4; ++a)
#pragma unroll
        for (int b = 0; b < 4; ++b) acc[a][b] = (f32x4){0.f, 0.f, 0.f, 0.f};
}
__device__ __forceinline__ void store_bf4(bf16_t* p, f32x4 v) { u32x2 w; w.x = pk2(v[0], v[1]); w.y = pk2(v[2], v[3]); *(u32x2*)p = w; }

enum { MAP_ID = 0, MAP_WIN = 1, MAP_GATE = 2, MAP_UP = 3 };
template <int MAP> __device__ __forceinline__ int rowmap(int n) {
    if (MAP == MAP_WIN) return n < 672 ? n : n + 32;
    if (MAP == MAP_GATE) return 32 * (n >> 4) + (n & 15);
    if (MAP == MAP_UP) return 32 * (n >> 4) + 16 + (n & 15);
    return n;
}
template <int MAP>
__device__ __forceinline__ void transpose_item(const float* W, int K, int N, bf16_t* WT, const float* gain, LAS float* scr, int item, int lane) {
    const int nblk = N / 32, kb = item / nblk, nb = item % nblk, k0 = 64 * kb, n0 = 32 * nb;
#pragma unroll 8
    for (int i = 0; i < 32; ++i) {
        const int kk = 2 * i + (lane >> 5);
        float v = W[(size_t)(k0 + kk) * N + n0 + (lane & 31)];
        if (gain) v *= gain[k0 + kk];
        scr[kk * 33 + (lane & 31)] = v;
    }
    asm volatile("s_waitcnt lgkmcnt(0)" ::: "memory");
    const int ch = lane & 7;
#pragma unroll
    for (int j = 0; j < 4; ++j) {
        const int n = (lane >> 3) + 8 * j;
        const LAS float* s = scr + (8 * ch) * 33 + n;
        u32x4 o;
        o.x = pk2(s[0 * 33], s[1 * 33]); o.y = pk2(s[2 * 33], s[3 * 33]); o.z = pk2(s[4 * 33], s[5 * 33]); o.w = pk2(s[6 * 33], s[7 * 33]);
        *(u32x4*)(WT + (size_t)rowmap<MAP>(n0 + n) * K + k0 + 8 * ch) = o;
    }
    asm volatile("s_waitcnt lgkmcnt(0)" ::: "memory");
}
__device__ __forceinline__ void phase0(const Params& p, const Ctx& c) {
    unsigned char* ws = p.ws;
    LAS float* scr = (LAS float*)(c.lds + c.wave * 8704);
    const int gw = c.vcu * NWAVES + c.wave, NGW = c.G * NWAVES, lane = c.lane;
    bf16_t* H0 = (bf16_t*)(ws + WS_H0);
    {
        f32x4 eg[4], eb[4];
#pragma unroll
        for (int j = 0; j < 4; ++j) { eg[j] = *((const f32x4*)p.emb_g + lane + 64 * j); eb[j] = *((const f32x4*)p.emb_b + lane + 64 * j); }
        for (int r0 = gw; r0 < NROWSP; r0 += 2 * NGW) {
            const int r1 = r0 + NGW;
            const bool h1 = r1 < NROWSP;
            const int q0 = min(r0, NROWS - 1), q1 = min(h1 ? r1 : r0, NROWS - 1);
            const float* x0 = q0 < NTOK ? p.x + (size_t)q0 * D : p.meta + (size_t)(q0 - NTOK) * D;
            const float* x1 = q1 < NTOK ? p.x + (size_t)q1 * D : p.meta + (size_t)(q1 - NTOK) * D;
            f32x4 v0[4], v1[4]; float s0 = 0.f, s1 = 0.f;
#pragma unroll
            for (int j = 0; j < 4; ++j) { v0[j] = *((const f32x4*)x0 + lane + 64 * j); v1[j] = *((const f32x4*)x1 + lane + 64 * j); }
#pragma unroll
            for (int j = 0; j < 4; ++j) { s0 += (v0[j][0] + v0[j][1]) + (v0[j][2] + v0[j][3]); s1 += (v1[j][0] + v1[j][1]) + (v1[j][2] + v1[j][3]); }
#pragma unroll
            for (int o = 1; o < 64; o <<= 1) { s0 += __shfl_xor(s0, o); s1 += __shfl_xor(s1, o); }
            const float m0 = s0 * (1.f / D), m1 = s1 * (1.f / D);
            float t0 = 0.f, t1 = 0.f;
#pragma unroll
            for (int j = 0; j < 4; ++j) { v0[j] = v0[j] - m0; v1[j] = v1[j] - m1;
                t0 += (v0[j][0] * v0[j][0] + v0[j][1] * v0[j][1]) + (v0[j][2] * v0[j][2] + v0[j][3] * v0[j][3]); t1 += (v1[j][0] * v1[j][0] + v1[j][1] * v1[j][1]) + (v1[j][2] * v1[j][2] + v1[j][3] * v1[j][3]); }
#pragma unroll
            for (int o = 1; o < 64; o <<= 1) { t0 += __shfl_xor(t0, o); t1 += __shfl_xor(t1, o); }
            const float rs0 = r0 < NROWS ? 1.f / sqrtf(t0 * (1.f / D) + 1e-5f) : 0.f, rs1 = r1 < NROWS ? 1.f / sqrtf(t1 * (1.f / D) + 1e-5f) : 0.f;
            u32x2* o0 = (u32x2*)(H0 + (size_t)r0 * D) + lane; u32x2* o1 = (u32x2*)(H0 + (size_t)r1 * D) + lane;
#pragma unroll
            for (int j = 0; j < 4; ++j) {
                const f32x4 y0 = r0 < NROWS ? v0[j] * rs0 * eg[j] + eb[j] : (f32x4){0.f, 0.f, 0.f, 0.f}, y1 = r1 < NROWS ? v1[j] * rs1 * eg[j] + eb[j] : (f32x4){0.f, 0.f, 0.f, 0.f};
                o0[64 * j] = (u32x2){pk2(y0[0], y0[1]), pk2(y0[2], y0[3])};
                if (h1) o1[64 * j] = (u32x2){pk2(y1[0], y1[1]), pk2(y1[2], y1[3])};
            }
        }
    }
    {
        float* rope = (float*)(ws + WS_ROPE);
        for (int idx = gw * 64 + lane; idx < LPOS * 16; idx += NGW * 64) {
            const int pos = idx >> 4, i = idx & 15;
            const float inv = exp2f(-(float)i * (13.287712379549449f / 16.f));
            const float ang = (float)pos * inv;
            double rev = (double)ang * 0.15915494309189535; rev -= floor(rev);
            const float rf = (float)rev;
            rope[idx * 2 + 0] = __builtin_amdgcn_cosf(rf);
            rope[idx * 2 + 1] = __builtin_amdgcn_sinf(rf);
        }
    }
    {
        bf16_t* WinT = (bf16_t*)(ws + WS_WIN);
        for (int it = gw; it < 96; it += NGW) {
            const int row = it < 32 ? 672 + it : 2240 + (it - 32);
            u32x2* o = (u32x2*)(WinT + (size_t)row * D) + lane;
#pragma unroll
            for (int j = 0; j < 4; ++j) o[64 * j] = (u32x2){0u, 0u};
        }
    }
    constexpr int I_WIN = 16 * 69, I_UQ = 6 * 24, I_UKV = 4 * 32, I_WO = 16 * 32, I_WR = 16 * 8, I_SG = 128, I_SD = 128;
    constexpr int I_SMALL = I_WIN + I_UQ + I_UKV + I_WO + I_WR + 2 * I_SG + I_SD;
    constexpr int I_EXP = NEXP * 128;
    constexpr int NITEMS = I_WIN + I_UQ + I_UKV + I_WO + I_WR;
    for (int it = gw; it < NITEMS; it += NGW) {
        int r = it;
        if (r < I_WIN) { transpose_item<MAP_WIN>(p.w_in, D, DIN, (bf16_t*)(ws + WS_WIN), nullptr, scr, r, lane); continue; } r -= I_WIN;
        if (r < I_UQ) { transpose_item<MAP_ID>(p.w_uq, QLORA, 768, (bf16_t*)(ws + WS_WUQ), p.q_norm, scr, r, lane); continue; } r -= I_UQ;
        if (r < I_UKV) { transpose_item<MAP_ID>(p.w_ukv, KVLORA, 1024, (bf16_t*)(ws + WS_WUKV), p.kv_norm, scr, r, lane); continue; } r -= I_UKV;
        if (r < I_WO) {
            const int kb = r / 32;
            transpose_item<MAP_ID>(p.w_o, D, D, (bf16_t*)(ws + WS_WO), kb < 8 ? p.attn_on : p.conv_on - 512, scr, r, lane); continue; } r -= I_WO;
        if (r < I_WR) { transpose_item<MAP_ID>(p.w_router, D, 256, (bf16_t*)(ws + WS_WR), nullptr, scr, r, lane); continue; } r -= I_WR;
        if (r < I_SG) { transpose_item<MAP_GATE>(p.ws_gate, D, 256, (bf16_t*)(ws + WS_WSGU), nullptr, scr, r, lane); continue; } r -= I_SG;
        if (r < I_SG) { transpose_item<MAP_UP>(p.ws_up, D, 256, (bf16_t*)(ws + WS_WSGU), nullptr, scr, r, lane); continue; } r -= I_SG;
        if (r < I_SD) { transpose_item<MAP_ID>(p.ws_down, DEXP, D, (bf16_t*)(ws + WS_WSD), nullptr, scr, r, lane); continue; } r -= I_SD;
        if (r < I_EXP) { const int e = r >> 7; transpose_item<MAP_GATE>(p.w_gate + (size_t)e * D * DEXP, D, 256, (bf16_t*)(ws + WS_WGU) + (size_t)e * 512 * D, nullptr, scr, r & 127, lane); continue; } r -= I_EXP;
        if (r < I_EXP) { const int e = r >> 7; transpose_item<MAP_UP>(p.w_up + (size_t)e * D * DEXP, D, 256, (bf16_t*)(ws + WS_WGU) + (size_t)e * 512 * D, nullptr, scr, r & 127, lane); continue; } r -= I_EXP;
        { const int e = r >> 7; transpose_item<MAP_ID>(p.w_down + (size_t)e * DEXP * D, DEXP, D, (bf16_t*)(ws + WS_WD) + (size_t)e * D * DEXP, nullptr, scr, r & 127, lane); }
    }
}

__device__ __forceinline__ void phase1(const Params& p, const Ctx& c) {
    unsigned char* ws = p.ws;
    const bf16_t* H0 = (const bf16_t*)(ws + WS_H0); const bf16_t* WinT = (const bf16_t*)(ws + WS_WIN);
    bf16_t* Z = (bf16_t*)(ws + WS_Z);
    float* psq = (float*)(ws + WS_PSQ);
    const int lane = c.lane, wr = c.wave >> 2, wc = c.wave & 3, fr = lane & 15, fq = lane >> 4;
    constexpr int NU = 129 * 9;
    for (int u = c.vcu; u < NU; u += c.G) {
        const int mt = u / 9, nt = u % 9, row0 = mt * 128, n0 = nt * 256;
        f32x4 acc[4][4]; acc_zero(acc);
        auto rp = [&](int r) { return H0 + (size_t)(row0 + r) * D; };
        gemm_kloop(acc, c, rp, WinT + (size_t)n0 * D, D, D);
        const int s0 = n0 + wc * 64;
#pragma unroll
        for (int mi = 0; mi < 4; ++mi) {
            const int row = row0 + wr * 64 + mi * 16 + fr;
            float ss = 0.f;
#pragma unroll
            for (int ni = 0; ni < 4; ++ni) {
                const f32x4 v = acc[mi][ni];
                store_bf4(Z + (size_t)row * ZC + s0 + ni * 16 + fq * 4, v);
                ss += (v[0] * v[0] + v[1] * v[1]) + (v[2] * v[2] + v[3] * v[3]);
            }
            if (s0 < ZKPE) {
                ss += __shfl_xor(ss, 16); ss += __shfl_xor(ss, 32);
                if (fq == 0) psq[(size_t)row * 16 + (s0 >> 6)] = ss;
            }
        }
    }
}

__device__ __forceinline__ void phase2_gemms(const Params& p, const Ctx& c);
__device__ __forceinline__ void phase2(const Params& p, const Ctx& c) {
    unsigned char* ws = p.ws;
    const bf16_t* Z = (const bf16_t*)(ws + WS_Z);
    const float* psq = (const float*)(ws + WS_PSQ);
    const float* rope = (const float*)(ws + WS_ROPE);
    bf16_t* Q = (bf16_t*)(ws + WS_Q); bf16_t* Kb = (bf16_t*)(ws + WS_K); bf16_t* Vb = (bf16_t*)(ws + WS_V);
    const int lane = c.lane, wr = c.wave >> 2, wc = c.wave & 3, fr = lane & 15, fq = lane >> 4;
    phase2_gemms(p, c);
    __syncthreads();
    const int gw = c.vcu * NWAVES + c.wave, NGW = c.G * NWAVES;
    const bf16_t* Zc = Z;
    for (int row = gw; row < NROWS; row += NGW) {
        const int nb = row < NTOK ? 1 : NBATCH;
        const int b0 = row < NTOK ? (row >> 11) : 0, pos = row < NTOK ? NMETA + (row & (SEQ - 1)) : row - NTOK;
        if (lane < 16) {
            const float x1 = bf2f(Zc[(size_t)row * ZC + ZKPE + lane]), x2 = bf2f(Zc[(size_t)row * ZC + ZKPE + 16 + lane]);
            const float co = rope[((size_t)pos * 16 + lane) * 2], si = rope[((size_t)pos * 16 + lane) * 2 + 1];
            const bf16_t o1 = (bf16_t)f2bf(x1 * co - x2 * si), o2 = (bf16_t)f2bf(x2 * co + x1 * si);
            for (int bb = 0; bb < nb; ++bb) {
                bf16_t* kp = Kb + ((size_t)(b0 + bb) * LPOS + pos) * 768;
#pragma unroll
                for (int h = 0; h < NH; ++h) { kp[h * 96 + 64 + lane] = o1; kp[h * 96 + 80 + lane] = o2; }
            }
        }
        if (row < NTOK) {
            const int i = row & (SEQ - 1);
            const int r1 = i >= 1 ? row - 1 : NTOK + 15;
            const int r2 = i >= 2 ? row - 2 : (i == 1 ? NTOK + 15 : NTOK + 14);
            const int ch = lane * 8;
            const u32x4 c0 = *(const u32x4*)(Zc + (size_t)row * ZC + ZCG + ch), u0 = *(const u32x4*)(Zc + (size_t)row * ZC + ZU + ch);
            const u32x4 c1 = *(const u32x4*)(Zc + (size_t)r1 * ZC + ZCG + ch), u1 = *(const u32x4*)(Zc + (size_t)r1 * ZC + ZU + ch);
            const u32x4 c2 = *(const u32x4*)(Zc + (size_t)r2 * ZC + ZCG + ch), u2 = *(const u32x4*)(Zc + (size_t)r2 * ZC + ZU + ch);
            const u32x4 bg = *(const u32x4*)(Zc + (size_t)row * ZC + ZB + ch);
            float y[8]; float ss = 0.f;
#pragma unroll
            for (int e = 0; e < 4; ++e) {
#pragma unroll
                for (int hh = 0; hh < 2; ++hh) {
                    const int cc = ch + e * 2 + hh;
                    const float w0 = p.conv_w[cc], w1 = p.conv_w[512 + cc], w2 = p.conv_w[1024 + cc];
                    const float v0 = hh ? bfhi(c0[e]) * bfhi(u0[e]) : bflo(c0[e]) * bflo(u0[e]);
                    const float v1 = hh ? bfhi(c1[e]) * bfhi(u1[e]) : bflo(c1[e]) * bflo(u1[e]);
                    const float v2 = hh ? bfhi(c2[e]) * bfhi(u2[e]) : bflo(c2[e]) * bflo(u2[e]);
                    const float bgv = hh ? bfhi(bg[e]) : bflo(bg[e]);
                    const float yy = bgv * (w0 * v2 + w1 * v1 + w2 * v0);
                    y[e * 2 + hh] = yy; ss += yy * yy;
                }
            }
            ss = wave_sum(ss);
            u32x4 o; o.x = pk2(y[0], y[1]); o.y = pk2(y[2], y[3]); o.z = pk2(y[4], y[5]); o.w = pk2(y[6], y[7]);
            *(u32x4*)((bf16_t*)(ws + WS_ATT) + (size_t)row * D + 512 + ch) = o;
            if (lane == 0) ((float*)(ws + WS_SSQC))[row] = ss;
        }
    }
}

__device__ __forceinline__ void phase3_naive(const Params& p, const Ctx& c) {
    unsigned char* ws = p.ws;
    const bf16_t* Q = (const bf16_t*)(ws + WS_Q); const bf16_t* Kb = (const bf16_t*)(ws + WS_K); const bf16_t* Vb = (const bf16_t*)(ws + WS_V);
    bf16_t* ATT = (bf16_t*)(ws + WS_ATT); float* patt = (float*)(ws + WS_PATT);
    const int gw = c.vcu * NWAVES + c.wave, NGW = c.G * NWAVES, lane = c.lane;
    for (int it = gw; it < NTOK * NH; it += NGW) {
        const int row = it >> 3, h = it & 7, b = row >> 11, i = row & (SEQ - 1), nkeys = NMETA + i + 1;
        float q[96];
#pragma unroll
        for (int j = 0; j < 12; ++j) {
            const u32x4 w = *(const u32x4*)(Q + (size_t)row * 768 + h * 96 + j * 8);
#pragma unroll
            for (int e = 0; e < 4; ++e) { q[j * 8 + e * 2] = bflo(w[e]); q[j * 8 + e * 2 + 1] = bfhi(w[e]); }
        }
        float m = -INFINITY, l = 0.f; float o[64];
#pragma unroll
        for (int d = 0; d < 64; ++d) o[d] = 0.f;
        for (int kk = lane; kk < nkeys; kk += 64) {
            const bf16_t* kp = Kb + ((size_t)b * LPOS + kk) * 768 + h * 96;
            float s = 0.f;
#pragma unroll
            for (int j = 0; j < 12; ++j) {
                const u32x4 w = *(const u32x4*)(kp + j * 8);
#pragma unroll
                for (int e = 0; e < 4; ++e) { s += q[j * 8 + e * 2] * bflo(w[e]); s += q[j * 8 + e * 2 + 1] * bfhi(w[e]); }
            }
            const float mn = fmaxf(m, s), f = exp2f(m - mn), pe = exp2f(s - mn);
            l = l * f + pe; m = mn;
            const bf16_t* vp = Vb + ((size_t)b * LPOS + kk) * 512 + h * 64;
#pragma unroll
            for (int j = 0; j < 8; ++j) {
                const u32x4 w = *(const u32x4*)(vp + j * 8);
#pragma unroll
                for (int e = 0; e < 4; ++e) { o[j * 8 + e * 2] = o[j * 8 + e * 2] * f + pe * bflo(w[e]); o[j * 8 + e * 2 + 1] = o[j * 8 + e * 2 + 1] * f + pe * bfhi(w[e]); }
            }
        }
        const float M = wave_max(m);
        const float f = (m == -INFINITY) ? 0.f : exp2f(m - M);
        const float lt = wave_sum(l * f);
        float res = 0.f;
#pragma unroll
        for (int d = 0; d < 64; ++d) { const float v = wave_sum(o[d] * f); if (lane == d) res = v; }
        res /= lt;
        ATT[(size_t)row * D + h * 64 + lane] = (bf16_t)f2bf(res);
        const float ss = wave_sum(res * res);
        if (lane == 0) patt[(size_t)row * 8 + h] = ss;
    }
}


typedef float f32x16 __attribute__((ext_vector_type(16)));
typedef short s16x4 __attribute__((ext_vector_type(4)));
constexpr int AK_PITCH = 208, AK_BYTES = 64 * AK_PITCH, AV_BYTES = 8192, ASTAGE = AK_BYTES + AV_BYTES, A_WSF = 4 * ASTAGE;
__device__ __forceinline__ int crow(int r, int hi) { return (r & 3) + 8 * (r >> 2) + 4 * hi; }
__device__ __forceinline__ s16x4 vtr(const LAS unsigned char* p) {
    return __builtin_bit_cast(s16x4, __builtin_amdgcn_ds_read_tr16_b64_v4i16((LAS s16x4*)p));
}
__device__ __forceinline__ void attn_unit(const Params& p, const Ctx& c, int b, int h, int qb) {
    unsigned char* ws = p.ws;
    const bf16_t* Q = (const bf16_t*)(ws + WS_Q); const bf16_t* Kb = (const bf16_t*)(ws + WS_K); const bf16_t* Vb = (const bf16_t*)(ws + WS_V);
    bf16_t* ATT = (bf16_t*)(ws + WS_ATT); float* patt = (float*)(ws + WS_PATT);
    const int tid = c.tid, lane = c.lane, w = c.wave, r32 = lane & 31, hi = lane >> 5;
    LAS unsigned char* lds = c.lds;
    LAS float* wsf = (LAS float*)(lds + A_WSF) + w * 32;
    const int row0 = b * SEQ + qb * 256;
    const int qpos0 = NMETA + qb * 256 + w * 32, myq = qpos0 + r32;
    bf16x8 qf[6];
#pragma unroll
    for (int ds = 0; ds < 6; ++ds) qf[ds] = *(const bf16x8*)(Q + (size_t)(row0 + w * 32 + r32) * 768 + h * 96 + ds * 16 + hi * 8);
    const bf16_t* Kg = Kb + (size_t)b * LPOS * 768 + h * 96;
    const bf16_t* Vg = Vb + (size_t)b * LPOS * 512 + h * 64;
    const int T = 4 * qb + 5;
    const int tl = (qpos0 + 31) >> 6;
    const int vrow = tid >> 3, vch = tid & 7;
    const int voff = AK_BYTES + (vch >> 2) * 4096 + vrow * 64 + (vch & 3) * 16;
    const int k1c = 512 + (tid & 255);
    const int k0row = tid / 12, k0ch = tid % 12, k1row = k1c / 12, k1ch = k1c % 12;
    const int k0off = k0row * AK_PITCH + k0ch * 16, k1off = k1row * AK_PITCH + k1ch * 16;
    u32x4 rkA0, rkA1, rvA, rkA2, rkA3, rvA2;
#define A_LOAD1(k0, k1, v, t) do { const int kb_ = min((t), T - 1) * 64; \
        k0 = *(const u32x4*)(Kg + (size_t)min(kb_ + k0row, LPOS - 1) * 768 + k0ch * 8); \
        k1 = *(const u32x4*)(Kg + (size_t)min(kb_ + k1row, LPOS - 1) * 768 + k1ch * 8); \
        v = *(const u32x4*)(Vg + (size_t)min(kb_ + vrow, LPOS - 1) * 512 + vch * 8); } while (0)
#define A_STORE1(k0, k1, v, off) do { LAS unsigned char* sb_ = lds + (off); \
        *(LAS u32x4*)(sb_ + k0off) = k0; *(LAS u32x4*)(sb_ + k1off) = k1; *(LAS u32x4*)(sb_ + voff) = v; } while (0)
#define A_LOAD_A(t2) do { A_LOAD1(rkA0, rkA1, rvA, 2 * (t2)); A_LOAD1(rkA2, rkA3, rvA2, 2 * (t2) + 1); } while (0)
#define A_STORE_A(buf) do { A_STORE1(rkA0, rkA1, rvA, (buf) * 2 * ASTAGE); A_STORE1(rkA2, rkA3, rvA2, (buf) * 2 * ASTAGE + ASTAGE); } while (0)
    float m = -INFINITY, l = 0.f;
    f32x16 o0, o1;
#pragma unroll
    for (int r = 0; r < 16; ++r) { o0[r] = 0.f; o1[r] = 0.f; }
    const int kfo = r32 * AK_PITCH + hi * 16;
    const int vfo = AK_BYTES + ((lane >> 4) & 1) * 32 + (lane & 3) * 8 + (4 * hi + ((lane & 15) >> 2)) * 64;
    const int T2 = (T + 1) >> 1;
    __syncthreads();
    A_LOAD_A(0);
    A_STORE_A(0);
    __syncthreads();
    auto compute_tile = [&](int t) __attribute__((always_inline)) {
        if (t <= tl) {
            const LAS unsigned char* sb = lds + ((t >> 1) & 1) * 2 * ASTAGE + (t & 1) * ASTAGE;
            f32x16 p0, p1;
#pragma unroll
            for (int r = 0; r < 16; ++r) { p0[r] = 0.f; p1[r] = 0.f; }
#pragma unroll
            for (int ds = 0; ds < 6; ++ds) {
                const bf16x8 a0 = *(const LAS bf16x8*)(sb + kfo + ds * 32);
                const bf16x8 a1 = *(const LAS bf16x8*)(sb + kfo + 32 * AK_PITCH + ds * 32);
                p0 = __builtin_amdgcn_mfma_f32_32x32x16_bf16(a0, qf[ds], p0, 0, 0, 0);
                p1 = __builtin_amdgcn_mfma_f32_32x32x16_bf16(a1, qf[ds], p1, 0, 0, 0);
            }
            if (t * 64 + 63 > qpos0) {
                const int kb0 = t * 64 + 4 * hi;
#pragma unroll
                for (int r = 0; r < 16; ++r) {
                    const int kv = kb0 + (r & 3) + 8 * (r >> 2);
                    if (kv > myq) p0[r] = -INFINITY;
                    if (kv + 32 > myq) p1[r] = -INFINITY;
                }
            }
            float mx = fmaxf(p0[0], p1[0]);
#pragma unroll
            for (int r = 1; r < 16; ++r) mx = fmaxf(mx, fmaxf(p0[r], p1[r]));
            mx = fmaxf(mx, __shfl_xor(mx, 32));
            if (__any(mx > m)) {
                const float mn = fmaxf(m, mx), alpha = __builtin_amdgcn_exp2f(m - mn);
                m = mn; l *= alpha;
                if (hi == 0) wsf[r32] = alpha;
                asm volatile("s_waitcnt lgkmcnt(0)" ::: "memory");
#pragma unroll
                for (int k = 0; k < 4; ++k) {
                    const f32x4 a = *(const LAS f32x4*)(wsf + 8 * k + 4 * hi);
#pragma unroll
                    for (int j = 0; j < 4; ++j) { o0[4 * k + j] *= a[j]; o1[4 * k + j] *= a[j]; }
                }
                asm volatile("s_waitcnt lgkmcnt(0)" ::: "memory");
            }
            float ls = 0.f;
#pragma unroll
            for (int r = 0; r < 16; ++r) { p0[r] = __builtin_amdgcn_exp2f(p0[r] - m); p1[r] = __builtin_amdgcn_exp2f(p1[r] - m); ls += p0[r] + p1[r]; }
            l += ls;
            bf16x8 pa[4];
#pragma unroll
            for (int s = 0; s < 4; ++s) {
                u32x4 wv;
#pragma unroll
                for (int e = 0; e < 4; ++e) {
                    const int r = 8 * (s & 1) + 2 * e;
                    wv[e] = (s >> 1) ? pk2(p1[r], p1[r + 1]) : pk2(p0[r], p0[r + 1]);
                }
                pa[s] = __builtin_bit_cast(bf16x8, wv);
            }
#pragma unroll
            for (int s = 0; s < 4; ++s) {
                const s16x4 l0 = vtr(sb + vfo + s * 1024), h0 = vtr(sb + vfo + s * 1024 + 512);
                const s16x4 l1 = vtr(sb + vfo + 4096 + s * 1024), h1 = vtr(sb + vfo + 4096 + s * 1024 + 512);
                const bf16x8 v0 = (bf16x8){l0[0], l0[1], l0[2], l0[3], h0[0], h0[1], h0[2], h0[3]};
                const bf16x8 v1 = (bf16x8){l1[0], l1[1], l1[2], l1[3], h1[0], h1[1], h1[2], h1[3]};
                o0 = __builtin_amdgcn_mfma_f32_32x32x16_bf16(pa[s], v0, o0, 0, 0, 0);
                o1 = __builtin_amdgcn_mfma_f32_32x32x16_bf16(pa[s], v1, o1, 0, 0, 0);
            }
        }
    };
#pragma unroll 1
    for (int t2 = 0; t2 < T2; ++t2) {
        A_LOAD_A(t2 + 1);
        compute_tile(2 * t2); compute_tile(2 * t2 + 1);
        A_STORE_A((t2 + 1) & 1);
        __syncthreads();
    }
#undef A_LOAD1
#undef A_STORE1
#undef A_LOAD_A
#undef A_STORE_A
    l += __shfl_xor(l, 32);
    if (hi == 0) wsf[r32] = 1.f / l;
    asm volatile("s_waitcnt lgkmcnt(0)" ::: "memory");
    float sq[16];
#pragma unroll
    for (int k = 0; k < 4; ++k) {
        const f32x4 a = *(const LAS f32x4*)(wsf + 8 * k + 4 * hi);
#pragma unroll
        for (int j = 0; j < 4; ++j) {
            const int r = 4 * k + j;
            const float x0 = o0[r] * a[j], x1 = o1[r] * a[j];
            bf16_t* op = ATT + (size_t)(row0 + w * 32 + crow(r, hi)) * D + h * 64 + r32;
            op[0] = (bf16_t)f2bf(x0); op[32] = (bf16_t)f2bf(x1);
            sq[r] = x0 * x0 + x1 * x1;
        }
    }
#pragma unroll
    for (int r = 0; r < 16; ++r) {
        float v = sq[r];
#pragma unroll
        for (int o = 1; o < 32; o <<= 1) v += __shfl_xor(v, o);
        if (r32 == 0) patt[(size_t)(row0 + w * 32 + crow(r, hi)) * 8 + h] = v;
    }
    asm volatile("s_waitcnt lgkmcnt(0)" ::: "memory");
}
__device__ __forceinline__ void phase3(const Params& p, const Ctx& c) {
    for (int pi = c.vcu; pi < 256; pi += c.G) {
        const int bh = pi >> 2, s = pi & 3;
        attn_unit(p, c, bh >> 3, bh & 7, 7 - s);
        attn_unit(p, c, bh >> 3, bh & 7, s);
    }
}

__device__ __forceinline__ void phase4(const Params& p, const Ctx& c) {
    unsigned char* ws = p.ws;
    const bf16_t* ATT = (const bf16_t*)(ws + WS_ATT); const bf16_t* CONV = (const bf16_t*)(ws + WS_CONV);
    const bf16_t* WoT = (const bf16_t*)(ws + WS_WO); const bf16_t* H0 = (const bf16_t*)(ws + WS_H0);
    const float* patt = (const float*)(ws + WS_PATT); const float* ssq_c = (const float*)(ws + WS_SSQC);
    bf16_t* Y1 = (bf16_t*)(ws + WS_Y1); float* pst = (float*)(ws + WS_PST);
    const int lane = c.lane, wr = c.wave >> 2, wc = c.wave & 3, fr = lane & 15, fq = lane >> 4;
    constexpr int NU = 128 * 4;
    for (int u = c.vcu; u < NU; u += c.G) {
        const int mt = u >> 2, nt = u & 3, row0 = mt * 128, n0 = nt * 256;
        f32x4 acc[4][4]; acc_zero(acc);
        auto rpa = [&](int r) { return ATT + (size_t)(row0 + r) * 512; };
        gemm_kloop(acc, c, rpa, WoT + (size_t)n0 * D, D, 512);
        float rc[4];
#pragma unroll
        for (int mi = 0; mi < 4; ++mi) {
            const int row = row0 + wr * 64 + mi * 16 + fr;
            const f32x4 pa = *(const f32x4*)(patt + (size_t)row * 8), pb = *(const f32x4*)(patt + (size_t)row * 8 + 4);
            const float ra = rsqrtf((((pa[0] + pa[1]) + (pa[2] + pa[3])) + ((pb[0] + pb[1]) + (pb[2] + pb[3]))) * (1.f / 512) + 1e-6f);
            rc[mi] = rsqrtf(ssq_c[row] * (1.f / 512) + 1e-6f);
            const float f = ra / rc[mi];
#pragma unroll
            for (int ni = 0; ni < 4; ++ni) acc[mi][ni] = acc[mi][ni] * f;
        }
        auto rpc = [&](int r) { return CONV + (size_t)(row0 + r) * 512; };
        gemm_kloop(acc, c, rpc, WoT + (size_t)n0 * D + 512, D, 512);
        const int s0 = n0 + wc * 64;
#pragma unroll
        for (int mi = 0; mi < 4; ++mi) {
            const int row = row0 + wr * 64 + mi * 16 + fr;
            float s = 0.f, ss = 0.f;
#pragma unroll
            for (int ni = 0; ni < 4; ++ni) {
                const int col = s0 + ni * 16 + fq * 4;
                const u32x2 hw = *(const u32x2*)(H0 + (size_t)row * D + col);
                f32x4 v = acc[mi][ni] * rc[mi];
                v[0] += ALPHA * bflo(hw.x); v[1] += ALPHA * bfhi(hw.x); v[2] += ALPHA * bflo(hw.y); v[3] += ALPHA * bfhi(hw.y);
                store_bf4(Y1 + (size_t)row * D + col, v);
                s += (v[0] + v[1]) + (v[2] + v[3]);
                ss += (v[0] * v[0] + v[1] * v[1]) + (v[2] * v[2] + v[3] * v[3]);
            }
            s += __shfl_xor(s, 16); s += __shfl_xor(s, 32);
            ss += __shfl_xor(ss, 16); ss += __shfl_xor(ss, 32);
            if (fq == 0) { float* q = pst + ((size_t)row * 16 + nt * 4 + wc) * 2; q[0] = s; q[1] = ss; }
        }
    }
}

__device__ __forceinline__ void phase5a(const Params& p, const Ctx& c) {
    unsigned char* ws = p.ws;
    const bf16_t* Y1 = (const bf16_t*)(ws + WS_Y1); bf16_t* H1 = (bf16_t*)(ws + WS_H1); const float* pst = (const float*)(ws + WS_PST);
    const int gw = c.vcu * NWAVES + c.wave, NGW = c.G * NWAVES, lane = c.lane;
    for (int row = gw; row < NTOK; row += NGW) {
        float s1 = 0.f, s2 = 0.f;
#pragma unroll
        for (int k = 0; k < 16; ++k) { s1 += pst[((size_t)row * 16 + k) * 2]; s2 += pst[((size_t)row * 16 + k) * 2 + 1]; }
        const float mean = s1 * (1.f / D), var = fmaxf(s2 * (1.f / D) - mean * mean, 0.f), rstd = rsqrtf(var + 1e-5f);
#pragma unroll
        for (int j = 0; j < 2; ++j) {
            const int col = (lane + 64 * j) * 8;
            const u32x4 w = *(const u32x4*)(Y1 + (size_t)row * D + col);
            float y[8];
#pragma unroll
            for (int e = 0; e < 4; ++e) { y[2 * e] = bflo(w[e]); y[2 * e + 1] = bfhi(w[e]); }
#pragma unroll
            for (int e = 0; e < 8; ++e) y[e] = (y[e] - mean) * rstd * p.ln1_g[col + e] + p.ln1_b[col + e];
            u32x4 o; o.x = pk2(y[0], y[1]); o.y = pk2(y[2], y[3]); o.z = pk2(y[4], y[5]); o.w = pk2(y[6], y[7]);
            *(u32x4*)(H1 + (size_t)row * D + col) = o;
        }
    }
}
__device__ __forceinline__ void phase5b(const Params& p, const Ctx& c) {
    unsigned char* ws = p.ws;
    const bf16_t* H1 = (const bf16_t*)(ws + WS_H1); float* LOG = (float*)(ws + WS_LOG);
    const int lane = c.lane, wr = c.wave >> 2, wc = c.wave & 3, fr = lane & 15, fq = lane >> 4;
    for (int u = c.vcu; u < 128; u += c.G) {
        const int row0 = u * 128;
        f32x4 acc[4][4]; acc_zero(acc);
        auto rp = [&](int r) { return H1 + (size_t)(row0 + r) * D; };
        gemm_kloop(acc, c, rp, (const bf16_t*)(ws + WS_WR), D, D);
#pragma unroll
        for (int mi = 0; mi < 4; ++mi) {
            const int row = row0 + wr * 64 + mi * 16 + fr;
#pragma unroll
            for (int ni = 0; ni < 4; ++ni) *(f32x4*)(LOG + (size_t)row * 256 + wc * 64 + ni * 16 + fq * 4) = acc[mi][ni];
        }
    }
}
__device__ __forceinline__ void phase5c(const Params& p, const Ctx& c) {
    unsigned char* ws = p.ws;
    const float* LOG = (const float*)(ws + WS_LOG);
    unsigned* cnt = (unsigned*)(ws + WS_CTL + CT_CNT); unsigned* laid = (unsigned*)(ws + WS_LAID); float* lgate = (float*)(ws + WS_LGATE);
    const int gw = c.vcu * NWAVES + c.wave, NGW = c.G * NWAVES, lane = c.lane;
    const f32x4 bias = *((const f32x4*)p.router_bias + lane);
    for (int t = gw; t < NTOK; t += NGW) {
        const f32x4 lg = *((const f32x4*)(LOG + (size_t)t * 256) + lane);
        float s[4], sel[4];
#pragma unroll
        for (int i = 0; i < 4; ++i) { s[i] = 1.f / (1.f + expf(-lg[i])); sel[i] = s[i] + bias[i]; }
        float a = fmaxf(sel[0], sel[1]), b = fminf(sel[0], sel[1]), cc = fmaxf(sel[2], sel[3]), d = fminf(sel[2], sel[3]);
        float t1 = fmaxf(a, cc), t2 = fmaxf(fminf(a, cc), a >= cc ? b : d);
#pragma unroll
        for (int o = 1; o < 8; o <<= 1) {
            const float y1 = __shfl_xor(t1, o), y2 = __shfl_xor(t2, o);
            const float n1 = fmaxf(t1, y1), n2 = fmaxf(fminf(t1, y1), t1 >= y1 ? t2 : y2);
            t1 = n1; t2 = n2;
        }
        const float gs = t1 + t2; const int g = lane >> 3;
        int better = 0;
#pragma unroll
        for (int gg = 0; gg < 8; ++gg) { const float o = __shfl(gs, gg * 8); better += (o > gs || (o == gs && gg < g)) ? 1 : 0; }
        if (better >= 4) { sel[0] = sel[1] = sel[2] = sel[3] = -INFINITY; }
        int ek[8]; float sk[8]; float ssum = 0.f;
#pragma unroll
        for (int k = 0; k < 8; ++k) {
            float bv = sel[0]; int bi = 0;
            if (sel[1] > bv) { bv = sel[1]; bi = 1; }
            if (sel[2] > bv) { bv = sel[2]; bi = 2; }
            if (sel[3] > bv) { bv = sel[3]; bi = 3; }
            const float wm = wave_max(bv);
            const unsigned long long mask = __ballot(bv == wm);
            const int src = __ffsll((long long)mask) - 1;
            const float sb = bi == 0 ? s[0] : bi == 1 ? s[1] : bi == 2 ? s[2] : s[3];
            ek[k] = src * 4 + __shfl(bi, src); sk[k] = __shfl(sb, src); ssum += sk[k];
            if (lane == src) { if (bi == 0) sel[0] = -INFINITY; else if (bi == 1) sel[1] = -INFINITY; else if (bi == 2) sel[2] = -INFINITY; else sel[3] = -INFINITY; }
        }
        int me = ek[0]; float mg = sk[0];
#pragma unroll
        for (int k = 1; k < 8; ++k) if (lane == k) { me = ek[k]; mg = sk[k]; }
        if (lane < 8) {
            const unsigned pos = atomicAdd(cnt + me, 1u);
            laid[(size_t)me * CAP + pos] = (unsigned)(t * 8 + lane);
            lgate[(size_t)me * CAP + pos] = mg / ssum * 2.5f;
        }
    }
}


__device__ __forceinline__ void route_token(const Params& p, int t, const f32x4 lg, const f32x4 bias, int lane, unsigned* cnt, unsigned* laid, float* lgate) {
    float s[4], sel[4];
#pragma unroll
    for (int i = 0; i < 4; ++i) { s[i] = 1.f / (1.f + expf(-lg[i])); sel[i] = s[i] + bias[i]; }
    float a = fmaxf(sel[0], sel[1]), b = fminf(sel[0], sel[1]), cc = fmaxf(sel[2], sel[3]), d = fminf(sel[2], sel[3]);
    float t1 = fmaxf(a, cc), t2 = fmaxf(fminf(a, cc), a >= cc ? b : d);
#pragma unroll
    for (int o = 1; o < 8; o <<= 1) {
        const float y1 = __shfl_xor(t1, o), y2 = __shfl_xor(t2, o);
        const float n1 = fmaxf(t1, y1), n2 = fmaxf(fminf(t1, y1), t1 >= y1 ? t2 : y2);
        t1 = n1; t2 = n2;
    }
    const float gs = t1 + t2; const int g = lane >> 3;
    int better = 0;
#pragma unroll
    for (int gg = 0; gg < 8; ++gg) { const float o = __shfl(gs, gg * 8); better += (o > gs || (o == gs && gg < g)) ? 1 : 0; }
    if (better >= 4) { sel[0] = sel[1] = sel[2] = sel[3] = -INFINITY; }
    int ek[8]; float sk[8]; float ssum = 0.f;
#pragma unroll
    for (int k = 0; k < 8; ++k) {
        float bv = sel[0]; int bi = 0;
        if (sel[1] > bv) { bv = sel[1]; bi = 1; }
        if (sel[2] > bv) { bv = sel[2]; bi = 2; }
        if (sel[3] > bv) { bv = sel[3]; bi = 3; }
        const float wm = wave_max(bv);
        const unsigned long long mask = __ballot(bv == wm);
        const int src = __ffsll((long long)mask) - 1;
        const float sb = bi == 0 ? s[0] : bi == 1 ? s[1] : bi == 2 ? s[2] : s[3];
        ek[k] = src * 4 + __shfl(bi, src); sk[k] = __shfl(sb, src); ssum += sk[k];
        if (lane == src) { if (bi == 0) sel[0] = -INFINITY; else if (bi == 1) sel[1] = -INFINITY; else if (bi == 2) sel[2] = -INFINITY; else sel[3] = -INFINITY; }
    }
    int me = ek[0]; float mg = sk[0];
#pragma unroll
    for (int k = 1; k < 8; ++k) if (lane == k) { me = ek[k]; mg = sk[k]; }
    if (lane < 8) {
        const unsigned pos = atomicAdd(cnt + me, 1u);
        laid[(size_t)me * CAP + pos] = (unsigned)(t * 8 + lane);
        lgate[(size_t)me * CAP + pos] = mg / ssum * 2.5f;
    }
}
__device__ __forceinline__ void route_select(const f32x4 lg, const f32x4 bias, int lane, int& me_out, float& gate_out) {
    float s[4], sel[4];
#pragma unroll
    for (int i = 0; i < 4; ++i) { s[i] = 1.f / (1.f + expf(-lg[i])); sel[i] = s[i] + bias[i]; }
    float a = fmaxf(sel[0], sel[1]), b = fminf(sel[0], sel[1]), cc = fmaxf(sel[2], sel[3]), d = fminf(sel[2], sel[3]);
    float t1 = fmaxf(a, cc), t2 = fmaxf(fminf(a, cc), a >= cc ? b : d);
#pragma unroll
    for (int o = 1; o < 8; o <<= 1) {
        const float y1 = __shfl_xor(t1, o), y2 = __shfl_xor(t2, o);
        const float n1 = fmaxf(t1, y1), n2 = fmaxf(fminf(t1, y1), t1 >= y1 ? t2 : y2);
        t1 = n1; t2 = n2;
    }
    const float gs = t1 + t2; const int g = lane >> 3;
    int better = 0;
#pragma unroll
    for (int gg = 0; gg < 8; ++gg) { const float o = __shfl(gs, gg * 8); better += (o > gs || (o == gs && gg < g)) ? 1 : 0; }
    if (better >= 4) { sel[0] = sel[1] = sel[2] = sel[3] = -INFINITY; }
    int ek[8]; float sk[8]; float ssum = 0.f;
#pragma unroll
    for (int k = 0; k < 8; ++k) {
        float bv = sel[0]; int bi = 0;
        if (sel[1] > bv) { bv = sel[1]; bi = 1; }
        if (sel[2] > bv) { bv = sel[2]; bi = 2; }
        if (sel[3] > bv) { bv = sel[3]; bi = 3; }
        const float wm = wave_max(bv);
        const unsigned long long mask = __ballot(bv == wm);
        const int src = __ffsll((long long)mask) - 1;
        const float sb = bi == 0 ? s[0] : bi == 1 ? s[1] : bi == 2 ? s[2] : s[3];
        ek[k] = src * 4 + __shfl(bi, src); sk[k] = __shfl(sb, src); ssum += sk[k];
        if (lane == src) { if (bi == 0) sel[0] = -INFINITY; else if (bi == 1) sel[1] = -INFINITY; else if (bi == 2) sel[2] = -INFINITY; else sel[3] = -INFINITY; }
    }
    int me = ek[0]; float mg = sk[0];
#pragma unroll
    for (int k = 1; k < 8; ++k) if (lane == k) { me = ek[k]; mg = sk[k]; }
    me_out = me; gate_out = mg / ssum * 2.5f;
}
__device__ __forceinline__ void phase5_fused(const Params& p, const Ctx& c) {
    unsigned char* ws = p.ws;
    const bf16_t* Y1 = (const bf16_t*)(ws + WS_Y1); bf16_t* H1 = (bf16_t*)(ws + WS_H1); const float* pst = (const float*)(ws + WS_PST);
    const bf16_t* WrT = (const bf16_t*)(ws + WS_WR);
    unsigned* cnt = (unsigned*)(ws + WS_CTL + CT_CNT); unsigned* laid = (unsigned*)(ws + WS_LAID); float* lgate = (float*)(ws + WS_LGATE);
    const int lane = c.lane, w = c.wave, r32 = lane & 31, hi = lane >> 5;
    LAS unsigned char* lds = c.lds;
    const f32x4 bias = *((const f32x4*)p.router_bias + lane);
    for (int u = c.vcu; u < NTOK / 64; u += c.G) {
        const int row0 = u * 64;
        __syncthreads();
        {
            float gg[16], bb[16];
#pragma unroll
            for (int j = 0; j < 2; ++j) {
                const int col = (lane + 64 * j) * 8;
#pragma unroll
                for (int e = 0; e < 2; ++e) { const f32x4 g4 = *(const f32x4*)(p.ln1_g + col + 4 * e), b4 = *(const f32x4*)(p.ln1_b + col + 4 * e);
#pragma unroll
                    for (int q = 0; q < 4; ++q) { gg[j * 8 + e * 4 + q] = g4[q]; bb[j * 8 + e * 4 + q] = b4[q]; } }
            }
#pragma unroll 2
            for (int rr = 0; rr < 8; ++rr) {
                const int lr = w * 8 + rr, row = row0 + lr;
                float s1 = 0.f, s2 = 0.f;
                if (lane < 16) { const float* q = pst + ((size_t)row * 16 + lane) * 2; s1 = q[0]; s2 = q[1]; }
#pragma unroll
                for (int o = 1; o < 16; o <<= 1) { s1 += __shfl_xor(s1, o); s2 += __shfl_xor(s2, o); }
                s1 = __shfl(s1, 0); s2 = __shfl(s2, 0);
                const float mean = s1 * (1.f / D), var = fmaxf(s2 * (1.f / D) - mean * mean, 0.f), rstd = rsqrtf(var + 1e-5f);
#pragma unroll
                for (int j = 0; j < 2; ++j) {
                    const int ch = lane + 64 * j, col = ch * 8;
                    const u32x4 wv = *(const u32x4*)(Y1 + (size_t)row * D + col);
                    float y[8];
#pragma unroll
                    for (int e = 0; e < 4; ++e) { y[2 * e] = bflo(wv[e]); y[2 * e + 1] = bfhi(wv[e]); }
#pragma unroll
                    for (int e = 0; e < 8; ++e) y[e] = (y[e] - mean) * rstd * gg[j * 8 + e] + bb[j * 8 + e];
                    u32x4 o; o.x = cvtpk(y[0], y[1]); o.y = cvtpk(y[2], y[3]); o.z = cvtpk(y[4], y[5]); o.w = cvtpk(y[6], y[7]);
                    *(u32x4*)(H1 + (size_t)row * D + col) = o;
                    *(LAS u32x4*)(lds + lr * 2048 + ((ch ^ (lr & 15)) << 4)) = o;
                }
            }
        }
        __syncthreads();
        f32x16 acc0, acc1;
#pragma unroll
        for (int r = 0; r < 16; ++r) { acc0[r] = 0.f; acc1[r] = 0.f; }
        {
            const bf16_t* bp = WrT + (size_t)(w * 32 + r32) * D + hi * 8;
            const LAS unsigned char* a0 = lds + r32 * 2048, * a1 = lds + (32 + r32) * 2048;
            const int sx = r32 & 15;
#pragma unroll 1
            for (int kb = 0; kb < 64; kb += 8) {
                bf16x8 bf[8];
#pragma unroll
                for (int q = 0; q < 8; ++q) bf[q] = *(const bf16x8*)(bp + (kb + q) * 16);
#pragma unroll
                for (int q = 0; q < 8; ++q) {
                    const int ch = 2 * (kb + q) + hi;
                    const bf16x8 f0 = *(const LAS bf16x8*)(a0 + ((ch ^ sx) << 4)), f1 = *(const LAS bf16x8*)(a1 + ((ch ^ sx) << 4));
                    acc0 = __builtin_amdgcn_mfma_f32_32x32x16_bf16(bf[q], f0, acc0, 0, 0, 0);
                    acc1 = __builtin_amdgcn_mfma_f32_32x32x16_bf16(bf[q], f1, acc1, 0, 0, 0);
                }
            }
        }
        __syncthreads();
        if (c.tid < 256) ((LAS unsigned*)(lds + 65536))[c.tid] = 0u;
#pragma unroll
        for (int g = 0; g < 4; ++g) {
            *(LAS f32x4*)(lds + (size_t)r32 * 1024 + (w * 32 + 8 * g + 4 * hi) * 4) = (f32x4){acc0[4 * g], acc0[4 * g + 1], acc0[4 * g + 2], acc0[4 * g + 3]};
            *(LAS f32x4*)(lds + (size_t)(32 + r32) * 1024 + (w * 32 + 8 * g + 4 * hi) * 4) = (f32x4){acc1[4 * g], acc1[4 * g + 1], acc1[4 * g + 2], acc1[4 * g + 3]};
        }
        __syncthreads();
        LAS unsigned* hist = (LAS unsigned*)(lds + 65536); LAS unsigned* basev = hist + 256; LAS int* asgE = (LAS int*)(basev + 256); LAS int* asgP = asgE + 512; LAS float* asgG = (LAS float*)(asgP + 512);
#pragma unroll 1
        for (int rr = 0; rr < 8; ++rr) {
            const int lr = w * 8 + rr;
            const f32x4 lg = *(const LAS f32x4*)(lds + lr * 1024 + lane * 16);
            int me; float gate;
            route_select(lg, bias, lane, me, gate);
            if (lane < 8) {
                const unsigned lp = __hip_atomic_fetch_add(hist + me, 1u, __ATOMIC_RELAXED, __HIP_MEMORY_SCOPE_WORKGROUP);
                asgE[lr * 8 + lane] = me; asgP[lr * 8 + lane] = (int)lp; asgG[lr * 8 + lane] = gate;
            }
        }
        __syncthreads();
        if (c.tid < 256) { const unsigned hc = hist[c.tid]; basev[c.tid] = hc ? atomicAdd(cnt + c.tid, hc) : 0u; }
        __syncthreads();
        {
            const int i = c.tid, e = asgE[i];
            const unsigned pos = basev[e] + (unsigned)asgP[i];
            ((u32x2*)(ws + WS_LAID))[(size_t)e * CAP + pos] = (u32x2){(unsigned)((row0 + (i >> 3)) * 8 + (i & 7)), __float_as_uint(asgG[i])};
        }
    }
}

struct MoeTab { LAS int* tstart; LAS int* roff; LAS int* tok; LAS float* gate; };
__device__ __forceinline__ MoeTab moe_tab_build(const Params& p, const Ctx& c) {
    MoeTab T; T.tstart = (LAS int*)(c.lds + LDS_MISC); T.roff = T.tstart + 260; T.tok = T.roff + 260; T.gate = (LAS float*)(T.tok + 128);
    const unsigned* cnt = (const unsigned*)(p.ws + WS_CTL + CT_CNT);
    __syncthreads();
    if (c.tid < 64) {
        int cv[4], tv[4]; int ls = 0, lt = 0;
#pragma unroll
        for (int i = 0; i < 4; ++i) { cv[i] = (int)cnt[c.tid * 4 + i]; tv[i] = (cv[i] + 127) >> 7; ls += cv[i]; lt += tv[i]; }
        int ps = ls, pt = lt;
#pragma unroll
        for (int o = 1; o < 64; o <<= 1) { const int a = __shfl_up(ps, o), b = __shfl_up(pt, o); if (c.tid >= o) { ps += a; pt += b; } }
        int es = ps - ls, et = pt - lt;
#pragma unroll
        for (int i = 0; i < 4; ++i) { T.roff[c.tid * 4 + i] = es; T.tstart[c.tid * 4 + i] = et; es += cv[i]; et += tv[i]; }
        if (c.tid == 63) { T.roff[256] = es; T.tstart[256] = et; }
    }
    __syncthreads();
    return T;
}
__device__ __forceinline__ int moe_find(const MoeTab& T, int g) {
    int lo = 0, hi = 255;
    while (lo < hi) { const int mid = (lo + hi + 1) >> 1; if (T.tstart[mid] <= g) lo = mid; else hi = mid - 1; }
    return lo;
}

__device__ __forceinline__ void phase6(const Params& p, const Ctx& c) {
    unsigned char* ws = p.ws;
    const bf16_t* H1 = (const bf16_t*)(ws + WS_H1); bf16_t* HID = (bf16_t*)(ws + WS_HID);
    const unsigned* laid = (const unsigned*)(ws + WS_LAID);
    const unsigned* cnt = (const unsigned*)(ws + WS_CTL + CT_CNT);
    const int lane = c.lane, wr = c.wave >> 2, wc = c.wave & 3, fr = lane & 15, fq = lane >> 4;
    const MoeTab T = moe_tab_build(p, c);
    const int tmt = T.tstart[256], NU = (tmt + 128) * 2;
    for (int u = c.vcu; u < NU; u += c.G) {
        const int g = u >> 1, nt = u & 1;
        int e, mt, nrows; size_t hbase;
        __syncthreads();
        if (g < tmt) {
            e = moe_find(T, g); mt = g - T.tstart[e]; nrows = min(128, (int)cnt[e] - mt * 128); hbase = (size_t)T.roff[e] + mt * 128;
            if (c.tid < 128) T.tok[c.tid] = (int)(laid[(size_t)e * CAP + mt * 128 + min(c.tid, nrows - 1)] >> 3);
        } else {
            e = NEXP; mt = g - tmt; nrows = 128; hbase = (size_t)NTOK * 8 + mt * 128;
            if (c.tid < 128) T.tok[c.tid] = mt * 128 + c.tid;
        }
        __syncthreads();
        f32x4 acc[4][4]; acc_zero(acc);
        auto rp = [&](int r) { return H1 + (size_t)T.tok[r] * D; };
        const bf16_t* Bt = (e < NEXP ? (const bf16_t*)(ws + WS_WGU) + (size_t)e * 512 * D : (const bf16_t*)(ws + WS_WSGU)) + (size_t)nt * 256 * D;
        gemm_kloop(acc, c, rp, Bt, D, D);
#pragma unroll
        for (int mi = 0; mi < 4; ++mi) {
            const int r = wr * 64 + mi * 16 + fr;
            if (r >= nrows) continue;
#pragma unroll
            for (int np = 0; np < 2; ++np) {
                const f32x4 gt = acc[mi][2 * np], up = acc[mi][2 * np + 1];
                f32x4 hv;
#pragma unroll
                for (int j = 0; j < 4; ++j) hv[j] = gt[j] / (1.f + __expf(-gt[j])) * up[j];
                store_bf4(HID + (hbase + r) * DEXP + nt * 128 + wc * 32 + np * 16 + fq * 4, hv);
            }
        }
    }
}
__device__ __forceinline__ void phase7(const Params& p, const Ctx& c) {
    unsigned char* ws = p.ws;
    const bf16_t* HID = (const bf16_t*)(ws + WS_HID); bf16_t* Y = (bf16_t*)(ws + WS_Y);
    const unsigned* laid = (const unsigned*)(ws + WS_LAID); const float* lgate = (const float*)(ws + WS_LGATE);
    const unsigned* cnt = (const unsigned*)(ws + WS_CTL + CT_CNT);
    const int lane = c.lane, wr = c.wave >> 2, wc = c.wave & 3, fr = lane & 15, fq = lane >> 4;
    const MoeTab T = moe_tab_build(p, c);
    const int tmt = T.tstart[256], NU = (tmt + 128) * 4;
    for (int u = c.vcu; u < NU; u += c.G) {
        const int g = u >> 2, nt = u & 3;
        int e, mt, nrows; size_t hbase;
        __syncthreads();
        if (g < tmt) {
            e = moe_find(T, g); mt = g - T.tstart[e]; nrows = min(128, (int)cnt[e] - mt * 128); hbase = (size_t)T.roff[e] + mt * 128;
            if (c.tid < 128) {
                const int rr = min(c.tid, nrows - 1);
                const unsigned aid = laid[(size_t)e * CAP + mt * 128 + rr];
                T.tok[c.tid] = (int)((aid >> 3) * 9 + (aid & 7)); T.gate[c.tid] = lgate[(size_t)e * CAP + mt * 128 + rr];
            }
        } else {
            e = NEXP; mt = g - tmt; nrows = 128; hbase = (size_t)NTOK * 8 + mt * 128;
            if (c.tid < 128) { T.tok[c.tid] = (mt * 128 + c.tid) * 9 + 8; T.gate[c.tid] = 1.f; }
        }
        __syncthreads();
        f32x4 acc[4][4]; acc_zero(acc);
        auto rp = [&](int r) { return HID + (hbase + min(r, nrows - 1)) * DEXP; };
        const bf16_t* Bt = (e < NEXP ? (const bf16_t*)(ws + WS_WD) + (size_t)e * D * DEXP : (const bf16_t*)(ws + WS_WSD)) + (size_t)nt * 256 * DEXP;
        gemm_kloop(acc, c, rp, Bt, DEXP, DEXP);
#pragma unroll
        for (int mi = 0; mi < 4; ++mi) {
            const int r = wr * 64 + mi * 16 + fr;
            if (r >= nrows) continue;
            const float gt = T.gate[r]; const size_t yrow = (size_t)T.tok[r];
#pragma unroll
            for (int ni = 0; ni < 4; ++ni) store_bf4(Y + yrow * D + nt * 256 + wc * 64 + ni * 16 + fq * 4, acc[mi][ni] * gt);
        }
    }
}

__device__ __forceinline__ int moe_find_l(const LAS int* tstart, int g) {
    int lo = 0, hi = 255;
    while (lo < hi) { const int mid = (lo + hi + 1) >> 1; if (tstart[mid] <= g) lo = mid; else hi = mid - 1; }
    return lo;
}

constexpr int MOE_A = 0, MOE_B = 32768, MOE_H0 = 98304, MOE_H1 = 0, MOE_MISC = 131072;
struct MoeUnit { const float* wg; const float* wu; const float* wd; int nrows; int par; };

__device__ __forceinline__ void phase_moe(const Params& p, const Ctx& c) {
    unsigned char* ws = p.ws;
    const bf16_t* H1 = (const bf16_t*)(ws + WS_H1); bf16_t* Y = (bf16_t*)(ws + WS_Y);
    const unsigned* laid = (const unsigned*)(ws + WS_LAID); const float* lgate = (const float*)(ws + WS_LGATE);
    const unsigned* cnt = (const unsigned*)(ws + WS_CTL + CT_CNT);
    const int tid = c.tid, lane = c.lane, wr = c.wave >> 2, wc = c.wave & 3, fr = lane & 15, fq = lane >> 4;
    LAS unsigned char* lds = c.lds;
    LAS int* tstart = (LAS int*)(lds + MOE_MISC); LAS int* cntl = tstart + 260;
    LAS int* tokT = cntl + 260; LAS int* yrowT = tokT + 256; LAS float* gateT = (LAS float*)(yrowT + 256);
    __syncthreads();
    if (tid < 64) {
        int cv[4], tv[4]; int lt = 0;
#pragma unroll
        for (int i = 0; i < 4; ++i) { cv[i] = (int)cnt[tid * 4 + i]; tv[i] = (cv[i] + 127) >> 7; lt += tv[i]; }
        int pt = lt;
#pragma unroll
        for (int o = 1; o < 64; o <<= 1) { const int b = __shfl_up(pt, o); if (tid >= o) pt += b; }
        int et = pt - lt;
#pragma unroll
        for (int i = 0; i < 4; ++i) { cntl[tid * 4 + i] = cv[i]; tstart[tid * 4 + i] = et; et += tv[i]; }
        if (tid == 63) tstart[256] = et;
    }
    __syncthreads();
    const int tmt = tstart[256], NU = tmt + 128;
    if (c.vcu >= NU) return;

    const int srow = tid >> 3, sch = tid & 7;
    const int soA = srow * 128 + ((sch ^ ((srow >> 1) & 7)) << 4);
    const int kk1 = tid >> 5, n4 = tid & 31;
    const int s1 = (kk1 & 3) | (((kk1 >> 3) & 1) << 2);
    const int soB1g = kk1 * 512 + (((2 * (n4 >> 2)) ^ s1) << 5) + (n4 & 3) * 8;
    const int soB1u = kk1 * 512 + (((2 * (n4 >> 2) + 1) ^ s1) << 5) + (n4 & 3) * 8;
    const int kk2 = tid >> 6, c4 = tid & 63;
    const int soB2e = kk2 * 512 + ((((c4 >> 2)) ^ (kk2 & 3)) << 5) + (c4 & 3) * 8;
    const int soB2o = kk2 * 512 + ((((c4 >> 2)) ^ ((kk2 & 3) | 4)) << 5) + (c4 & 3) * 8;
    const int sw0 = ((0 + fq) ^ ((fr >> 1) & 7)) << 4, sw1 = ((4 + fq) ^ ((fr >> 1) & 7)) << 4;
    const int aoff = (wr * 64 + fr) * 128;
    const int qp = fr >> 2, pp = fr & 3, sB = qp | ((fq & 1) << 2);
    const int brow = (8 * fq + qp) * 512 + pp * 8;
    int bblk[4];
#pragma unroll
    for (int ni = 0; ni < 4; ++ni) bblk[ni] = ((4 * wc + ni) ^ sB) << 5;
    const int hoff = (wr * 64 + fr) * 256;

    const unsigned lo1 = (unsigned)(kk1 * 256 + n4 * 4), lo2 = (unsigned)(kk2 * D + c4 * 4);
    u32x4 ra0, ra1; f32x4 rb[8];
    f32x4 acc[4][4];

#define M_LOAD1(U, nt, kt) do { \
        const int t0_ = tokT[(U).par * 128 + srow], t1_ = tokT[(U).par * 128 + srow + 64]; \
        ra0 = *(const u32x4*)(H1 + (size_t)t0_ * D + (kt) * 64 + sch * 8); ra1 = *(const u32x4*)(H1 + (size_t)t1_ * D + (kt) * 64 + sch * 8); \
        const float* g_ = (U).wg + ((kt) * 64 * 256 + (nt) * 128); const float* u_ = (U).wu + ((kt) * 64 * 256 + (nt) * 128); \
        _Pragma("unroll") for (int j = 0; j < 4; ++j) { rb[j] = *(const f32x4*)(g_ + j * 4096 + lo1); rb[4 + j] = *(const f32x4*)(u_ + j * 4096 + lo1); } } while (0)
#define M_STORE1(buf) do { LAS unsigned char* sa_ = lds + MOE_A + (buf) * 16384; LAS unsigned char* sb_ = lds + MOE_B + (buf) * 32768; \
        *(LAS u32x4*)(sa_ + soA) = ra0; *(LAS u32x4*)(sa_ + soA + 8192) = ra1; \
        _Pragma("unroll") for (int j = 0; j < 4; ++j) { \
            *(LAS u32x2*)(sb_ + soB1g + j * 8192) = (u32x2){cvtpk(rb[j][0], rb[j][1]), cvtpk(rb[j][2], rb[j][3])}; \
            *(LAS u32x2*)(sb_ + soB1u + j * 8192) = (u32x2){cvtpk(rb[4 + j][0], rb[4 + j][1]), cvtpk(rb[4 + j][2], rb[4 + j][3])}; } } while (0)
#define M_LOAD2(U, nt2, ksm) do { \
        const float* d_ = (U).wd + ((ksm) * 64 * D + (nt2) * 256); \
        _Pragma("unroll") for (int j = 0; j < 8; ++j) rb[j] = *(const f32x4*)(d_ + j * 8192 + lo2); } while (0)
#define M_STORE2(buf) do { LAS unsigned char* sb_ = lds + MOE_B + (buf) * 32768; \
        _Pragma("unroll") for (int j = 0; j < 8; ++j) \
            *(LAS u32x2*)(sb_ + ((j & 1) ? soB2o : soB2e) + j * 4096) = (u32x2){cvtpk(rb[j][0], rb[j][1]), cvtpk(rb[j][2], rb[j][3])}; } while (0)
#define M_BFRAG(dst, sbB, ks) do { _Pragma("unroll") for (int ni = 0; ni < 4; ++ni) { \
            const s16x4 lo_ = vtr((sbB) + brow + (ks) * 16384 + bblk[ni]), hi_ = vtr((sbB) + brow + (ks) * 16384 + 2048 + bblk[ni]); \
            dst[ni] = (bf16x8){lo_[0], lo_[1], lo_[2], lo_[3], hi_[0], hi_[1], hi_[2], hi_[3]}; } } while (0)
#define M_COMPUTE1(buf) do { const LAS unsigned char* sa_ = lds + MOE_A + (buf) * 16384; const LAS unsigned char* sbb_ = lds + MOE_B + (buf) * 32768; \
        _Pragma("unroll") for (int ks = 0; ks < 2; ++ks) { bf16x8 af[4], bfr[4]; \
            _Pragma("unroll") for (int mi = 0; mi < 4; ++mi) af[mi] = *(const LAS bf16x8*)(sa_ + aoff + mi * 2048 + (ks ? sw1 : sw0)); \
            M_BFRAG(bfr, sbb_, ks); \
            _Pragma("unroll") for (int mi = 0; mi < 4; ++mi) _Pragma("unroll") for (int ni = 0; ni < 4; ++ni) \
                acc[mi][ni] = __builtin_amdgcn_mfma_f32_16x16x32_bf16(bfr[ni], af[mi], acc[mi][ni], 0, 0, 0); } } while (0)
#define M_COMPUTE2(buf, ksm) do { const LAS unsigned char* sh_ = lds + (((ksm) >> 1) ? MOE_H1 : MOE_H0); const LAS unsigned char* sbb_ = lds + MOE_B + (buf) * 32768; \
        _Pragma("unroll") for (int ks = 0; ks < 2; ++ks) { bf16x8 af[4], bfr[4]; \
            _Pragma("unroll") for (int mi = 0; mi < 4; ++mi) af[mi] = *(const LAS bf16x8*)(sh_ + hoff + mi * 4096 + (((((ksm) & 1) * 8 + ks * 4 + fq) ^ fr) << 4)); \
            M_BFRAG(bfr, sbb_, ks); \
            _Pragma("unroll") for (int mi = 0; mi < 4; ++mi) _Pragma("unroll") for (int ni = 0; ni < 4; ++ni) \
                acc[mi][ni] = __builtin_amdgcn_mfma_f32_16x16x32_bf16(bfr[ni], af[mi], acc[mi][ni], 0, 0, 0); } } while (0)

    auto unit_make = [&](int u, int par, MoeUnit& U, int& e, int& mt) {
        if (u < tmt) { e = moe_find_l(tstart, u); mt = u - tstart[e]; U.nrows = min(128, cntl[e] - mt * 128);
            U.wg = p.w_gate + (size_t)e * D * DEXP; U.wu = p.w_up + (size_t)e * D * DEXP; U.wd = p.w_down + (size_t)e * D * DEXP; }
        else { e = NEXP; mt = u - tmt; U.nrows = 128; U.wg = p.ws_gate; U.wu = p.ws_up; U.wd = p.ws_down; }
        U.par = par;
    };
    auto unit_tables = [&](const MoeUnit& U, int e, int mt) {
        if (tid < 128) {
            int tok, yr; float gt;
            if (e < NEXP) { const int rr = min(tid, U.nrows - 1); const unsigned aid = laid[(size_t)e * CAP + mt * 128 + rr];
                tok = (int)(aid >> 3); yr = tok * 9 + (int)(aid & 7); gt = lgate[(size_t)e * CAP + mt * 128 + rr]; }
            else { tok = mt * 128 + tid; yr = tok * 9 + 8; gt = 1.f; }
            tokT[U.par * 128 + tid] = tok; yrowT[U.par * 128 + tid] = yr; gateT[U.par * 128 + tid] = gt;
        }
    };

    MoeUnit cur, nxt; int e_, mt_;
    unit_make(c.vcu, 0, cur, e_, mt_);
    unit_tables(cur, e_, mt_);
    __syncthreads();
    M_LOAD1(cur, 0, 0);
    M_STORE1(0);
    __syncthreads();
    for (int u = c.vcu, ui = 0; u < NU; u += c.G, ++ui) {
        const bool has_next = (u + c.G) < NU;
#pragma unroll 1
        for (int nt = 0; nt < 2; ++nt) {
            acc_zero(acc);
#pragma unroll 1
            for (int kt = 0; kt < 16; ++kt) {
                const bool last = (kt == 15);
                if (!last) M_LOAD1(cur, nt, kt + 1);
                else if (nt == 0) M_LOAD1(cur, 1, 0);
                else M_LOAD2(cur, 0, 2);
                M_COMPUTE1(kt & 1);
                if (!(last && nt == 1)) M_STORE1((kt + 1) & 1); else M_STORE2(0);
                __syncthreads();
            }
            {
                LAS unsigned char* hb = lds + (nt ? MOE_H1 : MOE_H0);
#pragma unroll
                for (int mi = 0; mi < 4; ++mi) {
                    const int r = wr * 64 + mi * 16 + fr;
#pragma unroll
                    for (int np = 0; np < 2; ++np) {
                        const f32x4 gt = acc[mi][2 * np], up = acc[mi][2 * np + 1];
                        float hv[4];
#pragma unroll
                        for (int j = 0; j < 4; ++j) hv[j] = gt[j] / (1.f + __expf(-gt[j])) * up[j];
                        const int chunk = wc * 4 + np * 2 + (fq >> 1);
                        *(LAS u32x2*)(hb + r * 256 + ((chunk ^ fr) << 4) + (fq & 1) * 8) = (u32x2){cvtpk(hv[0], hv[1]), cvtpk(hv[2], hv[3])};
                    }
                }
            }
            if (nt == 1) __syncthreads();
        }
#pragma unroll 1
        for (int nt2 = 0; nt2 < 4; ++nt2) {
            acc_zero(acc);
            if (nt2 == 0 && has_next) { unit_make(u + c.G, (ui + 1) & 1, nxt, e_, mt_); unit_tables(nxt, e_, mt_); }
#pragma unroll 1
            for (int kq = 0; kq < 4; ++kq) {
                const int ksm = kq ^ 2;
                const bool last = (kq == 3);
                if (!last) M_LOAD2(cur, nt2, (kq + 1) ^ 2);
                else if (nt2 < 3) M_LOAD2(cur, nt2 + 1, 2);
                else if (has_next) M_LOAD1(nxt, 0, 0);
                M_COMPUTE2(kq & 1, ksm);
                if (!(last && nt2 == 3)) M_STORE2((kq + 1) & 1); else if (has_next) M_STORE1(0);
                __syncthreads();
            }
#pragma unroll
            for (int mi = 0; mi < 4; ++mi) {
                const int r = wr * 64 + mi * 16 + fr;
                if (r < cur.nrows) {
                    const float gt = gateT[cur.par * 128 + r]; const size_t yrow = (size_t)yrowT[cur.par * 128 + r];
#pragma unroll
                    for (int ni = 0; ni < 4; ++ni) store_bf4(Y + yrow * D + nt2 * 256 + wc * 64 + ni * 16 + fq * 4, acc[mi][ni] * gt);
                }
            }
        }
        cur = nxt;
    }
#undef M_LOAD1
#undef M_STORE1
#undef M_LOAD2
#undef M_STORE2
#undef M_BFRAG
#undef M_COMPUTE1
#undef M_COMPUTE2
}


__device__ __forceinline__ void store_blk32_bf16(bf16_t* p, const f32x16& v, int hi, bool pred = true) {
#pragma unroll
    for (int pr = 0; pr < 2; ++pr) {
        unsigned ax = cvtpk(v[8 * pr + 0], v[8 * pr + 1]), ay = cvtpk(v[8 * pr + 2], v[8 * pr + 3]);
        unsigned bx = cvtpk(v[8 * pr + 4], v[8 * pr + 5]), by = cvtpk(v[8 * pr + 6], v[8 * pr + 7]);
        { auto r_ = __builtin_amdgcn_permlane32_swap(ax, bx, false, false); ax = r_[0]; bx = r_[1]; }
        { auto r_ = __builtin_amdgcn_permlane32_swap(ay, by, false, false); ay = r_[0]; by = r_[1]; }
        if (pred) *(u32x4*)(p + 16 * pr + (hi ? 8 : 0)) = (u32x4){ax, ay, bx, by};
    }
}

constexpr int G2_A = 0, G2_B = 65536, G2_MISC = 131072;
constexpr int G2_GATE = G2_MISC + 4096, G2_YROW = G2_GATE + 2048, G2_TAB = G2_YROW + 2048;
constexpr int BM_BF16T = 0, BM_F32 = 1, BM_F32_GU = 2;
struct G2Unit { const void* b0; const void* b1; int ldb; int nsteps; int nrows; int par; int i0, i1, i2; int kshift, bsub; };

#define G2_SGB(mask, n) __builtin_amdgcn_sched_group_barrier(mask, n, 0)
#define G2_MFMA_HALF(NMI, KM, kh) do { \
        __builtin_amdgcn_sched_barrier(0); \
        _Pragma("unroll") for (int kq = 0; kq < 2; ++kq) { const int k16_ = 2 * (kh) + kq; bf16x8 bfr[2]; \
            if (KM) { _Pragma("unroll") for (int ni = 0; ni < 2; ++ni) { const int bb_ = ((4 * wc + 2 * ni + bsel) ^ sB2) << 5; \
                const s16x4 lo_ = vtr(sbb_ + brow + k16_ * 8192 + bb_); const s16x4 hi_ = vtr(sbb_ + brow + k16_ * 8192 + 2048 + bb_); \
                bf16x8 t_; t_[0] = lo_[0]; t_[1] = lo_[1]; t_[2] = lo_[2]; t_[3] = lo_[3]; t_[4] = hi_[0]; t_[5] = hi_[1]; t_[6] = hi_[2]; t_[7] = hi_[3]; bfr[ni] = t_; } } \
            else { _Pragma("unroll") for (int ni = 0; ni < 2; ++ni) bfr[ni] = *(const LAS bf16x8*)(sbb_ + boffT + ni * 4096 + (((2 * k16_ + hi) ^ swx) << 4)); } \
            _Pragma("unroll") for (int mi = 0; mi < (NMI); ++mi) { \
                const bf16x8 af_ = *(const LAS bf16x8*)(sa_ + aoff + mi * 8192 + (((2 * k16_ + hi) ^ swx) << 4)); \
                _Pragma("unroll") for (int ni = 0; ni < 2; ++ni) acc[mi][ni] = __builtin_amdgcn_mfma_f32_32x32x16_bf16(bfr[ni], af_, acc[mi][ni], 0, 0, 0); } } \
        if (!(KM)) { _Pragma("unroll") for (int kq = 0; kq < 2; ++kq) { G2_SGB(0x100, 3); \
            _Pragma("unroll") for (int g = 0; g < (NMI) - 1; ++g) { G2_SGB(0x100, 1); G2_SGB(0x008, 2); } \
            G2_SGB(0x008, 2); } } \
        __builtin_amdgcn_sched_barrier(0); \
    } while (0)
#define G2_SEL(off) const int nst_ = st + (off); const bool wrap_ = nst_ >= cur.nsteps, usen_ = wrap_ && has_next; \
        const void* sb0_ = usen_ ? nxt.b0 : cur.b0; const void* sb1_ = usen_ ? nxt.b1 : cur.b1; const int spar_ = usen_ ? nxt.par : cur.par; \
        const int sk0_ = wrap_ ? (has_next ? nst_ - cur.nsteps : cur.nsteps - 1) : nst_; const int ldb_ = cur.ldb; (void)sb1_; \
        const int ssub_ = sk0_ >> cur.kshift, sk_ = sk0_ - (ssub_ << cur.kshift); const int sboff_ = ssub_ * cur.bsub; (void)sboff_

typedef __amdgpu_buffer_rsrc_t rsrc_t;
__device__ __forceinline__ rsrc_t make_rsrc(const void* p) {
    const unsigned long long a = (unsigned long long)(uintptr_t)p;
    const unsigned lo = __builtin_amdgcn_readfirstlane((unsigned)a), hi = __builtin_amdgcn_readfirstlane((unsigned)(a >> 32));
    return __builtin_amdgcn_make_buffer_rsrc((void*)(uintptr_t)(((unsigned long long)hi << 32) | lo), (short)0, 0x7fffffff, 0x00020000);
}
__device__ __forceinline__ u32x4 bload16(rsrc_t r, int voff, int soff) { return __builtin_bit_cast(u32x4, __builtin_amdgcn_raw_buffer_load_b128(r, voff, soff, 0)); }
template <int BMODE, bool FULL, class Sched, class Epi>
__device__ __forceinline__ void gemm256_stream(const Ctx& c, Sched& S, const Epi& E) {
    const int tid = c.tid, lane = c.lane, wr = c.wave >> 2, wc = c.wave & 3, r32 = lane & 31, hi = lane >> 5;
    LAS unsigned char* lds = c.lds;
    const LAS unsigned* rowT = (const LAS unsigned*)(lds + G2_MISC);
    const rsrc_t rsA = make_rsrc(S.abase());
    const int srow = tid >> 3, sch = tid & 7;
    const int soA = srow * 128 + ((sch ^ ((srow >> 1) & 7)) << 4);
    const int kk1 = tid >> 5, n4 = tid & 31;
    const int soB1g = kk1 * 512 + (((2 * (n4 >> 2)) ^ (2 * (kk1 & 3))) << 5) + (n4 & 3) * 8;
    const int soB1u = kk1 * 512 + (((2 * (n4 >> 2) + 1) ^ (2 * (kk1 & 3))) << 5) + (n4 & 3) * 8;
    const int kk2 = tid >> 6, c4 = tid & 63;
    const int soB2 = kk2 * 512 + ((((c4 >> 2)) ^ (2 * (kk2 & 3))) << 5) + (c4 & 3) * 8;
    const int swx = (r32 >> 1) & 7;
    const int aoff = (32 * wr + r32) * 128;
    const int boffT = (wc * 64 + r32) * 128;
    const int qp = (lane & 15) >> 2, pp = lane & 3, bsel = (lane >> 4) & 1, sB2 = 2 * qp;
    const int brow = (8 * hi + qp) * 512 + pp * 8;
    (void)boffT; (void)brow; (void)sB2; (void)bsel; (void)soB1g; (void)soB1u; (void)soB2;
    u32x4 ra[4]; u32x4 rbh[4]; f32x4 rb[8];
    f32x16 acc[4][2];
#define G1_LOAD(b0, b1, par, kst, ldb) do { \
        const LAS unsigned* rt_ = rowT + (par) * 256 + srow; \
        const int ksoff_ = __builtin_amdgcn_readfirstlane((kst) * 128); \
        _Pragma("unroll") for (int j = 0; j < 4; ++j) ra[j] = bload16(rsA, (int)rt_[64 * j] + sch * 16, ksoff_); \
        const rsrc_t rb0_ = make_rsrc(b0); \
        if (BMODE == BM_BF16T) { const int so_ = __builtin_amdgcn_readfirstlane((kst) * 128), js_ = __builtin_amdgcn_readfirstlane(128 * (ldb)); \
            _Pragma("unroll") for (int j = 0; j < 4; ++j) rbh[j] = bload16(rb0_, voB, so_ + j * js_); } \
        else if (BMODE == BM_F32) { const int so_ = __builtin_amdgcn_readfirstlane((kst) * 256 * (ldb)), js_ = __builtin_amdgcn_readfirstlane(32 * (ldb)); \
            _Pragma("unroll") for (int j = 0; j < 8; ++j) rb[j] = __builtin_bit_cast(f32x4, bload16(rb0_, voB, so_ + j * js_)); } \
        else { const rsrc_t rb1_ = make_rsrc(b1); const int so_ = __builtin_amdgcn_readfirstlane((kst) * 256 * (ldb)), js_ = __builtin_amdgcn_readfirstlane(64 * (ldb)); \
            _Pragma("unroll") for (int j = 0; j < 4; ++j) { rb[j] = __builtin_bit_cast(f32x4, bload16(rb0_, voB, so_ + j * js_)); rb[4 + j] = __builtin_bit_cast(f32x4, bload16(rb1_, voB, so_ + j * js_)); } } \
    } while (0)
#define G1_STORE(buf) do { LAS unsigned char* sa_ = lds + G2_A + (buf) * 32768; LAS unsigned char* sb_ = lds + G2_B + (buf) * 32768; \
        _Pragma("unroll") for (int j = 0; j < 4; ++j) *(LAS u32x4*)(sa_ + soA + j * 8192) = ra[j]; \
        if (BMODE == BM_BF16T) { _Pragma("unroll") for (int j = 0; j < 4; ++j) *(LAS u32x4*)(sb_ + soA + j * 8192) = rbh[j]; } \
        else if (BMODE == BM_F32) { _Pragma("unroll") for (int j = 0; j < 8; ++j) \
            *(LAS u32x2*)(sb_ + soB2 + j * 4096) = (u32x2){cvtpk(rb[j][0], rb[j][1]), cvtpk(rb[j][2], rb[j][3])}; } \
        else { _Pragma("unroll") for (int j = 0; j < 4; ++j) { \
            *(LAS u32x2*)(sb_ + soB1g + j * 8192) = (u32x2){cvtpk(rb[j][0], rb[j][1]), cvtpk(rb[j][2], rb[j][3])}; \
            *(LAS u32x2*)(sb_ + soB1u + j * 8192) = (u32x2){cvtpk(rb[4 + j][0], rb[4 + j][1]), cvtpk(rb[4 + j][2], rb[4 + j][3])}; } } \
    } while (0)
    G2Unit cur, nxt;
    if (!S.next(cur, 0)) return;
    nxt = cur;
    const int voB = BMODE == BM_BF16T ? (srow * cur.ldb + sch * 8) * 2 : BMODE == BM_F32 ? (kk2 * cur.ldb + c4 * 4) * 4 : (kk1 * cur.ldb + n4 * 4) * 4;
    __syncthreads();
    G1_LOAD(cur.b0, cur.b1, cur.par, 0, cur.ldb);
    G1_STORE(0);
    G1_LOAD(cur.b0, cur.b1, cur.par, 1, cur.ldb);
    __syncthreads();
    int gs = 0;
    bool has_cur = true;
    while (has_cur) {
#pragma unroll
        for (int a = 0; a < 4; ++a)
#pragma unroll
            for (int b = 0; b < 2; ++b)
#pragma unroll
                for (int r = 0; r < 16; ++r) acc[a][b][r] = 0.f;
        const int nb = (cur.nrows + 31) >> 5, nmi = (nb - wr + 1) >> 1;
        bool has_next = false;
#define G1_UNIT_LOOP(NMI) do { _Pragma("unroll 1") for (int st = 0; st < cur.nsteps; ++st) { \
            if (st == 1) has_next = S.next(nxt, cur.par ^ 1);     \
            if (st == 0) S.issue(); \
            { const LAS unsigned char* sa_ = lds + G2_A + (gs & 1) * 32768; const LAS unsigned char* sbb_ = lds + G2_B + (gs & 1) * 32768; \
              G2_MFMA_HALF(NMI, BMODE != BM_BF16T, 0); \
              G1_STORE((gs + 1) & 1);                             \
              __builtin_amdgcn_sched_barrier(0); \
              { G2_SEL(2); G1_LOAD((BMODE == BM_F32 ? (const void*)((const float*)sb0_ + sboff_) : sb0_), sb1_, spar_, sk_, ldb_); }     \
              G2_MFMA_HALF(NMI, BMODE != BM_BF16T, 1); } \
            if (st == 0) S.commit(); \
            __syncthreads(); \
            ++gs; \
            if (Epi::HAS_MID) E.mid(acc, cur, st, nmi, wr, r32); } } while (0)
        if (FULL || nmi >= 4) G1_UNIT_LOOP(4); else if (nmi == 3) G1_UNIT_LOOP(3); else if (nmi == 2) G1_UNIT_LOOP(2); else G1_UNIT_LOOP(1);
#undef G1_UNIT_LOOP
        E(acc, cur, nmi, wr, wc, r32, hi);
        cur = nxt; has_cur = has_next;
    }
#undef G1_LOAD
#undef G1_STORE
}

struct MoeSched2 {
    const Params& p; const Ctx& c; int NT; bool isB; int tru, NU, i;
    LAS int* tstart; LAS int* roff; LAS int* cntl; LAS int* rpuT; LAS int* qslot; unsigned* qctr; unsigned pend;
    __device__ __forceinline__ const void* abase() const { return isB ? p.ws + WS_HID : p.ws + WS_H1; }
    __device__ __forceinline__ void issue() { if (c.tid == 0) pend = __hip_atomic_fetch_add(qctr, 1u, __ATOMIC_RELAXED, __HIP_MEMORY_SCOPE_AGENT); }
    __device__ __forceinline__ void commit() { if (c.tid == 0) qslot[0] = (int)(32u + pend); }
    __device__ __forceinline__ MoeSched2(const Params& p_, const Ctx& c_, int NT_, bool isB_) : p(p_), c(c_), NT(NT_), isB(isB_), i(0) {
        tstart = (LAS int*)(c.lds + G2_TAB); roff = tstart + 260; cntl = roff + 260; rpuT = cntl + 260; qslot = rpuT + 260; pend = 0;
        qctr = (unsigned*)(p.ws + WS_CTL + CT_Q) + (isB_ ? 8 * 64 : 0) + (c.vcu >> 5) * 64;
        const unsigned* cnt = (const unsigned*)(p.ws + WS_CTL + CT_CNT);
        __syncthreads();
        if (c.tid < 64) {
            int cv[4], tv[4], rp[4]; int ls = 0, lt = 0;
#pragma unroll
            for (int k = 0; k < 4; ++k) { cv[k] = (int)cnt[c.tid * 4 + k]; tv[k] = (cv[k] + 255) >> 8; rp[k] = tv[k] ? ((((cv[k] + tv[k] - 1) / tv[k]) + 31) & ~31) : 0; ls += cv[k]; lt += tv[k]; }
            int ps = ls, pt = lt;
#pragma unroll
            for (int o = 1; o < 64; o <<= 1) { const int a = __shfl_up(ps, o), b = __shfl_up(pt, o); if (c.tid >= o) { ps += a; pt += b; } }
            int es = ps - ls, et = pt - lt;
#pragma unroll
            for (int k = 0; k < 4; ++k) { cntl[c.tid * 4 + k] = cv[k]; rpuT[c.tid * 4 + k] = rp[k]; roff[c.tid * 4 + k] = es; tstart[c.tid * 4 + k] = et; es += cv[k]; et += tv[k]; }
            if (c.tid == 63) { roff[256] = es; tstart[256] = et; }
        }
        __syncthreads();
        tru = tstart[256]; NU = (tru + 64) * NT;
    }
    __device__ __forceinline__ bool next(G2Unit& U, int par) {
        int tid_ = c.tid; asm volatile("" : "+v"(tid_));
        const int NUx = (NU + 7) >> 3, xg = c.vcu >> 5, pos = (i == 0) ? (c.vcu & 31) : qslot[0]; ++i;
        const int idx = xg * NUx + pos;
        if (pos >= NUx || idx >= NU) return false;
        int e, r0, nrows, nt; size_t hbase, lbase = 0;
        if (idx < tru * NT) { e = __builtin_amdgcn_readfirstlane(moe_find_l(tstart, idx / NT)); const int ts = __builtin_amdgcn_readfirstlane(tstart[e]), nu = __builtin_amdgcn_readfirstlane(tstart[e + 1]) - ts, loc = __builtin_amdgcn_readfirstlane(idx) - ts * NT, rpu = __builtin_amdgcn_readfirstlane(rpuT[e]);
            nt = (nu == 1) ? loc : (nu == 2) ? (loc >> 1) : loc / nu; const int ui = loc - nt * nu;
            r0 = ui * rpu; nrows = min(rpu, cntl[e] - r0); hbase = (size_t)roff[e] + r0; lbase = (size_t)e * CAP + r0; }
        else { const int loc = idx - tru * NT; e = NEXP; nt = loc >> 6; r0 = (loc & 63) * 256; nrows = 256; hbase = (size_t)NTOK * 8 + r0; }
        U.nrows = nrows; U.par = par; U.i0 = (int)hbase; U.i1 = nt; U.i2 = 0; U.kshift = 30; U.bsub = 0;
        const unsigned* laid = (const unsigned*)(p.ws + WS_LAID); const float* lgate = (const float*)(p.ws + WS_LGATE);
        LAS unsigned* rowT = (LAS unsigned*)(c.lds + G2_MISC) + par * 256;
        if (!isB) {
            U.b0 = (e < NEXP ? p.w_gate + (size_t)e * D * DEXP : p.ws_gate) + nt * 128; U.b1 = (e < NEXP ? p.w_up + (size_t)e * D * DEXP : p.ws_up) + nt * 128;
            U.ldb = DEXP; U.nsteps = D / 64;
            if (tid_ < 256) {
                const int rr = min(tid_, nrows - 1);
                const int tok = e < NEXP ? (int)(((const u32x2*)laid)[lbase + rr].x >> 3) : r0 + rr;
                rowT[tid_] = (unsigned)tok * (D * 2);
            }
        } else {
            U.b0 = (e < NEXP ? p.w_down + (size_t)e * DEXP * D : p.ws_down) + nt * 256; U.b1 = nullptr;
            U.ldb = D; U.nsteps = DEXP / 64;
            if (tid_ < 256) {
                const int rr = min(tid_, nrows - 1);
                rowT[tid_] = (unsigned)(hbase + rr) * (DEXP * 2);
                int yr; float gt;
                if (e < NEXP) { const u32x2 le = ((const u32x2*)laid)[lbase + rr]; yr = (int)((le.x >> 3) * 9 + (le.x & 7)); gt = __uint_as_float(le.y); }
                else { yr = (r0 + rr) * 9 + 8; gt = 1.f; }
                ((LAS float*)(c.lds + G2_GATE))[par * 256 + tid_] = gt; ((LAS int*)(c.lds + G2_YROW))[par * 256 + tid_] = yr;
            }
        }
        return true;
    }
};
struct EpiMoeA {
    static constexpr bool HAS_MID = false, HAS_SUB = false;
    bf16_t* HID;
    __device__ __forceinline__ void mid(f32x16 (&)[4][2], const G2Unit&, int, int, int, int) const {}
    __device__ __forceinline__ void operator()(f32x16 (&acc)[4][2], const G2Unit& U, int nmi, int wr, int wc, int r32, int hi) const {
        asm volatile("" : "+v"(r32), "+v"(hi));
#pragma unroll
        for (int mi = 0; mi < 4; ++mi) {
            if (mi < nmi) {
                const int r = 64 * mi + 32 * wr + r32;
#pragma unroll
                for (int ni = 0; ni < 2; ++ni) {
                    float hv[8];
#pragma unroll
                    for (int q = 0; q < 8; ++q) { const float gt = acc[mi][ni][q], up = acc[mi][ni][q + 8]; hv[q] = gt / (1.f + __expf(-gt)) * up; }
                    unsigned ax = cvtpk(hv[0], hv[1]), ay = cvtpk(hv[2], hv[3]), bx = cvtpk(hv[4], hv[5]), by = cvtpk(hv[6], hv[7]);
                    { auto r_ = __builtin_amdgcn_permlane32_swap(ax, bx, false, false); ax = r_[0]; bx = r_[1]; }
                    { auto r_ = __builtin_amdgcn_permlane32_swap(ay, by, false, false); ay = r_[0]; by = r_[1]; }
                    if (r < U.nrows) *(u32x4*)(HID + ((size_t)U.i0 + r) * DEXP + U.i1 * 128 + (2 * wc + ni) * 16 + (hi ? 8 : 0)) = (u32x4){ax, ay, bx, by};
                }
            }
        }
    }
};
constexpr float Y8_SCALE = 64.f;
struct EpiMoeB {
    static constexpr bool HAS_MID = false, HAS_SUB = false;
    unsigned char* Y8; const LAS float* gateT; const LAS int* yrowT;
    __device__ __forceinline__ void mid(f32x16 (&)[4][2], const G2Unit&, int, int, int, int) const {}
    __device__ __forceinline__ void operator()(f32x16 (&acc)[4][2], const G2Unit& U, int nmi, int wr, int wc, int r32, int hi) const {
        asm volatile("" : "+v"(r32), "+v"(hi));
#pragma unroll
        for (int mi = 0; mi < 4; ++mi) {
            if (mi < nmi) {
                const int r = 64 * mi + 32 * wr + r32;
                const float gt = gateT[U.par * 256 + r] * Y8_SCALE; const size_t yrow = (size_t)yrowT[U.par * 256 + r];
#pragma unroll
                for (int ni = 0; ni < 2; ++ni) {
                    unsigned d[4];
#pragma unroll
                    for (int g = 0; g < 4; ++g) {
                        int wv = __builtin_amdgcn_cvt_pk_fp8_f32(acc[mi][ni][4 * g] * gt, acc[mi][ni][4 * g + 1] * gt, 0, false);
                        wv = __builtin_amdgcn_cvt_pk_fp8_f32(acc[mi][ni][4 * g + 2] * gt, acc[mi][ni][4 * g + 3] * gt, wv, true);
                        d[g] = (unsigned)wv;
                    }
                    { auto r_ = __builtin_amdgcn_permlane32_swap(d[0], d[1], false, false); d[0] = r_[0]; d[1] = r_[1]; }
                    { auto r_ = __builtin_amdgcn_permlane32_swap(d[2], d[3], false, false); d[2] = r_[0]; d[3] = r_[1]; }
                    { auto r_ = __builtin_amdgcn_permlane32_swap(d[0], d[2], false, false); d[0] = r_[0]; d[2] = r_[1]; }
                    { auto r_ = __builtin_amdgcn_permlane32_swap(d[1], d[3], false, false); d[1] = r_[0]; d[3] = r_[1]; }
                    if (r < U.nrows) *(u32x4*)(Y8 + yrow * D + U.i1 * 256 + wc * 64 + ni * 32 + (hi ? 16 : 0)) = (u32x4){d[0], d[1], d[2], d[3]};
                }
            }
        }
    }
};
__device__ __forceinline__ void phase_moeA(const Params& p, const Ctx& c) {
    MoeSched2 S(p, c, 2, false);
    EpiMoeA E{(bf16_t*)(p.ws + WS_HID)};
    gemm256_stream<BM_F32_GU, false>(c, S, E);
}
__device__ __forceinline__ void phase_moeB(const Params& p, const Ctx& c) {
    MoeSched2 S(p, c, 4, true);
    EpiMoeB E{(unsigned char*)(p.ws + WS_Y), (const LAS float*)(c.lds + G2_GATE), (const LAS int*)(c.lds + G2_YROW)};
    gemm256_stream<BM_F32, false>(c, S, E);
}


struct Sched1 {
    const Params& p; const Ctx& c; int i;
    __device__ __forceinline__ const void* abase() const { return p.ws + WS_H0; }
    __device__ __forceinline__ void issue() {}
    __device__ __forceinline__ void commit() {}
    static constexpr int MT = 256, NMT = (NROWS + MT - 1) / MT, NU = NMT * 9;
    __device__ __forceinline__ bool next(G2Unit& U, int par) {
        const int idx = c.vcu + i * c.G; ++i;
        if (idx >= NU) return false;
        const int mt = idx / 9, nt = idx - mt * 9, row0 = mt * MT, nrows = min(MT, NROWS - row0);
        U.b0 = (const bf16_t*)(p.ws + WS_WIN) + (size_t)nt * 256 * D; U.b1 = nullptr; U.ldb = D; U.nsteps = D / 64; U.nrows = nrows; U.par = par; U.i0 = row0; U.i1 = nt; U.i2 = 0; U.kshift = 30; U.bsub = 0;
        if (c.tid < 256) ((LAS unsigned*)(c.lds + G2_MISC))[par * 256 + c.tid] = (unsigned)(row0 + min(c.tid, nrows - 1)) * (D * 2);
        return true;
    }
};
struct Epi1 {
    static constexpr bool HAS_MID = false, HAS_SUB = false;
    bf16_t* Z; float* psq;
    __device__ __forceinline__ void mid(f32x16 (&)[4][2], const G2Unit&, int, int, int, int) const {}
    __device__ __forceinline__ void operator()(f32x16 (&acc)[4][2], const G2Unit& U, int nmi, int wr, int wc, int r32, int hi) const {
        asm volatile("" : "+v"(r32), "+v"(hi));
        const int s0 = U.i1 * 256 + wc * 64;
#pragma unroll
        for (int mi = 0; mi < 4; ++mi) {
            if (mi < nmi) {
                const int r = 64 * mi + 32 * wr + r32, row = U.i0 + min(r, U.nrows - 1);
                float ss = 0.f;
#pragma unroll
                for (int ni = 0; ni < 2; ++ni) {
                    store_blk32_bf16(Z + (size_t)row * ZC + s0 + ni * 32, acc[mi][ni], hi, r < U.nrows);
#pragma unroll
                    for (int q = 0; q < 16; ++q) ss += acc[mi][ni][q] * acc[mi][ni][q];
                }
                if (s0 < ZKPE) {
                    ss += __shfl_xor(ss, 32);
                    if (hi == 0 && r < U.nrows) psq[(size_t)row * 16 + (s0 >> 6)] = ss;
                }
            }
        }
    }
};
__device__ __forceinline__ void phase1_g2(const Params& p, const Ctx& c) {
    Sched1 S{p, c, 0};
    Epi1 E{(bf16_t*)(p.ws + WS_Z), (float*)(p.ws + WS_PSQ)};
    gemm256_stream<BM_BF16T, true>(c, S, E);
}

struct Sched4 {
    const Params& p; const Ctx& c; int i;
    __device__ __forceinline__ const void* abase() const { return p.ws + WS_ATT; }
    __device__ __forceinline__ void issue() {}
    __device__ __forceinline__ void commit() {}
    __device__ __forceinline__ bool next(G2Unit& U, int par) {
        const int idx = c.vcu + i * c.G; ++i;
        if (idx >= 256) return false;
        const int mt = idx >> 2, nt = idx & 3, row0 = mt * 256;
        U.b0 = (const bf16_t*)(p.ws + WS_WO) + (size_t)nt * 256 * D; U.b1 = nullptr; U.ldb = D; U.nsteps = D / 64; U.nrows = 256; U.par = par; U.i0 = row0; U.i1 = nt; U.i2 = 0; U.kshift = 30; U.bsub = 0;
        if (c.tid < 256) {
            const int row = row0 + c.tid;
            ((LAS unsigned*)(c.lds + G2_MISC))[par * 256 + c.tid] = (unsigned)row * (D * 2);
            const float* patt = (const float*)(p.ws + WS_PATT);
            const f32x4 pa = *(const f32x4*)(patt + (size_t)row * 8), pb = *(const f32x4*)(patt + (size_t)row * 8 + 4);
            const float ra = rsqrtf((((pa[0] + pa[1]) + (pa[2] + pa[3])) + ((pb[0] + pb[1]) + (pb[2] + pb[3]))) * (1.f / 512) + 1e-6f);
            const float rc = rsqrtf(((const float*)(p.ws + WS_SSQC))[row] * (1.f / 512) + 1e-6f);
            ((LAS float*)(c.lds + G2_GATE))[par * 256 + c.tid] = ra / rc; ((LAS float*)(c.lds + G2_YROW))[par * 256 + c.tid] = rc;
        }
        return true;
    }
};
struct Epi4 {
    static constexpr bool HAS_MID = true, HAS_SUB = false;
    const LAS float* fT; const LAS float* rcT; const bf16_t* H0; bf16_t* Y1; float* pst;
    __device__ __forceinline__ void mid(f32x16 (&acc)[4][2], const G2Unit& U, int st, int nmi, int wr, int r32) const {
        if (st != 7) return;
#pragma unroll
        for (int mi = 0; mi < 4; ++mi) {
            const float f = fT[U.par * 256 + 64 * mi + 32 * wr + r32];
#pragma unroll
            for (int ni = 0; ni < 2; ++ni)
#pragma unroll
                for (int q = 0; q < 16; ++q) acc[mi][ni][q] *= f;
        }
    }
    __device__ __forceinline__ void operator()(f32x16 (&acc)[4][2], const G2Unit& U, int nmi, int wr, int wc, int r32, int hi) const {
        asm volatile("" : "+v"(r32), "+v"(hi));
        const int s0 = U.i1 * 256 + wc * 64;
#pragma unroll
        for (int mi = 0; mi < 4; ++mi) {
            const int r = 64 * mi + 32 * wr + r32, row = U.i0 + r;
            const float rc = rcT[U.par * 256 + r];
            float s = 0.f, ss = 0.f;
#pragma unroll
            for (int ni = 0; ni < 2; ++ni) {
                f32x16 v;
#pragma unroll
                for (int g = 0; g < 4; ++g) {
                    const u32x2 hw = *(const u32x2*)(H0 + (size_t)row * D + s0 + ni * 32 + 8 * g + 4 * hi);
                    v[4 * g + 0] = acc[mi][ni][4 * g + 0] * rc + ALPHA * bflo(hw.x); v[4 * g + 1] = acc[mi][ni][4 * g + 1] * rc + ALPHA * bfhi(hw.x);
                    v[4 * g + 2] = acc[mi][ni][4 * g + 2] * rc + ALPHA * bflo(hw.y); v[4 * g + 3] = acc[mi][ni][4 * g + 3] * rc + ALPHA * bfhi(hw.y);
                }
#pragma unroll
                for (int q = 0; q < 16; ++q) { s += v[q]; ss += v[q] * v[q]; }
                store_blk32_bf16(Y1 + (size_t)row * D + s0 + ni * 32, v, hi);
            }
            s += __shfl_xor(s, 32); ss += __shfl_xor(ss, 32);
            if (hi == 0) { float* q = pst + ((size_t)row * 16 + U.i1 * 4 + wc) * 2; q[0] = s; q[1] = ss; }
        }
    }
};
__device__ __forceinline__ void phase4_g2(const Params& p, const Ctx& c) {
    Sched4 S{p, c, 0};
    Epi4 E{(const LAS float*)(c.lds + G2_GATE), (const LAS float*)(c.lds + G2_YROW), (const bf16_t*)(p.ws + WS_H0), (bf16_t*)(p.ws + WS_Y1), (float*)(p.ws + WS_PST)};
    gemm256_stream<BM_BF16T, true>(c, S, E);
}


struct Sched2 {
    const Params& p; const Ctx& c; int i; bool kv;
    __device__ __forceinline__ const void* abase() const { return p.ws + WS_Z; }
    __device__ __forceinline__ void issue() {}
    __device__ __forceinline__ void commit() {}
    __device__ __forceinline__ bool next(G2Unit& U, int par) {
        const int NT = kv ? 4 : 3, NU = kv ? 65 * 4 : 64 * 3;
        const int idx = (kv ? ((c.vcu + 64) & 255) : c.vcu) + i * 256; ++i;
        if (idx >= NU) return false;
        const int mt = idx / NT, nt = idx - mt * NT, row0 = mt * 256, nrows = min(256, (kv ? NROWS : NTOK) - row0);
        const int K = kv ? KVLORA : QLORA;
        U.b0 = (const bf16_t*)(p.ws + (kv ? WS_WUKV : WS_WUQ)) + (size_t)nt * 256 * K; U.b1 = nullptr; U.ldb = K; U.nsteps = K / 64; U.nrows = nrows; U.par = par;
        U.i0 = row0; U.i1 = nt; U.i2 = 0; U.kshift = 30; U.bsub = 0;
        if (c.tid < 256) ((LAS unsigned*)(c.lds + G2_MISC))[par * 256 + c.tid] = (unsigned)(row0 + min(c.tid, nrows - 1)) * (ZC * 2) + (kv ? ZKV : ZQ) * 2;
        return true;
    }
};
struct Epi2q {
    static constexpr bool HAS_MID = false, HAS_SUB = false;
    const float* psq; const float* rope; bf16_t* Q;
    __device__ __forceinline__ void mid(f32x16 (&)[4][2], const G2Unit&, int, int, int, int) const {}
    __device__ __forceinline__ void operator()(f32x16 (&acc)[4][2], const G2Unit& U, int nmi, int wr, int wc, int r32, int hi) const {
        asm volatile("" : "+v"(r32), "+v"(hi));
#pragma unroll
        for (int mi = 0; mi < 4; ++mi) {
            const int row = U.i0 + 64 * mi + 32 * wr + r32;
            const f32x4 pa = *(const f32x4*)(psq + (size_t)row * 16), pb = *(const f32x4*)(psq + (size_t)row * 16 + 4);
            const float rq = rsqrtf((((pa[0] + pa[1]) + (pa[2] + pa[3])) + (pb[0] + pb[1])) * (1.f / QLORA) + 1e-6f) * QSCALE;
            const int pos = NMETA + (row & (SEQ - 1));
#pragma unroll
            for (int ni = 0; ni < 2; ++ni) {
                const int c0 = U.i1 * 256 + wc * 64 + ni * 32;
                f32x16 v = acc[mi][ni];
#pragma unroll
                for (int q = 0; q < 16; ++q) v[q] *= rq;
                if ((c0 % 96) == 64) {
#pragma unroll
                    for (int g = 0; g < 2; ++g) {
                        const float* rp = rope + ((size_t)pos * 16 + 8 * g + 4 * hi) * 2;
                        const f32x4 cs0 = *(const f32x4*)rp, cs1 = *(const f32x4*)(rp + 4);
                        const float co[4] = {cs0[0], cs0[2], cs1[0], cs1[2]}, si[4] = {cs0[1], cs0[3], cs1[1], cs1[3]};
#pragma unroll
                        for (int j = 0; j < 4; ++j) { const float x1 = v[4 * g + j], x2 = v[4 * g + j + 8]; v[4 * g + j] = x1 * co[j] - x2 * si[j]; v[4 * g + j + 8] = x2 * co[j] + x1 * si[j]; }
                    }
                }
                store_blk32_bf16(Q + (size_t)row * 768 + c0, v, hi);
            }
        }
    }
};
struct Epi2kv {
    static constexpr bool HAS_MID = false, HAS_SUB = false;
    const float* psq; bf16_t* Kb; bf16_t* Vb;
    __device__ __forceinline__ void mid(f32x16 (&)[4][2], const G2Unit&, int, int, int, int) const {}
    __device__ __forceinline__ void operator()(f32x16 (&acc)[4][2], const G2Unit& U, int nmi, int wr, int wc, int r32, int hi) const {
        asm volatile("" : "+v"(r32), "+v"(hi));
        const int s0 = U.i1 * 256 + wc * 64, h = s0 >> 7; const bool isv = (s0 & 64) != 0;
#pragma unroll
        for (int mi = 0; mi < 4; ++mi) {
            if (mi < nmi) {
                const int r = 64 * mi + 32 * wr + r32, row = U.i0 + min(r, U.nrows - 1);
                const f32x4 pa = *(const f32x4*)(psq + (size_t)row * 16 + 4), pb = *(const f32x4*)(psq + (size_t)row * 16 + 8);
                const float rk = rsqrtf(((pa[2] + pa[3]) + (pb[0] + pb[1])) * (1.f / KVLORA) + 1e-6f);
                const bool meta = U.i0 >= NTOK;
                const int ncopy = meta ? NBATCH : 1;
                const int pos = meta ? row - NTOK : NMETA + (row & (SEQ - 1));
#pragma unroll
                for (int ni = 0; ni < 2; ++ni) {
                    f32x16 v = acc[mi][ni];
#pragma unroll
                    for (int q = 0; q < 16; ++q) v[q] *= rk;
                    for (int bb = 0; bb < ncopy; ++bb) {
                        const size_t prow = (size_t)(meta ? bb : (row >> 11)) * LPOS + pos;
                        bf16_t* dst = isv ? Vb + prow * 512 + h * 64 + ni * 32 : Kb + prow * 768 + h * 96 + ni * 32;
                        store_blk32_bf16(dst, v, hi, r < U.nrows);
                    }
                }
            }
        }
    }
};

__device__ __forceinline__ void phase2_gemms(const Params& p, const Ctx& c) {
    { Sched2 S{p, c, 0, false}; Epi2q E{(const float*)(p.ws + WS_PSQ), (const float*)(p.ws + WS_ROPE), (bf16_t*)(p.ws + WS_Q)}; gemm256_stream<BM_BF16T, true>(c, S, E); }
    __syncthreads();
    { Sched2 S{p, c, 0, true}; Epi2kv E{(const float*)(p.ws + WS_PSQ), (bf16_t*)(p.ws + WS_K), (bf16_t*)(p.ws + WS_V)}; gemm256_stream<BM_BF16T, false>(c, S, E); }
}

__device__ __forceinline__ void phase8(const Params& p, const Ctx& c) {
    unsigned char* ws = p.ws;
    const bf16_t* H1 = (const bf16_t*)(ws + WS_H1); const unsigned char* Y8 = (const unsigned char*)(ws + WS_Y);
    const int gw = c.vcu * NWAVES + c.wave, NGW = c.G * NWAVES, lane = c.lane;
    const int col = lane * 16;
    float gg[16], bb[16];
#pragma unroll
    for (int e = 0; e < 4; ++e) { const f32x4 g4 = *(const f32x4*)(p.ln2_g + col + 4 * e), b4 = *(const f32x4*)(p.ln2_b + col + 4 * e);
#pragma unroll
        for (int q = 0; q < 4; ++q) { gg[4 * e + q] = g4[q]; bb[4 * e + q] = b4[q]; } }
    for (int t = gw; t < NTOK; t += NGW) {
        float v[16], y[16];
        const u32x4 w0 = *(const u32x4*)(H1 + (size_t)t * D + col), w1 = *(const u32x4*)(H1 + (size_t)t * D + col + 8);
#pragma unroll
        for (int e = 0; e < 4; ++e) { v[2 * e] = ALPHA * bflo(w0[e]); v[2 * e + 1] = ALPHA * bfhi(w0[e]); v[8 + 2 * e] = ALPHA * bflo(w1[e]); v[8 + 2 * e + 1] = ALPHA * bfhi(w1[e]); }
#pragma unroll
        for (int e = 0; e < 16; ++e) y[e] = 0.f;
#pragma unroll
        for (int k = 0; k < 9; ++k) {
            const u32x4 yw = *(const u32x4*)(Y8 + ((size_t)t * 9 + k) * D + col);
#pragma unroll
            for (int e = 0; e < 4; ++e) {
                const f32x2 lo = __builtin_amdgcn_cvt_pk_f32_fp8((int)yw[e], false), hi2 = __builtin_amdgcn_cvt_pk_f32_fp8((int)yw[e], true);
                y[4 * e] += lo[0]; y[4 * e + 1] += lo[1]; y[4 * e + 2] += hi2[0]; y[4 * e + 3] += hi2[1];
            }
        }
        float s = 0.f;
#pragma unroll
        for (int e = 0; e < 16; ++e) { v[e] += y[e] * (1.f / Y8_SCALE); s += v[e]; }
        const float mean = wave_sum(s) * (1.f / D);
        float ss = 0.f;
#pragma unroll
        for (int e = 0; e < 16; ++e) { v[e] -= mean; ss += v[e] * v[e]; }
        const float rstd = rsqrtf(wave_sum(ss) * (1.f / D) + 1e-5f);
#pragma unroll
        for (int e = 0; e < 4; ++e) {
            f32x4 o;
#pragma unroll
            for (int q = 0; q < 4; ++q) o[q] = v[4 * e + q] * rstd * gg[4 * e + q] + bb[4 * e + q];
            *(f32x4*)(p.out + (size_t)t * D + col + 4 * e) = o;
        }
    }
}


#define XB_TMO      128
#define XB_XCNT(j)  (256  + 64 * (j))
#define XB_XSUB(j)  (1280 + 64 * (j))
#define XB_XGEN(j)  (2304 + 64 * (j))
#define XB_TOP      3328
#define XB_TOPGEN   3392
#define XB_SPIN_CAP (1u << 22)
__device__ __forceinline__ unsigned xb_ld(unsigned* p)              { return __hip_atomic_load(p, __ATOMIC_RELAXED, __HIP_MEMORY_SCOPE_AGENT); }
__device__ __forceinline__ unsigned xb_add(unsigned* p, unsigned v) { return __hip_atomic_fetch_add(p, v, __ATOMIC_RELAXED, __HIP_MEMORY_SCOPE_AGENT); }
__device__ __forceinline__ unsigned xb_xcc_id() { return (unsigned)__builtin_amdgcn_s_getreg((3 << 11) | 20) & 0xFu; }
#define XB_SPIN(cond, bar) do { unsigned _sp = 0; while (cond) { __builtin_amdgcn_s_sleep(1); \
    if ((++_sp & 255u) == 0u) { if (xb_ld(&(bar)[XB_TMO])) break; if (_sp > XB_SPIN_CAP) { atomicAdd(&(bar)[XB_TMO], 1u); break; } } } } while (0)
struct XcdBarrier { unsigned* bar; unsigned x; volatile LAS unsigned* st; };
__device__ __forceinline__ XcdBarrier xcd_barrier_post(unsigned* bar, volatile LAS unsigned* st) {
    XcdBarrier b; b.bar = bar; b.x = xb_xcc_id(); b.st = st;
    if (threadIdx.x == 0) (void)xb_add(&bar[XB_XCNT(b.x)], 1u);
    return b;
}
__device__ __forceinline__ void xcd_barrier_complete(unsigned* bar, unsigned x, unsigned& nloc, unsigned& nx) {
    const unsigned G = gridDim.x * gridDim.y * gridDim.z;
    unsigned sum, cnt, mine, sp = 0u;
    for (;;) {
        sum = 0u; cnt = 0u; mine = 0u;
#pragma unroll
        for (unsigned j = 0; j < 16; ++j) { const unsigned c = xb_ld(&bar[XB_XCNT(j)]); sum += c; cnt += (c > 0u) ? 1u : 0u; mine = (j == x) ? c : mine; }
        if (sum == G) break;
        __builtin_amdgcn_s_sleep(1);
        if ((++sp & 255u) == 0u) { if (xb_ld(&bar[XB_TMO])) break; if (sp > XB_SPIN_CAP) { atomicAdd(&bar[XB_TMO], 1u); break; } }
    }
    nloc = mine > 0u ? mine : 1u; nx = cnt > 0u ? cnt : 1u;
}
__device__ __forceinline__ void xcd_barrier(const XcdBarrier& b) {
    asm volatile("s_waitcnt vmcnt(0)" ::: "memory");
    __syncthreads();
    if (threadIdx.x == 0) {
        unsigned* bar = b.bar;
        __builtin_amdgcn_s_waitcnt(0);
        unsigned nloc = b.st[0], nx = b.st[1];
        if (nloc == 0u) { xcd_barrier_complete(bar, b.x, nloc, nx); b.st[0] = nloc; b.st[1] = nx; }
        const unsigned old = xb_add(&bar[XB_XSUB(b.x)], 1u);
        const unsigned gen = old / nloc;
        if (old + 1u == (gen + 1u) * nloc) {
            __builtin_amdgcn_fence(__ATOMIC_RELEASE, "agent");
            asm volatile("s_waitcnt vmcnt(0)" ::: "memory");
            const unsigned og = xb_add(&bar[XB_TOP], 1u);
            const unsigned tg = og / nx;
            if (og + 1u == (tg + 1u) * nx) xb_add(&bar[XB_TOPGEN], 1u);
            else XB_SPIN(xb_ld(&bar[XB_TOPGEN]) == tg, bar);
            __builtin_amdgcn_fence(__ATOMIC_ACQUIRE, "agent");
            xb_add(&bar[XB_XGEN(b.x)], 1u);
            asm volatile("s_waitcnt vmcnt(0)" ::: "memory");
        } else {
            XB_SPIN(xb_ld(&bar[XB_XGEN(b.x)]) == gen, bar);
            __builtin_amdgcn_fence(__ATOMIC_ACQUIRE, "agent");
            asm volatile("s_waitcnt vmcnt(0)" ::: "memory");
        }
    }
    __syncthreads();
}

template <int PH> __device__ __forceinline__ void run_phase(const Params& p, const Ctx& c0) {
    Ctx c = c0;
    { int l; asm volatile("v_mbcnt_lo_u32_b32 %0, -1, 0\n\tv_mbcnt_hi_u32_b32 %0, -1, %0" : "=v"(l)); c.lane = l; c.tid = c0.wave * 64 + l; c.wave = c0.wave; }
    if (PH == 0) phase0(p, c);
    if (PH == 1) phase1_g2(p, c);
    if (PH == 2) phase2(p, c);
#if NAIVE_ATTN
    if (PH == 3) phase3_naive(p, c);
#else
    if (PH == 3) phase3(p, c);
#endif
    if (PH == 4) phase4_g2(p, c);
    if (PH == 5) phase5_fused(p, c);
    if (PH == 8) phase_moeA(p, c);
    if (PH == 9) phase_moeB(p, c);
    if (PH == 10) phase8(p, c);
}
constexpr int NPHASES = 11;
__device__ __forceinline__ Ctx make_ctx(unsigned char* lds) {
    Ctx c; c.lds = (LAS unsigned char*)lds; c.tid = threadIdx.x; c.lane = c.tid & 63; c.wave = __builtin_amdgcn_readfirstlane(c.tid >> 6);
    c.G = gridDim.x; const int bx = blockIdx.x; c.vcu = (c.G % 8 == 0) ? (bx % 8) * (c.G / 8) + bx / 8 : bx;
    return c;
}
template <int PH> __global__ void __launch_bounds__(NTHREADS, 2) phase_kernel(Params p) {
    extern __shared__ __attribute__((aligned(16))) unsigned char lds[];
    const Ctx c = make_ctx(lds);
    run_phase<PH>(p, c);
}
#if MEGA
__global__ void __launch_bounds__(NTHREADS, 2) mega_kernel(Params p) {
    extern __shared__ __attribute__((aligned(16))) unsigned char lds[];
    Ctx c = make_ctx(lds);
    cg::grid_group grid = cg::this_grid();
    volatile LAS unsigned* bst = (volatile LAS unsigned*)(c.lds + LDS_BYTES - 64);
    if (c.tid < 4) bst[c.tid] = 0u;
    __syncthreads();
    XcdBarrier bar; bar.bar = (unsigned*)(p.ws + WS_CTL + CT_BAR); bar.x = xb_xcc_id(); bar.st = bst;
    if (c.tid == 0) bst[2] = xb_add(&bar.bar[XB_XCNT(bar.x)], 1u);
    if (p.out == nullptr) grid.sync();
    run_phase<0>(p, c); xcd_barrier(bar);
    if (c.tid == 0) {
        unsigned pre = 0;
        for (unsigned j = 0; j < 16; ++j) { const unsigned n = xb_ld(&bar.bar[XB_XCNT(j)]); if (j < bar.x) pre += n; }
        bst[3] = pre + bst[2];
    }
    __syncthreads();
    c.vcu = (int)bst[3];
    run_phase<1>(p, c); xcd_barrier(bar);
    run_phase<2>(p, c); xcd_barrier(bar);
    run_phase<3>(p, c); xcd_barrier(bar);
    run_phase<4>(p, c); xcd_barrier(bar);
    run_phase<5>(p, c); xcd_barrier(bar);
    run_phase<8>(p, c); xcd_barrier(bar);
    run_phase<9>(p, c); xcd_barrier(bar);
    run_phase<10>(p, c);
}

#endif
template <int PH> static void launch_phase(const Params& p, int grid, hipStream_t stream) {
    static bool attr = false;
    if (!attr) { (void)hipFuncSetAttribute((const void*)phase_kernel<PH>, hipFuncAttributeMaxDynamicSharedMemorySize, LDS_BYTES); attr = true; }
    hipLaunchKernelGGL(phase_kernel<PH>, dim3(grid), dim3(NTHREADS), LDS_BYTES, stream, p);
}

extern "C" void kernel_launch(void* const* d_in, const int* in_sizes, int n_in, void* d_out, int out_size, void* d_ws, size_t ws_size, hipStream_t stream) {
    if (n_in != 25 || ws_size < WS_END) { fprintf(stderr, "kernel_launch: unexpected n_in %d or ws_size %zu (need %zu)\n", n_in, ws_size, (size_t)WS_END); return; }
    Params p{};
    const float** pp = (const float**)&p;
    for (int i = 0; i < 25; ++i) pp[i] = (const float*)d_in[i];
    p.out = (float*)d_out; p.ws = (unsigned char*)d_ws;
    (void)hipMemsetAsync((char*)d_ws + WS_CTL, 0, CTL_BYTES, stream);
#if MEGA
    static int grid = 0;
    if (!grid) {
        int dev = 0, cus = 0, per_cu = 0;
        (void)hipGetDevice(&dev);
        (void)hipDeviceGetAttribute(&cus, hipDeviceAttributeMultiprocessorCount, dev);
        (void)hipFuncSetAttribute((const void*)mega_kernel, hipFuncAttributeMaxDynamicSharedMemorySize, LDS_BYTES);
        (void)hipOccupancyMaxActiveBlocksPerMultiprocessor(&per_cu, (const void*)mega_kernel, NTHREADS, LDS_BYTES);
        if (per_cu < 1) per_cu = 1;
        grid = cus;
        (void)per_cu;
    }
    void* args[] = {&p};
    hipError_t e = hipLaunchCooperativeKernel((const void*)mega_kernel, dim3(grid), dim3(NTHREADS), args, LDS_BYTES, stream);
    if (e != hipSuccess) fprintf(stderr, "cooperative launch failed: %s (grid %d)\n", hipGetErrorString(e), grid);
#else
    const int grid = 256;
#define LP(k) do { launch_phase<k>(p, grid, stream); if (REPEAT_PH == k) { if (k == 5) (void)hipMemsetAsync((char*)d_ws + WS_CTL + CT_CNT, 0, 1024, stream); (void)hipMemsetAsync((char*)d_ws + WS_CTL + CT_Q, 0, 4096, stream); launch_phase<k>(p, grid, stream); } } while (0)
    LP(0); LP(1); LP(2); LP(3); LP(4); LP(5); LP(8); LP(9); LP(10);
#undef LP
#endif
}
```

```cpp
#include <hip/hip_runtime.h>
#include <hip/hip_cooperative_groups.h>
#include <cstdint>
#include <cstdio>
namespace cg = cooperative_groups;

#ifndef NAIVE_GEMM
#define NAIVE_GEMM 0
#endif
#ifndef NAIVE_ATTN
#define NAIVE_ATTN 0
#endif
#ifndef REPEAT_PH
#define REPEAT_PH -1
#endif
#ifndef MEGA
#define MEGA 1
#endif

#define LAS __attribute__((address_space(3)))
#define GAS __attribute__((address_space(1)))
typedef unsigned short bf16_t;
typedef short bf16x8 __attribute__((ext_vector_type(8)));
typedef float f32x4 __attribute__((ext_vector_type(4)));
typedef unsigned u32x4 __attribute__((ext_vector_type(4)));
typedef unsigned u32x2 __attribute__((ext_vector_type(2)));

constexpr int D = 1024, NBATCH = 8, SEQ = 2048, NMETA = 16, LPOS = SEQ + NMETA;
constexpr int NTOK = NBATCH * SEQ;
constexpr int NROWS = NTOK + NMETA;
constexpr int NROWSP = 16512;
constexpr int NH = 8, DQK = 96, DNOPE = 64, DROPE = 32, DV = 64;
constexpr int QLORA = 384, KVLORA = 256;
constexpr int ZC = 2304;
constexpr int ZQ = 0, ZKV = 384, ZKPE = 640, ZB = 704, ZCG = 1216, ZU = 1728;
constexpr int DIN = 2208;
constexpr int NEXP = 256, DEXP = 256, TOPK = 8, CAP = 16384;
constexpr float ALPHA = 1.189207115002721f;
constexpr float QSCALE = 0.10206207261596577f * 1.4426950408889634f;

constexpr int NTHREADS = 512, NWAVES = 8;
constexpr int LDS_BYTES = 147456;
constexpr int STAGE_BYTES = 49152;
constexpr int LDS_MISC = 2 * STAGE_BYTES;

constexpr size_t MiB = 1u << 20;
constexpr size_t WS_CTL = 0;
constexpr size_t CTL_BYTES = 1 * MiB;
constexpr size_t CT_CNT = 0;
constexpr size_t CT_Q = 1024;
constexpr size_t CT_BAR = 8192;
constexpr size_t CT_SSQ_Q = 32768;
constexpr size_t CT_SSQ_KV = CT_SSQ_Q + 66048;
constexpr size_t CT_SSQ_ATT = CT_SSQ_KV + 66048;
constexpr size_t CT_STATS1 = CT_SSQ_ATT + 65536;
static_assert(CT_STATS1 + 131072 <= CTL_BYTES, "ctl");
constexpr size_t WS_WIN = 1 * MiB;
constexpr size_t WS_WUQ = 6 * MiB;
constexpr size_t WS_WUKV = 7 * MiB;
constexpr size_t WS_WO = 8 * MiB;
constexpr size_t WS_WR = 10 * MiB;
constexpr size_t WS_WSGU = 11 * MiB;
constexpr size_t WS_WSD = 12 * MiB;
constexpr size_t WS_ROPE = 13 * MiB;
constexpr size_t WS_WGU = 14 * MiB;
constexpr size_t WS_WD = 270 * MiB;
constexpr size_t WS_H1 = 398 * MiB;
constexpr size_t WS_HID = 430 * MiB;
constexpr size_t WS_LAID = 502 * MiB;
constexpr size_t WS_LGATE = 518 * MiB;
constexpr size_t WS_Y = 534 * MiB;
constexpr size_t WS_Z = WS_Y;
constexpr size_t WS_H0 = WS_Y + 73 * MiB;
constexpr size_t WS_Q = WS_Y + 106 * MiB;
constexpr size_t WS_K = WS_Y + 130 * MiB;
constexpr size_t WS_V = WS_Y + 155 * MiB;
constexpr size_t WS_ATT = WS_Y + 172 * MiB;
constexpr size_t WS_CONV = WS_Y + 188 * MiB;
constexpr size_t WS_SSQC = WS_Y + 204 * MiB;
constexpr size_t WS_Y1 = WS_Y + 205 * MiB;
constexpr size_t WS_LOG = WS_Y + 237 * MiB;
constexpr size_t WS_PSQ = WS_Y + 253 * MiB;
constexpr size_t WS_PATT = WS_Y + 254 * MiB;
constexpr size_t WS_PST = WS_Y + 255 * MiB;
constexpr size_t WS_END = WS_Y + 288 * MiB;

struct Params {
    const float *x, *meta, *emb_g, *emb_b, *w_in, *q_norm, *w_uq, *kv_norm, *w_ukv, *conv_w, *attn_on, *conv_on, *w_o,
        *ln1_g, *ln1_b, *w_router, *router_bias, *w_gate, *w_up, *w_down, *ws_gate, *ws_up, *ws_down, *ln2_g, *ln2_b;
    float* out;
    unsigned char* ws;
};

__device__ __forceinline__ unsigned f2bf(float f) { unsigned u = __float_as_uint(f); return (u + 0x7fffu + ((u >> 16) & 1u)) >> 16; }
typedef float f32x2 __attribute__((ext_vector_type(2)));
typedef __bf16 bf16x2_t __attribute__((ext_vector_type(2)));
__device__ __forceinline__ unsigned cvtpk(float lo, float hi) { f32x2 v = {lo, hi}; bf16x2_t b = __builtin_convertvector(v, bf16x2_t); return __builtin_bit_cast(unsigned, b); }
__device__ __forceinline__ unsigned pk2(float lo, float hi) { return cvtpk(lo, hi); }
__device__ __forceinline__ float bf2f(unsigned b) { return __uint_as_float(b << 16); }
__device__ __forceinline__ float bflo(unsigned w) { return __uint_as_float(w << 16); }
__device__ __forceinline__ float bfhi(unsigned w) { return __uint_as_float(w & 0xffff0000u); }
__device__ __forceinline__ float wave_sum(float v) {
#pragma unroll
    for (int o = 1; o < 64; o <<= 1) v += __shfl_xor(v, o);
    return v;
}
__device__ __forceinline__ float wave_max(float v) {
#pragma unroll
    for (int o = 1; o < 64; o <<= 1) v = fmaxf(v, __shfl_xor(v, o));
    return v;
}

struct Ctx {
    LAS unsigned char* lds;
    int tid, lane, wave, vcu, G;
};

template <class RowPtr>
__device__ __forceinline__ void gemm_kloop(f32x4 (&acc)[4][4], const Ctx& c, const RowPtr& rp, const bf16_t* Bt, long ldb, int K) {
    const int tid = c.tid, lane = c.lane, wid = c.wave, wr = wid >> 2, wc = wid & 3, fr = lane & 15, fq = lane >> 4;
#if NAIVE_GEMM
    const bf16_t* ar[4];
#pragma unroll
    for (int mi = 0; mi < 4; ++mi) ar[mi] = rp(wr * 64 + mi * 16 + fr);
    const bf16_t* br = Bt + (long)(wc * 64 + fq * 4) * ldb;
#pragma nounroll
    for (int k = 0; k < K; k += 2) {
        unsigned av[4];
#pragma unroll
        for (int mi = 0; mi < 4; ++mi) av[mi] = *(const unsigned*)(ar[mi] + k);
#pragma unroll
        for (int ni = 0; ni < 4; ++ni)
#pragma unroll
            for (int j = 0; j < 4; ++j) {
                const unsigned bv = *(const unsigned*)(br + (long)(ni * 16 + j) * ldb + k);
#pragma unroll
                for (int mi = 0; mi < 4; ++mi) acc[mi][ni][j] += bflo(av[mi]) * bflo(bv) + bfhi(av[mi]) * bfhi(bv);
            }
    }
#else
    LAS unsigned char* lds = c.lds;
    const int nt = K >> 6;
    const int srow = tid >> 3, sch = tid & 7;
    const bf16_t* ap0 = rp(srow) + sch * 8;
    const bf16_t* ap1 = rp(srow + 64) + sch * 8;
    const bf16_t* bp = Bt + (long)srow * ldb + sch * 8;
    const long bstep = 64 * ldb;
    const int so = srow * 128 + ((sch ^ ((srow >> 1) & 7)) << 4);
    u32x4 ra0, ra1, rb0, rb1, rb2, rb3;
#define G_LOAD(t) do { const int ko = (t) * 64; ra0 = *(const u32x4*)(ap0 + ko); ra1 = *(const u32x4*)(ap1 + ko); \
        rb0 = *(const u32x4*)(bp + ko); rb1 = *(const u32x4*)(bp + bstep + ko); rb2 = *(const u32x4*)(bp + 2 * bstep + ko); rb3 = *(const u32x4*)(bp + 3 * bstep + ko); } while (0)
#define G_STORE(buf) do { LAS unsigned char* sb = lds + (buf) * STAGE_BYTES; \
        *(LAS u32x4*)(sb + so) = ra0; *(LAS u32x4*)(sb + so + 8192) = ra1; \
        *(LAS u32x4*)(sb + 16384 + so) = rb0; *(LAS u32x4*)(sb + 16384 + so + 8192) = rb1; \
        *(LAS u32x4*)(sb + 16384 + so + 16384) = rb2; *(LAS u32x4*)(sb + 16384 + so + 24576) = rb3; } while (0)
    __syncthreads();
    G_LOAD(0);
    G_STORE(0);
    __syncthreads();
    const int sw0 = ((0 + fq) ^ ((fr >> 1) & 7)) << 4, sw1 = ((4 + fq) ^ ((fr >> 1) & 7)) << 4;
    const int aoff = (wr * 64 + fr) * 128, boff = 16384 + (wc * 64 + fr) * 128;
    for (int t = 0; t < nt; ++t) {
        if (t + 1 < nt) G_LOAD(t + 1);
        const LAS unsigned char* sb = lds + (t & 1) * STAGE_BYTES;
#pragma unroll
        for (int ks = 0; ks < 2; ++ks) {
            const int sw = ks ? sw1 : sw0;
            bf16x8 af[4], bfr[4];
#pragma unroll
            for (int mi = 0; mi < 4; ++mi) af[mi] = *(const LAS bf16x8*)(sb + aoff + mi * 2048 + sw);
#pragma unroll
            for (int ni = 0; ni < 4; ++ni) bfr[ni] = *(const LAS bf16x8*)(sb + boff + ni * 2048 + sw);
#pragma unroll
            for (int mi = 0; mi < 4; ++mi)
#pragma unroll
                for (int ni = 0; ni < 4; ++ni) acc[mi][ni] = __builtin_amdgcn_mfma_f32_16x16x32_bf16(bfr[ni], af[mi], acc[mi][ni], 0, 0, 0);
        }
        if (t + 1 < nt) G_STORE((t + 1) & 1);
        __syncthreads();
    }
#undef G_LOAD
#undef G_STORE
#endif
}
__device__ __forceinline__ void acc_zero(f32x4 (&acc)[4][4]) {
#pragma unroll
    for (int a = 0; a < 4; ++a)
#pragma unroll
        for (int b = 0; b < 4; ++b) acc[a][b] = (f32x4){0.f, 0.f, 0.f, 0.f};
}
__device__ __forceinline__ void store_bf4(bf16_t* p, f32x4 v) { u32x2 w; w.x = pk2(v[0], v[1]); w.y = pk2(v[2], v[3]); *(u32x2*)p = w; }

enum { MAP_ID = 0, MAP_WIN = 1, MAP_GATE = 2, MAP_UP = 3 };
template <int MAP> __device__ __forceinline__ int rowmap(int n) {
    if (MAP == MAP_WIN) return n < 672 ? n : n + 32;
    if (MAP == MAP_GATE) return 32 * (n >> 4) + (n & 15);
    if (MAP == MAP_UP) return 32 * (n >> 4) + 16 + (n & 15);
    return n;
}
template <int MAP>
__device__ __forceinline__ void transpose_item(const float* W, int K, int N, bf16_t* WT, const float* gain, LAS float* scr, int item, int lane) {
    const int nblk = N / 32, kb = item / nblk, nb = item % nblk, k0 = 64 * kb, n0 = 32 * nb;
#pragma unroll 8
    for (int i = 0; i < 32; ++i) {
        const int kk = 2 * i + (lane >> 5);
        float v = W[(size_t)(k0 + kk) * N + n0 + (lane & 31)];
        if (gain) v *= gain[k0 + kk];
        scr[kk * 33 + (lane & 31)] = v;
    }
    asm volatile("s_waitcnt lgkmcnt(0)" ::: "memory");
    const int ch = lane & 7;
#pragma unroll
    for (int j = 0; j < 4; ++j) {
        const int n = (lane >> 3) + 8 * j;
        const LAS float* s = scr + (8 * ch) * 33 + n;
        u32x4 o;
        o.x = pk2(s[0 * 33], s[1 * 33]); o.y = pk2(s[2 * 33], s[3 * 33]); o.z = pk2(s[4 * 33], s[5 * 33]); o.w = pk2(s[6 * 33], s[7 * 33]);
        *(u32x4*)(WT + (size_t)rowmap<MAP>(n0 + n) * K + k0 + 8 * ch) = o;
    }
    asm volatile("s_waitcnt lgkmcnt(0)" ::: "memory");
}
__device__ __forceinline__ void phase0(const Params& p, const Ctx& c) {
    unsigned char* ws = p.ws;
    LAS float* scr = (LAS float*)(c.lds + c.wave * 8704);
    const int gw = c.vcu * NWAVES + c.wave, NGW = c.G * NWAVES, lane = c.lane;
    bf16_t* H0 = (bf16_t*)(ws + WS_H0);
    {
        f32x4 eg[4], eb[4];
#pragma unroll
        for (int j = 0; j < 4; ++j) { eg[j] = *((const f32x4*)p.emb_g + lane + 64 * j); eb[j] = *((const f32x4*)p.emb_b + lane + 64 * j); }
        for (int r0 = gw; r0 < NROWSP; r0 += 2 * NGW) {
            const int r1 = r0 + NGW;
            const bool h1 = r1 < NROWSP;
            const int q0 = min(r0, NROWS - 1), q1 = min(h1 ? r1 : r0, NROWS - 1);
            const float* x0 = q0 < NTOK ? p.x + (size_t)q0 * D : p.meta + (size_t)(q0 - NTOK) * D;
            const float* x1 = q1 < NTOK ? p.x + (size_t)q1 * D : p.meta + (size_t)(q1 - NTOK) * D;
            f32x4 v0[4], v1[4]; float s0 = 0.f, s1 = 0.f;
#pragma unroll
            for (int j = 0; j < 4; ++j) { v0[j] = *((const f32x4*)x0 + lane + 64 * j); v1[j] = *((const f32x4*)x1 + lane + 64 * j); }
#pragma unroll
            for (int j = 0; j < 4; ++j) { s0 += (v0[j][0] + v0[j][1]) + (v0[j][2] + v0[j][3]); s1 += (v1[j][0] + v1[j][1]) + (v1[j][2] + v1[j][3]); }
#pragma unroll
            for (int o = 1; o < 64; o <<= 1) { s0 += __shfl_xor(s0, o); s1 += __shfl_xor(s1, o); }
            const float m0 = s0 * (1.f / D), m1 = s1 * (1.f / D);
            float t0 = 0.f, t1 = 0.f;
#pragma unroll
            for (int j = 0; j < 4; ++j) { v0[j] = v0[j] - m0; v1[j] = v1[j] - m1;
                t0 += (v0[j][0] * v0[j][0] + v0[j][1] * v0[j][1]) + (v0[j][2] * v0[j][2] + v0[j][3] * v0[j][3]); t1 += (v1[j][0] * v1[j][0] + v1[j][1] * v1[j][1]) + (v1[j][2] * v1[j][2] + v1[j][3] * v1[j][3]); }
#pragma unroll
            for (int o = 1; o < 64; o <<= 1) { t0 += __shfl_xor(t0, o); t1 += __shfl_xor(t1, o); }
            const float rs0 = r0 < NROWS ? 1.f / sqrtf(t0 * (1.f / D) + 1e-5f) : 0.f, rs1 = r1 < NROWS ? 1.f / sqrtf(t1 * (1.f / D) + 1e-5f) : 0.f;
            u32x2* o0 = (u32x2*)(H0 + (size_t)r0 * D) + lane; u32x2* o1 = (u32x2*)(H0 + (size_t)r1 * D) + lane;
#pragma unroll
            for (int j = 0; j < 4; ++j) {
                const f32x4 y0 = r0 < NROWS ? v0[j] * rs0 * eg[j] + eb[j] : (f32x4){0.f, 0.f, 0.f, 0.f}, y1 = r1 < NROWS ? v1[j] * rs1 * eg[j] + eb[j] : (f32x4){0.f, 0.f, 0.f, 0.f};
                o0[64 * j] = (u32x2){pk2(y0[0], y0[1]), pk2(y0[2], y0[3])};
                if (h1) o1[64 * j] = (u32x2){pk2(y1[0], y1[1]), pk2(y1[2], y1[3])};
            }
        }
    }
    {
        float* rope = (float*)(ws + WS_ROPE);
        for (int idx = gw * 64 + lane; idx < LPOS * 16; idx += NGW * 64) {
            const int pos = idx >> 4, i = idx & 15;
            const float inv = exp2f(-(float)i * (13.287712379549449f / 16.f));
            const float ang = (float)pos * inv;
            double rev = (double)ang * 0.15915494309189535; rev -= floor(rev);
            const float rf = (float)rev;
            rope[idx * 2 + 0] = __builtin_amdgcn_cosf(rf);
            rope[idx * 2 + 1] = __builtin_amdgcn_sinf(rf);
        }
    }
    {
        bf16_t* WinT = (bf16_t*)(ws + WS_WIN);
        for (int it = gw; it < 96; it += NGW) {
            const int row = it < 32 ? 672 + it : 2240 + (it - 32);
            u32x2* o = (u32x2*)(WinT + (size_t)row * D) + lane;
#pragma unroll
            for (int j = 0; j < 4; ++j) o[64 * j] = (u32x2){0u, 0u};
        }
    }
    constexpr int I_WIN = 16 * 69, I_UQ = 6 * 24, I_UKV = 4 * 32, I_WO = 16 * 32, I_WR = 16 * 8, I_SG = 128, I_SD = 128;
    constexpr int I_SMALL = I_WIN + I_UQ + I_UKV + I_WO + I_WR + 2 * I_SG + I_SD;
    constexpr int I_EXP = NEXP * 128;
    constexpr int NITEMS = I_WIN + I_UQ + I_UKV + I_WO + I_WR;
    for (int it = gw; it < NITEMS; it += NGW) {
        int r = it;
        if (r < I_WIN) { transpose_item<MAP_WIN>(p.w_in, D, DIN, (bf16_t*)(ws + WS_WIN), nullptr, scr, r, lane); continue; } r -= I_WIN;
        if (r < I_UQ) { transpose_item<MAP_ID>(p.w_uq, QLORA, 768, (bf16_t*)(ws + WS_WUQ), p.q_norm, scr, r, lane); continue; } r -= I_UQ;
        if (r < I_UKV) { transpose_item<MAP_ID>(p.w_ukv, KVLORA, 1024, (bf16_t*)(ws + WS_WUKV), p.kv_norm, scr, r, lane); continue; } r -= I_UKV;
        if (r < I_WO) {
            const int kb = r / 32;
            transpose_item<MAP_ID>(p.w_o, D, D, (bf16_t*)(ws + WS_WO), kb < 8 ? p.attn_on : p.conv_on - 512, scr, r, lane); continue; } r -= I_WO;
        if (r < I_WR) { transpose_item<MAP_ID>(p.w_router, D, 256, (bf16_t*)(ws + WS_WR), nullptr, scr, r, lane); continue; } r -= I_WR;
        if (r < I_SG) { transpose_item<MAP_GATE>(p.ws_gate, D, 256, (bf16_t*)(ws + WS_WSGU), nullptr, scr, r, lane); continue; } r -= I_SG;
        if (r < I_SG) { transpose_item<MAP_UP>(p.ws_up, D, 256, (bf16_t*)(ws + WS_WSGU), nullptr, scr, r, lane); continue; } r -= I_SG;
        if (r < I_SD) { transpose_item<MAP_ID>(p.ws_down, DEXP, D, (bf16_t*)(ws + WS_WSD), nullptr, scr, r, lane); continue; } r -= I_SD;
        if (r < I_EXP) { const int e = r >> 7; transpose_item<MAP_GATE>(p.w_gate + (size_t)e * D * DEXP, D, 256, (bf16_t*)(ws + WS_WGU) + (size_t)e * 512 * D, nullptr, scr, r & 127, lane); continue; } r -= I_EXP;
        if (r < I_EXP) { const int e = r >> 7; transpose_item<MAP_UP>(p.w_up + (size_t)e * D * DEXP, D, 256, (bf16_t*)(ws + WS_WGU) + (size_t)e * 512 * D, nullptr, scr, r & 127, lane); continue; } r -= I_EXP;
        { const int e = r >> 7; transpose_item<MAP_ID>(p.w_down + (size_t)e * DEXP * D, DEXP, D, (bf16_t*)(ws + WS_WD) + (size_t)e * D * DEXP, nullptr, scr, r & 127, lane); }
    }
}

__device__ __forceinline__ void phase1(const Params& p, const Ctx& c) {
    unsigned char* ws = p.ws;
    const bf16_t* H0 = (const bf16_t*)(ws + WS_H0); const bf16_t* WinT = (const bf16_t*)(ws + WS_WIN);
    bf16_t* Z = (bf16_t*)(ws + WS_Z);
    float* psq = (float*)(ws + WS_PSQ);
    const int lane = c.lane, wr = c.wave >> 2, wc = c.wave & 3, fr = lane & 15, fq = lane >> 4;
    constexpr int NU = 129 * 9;
    for (int u = c.vcu; u < NU; u += c.G) {
        const int mt = u / 9, nt = u % 9, row0 = mt * 128, n0 = nt * 256;
        f32x4 acc[4][4]; acc_zero(acc);
        auto rp = [&](int r) { return H0 + (size_t)(row0 + r) * D; };
        gemm_kloop(acc, c, rp, WinT + (size_t)n0 * D, D, D);
        const int s0 = n0 + wc * 64;
#pragma unroll
        for (int mi = 0; mi < 4; ++mi) {
            const int row = row0 + wr * 64 + mi * 16 + fr;
            float ss = 0.f;
#pragma unroll
            for (int ni = 0; ni < 4; ++ni) {
                const f32x4 v = acc[mi][ni];
                store_bf4(Z + (size_t)row * ZC + s0 + ni * 16 + fq * 4, v);
                ss += (v[0] * v[0] + v[1] * v[1]) + (v[2] * v[2] + v[3] * v[3]);
            }
            if (s0 < ZKPE) {
                ss += __shfl_xor(ss, 16); ss += __shfl_xor(ss, 32);
                if (fq == 0) psq[(size_t)row * 16 + (s0 >> 6)] = ss;
            }
        }
    }
}

__device__ __forceinline__ void phase2_gemms(const Params& p, const Ctx& c);
__device__ __forceinline__ void phase2(const Params& p, const Ctx& c) {
    unsigned char* ws = p.ws;
    const bf16_t* Z = (const bf16_t*)(ws + WS_Z);
    const float* psq = (const float*)(ws + WS_PSQ);
    const float* rope = (const float*)(ws + WS_ROPE);
    bf16_t* Q = (bf16_t*)(ws + WS_Q); bf16_t* Kb = (bf16_t*)(ws + WS_K); bf16_t* Vb = (bf16_t*)(ws + WS_V);
    const int lane = c.lane, wr = c.wave >> 2, wc = c.wave & 3, fr = lane & 15, fq = lane >> 4;
    phase2_gemms(p, c);
    __syncthreads();
    const int gw = c.vcu * NWAVES + c.wave, NGW = c.G * NWAVES;
    const bf16_t* Zc = Z;
    for (int row = gw; row < NROWS; row += NGW) {
        const int nb = row < NTOK ? 1 : NBATCH;
        const int b0 = row < NTOK ? (row >> 11) : 0, pos = row < NTOK ? NMETA + (row & (SEQ - 1)) : row - NTOK;
        if (lane < 16) {
            const float x1 = bf2f(Zc[(size_t)row * ZC + ZKPE + lane]), x2 = bf2f(Zc[(size_t)row * ZC + ZKPE + 16 + lane]);
            const float co = rope[((size_t)pos * 16 + lane) * 2], si = rope[((size_t)pos * 16 + lane) * 2 + 1];
            const bf16_t o1 = (bf16_t)f2bf(x1 * co - x2 * si), o2 = (bf16_t)f2bf(x2 * co + x1 * si);
            for (int bb = 0; bb < nb; ++bb) {
                bf16_t* kp = Kb + ((size_t)(b0 + bb) * LPOS + pos) * 768;
#pragma unroll
                for (int h = 0; h < NH; ++h) { kp[h * 96 + 64 + lane] = o1; kp[h * 96 + 80 + lane] = o2; }
            }
        }
        if (row < NTOK) {
            const int i = row & (SEQ - 1);
            const int r1 = i >= 1 ? row - 1 : NTOK + 15;
            const int r2 = i >= 2 ? row - 2 : (i == 1 ? NTOK + 15 : NTOK + 14);
            const int ch = lane * 8;
            const u32x4 c0 = *(const u32x4*)(Zc + (size_t)row * ZC + ZCG + ch), u0 = *(const u32x4*)(Zc + (size_t)row * ZC + ZU + ch);
            const u32x4 c1 = *(const u32x4*)(Zc + (size_t)r1 * ZC + ZCG + ch), u1 = *(const u32x4*)(Zc + (size_t)r1 * ZC + ZU + ch);
            const u32x4 c2 = *(const u32x4*)(Zc + (size_t)r2 * ZC + ZCG + ch), u2 = *(const u32x4*)(Zc + (size_t)r2 * ZC + ZU + ch);
            const u32x4 bg = *(const u32x4*)(Zc + (size_t)row * ZC + ZB + ch);
            float y[8]; float ss = 0.f;
#pragma unroll
            for (int e = 0; e < 4; ++e) {
#pragma unroll
                for (int hh = 0; hh < 2; ++hh) {
                    const int cc = ch + e * 2 + hh;
                    const float w0 = p.conv_w[cc], w1 = p.conv_w[512 + cc], w2 = p.conv_w[1024 + cc];
                    const float v0 = hh ? bfhi(c0[e]) * bfhi(u0[e]) : bflo(c0[e]) * bflo(u0[e]);
                    const float v1 = hh ? bfhi(c1[e]) * bfhi(u1[e]) : bflo(c1[e]) * bflo(u1[e]);
                    const float v2 = hh ? bfhi(c2[e]) * bfhi(u2[e]) : bflo(c2[e]) * bflo(u2[e]);
                    const float bgv = hh ? bfhi(bg[e]) : bflo(bg[e]);
                    const float yy = bgv * (w0 * v2 + w1 * v1 + w2 * v0);
                    y[e * 2 + hh] = yy; ss += yy * yy;
                }
            }
            ss = wave_sum(ss);
            u32x4 o; o.x = pk2(y[0], y[1]); o.y = pk2(y[2], y[3]); o.z = pk2(y[4], y[5]); o.w = pk2(y[6], y[7]);
            *(u32x4*)((bf16_t*)(ws + WS_ATT) + (size_t)row * D + 512 + ch) = o;
            if (lane == 0) ((float*)(ws + WS_SSQC))[row] = ss;
        }
    }
}

__device__ __forceinline__ void phase3_naive(const Params& p, const Ctx& c) {
    unsigned char* ws = p.ws;
    const bf16_t* Q = (const bf16_t*)(ws + WS_Q); const bf16_t* Kb = (const bf16_t*)(ws + WS_K); const bf16_t* Vb = (const bf16_t*)(ws + WS_V);
    bf16_t* ATT = (bf16_t*)(ws + WS_ATT); float* patt = (float*)(ws + WS_PATT);
    const int gw = c.vcu * NWAVES + c.wave, NGW = c.G * NWAVES, lane = c.lane;
    for (int it = gw; it < NTOK * NH; it += NGW) {
        const int row = it >> 3, h = it & 7, b = row >> 11, i = row & (SEQ - 1), nkeys = NMETA + i + 1;
        float q[96];
#pragma unroll
        for (int j = 0; j < 12; ++j) {
            const u32x4 w = *(const u32x4*)(Q + (size_t)row * 768 + h * 96 + j * 8);
#pragma unroll
            for (int e = 0; e < 4; ++e) { q[j * 8 + e * 2] = bflo(w[e]); q[j * 8 + e * 2 + 1] = bfhi(w[e]); }
        }
        float m = -INFINITY, l = 0.f; float o[64];
#pragma unroll
        for (int d = 0; d < 64; ++d) o[d] = 0.f;
        for (int kk = lane; kk < nkeys; kk += 64) {
            const bf16_t* kp = Kb + ((size_t)b * LPOS + kk) * 768 + h * 96;
            float s = 0.f;
#pragma unroll
            for (int j = 0; j < 12; ++j) {
                const u32x4 w = *(const u32x4*)(kp + j * 8);
#pragma unroll
                for (int e = 0; e < 4; ++e) { s += q[j * 8 + e * 2] * bflo(w[e]); s += q[j * 8 + e * 2 + 1] * bfhi(w[e]); }
            }
            const float mn = fmaxf(m, s), f = exp2f(m - mn), pe = exp2f(s - mn);
            l = l * f + pe; m = mn;
            const bf16_t* vp = Vb + ((size_t)b * LPOS + kk) * 512 + h * 64;
#pragma unroll
            for (int j = 0; j < 8; ++j) {
                const u32x4 w = *(const u32x4*)(vp + j * 8);
#pragma unroll
                for (int e = 0; e < 4; ++e) { o[j * 8 + e * 2] = o[j * 8 + e * 2] * f + pe * bflo(w[e]); o[j * 8 + e * 2 + 1] = o[j * 8 + e * 2 + 1] * f + pe * bfhi(w[e]); }
            }
        }
        const float M = wave_max(m);
        const float f = (m == -INFINITY) ? 0.f : exp2f(m - M);
        const float lt = wave_sum(l * f);
        float res = 0.f;
#pragma unroll
        for (int d = 0; d < 64; ++d) { const float v = wave_sum(o[d] * f); if (lane == d) res = v; }
        res /= lt;
        ATT[(size_t)row * D + h * 64 + lane] = (bf16_t)f2bf(res);
        const float ss = wave_sum(res * res);
        if (lane == 0) patt[(size_t)row * 8 + h] = ss;
    }
}


typedef float f32x16 __attribute__((ext_vector_type(16)));
typedef short s16x4 __attribute__((ext_vector_type(4)));
constexpr int AK_PITCH = 208, AK_BYTES = 64 * AK_PITCH, AV_BYTES = 8192, ASTAGE = AK_BYTES + AV_BYTES, A_WSF = 4 * ASTAGE;
__device__ __forceinline__ int crow(int r, int hi) { return (r & 3) + 8 * (r >> 2) + 4 * hi; }
__device__ __forceinline__ s16x4 vtr(const LAS unsigned char* p) {
    return __builtin_bit_cast(s16x4, __builtin_amdgcn_ds_read_tr16_b64_v4i16((LAS s16x4*)p));
}
__device__ __forceinline__ void attn_unit(const Params& p, const Ctx& c, int b, int h, int qb) {
    unsigned char* ws = p.ws;
    const bf16_t* Q = (const bf16_t*)(ws + WS_Q); const bf16_t* Kb = (const bf16_t*)(ws + WS_K); const bf16_t* Vb = (const bf16_t*)(ws + WS_V);
    bf16_t* ATT = (bf16_t*)(ws + WS_ATT); float* patt = (float*)(ws + WS_PATT);
    const int tid = c.tid, lane = c.lane, w = c.wave, r32 = lane & 31, hi = lane >> 5;
    LAS unsigned char* lds = c.lds;
    LAS float* wsf = (LAS float*)(lds + A_WSF) + w * 32;
    const int row0 = b * SEQ + qb * 256;
    const int qpos0 = NMETA + qb * 256 + w * 32, myq = qpos0 + r32;
    bf16x8 qf[6];
#pragma unroll
    for (int ds = 0; ds < 6; ++ds) qf[ds] = *(const bf16x8*)(Q + (size_t)(row0 + w * 32 + r32) * 768 + h * 96 + ds * 16 + hi * 8);
    const bf16_t* Kg = Kb + (size_t)b * LPOS * 768 + h * 96;
    const bf16_t* Vg = Vb + (size_t)b * LPOS * 512 + h * 64;
    const int T = 4 * qb + 5;
    const int tl = (qpos0 + 31) >> 6;
    const int vrow = tid >> 3, vch = tid & 7;
    const int voff = AK_BYTES + (vch >> 2) * 4096 + vrow * 64 + (vch & 3) * 16;
    const int k1c = 512 + (tid & 255);
    const int k0row = tid / 12, k0ch = tid % 12, k1row = k1c / 12, k1ch = k1c % 12;
    const int k0off = k0row * AK_PITCH + k0ch * 16, k1off = k1row * AK_PITCH + k1ch * 16;
    u32x4 rkA0, rkA1, rvA, rkA2, rkA3, rvA2;
#define A_LOAD1(k0, k1, v, t) do { const int kb_ = min((t), T - 1) * 64; \
        k0 = *(const u32x4*)(Kg + (size_t)min(kb_ + k0row, LPOS - 1) * 768 + k0ch * 8); \
        k1 = *(const u32x4*)(Kg + (size_t)min(kb_ + k1row, LPOS - 1) * 768 + k1ch * 8); \
        v = *(const u32x4*)(Vg + (size_t)min(kb_ + vrow, LPOS - 1) * 512 + vch * 8); } while (0)
#define A_STORE1(k0, k1, v, off) do { LAS unsigned char* sb_ = lds + (off); \
        *(LAS u32x4*)(sb_ + k0off) = k0; *(LAS u32x4*)(sb_ + k1off) = k1; *(LAS u32x4*)(sb_ + voff) = v; } while (0)
#define A_LOAD_A(t2) do { A_LOAD1(rkA0, rkA1, rvA, 2 * (t2)); A_LOAD1(rkA2, rkA3, rvA2, 2 * (t2) + 1); } while (0)
#define A_STORE_A(buf) do { A_STORE1(rkA0, rkA1, rvA, (buf) * 2 * ASTAGE); A_STORE1(rkA2, rkA3, rvA2, (buf) * 2 * ASTAGE + ASTAGE); } while (0)
    float m = -INFINITY, l = 0.f;
    f32x16 o0, o1;
#pragma unroll
    for (int r = 0; r < 16; ++r) { o0[r] = 0.f; o1[r] = 0.f; }
    const int kfo = r32 * AK_PITCH + hi * 16;
    const int vfo = AK_BYTES + ((lane >> 4) & 1) * 32 + (lane & 3) * 8 + (4 * hi + ((lane & 15) >> 2)) * 64;
    const int T2 = (T + 1) >> 1;
    __syncthreads();
    A_LOAD_A(0);
    A_STORE_A(0);
    __syncthreads();
    auto compute_tile = [&](int t) __attribute__((always_inline)) {
        if (t <= tl) {
            const LAS unsigned char* sb = lds + ((t >> 1) & 1) * 2 * ASTAGE + (t & 1) * ASTAGE;
            f32x16 p0, p1;
#pragma unroll
            for (int r = 0; r < 16; ++r) { p0[r] = 0.f; p1[r] = 0.f; }
#pragma unroll
            for (int ds = 0; ds < 6; ++ds) {
                const bf16x8 a0 = *(const LAS bf16x8*)(sb + kfo + ds * 32);
                const bf16x8 a1 = *(const LAS bf16x8*)(sb + kfo + 32 * AK_PITCH + ds * 32);
                p0 = __builtin_amdgcn_mfma_f32_32x32x16_bf16(a0, qf[ds], p0, 0, 0, 0);
                p1 = __builtin_amdgcn_mfma_f32_32x32x16_bf16(a1, qf[ds], p1, 0, 0, 0);
            }
            if (t * 64 + 63 > qpos0) {
                const int kb0 = t * 64 + 4 * hi;
#pragma unroll
                for (int r = 0; r < 16; ++r) {
                    const int kv = kb0 + (r & 3) + 8 * (r >> 2);
                    if (kv > myq) p0[r] = -INFINITY;
                    if (kv + 32 > myq) p1[r] = -INFINITY;
                }
            }
            float mx = fmaxf(p0[0], p1[0]);
#pragma unroll
            for (int r = 1; r < 16; ++r) mx = fmaxf(mx, fmaxf(p0[r], p1[r]));
            mx = fmaxf(mx, __shfl_xor(mx, 32));
            if (__any(mx > m)) {
                const float mn = fmaxf(m, mx), alpha = __builtin_amdgcn_exp2f(m - mn);
                m = mn; l *= alpha;
                if (hi == 0) wsf[r32] = alpha;
                asm volatile("s_waitcnt lgkmcnt(0)" ::: "memory");
#pragma unroll
                for (int k = 0; k < 4; ++k) {
                    const f32x4 a = *(const LAS f32x4*)(wsf + 8 * k + 4 * hi);
#pragma unroll
                    for (int j = 0; j < 4; ++j) { o0[4 * k + j] *= a[j]; o1[4 * k + j] *= a[j]; }
                }
                asm volatile("s_waitcnt lgkmcnt(0)" ::: "memory");
            }
            float ls = 0.f;
#pragma unroll
            for (int r = 0; r < 16; ++r) { p0[r] = __builtin_amdgcn_exp2f(p0[r] - m); p1[r] = __builtin_amdgcn_exp2f(p1[r] - m); ls += p0[r] + p1[r]; }
            l += ls;
            bf16x8 pa[4];
#pragma unroll
            for (int s = 0; s < 4; ++s) {
                u32x4 wv;
#pragma unroll
                for (int e = 0; e < 4; ++e) {
                    const int r = 8 * (s & 1) + 2 * e;
                    wv[e] = (s >> 1) ? pk2(p1[r], p1[r + 1]) : pk2(p0[r], p0[r + 1]);
                }
                pa[s] = __builtin_bit_cast(bf16x8, wv);
            }
#pragma unroll
            for (int s = 0; s < 4; ++s) {
                const s16x4 l0 = vtr(sb + vfo + s * 1024), h0 = vtr(sb + vfo + s * 1024 + 512);
                const s16x4 l1 = vtr(sb + vfo + 4096 + s * 1024), h1 = vtr(sb + vfo + 4096 + s * 1024 + 512);
                const bf16x8 v0 = (bf16x8){l0[0], l0[1], l0[2], l0[3], h0[0], h0[1], h0[2], h0[3]};
                const bf16x8 v1 = (bf16x8){l1[0], l1[1], l1[2], l1[3], h1[0], h1[1], h1[2], h1[3]};
                o0 = __builtin_amdgcn_mfma_f32_32x32x16_bf16(pa[s], v0, o0, 0, 0, 0);
                o1 = __builtin_amdgcn_mfma_f32_32x32x16_bf16(pa[s], v1, o1, 0, 0, 0);
            }
        }
    };
#pragma unroll 1
    for (int t2 = 0; t2 < T2; ++t2) {
        A_LOAD_A(t2 + 1);
        compute_tile(2 * t2); compute_tile(2 * t2 + 1);
        A_STORE_A((t2 + 1) & 1);
        __syncthreads();
    }
#undef A_LOAD1
#undef A_STORE1
#undef A_LOAD_A
#undef A_STORE_A
    l += __shfl_xor(l, 32);
    if (hi == 0) wsf[r32] = 1.f / l;
    asm volatile("s_waitcnt lgkmcnt(0)" ::: "memory");
    float sq[16];
#pragma unroll
    for (int k = 0; k < 4; ++k) {
        const f32x4 a = *(const LAS f32x4*)(wsf + 8 * k + 4 * hi);
#pragma unroll
        for (int j = 0; j < 4; ++j) {
            const int r = 4 * k + j;
            const float x0 = o0[r] * a[j], x1 = o1[r] * a[j];
            bf16_t* op = ATT + (size_t)(row0 + w * 32 + crow(r, hi)) * D + h * 64 + r32;
            op[0] = (bf16_t)f2bf(x0); op[32] = (bf16_t)f2bf(x1);
            sq[r] = x0 * x0 + x1 * x1;
        }
    }
#pragma unroll
    for (int r = 0; r < 16; ++r) {
        float v = sq[r];
#pragma unroll
        for (int o = 1; o < 32; o <<= 1) v += __shfl_xor(v, o);
        if (r32 == 0) patt[(size_t)(row0 + w * 32 + crow(r, hi)) * 8 + h] = v;
    }
    asm volatile("s_waitcnt lgkmcnt(0)" ::: "memory");
}
__device__ __forceinline__ void phase3(const Params& p, const Ctx& c) {
    for (int pi = c.vcu; pi < 256; pi += c.G) {
        const int bh = pi >> 2, s = pi & 3;
        attn_unit(p, c, bh >> 3, bh & 7, 7 - s);
        attn_unit(p, c, bh >> 3, bh & 7, s);
    }
}

__device__ __forceinline__ void phase4(const Params& p, const Ctx& c) {
    unsigned char* ws = p.ws;
    const bf16_t* ATT = (const bf16_t*)(ws + WS_ATT); const bf16_t* CONV = (const bf16_t*)(ws + WS_CONV);
    const bf16_t* WoT = (const bf16_t*)(ws + WS_WO); const bf16_t* H0 = (const bf16_t*)(ws + WS_H0);
    const float* patt = (const float*)(ws + WS_PATT); const float* ssq_c = (const float*)(ws + WS_SSQC);
    bf16_t* Y1 = (bf16_t*)(ws + WS_Y1); float* pst = (float*)(ws + WS_PST);
    const int lane = c.lane, wr = c.wave >> 2, wc = c.wave & 3, fr = lane & 15, fq = lane >> 4;
    constexpr int NU = 128 * 4;
    for (int u = c.vcu; u < NU; u += c.G) {
        const int mt = u >> 2, nt = u & 3, row0 = mt * 128, n0 = nt * 256;
        f32x4 acc[4][4]; acc_zero(acc);
        auto rpa = [&](int r) { return ATT + (size_t)(row0 + r) * 512; };
        gemm_kloop(acc, c, rpa, WoT + (size_t)n0 * D, D, 512);
        float rc[4];
#pragma unroll
        for (int mi = 0; mi < 4; ++mi) {
            const int row = row0 + wr * 64 + mi * 16 + fr;
            const f32x4 pa = *(const f32x4*)(patt + (size_t)row * 8), pb = *(const f32x4*)(patt + (size_t)row * 8 + 4);
            const float ra = rsqrtf((((pa[0] + pa[1]) + (pa[2] + pa[3])) + ((pb[0] + pb[1]) + (pb[2] + pb[3]))) * (1.f / 512) + 1e-6f);
            rc[mi] = rsqrtf(ssq_c[row] * (1.f / 512) + 1e-6f);
            const float f = ra / rc[mi];
#pragma unroll
            for (int ni = 0; ni < 4; ++ni) acc[mi][ni] = acc[mi][ni] * f;
        }
        auto rpc = [&](int r) { return CONV + (size_t)(row0 + r) * 512; };
        gemm_kloop(acc, c, rpc, WoT + (size_t)n0 * D + 512, D, 512);
        const int s0 = n0 + wc * 64;
#pragma unroll
        for (int mi = 0; mi < 4; ++mi) {
            const int row = row0 + wr * 64 + mi * 16 + fr;
            float s = 0.f, ss = 0.f;
#pragma unroll
            for (int ni = 0; ni < 4; ++ni) {
                const int col = s0 + ni * 16 + fq * 4;
                const u32x2 hw = *(const u32x2*)(H0 + (size_t)row * D + col);
                f32x4 v = acc[mi][ni] * rc[mi];
                v[0] += ALPHA * bflo(hw.x); v[1] += ALPHA * bfhi(hw.x); v[2] += ALPHA * bflo(hw.y); v[3] += ALPHA * bfhi(hw.y);
                store_bf4(Y1 + (size_t)row * D + col, v);
                s += (v[0] + v[1]) + (v[2] + v[3]);
                ss += (v[0] * v[0] + v[1] * v[1]) + (v[2] * v[2] + v[3] * v[3]);
            }
            s += __shfl_xor(s, 16); s += __shfl_xor(s, 32);
            ss += __shfl_xor(ss, 16); ss += __shfl_xor(ss, 32);
            if (fq == 0) { float* q = pst + ((size_t)row * 16 + nt * 4 + wc) * 2; q[0] = s; q[1] = ss; }
        }
    }
}

__device__ __forceinline__ void phase5a(const Params& p, const Ctx& c) {
    unsigned char* ws = p.ws;
    const bf16_t* Y1 = (const bf16_t*)(ws + WS_Y1); bf16_t* H1 = (bf16_t*)(ws + WS_H1); const float* pst = (const float*)(ws + WS_PST);
    const int gw = c.vcu * NWAVES + c.wave, NGW = c.G * NWAVES, lane = c.lane;
    for (int row = gw; row < NTOK; row += NGW) {
        float s1 = 0.f, s2 = 0.f;
#pragma unroll
        for (int k = 0; k < 16; ++k) { s1 += pst[((size_t)row * 16 + k) * 2]; s2 += pst[((size_t)row * 16 + k) * 2 + 1]; }
        const float mean = s1 * (1.f / D), var = fmaxf(s2 * (1.f / D) - mean * mean, 0.f), rstd = rsqrtf(var + 1e-5f);
#pragma unroll
        for (int j = 0; j < 2; ++j) {
            const int col = (lane + 64 * j) * 8;
            const u32x4 w = *(const u32x4*)(Y1 + (size_t)row * D + col);
            float y[8];
#pragma unroll
            for (int e = 0; e < 4; ++e) { y[2 * e] = bflo(w[e]); y[2 * e + 1] = bfhi(w[e]); }
#pragma unroll
            for (int e = 0; e < 8; ++e) y[e] = (y[e] - mean) * rstd * p.ln1_g[col + e] + p.ln1_b[col + e];
            u32x4 o; o.x = pk2(y[0], y[1]); o.y = pk2(y[2], y[3]); o.z = pk2(y[4], y[5]); o.w = pk2(y[6], y[7]);
            *(u32x4*)(H1 + (size_t)row * D + col) = o;
        }
    }
}
__device__ __forceinline__ void phase5b(const Params& p, const Ctx& c) {
    unsigned char* ws = p.ws;
    const bf16_t* H1 = (const bf16_t*)(ws + WS_H1); float* LOG = (float*)(ws + WS_LOG);
    const int lane = c.lane, wr = c.wave >> 2, wc = c.wave & 3, fr = lane & 15, fq = lane >> 4;
    for (int u = c.vcu; u < 128; u += c.G) {
        const int row0 = u * 128;
        f32x4 acc[4][4]; acc_zero(acc);
        auto rp = [&](int r) { return H1 + (size_t)(row0 + r) * D; };
        gemm_kloop(acc, c, rp, (const bf16_t*)(ws + WS_WR), D, D);
#pragma unroll
        for (int mi = 0; mi < 4; ++mi) {
            const int row = row0 + wr * 64 + mi * 16 + fr;
#pragma unroll
            for (int ni = 0; ni < 4; ++ni) *(f32x4*)(LOG + (size_t)row * 256 + wc * 64 + ni * 16 + fq * 4) = acc[mi][ni];
        }
    }
}
__device__ __forceinline__ void phase5c(const Params& p, const Ctx& c) {
    unsigned char* ws = p.ws;
    const float* LOG = (const float*)(ws + WS_LOG);
    unsigned* cnt = (unsigned*)(ws + WS_CTL + CT_CNT); unsigned* laid = (unsigned*)(ws + WS_LAID); float* lgate = (float*)(ws + WS_LGATE);
    const int gw = c.vcu * NWAVES + c.wave, NGW = c.G * NWAVES, lane = c.lane;
    const f32x4 bias = *((const f32x4*)p.router_bias + lane);
    for (int t = gw; t < NTOK; t += NGW) {
        const f32x4 lg = *((const f32x4*)(LOG + (size_t)t * 256) + lane);
        float s[4], sel[4];
#pragma unroll
        for (int i = 0; i < 4; ++i) { s[i] = 1.f / (1.f + expf(-lg[i])); sel[i] = s[i] + bias[i]; }
        float a = fmaxf(sel[0], sel[1]), b = fminf(sel[0], sel[1]), cc = fmaxf(sel[2], sel[3]), d = fminf(sel[2], sel[3]);
        float t1 = fmaxf(a, cc), t2 = fmaxf(fminf(a, cc), a >= cc ? b : d);
#pragma unroll
        for (int o = 1; o < 8; o <<= 1) {
            const float y1 = __shfl_xor(t1, o), y2 = __shfl_xor(t2, o);
            const float n1 = fmaxf(t1, y1), n2 = fmaxf(fminf(t1, y1), t1 >= y1 ? t2 : y2);
            t1 = n1; t2 = n2;
        }
        const float gs = t1 + t2; const int g = lane >> 3;
        int better = 0;
#pragma unroll
        for (int gg = 0; gg < 8; ++gg) { const float o = __shfl(gs, gg * 8); better += (o > gs || (o == gs && gg < g)) ? 1 : 0; }
        if (better >= 4) { sel[0] = sel[1] = sel[2] = sel[3] = -INFINITY; }
        int ek[8]; float sk[8]; float ssum = 0.f;
#pragma unroll
        for (int k = 0; k < 8; ++k) {
            float bv = sel[0]; int bi = 0;
            if (sel[1] > bv) { bv = sel[1]; bi = 1; }
            if (sel[2] > bv) { bv = sel[2]; bi = 2; }
            if (sel[3] > bv) { bv = sel[3]; bi = 3; }
            const float wm = wave_max(bv);
            const unsigned long long mask = __ballot(bv == wm);
            const int src = __ffsll((long long)mask) - 1;
            const float sb = bi == 0 ? s[0] : bi == 1 ? s[1] : bi == 2 ? s[2] : s[3];
            ek[k] = src * 4 + __shfl(bi, src); sk[k] = __shfl(sb, src); ssum += sk[k];
            if (lane == src) { if (bi == 0) sel[0] = -INFINITY; else if (bi == 1) sel[1] = -INFINITY; else if (bi == 2) sel[2] = -INFINITY; else sel[3] = -INFINITY; }
        }
        int me = ek[0]; float mg = sk[0];
#pragma unroll
        for (int k = 1; k < 8; ++k) if (lane == k) { me = ek[k]; mg = sk[k]; }
        if (lane < 8) {
            const unsigned pos = atomicAdd(cnt + me, 1u);
            laid[(size_t)me * CAP + pos] = (unsigned)(t * 8 + lane);
            lgate[(size_t)me * CAP + pos] = mg / ssum * 2.5f;
        }
    }
}


__device__ __forceinline__ void route_token(const Params& p, int t, const f32x4 lg, const f32x4 bias, int lane, unsigned* cnt, unsigned* laid, float* lgate) {
    float s[4], sel[4];
#pragma unroll
    for (int i = 0; i < 4; ++i) { s[i] = 1.f / (1.f + expf(-lg[i])); sel[i] = s[i] + bias[i]; }
    float a = fmaxf(sel[0], sel[1]), b = fminf(sel[0], sel[1]), cc = fmaxf(sel[2], sel[3]), d = fminf(sel[2], sel[3]);
    float t1 = fmaxf(a, cc), t2 = fmaxf(fminf(a, cc), a >= cc ? b : d);
#pragma unroll
    for (int o = 1; o < 8; o <<= 1) {
        const float y1 = __shfl_xor(t1, o), y2 = __shfl_xor(t2, o);
        const float n1 = fmaxf(t1, y1), n2 = fmaxf(fminf(t1, y1), t1 >= y1 ? t2 : y2);
        t1 = n1; t2 = n2;
    }
    const float gs = t1 + t2; const int g = lane >> 3;
    int better = 0;
#pragma unroll
    for (int gg = 0; gg < 8; ++gg) { const float o = __shfl(gs, gg * 8); better += (o > gs || (o == gs && gg < g)) ? 1 : 0; }
    if (better >= 4) { sel[0] = sel[1] = sel[2] = sel[3] = -INFINITY; }
    int ek[8]; float sk[8]; float ssum = 0.f;
#pragma unroll
    for (int k = 0; k < 8; ++k) {
        float bv = sel[0]; int bi = 0;
        if (sel[1] > bv) { bv = sel[1]; bi = 1; }
        if (sel[2] > bv) { bv = sel[2]; bi = 2; }
        if (sel[3] > bv) { bv = sel[3]; bi = 3; }
        const float wm = wave_max(bv);
        const unsigned long long mask = __ballot(bv == wm);
        const int src = __ffsll((long long)mask) - 1;
        const float sb = bi == 0 ? s[0] : bi == 1 ? s[1] : bi == 2 ? s[2] : s[3];
        ek[k] = src * 4 + __shfl(bi, src); sk[k] = __shfl(sb, src); ssum += sk[k];
        if (lane == src) { if (bi == 0) sel[0] = -INFINITY; else if (bi == 1) sel[1] = -INFINITY; else if (bi == 2) sel[2] = -INFINITY; else sel[3] = -INFINITY; }
    }
    int me = ek[0]; float mg = sk[0];
#pragma unroll
    for (int k = 1; k < 8; ++k) if (lane == k) { me = ek[k]; mg = sk[k]; }
    if (lane < 8) {
        const unsigned pos = atomicAdd(cnt + me, 1u);
        laid[(size_t)me * CAP + pos] = (unsigned)(t * 8 + lane);
        lgate[(size_t)me * CAP + pos] = mg / ssum * 2.5f;
    }
}
__device__ __forceinline__ void route_select(const f32x4 lg, const f32x4 bias, int lane, int& me_out, float& gate_out) {
    float s[4], sel[4];
#pragma unroll
    for (int i = 0; i < 4; ++i) { s[i] = 1.f / (1.f + expf(-lg[i])); sel[i] = s[i] + bias[i]; }
    float a = fmaxf(sel[0], sel[1]), b = fminf(sel[0], sel[1]), cc = fmaxf(sel[2], sel[3]), d = fminf(sel[2], sel[3]);
    float t1 = fmaxf(a, cc), t2 = fmaxf(fminf(a, cc), a >= cc ? b : d);
#pragma unroll
    for (int o = 1; o < 8; o <<= 1) {
        const float y1 = __shfl_xor(t1, o), y2 = __shfl_xor(t2, o);
        const float n1 = fmaxf(t1, y1), n2 = fmaxf(fminf(t1, y1), t1 >= y1 ? t2 : y2);
        t1 = n1; t2 = n2;
    }
    const float gs = t1 + t2; const int g = lane >> 3;
    int better = 0;
#pragma unroll
    for (int gg = 0; gg < 8; ++gg) { const float o = __shfl(gs, gg * 8); better += (o > gs || (o == gs && gg < g)) ? 1 : 0; }
    if (better >= 4) { sel[0] = sel[1] = sel[2] = sel[3] = -INFINITY; }
    int ek[8]; float sk[8]; float ssum = 0.f;
#pragma unroll
    for (int k = 0; k < 8; ++k) {
        float bv = sel[0]; int bi = 0;
        if (sel[1] > bv) { bv = sel[1]; bi = 1; }
        if (sel[2] > bv) { bv = sel[2]; bi = 2; }
        if (sel[3] > bv) { bv = sel[3]; bi = 3; }
        const float wm = wave_max(bv);
        const unsigned long long mask = __ballot(bv == wm);
        const int src = __ffsll((long long)mask) - 1;
        const float sb = bi == 0 ? s[0] : bi == 1 ? s[1] : bi == 2 ? s[2] : s[3];
        ek[k] = src * 4 + __shfl(bi, src); sk[k] = __shfl(sb, src); ssum += sk[k];
        if (lane == src) { if (bi == 0) sel[0] = -INFINITY; else if (bi == 1) sel[1] = -INFINITY; else if (bi == 2) sel[2] = -INFINITY; else sel[3] = -INFINITY; }
    }
    int me = ek[0]; float mg = sk[0];
#pragma unroll
    for (int k = 1; k < 8; ++k) if (lane == k) { me = ek[k]; mg = sk[k]; }
    me_out = me; gate_out = mg / ssum * 2.5f;
}
__device__ __forceinline__ void phase5_fused(const Params& p, const Ctx& c) {
    unsigned char* ws = p.ws;
    const bf16_t* Y1 = (const bf16_t*)(ws + WS_Y1); bf16_t* H1 = (bf16_t*)(ws + WS_H1); const float* pst = (const float*)(ws + WS_PST);
    const bf16_t* WrT = (const bf16_t*)(ws + WS_WR);
    unsigned* cnt = (unsigned*)(ws + WS_CTL + CT_CNT); unsigned* laid = (unsigned*)(ws + WS_LAID); float* lgate = (float*)(ws + WS_LGATE);
    const int lane = c.lane, w = c.wave, r32 = lane & 31, hi = lane >> 5;
    LAS unsigned char* lds = c.lds;
    const f32x4 bias = *((const f32x4*)p.router_bias + lane);
    for (int u = c.vcu; u < NTOK / 64; u += c.G) {
        const int row0 = u * 64;
        __syncthreads();
        {
            float gg[16], bb[16];
#pragma unroll
            for (int j = 0; j < 2; ++j) {
                const int col = (lane + 64 * j) * 8;
#pragma unroll
                for (int e = 0; e < 2; ++e) { const f32x4 g4 = *(const f32x4*)(p.ln1_g + col + 4 * e), b4 = *(const f32x4*)(p.ln1_b + col + 4 * e);
#pragma unroll
                    for (int q = 0; q < 4; ++q) { gg[j * 8 + e * 4 + q] = g4[q]; bb[j * 8 + e * 4 + q] = b4[q]; } }
            }
#pragma unroll 2
            for (int rr = 0; rr < 8; ++rr) {
                const int lr = w * 8 + rr, row = row0 + lr;
                float s1 = 0.f, s2 = 0.f;
                if (lane < 16) { const float* q = pst + ((size_t)row * 16 + lane) * 2; s1 = q[0]; s2 = q[1]; }
#pragma unroll
                for (int o = 1; o < 16; o <<= 1) { s1 += __shfl_xor(s1, o); s2 += __shfl_xor(s2, o); }
                s1 = __shfl(s1, 0); s2 = __shfl(s2, 0);
                const float mean = s1 * (1.f / D), var = fmaxf(s2 * (1.f / D) - mean * mean, 0.f), rstd = rsqrtf(var + 1e-5f);
#pragma unroll
                for (int j = 0; j < 2; ++j) {
                    const int ch = lane + 64 * j, col = ch * 8;
                    const u32x4 wv = *(const u32x4*)(Y1 + (size_t)row * D + col);
                    float y[8];
#pragma unroll
                    for (int e = 0; e < 4; ++e) { y[2 * e] = bflo(wv[e]); y[2 * e + 1] = bfhi(wv[e]); }
#pragma unroll
                    for (int e = 0; e < 8; ++e) y[e] = (y[e] - mean) * rstd * gg[j * 8 + e] + bb[j * 8 + e];
                    u32x4 o; o.x = cvtpk(y[0], y[1]); o.y = cvtpk(y[2], y[3]); o.z = cvtpk(y[4], y[5]); o.w = cvtpk(y[6], y[7]);
                    *(u32x4*)(H1 + (size_t)row * D + col) = o;
                    *(LAS u32x4*)(lds + lr * 2048 + ((ch ^ (lr & 15)) << 4)) = o;
                }
            }
        }
        __syncthreads();
        f32x16 acc0, acc1;
#pragma unroll
        for (int r = 0; r < 16; ++r) { acc0[r] = 0.f; acc1[r] = 0.f; }
        {
            const bf16_t* bp = WrT + (size_t)(w * 32 + r32) * D + hi * 8;
            const LAS unsigned char* a0 = lds + r32 * 2048, * a1 = lds + (32 + r32) * 2048;
            const int sx = r32 & 15;
#pragma unroll 1
            for (int kb = 0; kb < 64; kb += 8) {
                bf16x8 bf[8];
#pragma unroll
                for (int q = 0; q < 8; ++q) bf[q] = *(const bf16x8*)(bp + (kb + q) * 16);
#pragma unroll
                for (int q = 0; q < 8; ++q) {
                    const int ch = 2 * (kb + q) + hi;
                    const bf16x8 f0 = *(const LAS bf16x8*)(a0 + ((ch ^ sx) << 4)), f1 = *(const LAS bf16x8*)(a1 + ((ch ^ sx) << 4));
                    acc0 = __builtin_amdgcn_mfma_f32_32x32x16_bf16(bf[q], f0, acc0, 0, 0, 0);
                    acc1 = __builtin_amdgcn_mfma_f32_32x32x16_bf16(bf[q], f1, acc1, 0, 0, 0);
                }
            }
        }
        __syncthreads();
        if (c.tid < 256) ((LAS unsigned*)(lds + 65536))[c.tid] = 0u;
#pragma unroll
        for (int g = 0; g < 4; ++g) {
            *(LAS f32x4*)(lds + (size_t)r32 * 1024 + (w * 32 + 8 * g + 4 * hi) * 4) = (f32x4){acc0[4 * g], acc0[4 * g + 1], acc0[4 * g + 2], acc0[4 * g + 3]};
            *(LAS f32x4*)(lds + (size_t)(32 + r32) * 1024 + (w * 32 + 8 * g + 4 * hi) * 4) = (f32x4){acc1[4 * g], acc1[4 * g + 1], acc1[4 * g + 2], acc1[4 * g + 3]};
        }
        __syncthreads();
        LAS unsigned* hist = (LAS unsigned*)(lds + 65536); LAS unsigned* basev = hist + 256; LAS int* asgE = (LAS int*)(basev + 256); LAS int* asgP = asgE + 512; LAS float* asgG = (LAS float*)(asgP + 512);
#pragma unroll 1
        for (int rr = 0; rr < 8; ++rr) {
            const int lr = w * 8 + rr;
            const f32x4 lg = *(const LAS f32x4*)(lds + lr * 1024 + lane * 16);
            int me; float gate;
            route_select(lg, bias, lane, me, gate);
            if (lane < 8) {
                const unsigned lp = __hip_atomic_fetch_add(hist + me, 1u, __ATOMIC_RELAXED, __HIP_MEMORY_SCOPE_WORKGROUP);
                asgE[lr * 8 + lane] = me; asgP[lr * 8 + lane] = (int)lp; asgG[lr * 8 + lane] = gate;
            }
        }
        __syncthreads();
        if (c.tid < 256) { const unsigned hc = hist[c.tid]; basev[c.tid] = hc ? atomicAdd(cnt + c.tid, hc) : 0u; }
        __syncthreads();
        {
            const int i = c.tid, e = asgE[i];
            const unsigned pos = basev[e] + (unsigned)asgP[i];
            ((u32x2*)(ws + WS_LAID))[(size_t)e * CAP + pos] = (u32x2){(unsigned)((row0 + (i >> 3)) * 8 + (i & 7)), __float_as_uint(asgG[i])};
        }
    }
}

struct MoeTab { LAS int* tstart; LAS int* roff; LAS int* tok; LAS float* gate; };
__device__ __forceinline__ MoeTab moe_tab_build(const Params& p, const Ctx& c) {
    MoeTab T; T.tstart = (LAS int*)(c.lds + LDS_MISC); T.roff = T.tstart + 260; T.tok = T.roff + 260; T.gate = (LAS float*)(T.tok + 128);
    const unsigned* cnt = (const unsigned*)(p.ws + WS_CTL + CT_CNT);
    __syncthreads();
    if (c.tid < 64) {
        int cv[4], tv[4]; int ls = 0, lt = 0;
#pragma unroll
        for (int i = 0; i < 4; ++i) { cv[i] = (int)cnt[c.tid * 4 + i]; tv[i] = (cv[i] + 127) >> 7; ls += cv[i]; lt += tv[i]; }
        int ps = ls, pt = lt;
#pragma unroll
        for (int o = 1; o < 64; o <<= 1) { const int a = __shfl_up(ps, o), b = __shfl_up(pt, o); if (c.tid >= o) { ps += a; pt += b; } }
        int es = ps - ls, et = pt - lt;
#pragma unroll
        for (int i = 0; i < 4; ++i) { T.roff[c.tid * 4 + i] = es; T.tstart[c.tid * 4 + i] = et; es += cv[i]; et += tv[i]; }
        if (c.tid == 63) { T.roff[256] = es; T.tstart[256] = et; }
    }
    __syncthreads();
    return T;
}
__device__ __forceinline__ int moe_find(const MoeTab& T, int g) {
    int lo = 0, hi = 255;
    while (lo < hi) { const int mid = (lo + hi + 1) >> 1; if (T.tstart[mid] <= g) lo = mid; else hi = mid - 1; }
    return lo;
}

__device__ __forceinline__ void phase6(const Params& p, const Ctx& c) {
    unsigned char* ws = p.ws;
    const bf16_t* H1 = (const bf16_t*)(ws + WS_H1); bf16_t* HID = (bf16_t*)(ws + WS_HID);
    const unsigned* laid = (const unsigned*)(ws + WS_LAID);
    const unsigned* cnt = (const unsigned*)(ws + WS_CTL + CT_CNT);
    const int lane = c.lane, wr = c.wave >> 2, wc = c.wave & 3, fr = lane & 15, fq = lane >> 4;
    const MoeTab T = moe_tab_build(p, c);
    const int tmt = T.tstart[256], NU = (tmt + 128) * 2;
    for (int u = c.vcu; u < NU; u += c.G) {
        const int g = u >> 1, nt = u & 1;
        int e, mt, nrows; size_t hbase;
        __syncthreads();
        if (g < tmt) {
            e = moe_find(T, g); mt = g - T.tstart[e]; nrows = min(128, (int)cnt[e] - mt * 128); hbase = (size_t)T.roff[e] + mt * 128;
            if (c.tid < 128) T.tok[c.tid] = (int)(laid[(size_t)e * CAP + mt * 128 + min(c.tid, nrows - 1)] >> 3);
        } else {
            e = NEXP; mt = g - tmt; nrows = 128; hbase = (size_t)NTOK * 8 + mt * 128;
            if (c.tid < 128) T.tok[c.tid] = mt * 128 + c.tid;
        }
        __syncthreads();
        f32x4 acc[4][4]; acc_zero(acc);
        auto rp = [&](int r) { return H1 + (size_t)T.tok[r] * D; };
        const bf16_t* Bt = (e < NEXP ? (const bf16_t*)(ws + WS_WGU) + (size_t)e * 512 * D : (const bf16_t*)(ws + WS_WSGU)) + (size_t)nt * 256 * D;
        gemm_kloop(acc, c, rp, Bt, D, D);
#pragma unroll
        for (int mi = 0; mi < 4; ++mi) {
            const int r = wr * 64 + mi * 16 + fr;
            if (r >= nrows) continue;
#pragma unroll
            for (int np = 0; np < 2; ++np) {
                const f32x4 gt = acc[mi][2 * np], up = acc[mi][2 * np + 1];
                f32x4 hv;
#pragma unroll
                for (int j = 0; j < 4; ++j) hv[j] = gt[j] / (1.f + __expf(-gt[j])) * up[j];
                store_bf4(HID + (hbase + r) * DEXP + nt * 128 + wc * 32 + np * 16 + fq * 4, hv);
            }
        }
    }
}
__device__ __forceinline__ void phase7(const Params& p, const Ctx& c) {
    unsigned char* ws = p.ws;
    const bf16_t* HID = (const bf16_t*)(ws + WS_HID); bf16_t* Y = (bf16_t*)(ws + WS_Y);
    const unsigned* laid = (const unsigned*)(ws + WS_LAID); const float* lgate = (const float*)(ws + WS_LGATE);
    const unsigned* cnt = (const unsigned*)(ws + WS_CTL + CT_CNT);
    const int lane = c.lane, wr = c.wave >> 2, wc = c.wave & 3, fr = lane & 15, fq = lane >> 4;
    const MoeTab T = moe_tab_build(p, c);
    const int tmt = T.tstart[256], NU = (tmt + 128) * 4;
    for (int u = c.vcu; u < NU; u += c.G) {
        const int g = u >> 2, nt = u & 3;
        int e, mt, nrows; size_t hbase;
        __syncthreads();
        if (g < tmt) {
            e = moe_find(T, g); mt = g - T.tstart[e]; nrows = min(128, (int)cnt[e] - mt * 128); hbase = (size_t)T.roff[e] + mt * 128;
            if (c.tid < 128) {
                const int rr = min(c.tid, nrows - 1);
                const unsigned aid = laid[(size_t)e * CAP + mt * 128 + rr];
                T.tok[c.tid] = (int)((aid >> 3) * 9 + (aid & 7)); T.gate[c.tid] = lgate[(size_t)e * CAP + mt * 128 + rr];
            }
        } else {
            e = NEXP; mt = g - tmt; nrows = 128; hbase = (size_t)NTOK * 8 + mt * 128;
            if (c.tid < 128) { T.tok[c.tid] = (mt * 128 + c.tid) * 9 + 8; T.gate[c.tid] = 1.f; }
        }
        __syncthreads();
        f32x4 acc[4][4]; acc_zero(acc);
        auto rp = [&](int r) { return HID + (hbase + min(r, nrows - 1)) * DEXP; };
        const bf16_t* Bt = (e < NEXP ? (const bf16_t*)(ws + WS_WD) + (size_t)e * D * DEXP : (const bf16_t*)(ws + WS_WSD)) + (size_t)nt * 256 * DEXP;
        gemm_kloop(acc, c, rp, Bt, DEXP, DEXP);
#pragma unroll
        for (int mi = 0; mi < 4; ++mi) {
            const int r = wr * 64 + mi * 16 + fr;
            if (r >= nrows) continue;
            const float gt = T.gate[r]; const size_t yrow = (size_t)T.tok[r];
#pragma unroll
            for (int ni = 0; ni < 4; ++ni) store_bf4(Y + yrow * D + nt * 256 + wc * 64 + ni * 16 + fq * 4, acc[mi][ni] * gt);
        }
    }
}

__device__ __forceinline__ int moe_find_l(const LAS int* tstart, int g) {
    int lo = 0, hi = 255;
    while (lo < hi) { const int mid = (lo + hi + 1) >> 1; if (tstart[mid] <= g) lo = mid; else hi = mid - 1; }
    return lo;
}

constexpr int MOE_A = 0, MOE_B = 32768, MOE_H0 = 98304, MOE_H1 = 0, MOE_MISC = 131072;
struct MoeUnit { const float* wg; const float* wu; const float* wd; int nrows; int par; };

__device__ __forceinline__ void phase_moe(const Params& p, const Ctx& c) {
    unsigned char* ws = p.ws;
    const bf16_t* H1 = (const bf16_t*)(ws + WS_H1); bf16_t* Y = (bf16_t*)(ws + WS_Y);
    const unsigned* laid = (const unsigned*)(ws + WS_LAID); const float* lgate = (const float*)(ws + WS_LGATE);
    const unsigned* cnt = (const unsigned*)(ws + WS_CTL + CT_CNT);
    const int tid = c.tid, lane = c.lane, wr = c.wave >> 2, wc = c.wave & 3, fr = lane & 15, fq = lane >> 4;
    LAS unsigned char* lds = c.lds;
    LAS int* tstart = (LAS int*)(lds + MOE_MISC); LAS int* cntl = tstart + 260;
    LAS int* tokT = cntl + 260; LAS int* yrowT = tokT + 256; LAS float* gateT = (LAS float*)(yrowT + 256);
    __syncthreads();
    if (tid < 64) {
        int cv[4], tv[4]; int lt = 0;
#pragma unroll
        for (int i = 0; i < 4; ++i) { cv[i] = (int)cnt[tid * 4 + i]; tv[i] = (cv[i] + 127) >> 7; lt += tv[i]; }
        int pt = lt;
#pragma unroll
        for (int o = 1; o < 64; o <<= 1) { const int b = __shfl_up(pt, o); if (tid >= o) pt += b; }
        int et = pt - lt;
#pragma unroll
        for (int i = 0; i < 4; ++i) { cntl[tid * 4 + i] = cv[i]; tstart[tid * 4 + i] = et; et += tv[i]; }
        if (tid == 63) tstart[256] = et;
    }
    __syncthreads();
    const int tmt = tstart[256], NU = tmt + 128;
    if (c.vcu >= NU) return;

    const int srow = tid >> 3, sch = tid & 7;
    const int soA = srow * 128 + ((sch ^ ((srow >> 1) & 7)) << 4);
    const int kk1 = tid >> 5, n4 = tid & 31;
    const int s1 = (kk1 & 3) | (((kk1 >> 3) & 1) << 2);
    const int soB1g = kk1 * 512 + (((2 * (n4 >> 2)) ^ s1) << 5) + (n4 & 3) * 8;
    const int soB1u = kk1 * 512 + (((2 * (n4 >> 2) + 1) ^ s1) << 5) + (n4 & 3) * 8;
    const int kk2 = tid >> 6, c4 = tid & 63;
    const int soB2e = kk2 * 512 + ((((c4 >> 2)) ^ (kk2 & 3)) << 5) + (c4 & 3) * 8;
    const int soB2o = kk2 * 512 + ((((c4 >> 2)) ^ ((kk2 & 3) | 4)) << 5) + (c4 & 3) * 8;
    const int sw0 = ((0 + fq) ^ ((fr >> 1) & 7)) << 4, sw1 = ((4 + fq) ^ ((fr >> 1) & 7)) << 4;
    const int aoff = (wr * 64 + fr) * 128;
    const int qp = fr >> 2, pp = fr & 3, sB = qp | ((fq & 1) << 2);
    const int brow = (8 * fq + qp) * 512 + pp * 8;
    int bblk[4];
#pragma unroll
    for (int ni = 0; ni < 4; ++ni) bblk[ni] = ((4 * wc + ni) ^ sB) << 5;
    const int hoff = (wr * 64 + fr) * 256;

    const unsigned lo1 = (unsigned)(kk1 * 256 + n4 * 4), lo2 = (unsigned)(kk2 * D + c4 * 4);
    u32x4 ra0, ra1; f32x4 rb[8];
    f32x4 acc[4][4];

#define M_LOAD1(U, nt, kt) do { \
        const int t0_ = tokT[(U).par * 128 + srow], t1_ = tokT[(U).par * 128 + srow + 64]; \
        ra0 = *(const u32x4*)(H1 + (size_t)t0_ * D + (kt) * 64 + sch * 8); ra1 = *(const u32x4*)(H1 + (size_t)t1_ * D + (kt) * 64 + sch * 8); \
        const float* g_ = (U).wg + ((kt) * 64 * 256 + (nt) * 128); const float* u_ = (U).wu + ((kt) * 64 * 256 + (nt) * 128); \
        _Pragma("unroll") for (int j = 0; j < 4; ++j) { rb[j] = *(const f32x4*)(g_ + j * 4096 + lo1); rb[4 + j] = *(const f32x4*)(u_ + j * 4096 + lo1); } } while (0)
#define M_STORE1(buf) do { LAS unsigned char* sa_ = lds + MOE_A + (buf) * 16384; LAS unsigned char* sb_ = lds + MOE_B + (buf) * 32768; \
        *(LAS u32x4*)(sa_ + soA) = ra0; *(LAS u32x4*)(sa_ + soA + 8192) = ra1; \
        _Pragma("unroll") for (int j = 0; j < 4; ++j) { \
            *(LAS u32x2*)(sb_ + soB1g + j * 8192) = (u32x2){cvtpk(rb[j][0], rb[j][1]), cvtpk(rb[j][2], rb[j][3])}; \
            *(LAS u32x2*)(sb_ + soB1u + j * 8192) = (u32x2){cvtpk(rb[4 + j][0], rb[4 + j][1]), cvtpk(rb[4 + j][2], rb[4 + j][3])}; } } while (0)
#define M_LOAD2(U, nt2, ksm) do { \
        const float* d_ = (U).wd + ((ksm) * 64 * D + (nt2) * 256); \
        _Pragma("unroll") for (int j = 0; j < 8; ++j) rb[j] = *(const f32x4*)(d_ + j * 8192 + lo2); } while (0)
#define M_STORE2(buf) do { LAS unsigned char* sb_ = lds + MOE_B + (buf) * 32768; \
        _Pragma("unroll") for (int j = 0; j < 8; ++j) \
            *(LAS u32x2*)(sb_ + ((j & 1) ? soB2o : soB2e) + j * 4096) = (u32x2){cvtpk(rb[j][0], rb[j][1]), cvtpk(rb[j][2], rb[j][3])}; } while (0)
#define M_BFRAG(dst, sbB, ks) do { _Pragma("unroll") for (int ni = 0; ni < 4; ++ni) { \
            const s16x4 lo_ = vtr((sbB) + brow + (ks) * 16384 + bblk[ni]), hi_ = vtr((sbB) + brow + (ks) * 16384 + 2048 + bblk[ni]); \
            dst[ni] = (bf16x8){lo_[0], lo_[1], lo_[2], lo_[3], hi_[0], hi_[1], hi_[2], hi_[3]}; } } while (0)
#define M_COMPUTE1(buf) do { const LAS unsigned char* sa_ = lds + MOE_A + (buf) * 16384; const LAS unsigned char* sbb_ = lds + MOE_B + (buf) * 32768; \
        _Pragma("unroll") for (int ks = 0; ks < 2; ++ks) { bf16x8 af[4], bfr[4]; \
            _Pragma("unroll") for (int mi = 0; mi < 4; ++mi) af[mi] = *(const LAS bf16x8*)(sa_ + aoff + mi * 2048 + (ks ? sw1 : sw0)); \
            M_BFRAG(bfr, sbb_, ks); \
            _Pragma("unroll") for (int mi = 0; mi < 4; ++mi) _Pragma("unroll") for (int ni = 0; ni < 4; ++ni) \
                acc[mi][ni] = __builtin_amdgcn_mfma_f32_16x16x32_bf16(bfr[ni], af[mi], acc[mi][ni], 0, 0, 0); } } while (0)
#define M_COMPUTE2(buf, ksm) do { const LAS unsigned char* sh_ = lds + (((ksm) >> 1) ? MOE_H1 : MOE_H0); const LAS unsigned char* sbb_ = lds + MOE_B + (buf) * 32768; \
        _Pragma("unroll") for (int ks = 0; ks < 2; ++ks) { bf16x8 af[4], bfr[4]; \
            _Pragma("unroll") for (int mi = 0; mi < 4; ++mi) af[mi] = *(const LAS bf16x8*)(sh_ + hoff + mi * 4096 + (((((ksm) & 1) * 8 + ks * 4 + fq) ^ fr) << 4)); \
            M_BFRAG(bfr, sbb_, ks); \
            _Pragma("unroll") for (int mi = 0; mi < 4; ++mi) _Pragma("unroll") for (int ni = 0; ni < 4; ++ni) \
                acc[mi][ni] = __builtin_amdgcn_mfma_f32_16x16x32_bf16(bfr[ni], af[mi], acc[mi][ni], 0, 0, 0); } } while (0)

    auto unit_make = [&](int u, int par, MoeUnit& U, int& e, int& mt) {
        if (u < tmt) { e = moe_find_l(tstart, u); mt = u - tstart[e]; U.nrows = min(128, cntl[e] - mt * 128);
            U.wg = p.w_gate + (size_t)e * D * DEXP; U.wu = p.w_up + (size_t)e * D * DEXP; U.wd = p.w_down + (size_t)e * D * DEXP; }
        else { e = NEXP; mt = u - tmt; U.nrows = 128; U.wg = p.ws_gate; U.wu = p.ws_up; U.wd = p.ws_down; }
        U.par = par;
    };
    auto unit_tables = [&](const MoeUnit& U, int e, int mt) {
        if (tid < 128) {
            int tok, yr; float gt;
            if (e < NEXP) { const int rr = min(tid, U.nrows - 1); const unsigned aid = laid[(size_t)e * CAP + mt * 128 + rr];
                tok = (int)(aid >> 3); yr = tok * 9 + (int)(aid & 7); gt = lgate[(size_t)e * CAP + mt * 128 + rr]; }
            else { tok = mt * 128 + tid; yr = tok * 9 + 8; gt = 1.f; }
            tokT[U.par * 128 + tid] = tok; yrowT[U.par * 128 + tid] = yr; gateT[U.par * 128 + tid] = gt;
        }
    };

    MoeUnit cur, nxt; int e_, mt_;
    unit_make(c.vcu, 0, cur, e_, mt_);
    unit_tables(cur, e_, mt_);
    __syncthreads();
    M_LOAD1(cur, 0, 0);
    M_STORE1(0);
    __syncthreads();
    for (int u = c.vcu, ui = 0; u < NU; u += c.G, ++ui) {
        const bool has_next = (u + c.G) < NU;
#pragma unroll 1
        for (int nt = 0; nt < 2; ++nt) {
            acc_zero(acc);
#pragma unroll 1
            for (int kt = 0; kt < 16; ++kt) {
                const bool last = (kt == 15);
                if (!last) M_LOAD1(cur, nt, kt + 1);
                else if (nt == 0) M_LOAD1(cur, 1, 0);
                else M_LOAD2(cur, 0, 2);
                M_COMPUTE1(kt & 1);
                if (!(last && nt == 1)) M_STORE1((kt + 1) & 1); else M_STORE2(0);
                __syncthreads();
            }
            {
                LAS unsigned char* hb = lds + (nt ? MOE_H1 : MOE_H0);
#pragma unroll
                for (int mi = 0; mi < 4; ++mi) {
                    const int r = wr * 64 + mi * 16 + fr;
#pragma unroll
                    for (int np = 0; np < 2; ++np) {
                        const f32x4 gt = acc[mi][2 * np], up = acc[mi][2 * np + 1];
                        float hv[4];
#pragma unroll
                        for (int j = 0; j < 4; ++j) hv[j] = gt[j] / (1.f + __expf(-gt[j])) * up[j];
                        const int chunk = wc * 4 + np * 2 + (fq >> 1);
                        *(LAS u32x2*)(hb + r * 256 + ((chunk ^ fr) << 4) + (fq & 1) * 8) = (u32x2){cvtpk(hv[0], hv[1]), cvtpk(hv[2], hv[3])};
                    }
                }
            }
            if (nt == 1) __syncthreads();
        }
#pragma unroll 1
        for (int nt2 = 0; nt2 < 4; ++nt2) {
            acc_zero(acc);
            if (nt2 == 0 && has_next) { unit_make(u + c.G, (ui + 1) & 1, nxt, e_, mt_); unit_tables(nxt, e_, mt_); }
#pragma unroll 1
            for (int kq = 0; kq < 4; ++kq) {
                const int ksm = kq ^ 2;
                const bool last = (kq == 3);
                if (!last) M_LOAD2(cur, nt2, (kq + 1) ^ 2);
                else if (nt2 < 3) M_LOAD2(cur, nt2 + 1, 2);
                else if (has_next) M_LOAD1(nxt, 0, 0);
                M_COMPUTE2(kq & 1, ksm);
                if (!(last && nt2 == 3)) M_STORE2((kq + 1) & 1); else if (has_next) M_STORE1(0);
                __syncthreads();
            }
#pragma unroll
            for (int mi = 0; mi < 4; ++mi) {
                const int r = wr * 64 + mi * 16 + fr;
                if (r < cur.nrows) {
                    const float gt = gateT[cur.par * 128 + r]; const size_t yrow = (size_t)yrowT[cur.par * 128 + r];
#pragma unroll
                    for (int ni = 0; ni < 4; ++ni) store_bf4(Y + yrow * D + nt2 * 256 + wc * 64 + ni * 16 + fq * 4, acc[mi][ni] * gt);
                }
            }
        }
        cur = nxt;
    }
#undef M_LOAD1
#undef M_STORE1
#undef M_LOAD2
#undef M_STORE2
#undef M_BFRAG
#undef M_COMPUTE1
#undef M_COMPUTE2
}


__device__ __forceinline__ void store_blk32_bf16(bf16_t* p, const f32x16& v, int hi, bool pred = true) {
#pragma unroll
    for (int pr = 0; pr < 2; ++pr) {
        unsigned ax = cvtpk(v[8 * pr + 0], v[8 * pr + 1]), ay = cvtpk(v[8 * pr + 2], v[8 * pr + 3]);
        unsigned bx = cvtpk(v[8 * pr + 4], v[8 * pr + 5]), by = cvtpk(v[8 * pr + 6], v[8 * pr + 7]);
        { auto r_ = __builtin_amdgcn_permlane32_swap(ax, bx, false, false); ax = r_[0]; bx = r_[1]; }
        { auto r_ = __builtin_amdgcn_permlane32_swap(ay, by, false, false); ay = r_[0]; by = r_[1]; }
        if (pred) *(u32x4*)(p + 16 * pr + (hi ? 8 : 0)) = (u32x4){ax, ay, bx, by};
    }
}

constexpr int G2_A = 0, G2_B = 65536, G2_MISC = 131072;
constexpr int G2_GATE = G2_MISC + 4096, G2_YROW = G2_GATE + 2048, G2_TAB = G2_YROW + 2048;
constexpr int BM_BF16T = 0, BM_F32 = 1, BM_F32_GU = 2;
struct G2Unit { const void* b0; const void* b1; int ldb; int nsteps; int nrows; int par; int i0, i1, i2; int kshift, bsub; };

#define G2_SGB(mask, n) __builtin_amdgcn_sched_group_barrier(mask, n, 0)
#define G2_MFMA_HALF(NMI, KM, kh) do { \
        __builtin_amdgcn_sched_barrier(0); \
        _Pragma("unroll") for (int kq = 0; kq < 2; ++kq) { const int k16_ = 2 * (kh) + kq; bf16x8 bfr[2]; \
            if (KM) { _Pragma("unroll") for (int ni = 0; ni < 2; ++ni) { const int bb_ = ((4 * wc + 2 * ni + bsel) ^ sB2) << 5; \
                const s16x4 lo_ = vtr(sbb_ + brow + k16_ * 8192 + bb_); const s16x4 hi_ = vtr(sbb_ + brow + k16_ * 8192 + 2048 + bb_); \
                bf16x8 t_; t_[0] = lo_[0]; t_[1] = lo_[1]; t_[2] = lo_[2]; t_[3] = lo_[3]; t_[4] = hi_[0]; t_[5] = hi_[1]; t_[6] = hi_[2]; t_[7] = hi_[3]; bfr[ni] = t_; } } \
            else { _Pragma("unroll") for (int ni = 0; ni < 2; ++ni) bfr[ni] = *(const LAS bf16x8*)(sbb_ + boffT + ni * 4096 + (((2 * k16_ + hi) ^ swx) << 4)); } \
            _Pragma("unroll") for (int mi = 0; mi < (NMI); ++mi) { \
                const bf16x8 af_ = *(const LAS bf16x8*)(sa_ + aoff + mi * 8192 + (((2 * k16_ + hi) ^ swx) << 4)); \
                _Pragma("unroll") for (int ni = 0; ni < 2; ++ni) acc[mi][ni] = __builtin_amdgcn_mfma_f32_32x32x16_bf16(bfr[ni], af_, acc[mi][ni], 0, 0, 0); } } \
        if (!(KM)) { _Pragma("unroll") for (int kq = 0; kq < 2; ++kq) { G2_SGB(0x100, 3); \
            _Pragma("unroll") for (int g = 0; g < (NMI) - 1; ++g) { G2_SGB(0x100, 1); G2_SGB(0x008, 2); } \
            G2_SGB(0x008, 2); } } \
        __builtin_amdgcn_sched_barrier(0); \
    } while (0)
#define G2_SEL(off) const int nst_ = st + (off); const bool wrap_ = nst_ >= cur.nsteps, usen_ = wrap_ && has_next; \
        const void* sb0_ = usen_ ? nxt.b0 : cur.b0; const void* sb1_ = usen_ ? nxt.b1 : cur.b1; const int spar_ = usen_ ? nxt.par : cur.par; \
        const int sk0_ = wrap_ ? (has_next ? nst_ - cur.nsteps : cur.nsteps - 1) : nst_; const int ldb_ = cur.ldb; (void)sb1_; \
        const int ssub_ = sk0_ >> cur.kshift, sk_ = sk0_ - (ssub_ << cur.kshift); const int sboff_ = ssub_ * cur.bsub; (void)sboff_

typedef __amdgpu_buffer_rsrc_t rsrc_t;
__device__ __forceinline__ rsrc_t make_rsrc(const void* p) {
    const unsigned long long a = (unsigned long long)(uintptr_t)p;
    const unsigned lo = __builtin_amdgcn_readfirstlane((unsigned)a), hi = __builtin_amdgcn_readfirstlane((unsigned)(a >> 32));
    return __builtin_amdgcn_make_buffer_rsrc((void*)(uintptr_t)(((unsigned long long)hi << 32) | lo), (short)0, 0x7fffffff, 0x00020000);
}
__device__ __forceinline__ u32x4 bload16(rsrc_t r, int voff, int soff) { return __builtin_bit_cast(u32x4, __builtin_amdgcn_raw_buffer_load_b128(r, voff, soff, 0)); }
template <int BMODE, bool FULL, class Sched, class Epi>
__device__ __forceinline__ void gemm256_stream(const Ctx& c, Sched& S, const Epi& E) {
    const int tid = c.tid, lane = c.lane, wr = c.wave >> 2, wc = c.wave & 3, r32 = lane & 31, hi = lane >> 5;
    LAS unsigned char* lds = c.lds;
    const LAS unsigned* rowT = (const LAS unsigned*)(lds + G2_MISC);
    const rsrc_t rsA = make_rsrc(S.abase());
    const int srow = tid >> 3, sch = tid & 7;
    const int soA = srow * 128 + ((sch ^ ((srow >> 1) & 7)) << 4);
    const int kk1 = tid >> 5, n4 = tid & 31;
    const int soB1g = kk1 * 512 + (((2 * (n4 >> 2)) ^ (2 * (kk1 & 3))) << 5) + (n4 & 3) * 8;
    const int soB1u = kk1 * 512 + (((2 * (n4 >> 2) + 1) ^ (2 * (kk1 & 3))) << 5) + (n4 & 3) * 8;
    const int kk2 = tid >> 6, c4 = tid & 63;
    const int soB2 = kk2 * 512 + ((((c4 >> 2)) ^ (2 * (kk2 & 3))) << 5) + (c4 & 3) * 8;
    const int swx = (r32 >> 1) & 7;
    const int aoff = (32 * wr + r32) * 128;
    const int boffT = (wc * 64 + r32) * 128;
    const int qp = (lane & 15) >> 2, pp = lane & 3, bsel = (lane >> 4) & 1, sB2 = 2 * qp;
    const int brow = (8 * hi + qp) * 512 + pp * 8;
    (void)boffT; (void)brow; (void)sB2; (void)bsel; (void)soB1g; (void)soB1u; (void)soB2;
    u32x4 ra[4]; u32x4 rbh[4]; f32x4 rb[8];
    f32x16 acc[4][2];
#define G1_LOAD(b0, b1, par, kst, ldb) do { \
        const LAS unsigned* rt_ = rowT + (par) * 256 + srow; \
        const int ksoff_ = __builtin_amdgcn_readfirstlane((kst) * 128); \
        _Pragma("unroll") for (int j = 0; j < 4; ++j) ra[j] = bload16(rsA, (int)rt_[64 * j] + sch * 16, ksoff_); \
        const rsrc_t rb0_ = make_rsrc(b0); \
        if (BMODE == BM_BF16T) { const int so_ = __builtin_amdgcn_readfirstlane((kst) * 128), js_ = __builtin_amdgcn_readfirstlane(128 * (ldb)); \
            _Pragma("unroll") for (int j = 0; j < 4; ++j) rbh[j] = bload16(rb0_, voB, so_ + j * js_); } \
        else if (BMODE == BM_F32) { const int so_ = __builtin_amdgcn_readfirstlane((kst) * 256 * (ldb)), js_ = __builtin_amdgcn_readfirstlane(32 * (ldb)); \
            _Pragma("unroll") for (int j = 0; j < 8; ++j) rb[j] = __builtin_bit_cast(f32x4, bload16(rb0_, voB, so_ + j * js_)); } \
        else { const rsrc_t rb1_ = make_rsrc(b1); const int so_ = __builtin_amdgcn_readfirstlane((kst) * 256 * (ldb)), js_ = __builtin_amdgcn_readfirstlane(64 * (ldb)); \
            _Pragma("unroll") for (int j = 0; j < 4; ++j) { rb[j] = __builtin_bit_cast(f32x4, bload16(rb0_, voB, so_ + j * js_)); rb[4 + j] = __builtin_bit_cast(f32x4, bload16(rb1_, voB, so_ + j * js_)); } } \
    } while (0)
#define G1_STORE(buf) do { LAS unsigned char* sa_ = lds + G2_A + (buf) * 32768; LAS unsigned char* sb_ = lds + G2_B + (buf) * 32768; \
        _Pragma("unroll") for (int j = 0; j < 4; ++j) *(LAS u32x4*)(sa_ + soA + j * 8192) = ra[j]; \
        if (BMODE == BM_BF16T) { _Pragma("unroll") for (int j = 0; j < 4; ++j) *(LAS u32x4*)(sb_ + soA + j * 8192) = rbh[j]; } \
        else if (BMODE == BM_F32) { _Pragma("unroll") for (int j = 0; j < 8; ++j) \
            *(LAS u32x2*)(sb_ + soB2 + j * 4096) = (u32x2){cvtpk(rb[j][0], rb[j][1]), cvtpk(rb[j][2], rb[j][3])}; } \
        else { _Pragma("unroll") for (int j = 0; j < 4; ++j) { \
            *(LAS u32x2*)(sb_ + soB1g + j * 8192) = (u32x2){cvtpk(rb[j][0], rb[j][1]), cvtpk(rb[j][2], rb[j][3])}; \
            *(LAS u32x2*)(sb_ + soB1u + j * 8192) = (u32x2){cvtpk(rb[4 + j][0], rb[4 + j][1]), cvtpk(rb[4 + j][2], rb[4 + j][3])}; } } \
    } while (0)
    G2Unit cur, nxt;
    if (!S.next(cur, 0)) return;
    nxt = cur;
    const int voB = BMODE == BM_BF16T ? (srow * cur.ldb + sch * 8) * 2 : BMODE == BM_F32 ? (kk2 * cur.ldb + c4 * 4) * 4 : (kk1 * cur.ldb + n4 * 4) * 4;
    __syncthreads();
    G1_LOAD(cur.b0, cur.b1, cur.par, 0, cur.ldb);
    G1_STORE(0);
    G1_LOAD(cur.b0, cur.b1, cur.par, 1, cur.ldb);
    __syncthreads();
    int gs = 0;
    bool has_cur = true;
    while (has_cur) {
#pragma unroll
        for (int a = 0; a < 4; ++a)
#pragma unroll
            for (int b = 0; b < 2; ++b)
#pragma unroll
                for (int r = 0; r < 16; ++r) acc[a][b][r] = 0.f;
        const int nb = (cur.nrows + 31) >> 5, nmi = (nb - wr + 1) >> 1;
        bool has_next = false;
#define G1_UNIT_LOOP(NMI) do { _Pragma("unroll 1") for (int st = 0; st < cur.nsteps; ++st) { \
            if (st == 1) has_next = S.next(nxt, cur.par ^ 1);     \
            if (st == 0) S.issue(); \
            { const LAS unsigned char* sa_ = lds + G2_A + (gs & 1) * 32768; const LAS unsigned char* sbb_ = lds + G2_B + (gs & 1) * 32768; \
              G2_MFMA_HALF(NMI, BMODE != BM_BF16T, 0); \
              G1_STORE((gs + 1) & 1);                             \
              __builtin_amdgcn_sched_barrier(0); \
              { G2_SEL(2); G1_LOAD((BMODE == BM_F32 ? (const void*)((const float*)sb0_ + sboff_) : sb0_), sb1_, spar_, sk_, ldb_); }     \
              G2_MFMA_HALF(NMI, BMODE != BM_BF16T, 1); } \
            if (st == 0) S.commit(); \
            __syncthreads(); \
            ++gs; \
            if (Epi::HAS_MID) E.mid(acc, cur, st, nmi, wr, r32); } } while (0)
        if (FULL || nmi >= 4) G1_UNIT_LOOP(4); else if (nmi == 3) G1_UNIT_LOOP(3); else if (nmi == 2) G1_UNIT_LOOP(2); else G1_UNIT_LOOP(1);
#undef G1_UNIT_LOOP
        E(acc, cur, nmi, wr, wc, r32, hi);
        cur = nxt; has_cur = has_next;
    }
#undef G1_LOAD
#undef G1_STORE
}

struct MoeSched2 {
    const Params& p; const Ctx& c; int NT; bool isB; int tru, NU, i;
    LAS int* tstart; LAS int* roff; LAS int* cntl; LAS int* rpuT; LAS int* qslot; unsigned* qctr; unsigned pend;
    __device__ __forceinline__ const void* abase() const { return isB ? p.ws + WS_HID : p.ws + WS_H1; }
    __device__ __forceinline__ void issue() { if (c.tid == 0) pend = __hip_atomic_fetch_add(qctr, 1u, __ATOMIC_RELAXED, __HIP_MEMORY_SCOPE_AGENT); }
    __device__ __forceinline__ void commit() { if (c.tid == 0) qslot[0] = (int)(32u + pend); }
    __device__ __forceinline__ MoeSched2(const Params& p_, const Ctx& c_, int NT_, bool isB_) : p(p_), c(c_), NT(NT_), isB(isB_), i(0) {
        tstart = (LAS int*)(c.lds + G2_TAB); roff = tstart + 260; cntl = roff + 260; rpuT = cntl + 260; qslot = rpuT + 260; pend = 0;
        qctr = (unsigned*)(p.ws + WS_CTL + CT_Q) + (isB_ ? 8 * 64 : 0) + (c.vcu >> 5) * 64;
        const unsigned* cnt = (const unsigned*)(p.ws + WS_CTL + CT_CNT);
        __syncthreads();
        if (c.tid < 64) {
            int cv[4], tv[4], rp[4]; int ls = 0, lt = 0;
#pragma unroll
            for (int k = 0; k < 4; ++k) { cv[k] = (int)cnt[c.tid * 4 + k]; tv[k] = (cv[k] + 255) >> 8; rp[k] = tv[k] ? ((((cv[k] + tv[k] - 1) / tv[k]) + 31) & ~31) : 0; ls += cv[k]; lt += tv[k]; }
            int ps = ls, pt = lt;
#pragma unroll
            for (int o = 1; o < 64; o <<= 1) { const int a = __shfl_up(ps, o), b = __shfl_up(pt, o); if (c.tid >= o) { ps += a; pt += b; } }
            int es = ps - ls, et = pt - lt;
#pragma unroll
            for (int k = 0; k < 4; ++k) { cntl[c.tid * 4 + k] = cv[k]; rpuT[c.tid * 4 + k] = rp[k]; roff[c.tid * 4 + k] = es; tstart[c.tid * 4 + k] = et; es += cv[k]; et += tv[k]; }
            if (c.tid == 63) { roff[256] = es; tstart[256] = et; }
        }
        __syncthreads();
        tru = tstart[256]; NU = (tru + 64) * NT;
    }
    __device__ __forceinline__ bool next(G2Unit& U, int par) {
        int tid_ = c.tid; asm volatile("" : "+v"(tid_));
        const int NUx = (NU + 7) >> 3, xg = c.vcu >> 5, pos = (i == 0) ? (c.vcu & 31) : qslot[0]; ++i;
        const int idx = xg * NUx + pos;
        if (pos >= NUx || idx >= NU) return false;
        int e, r0, nrows, nt; size_t hbase, lbase = 0;
        if (idx < tru * NT) { e = __builtin_amdgcn_readfirstlane(moe_find_l(tstart, idx / NT)); const int ts = __builtin_amdgcn_readfirstlane(tstart[e]), nu = __builtin_amdgcn_readfirstlane(tstart[e + 1]) - ts, loc = __builtin_amdgcn_readfirstlane(idx) - ts * NT, rpu = __builtin_amdgcn_readfirstlane(rpuT[e]);
            nt = (nu == 1) ? loc : (nu == 2) ? (loc >> 1) : loc / nu; const int ui = loc - nt * nu;
            r0 = ui * rpu; nrows = min(rpu, cntl[e] - r0); hbase = (size_t)roff[e] + r0; lbase = (size_t)e * CAP + r0; }
        else { const int loc = idx - tru * NT; e = NEXP; nt = loc >> 6; r0 = (loc & 63) * 256; nrows = 256; hbase = (size_t)NTOK * 8 + r0; }
        U.nrows = nrows; U.par = par; U.i0 = (int)hbase; U.i1 = nt; U.i2 = 0; U.kshift = 30; U.bsub = 0;
        const unsigned* laid = (const unsigned*)(p.ws + WS_LAID); const float* lgate = (const float*)(p.ws + WS_LGATE);
        LAS unsigned* rowT = (LAS unsigned*)(c.lds + G2_MISC) + par * 256;
        if (!isB) {
            U.b0 = (e < NEXP ? p.w_gate + (size_t)e * D * DEXP : p.ws_gate) + nt * 128; U.b1 = (e < NEXP ? p.w_up + (size_t)e * D * DEXP : p.ws_up) + nt * 128;
            U.ldb = DEXP; U.nsteps = D / 64;
            if (tid_ < 256) {
                const int rr = min(tid_, nrows - 1);
                const int tok = e < NEXP ? (int)(((const u32x2*)laid)[lbase + rr].x >> 3) : r0 + rr;
                rowT[tid_] = (unsigned)tok * (D * 2);
            }
        } else {
            U.b0 = (e < NEXP ? p.w_down + (size_t)e * DEXP * D : p.ws_down) + nt * 256; U.b1 = nullptr;
            U.ldb = D; U.nsteps = DEXP / 64;
            if (tid_ < 256) {
                const int rr = min(tid_, nrows - 1);
                rowT[tid_] = (unsigned)(hbase + rr) * (DEXP * 2);
                int yr; float gt;
                if (e < NEXP) { const u32x2 le = ((const u32x2*)laid)[lbase + rr]; yr = (int)((le.x >> 3) * 9 + (le.x & 7)); gt = __uint_as_float(le.y); }
                else { yr = (r0 + rr) * 9 + 8; gt = 1.f; }
                ((LAS float*)(c.lds + G2_GATE))[par * 256 + tid_] = gt; ((LAS int*)(c.lds + G2_YROW))[par * 256 + tid_] = yr;
            }
        }
        return true;
    }
};
struct EpiMoeA {
    static constexpr bool HAS_MID = false, HAS_SUB = false;
    bf16_t* HID;
    __device__ __forceinline__ void mid(f32x16 (&)[4][2], const G2Unit&, int, int, int, int) const {}
    __device__ __forceinline__ void operator()(f32x16 (&acc)[4][2], const G2Unit& U, int nmi, int wr, int wc, int r32, int hi) const {
        asm volatile("" : "+v"(r32), "+v"(hi));
#pragma unroll
        for (int mi = 0; mi < 4; ++mi) {
            if (mi < nmi) {
                const int r = 64 * mi + 32 * wr + r32;
#pragma unroll
                for (int ni = 0; ni < 2; ++ni) {
                    float hv[8];
#pragma unroll
                    for (int q = 0; q < 8; ++q) { const float gt = acc[mi][ni][q], up = acc[mi][ni][q + 8]; hv[q] = gt * __builtin_amdgcn_rcpf(1.f + __builtin_amdgcn_exp2f(-1.4426950408889634f * gt)) * up; }
                    unsigned ax = cvtpk(hv[0], hv[1]), ay = cvtpk(hv[2], hv[3]), bx = cvtpk(hv[4], hv[5]), by = cvtpk(hv[6], hv[7]);
                    { auto r_ = __builtin_amdgcn_permlane32_swap(ax, bx, false, false); ax = r_[0]; bx = r_[1]; }
                    { auto r_ = __builtin_amdgcn_permlane32_swap(ay, by, false, false); ay = r_[0]; by = r_[1]; }
                    if (r < U.nrows) *(u32x4*)(HID + ((size_t)U.i0 + r) * DEXP + U.i1 * 128 + (2 * wc + ni) * 16 + (hi ? 8 : 0)) = (u32x4){ax, ay, bx, by};
                }
            }
        }
    }
};
constexpr float Y8_SCALE = 64.f;
struct EpiMoeB {
    static constexpr bool HAS_MID = false, HAS_SUB = false;
    unsigned char* Y8; const LAS float* gateT; const LAS int* yrowT;
    __device__ __forceinline__ void mid(f32x16 (&)[4][2], const G2Unit&, int, int, int, int) const {}
    __device__ __forceinline__ void operator()(f32x16 (&acc)[4][2], const G2Unit& U, int nmi, int wr, int wc, int r32, int hi) const {
        asm volatile("" : "+v"(r32), "+v"(hi));
#pragma unroll
        for (int mi = 0; mi < 4; ++mi) {
            if (mi < nmi) {
                const int r = 64 * mi + 32 * wr + r32;
                const float gt = gateT[U.par * 256 + r] * Y8_SCALE; const size_t yrow = (size_t)yrowT[U.par * 256 + r];
#pragma unroll
                for (int ni = 0; ni < 2; ++ni) {
                    unsigned d[4];
#pragma unroll
                    for (int g = 0; g < 4; ++g) {
                        int wv = __builtin_amdgcn_cvt_pk_fp8_f32(acc[mi][ni][4 * g] * gt, acc[mi][ni][4 * g + 1] * gt, 0, false);
                        wv = __builtin_amdgcn_cvt_pk_fp8_f32(acc[mi][ni][4 * g + 2] * gt, acc[mi][ni][4 * g + 3] * gt, wv, true);
                        d[g] = (unsigned)wv;
                    }
                    { auto r_ = __builtin_amdgcn_permlane32_swap(d[0], d[1], false, false); d[0] = r_[0]; d[1] = r_[1]; }
                    { auto r_ = __builtin_amdgcn_permlane32_swap(d[2], d[3], false, false); d[2] = r_[0]; d[3] = r_[1]; }
                    { auto r_ = __builtin_amdgcn_permlane32_swap(d[0], d[2], false, false); d[0] = r_[0]; d[2] = r_[1]; }
                    { auto r_ = __builtin_amdgcn_permlane32_swap(d[1], d[3], false, false); d[1] = r_[0]; d[3] = r_[1]; }
                    if (r < U.nrows) *(u32x4*)(Y8 + yrow * D + U.i1 * 256 + wc * 64 + ni * 32 + (hi ? 16 : 0)) = (u32x4){d[0], d[1], d[2], d[3]};
                }
            }
        }
    }
};
__device__ __forceinline__ void phase_moeA(const Params& p, const Ctx& c) {
    MoeSched2 S(p, c, 2, false);
    EpiMoeA E{(bf16_t*)(p.ws + WS_HID)};
    gemm256_stream<BM_F32_GU, false>(c, S, E);
}
__device__ __forceinline__ void phase_moeB(const Params& p, const Ctx& c) {
    MoeSched2 S(p, c, 4, true);
    EpiMoeB E{(unsigned char*)(p.ws + WS_Y), (const LAS float*)(c.lds + G2_GATE), (const LAS int*)(c.lds + G2_YROW)};
    gemm256_stream<BM_F32, false>(c, S, E);
}


struct Sched1 {
    const Params& p; const Ctx& c; int i;
    __device__ __forceinline__ const void* abase() const { return p.ws + WS_H0; }
    __device__ __forceinline__ void issue() {}
    __device__ __forceinline__ void commit() {}
    __device__ __forceinline__ bool next(G2Unit& U, int par) {
        int mt, nt, row0, nrows;
        if (i < 2) { const int idx = c.vcu + 256 * i; mt = idx / 9; nt = idx - mt * 9; row0 = mt * 256; nrows = 256; }
        else if (i == 2 && c.vcu < 137) {
            if (c.vcu < 128) { const int idx = 512 + (c.vcu >> 1); mt = idx / 9; nt = idx - mt * 9; row0 = mt * 256 + (c.vcu & 1) * 128; nrows = 128; }
            else { mt = 64; nt = c.vcu - 128; row0 = NTOK; nrows = NMETA; }
        } else return false;
        ++i;
        U.b0 = (const bf16_t*)(p.ws + WS_WIN) + (size_t)nt * 256 * D; U.b1 = nullptr; U.ldb = D; U.nsteps = D / 64; U.nrows = nrows; U.par = par; U.i0 = row0; U.i1 = nt; U.i2 = 0; U.kshift = 30; U.bsub = 0;
        if (c.tid < 256) ((LAS unsigned*)(c.lds + G2_MISC))[par * 256 + c.tid] = (unsigned)(row0 + min(c.tid, nrows - 1)) * (D * 2);
        return true;
    }
};
struct Epi1 {
    static constexpr bool HAS_MID = false, HAS_SUB = false;
    bf16_t* Z; float* psq;
    __device__ __forceinline__ void mid(f32x16 (&)[4][2], const G2Unit&, int, int, int, int) const {}
    __device__ __forceinline__ void operator()(f32x16 (&acc)[4][2], const G2Unit& U, int nmi, int wr, int wc, int r32, int hi) const {
        asm volatile("" : "+v"(r32), "+v"(hi));
        const int s0 = U.i1 * 256 + wc * 64;
#pragma unroll
        for (int mi = 0; mi < 4; ++mi) {
            if (mi < nmi) {
                const int r = 64 * mi + 32 * wr + r32, row = U.i0 + min(r, U.nrows - 1);
                float ss = 0.f;
#pragma unroll
                for (int ni = 0; ni < 2; ++ni) {
                    store_blk32_bf16(Z + (size_t)row * ZC + s0 + ni * 32, acc[mi][ni], hi, r < U.nrows);
#pragma unroll
                    for (int q = 0; q < 16; ++q) ss += acc[mi][ni][q] * acc[mi][ni][q];
                }
                if (s0 < ZKPE) {
                    ss += __shfl_xor(ss, 32);
                    if (hi == 0 && r < U.nrows) psq[(size_t)row * 16 + (s0 >> 6)] = ss;
                }
            }
        }
    }
};
__device__ __forceinline__ void phase1_g2(const Params& p, const Ctx& c) {
    Sched1 S{p, c, 0};
    Epi1 E{(bf16_t*)(p.ws + WS_Z), (float*)(p.ws + WS_PSQ)};
    gemm256_stream<BM_BF16T, false>(c, S, E);
}

struct Sched4 {
    const Params& p; const Ctx& c; int i;
    __device__ __forceinline__ const void* abase() const { return p.ws + WS_ATT; }
    __device__ __forceinline__ void issue() {}
    __device__ __forceinline__ void commit() {}
    __device__ __forceinline__ bool next(G2Unit& U, int par) {
        const int idx = c.vcu + i * c.G; ++i;
        if (idx >= 256) return false;
        const int mt = idx >> 2, nt = idx & 3, row0 = mt * 256;
        U.b0 = (const bf16_t*)(p.ws + WS_WO) + (size_t)nt * 256 * D; U.b1 = nullptr; U.ldb = D; U.nsteps = D / 64; U.nrows = 256; U.par = par; U.i0 = row0; U.i1 = nt; U.i2 = 0; U.kshift = 30; U.bsub = 0;
        if (c.tid < 256) {
            const int row = row0 + c.tid;
            ((LAS unsigned*)(c.lds + G2_MISC))[par * 256 + c.tid] = (unsigned)row * (D * 2);
            const float* patt = (const float*)(p.ws + WS_PATT);
            const f32x4 pa = *(const f32x4*)(patt + (size_t)row * 8), pb = *(const f32x4*)(patt + (size_t)row * 8 + 4);
            const float ra = rsqrtf((((pa[0] + pa[1]) + (pa[2] + pa[3])) + ((pb[0] + pb[1]) + (pb[2] + pb[3]))) * (1.f / 512) + 1e-6f);
            const float rc = rsqrtf(((const float*)(p.ws + WS_SSQC))[row] * (1.f / 512) + 1e-6f);
            ((LAS float*)(c.lds + G2_GATE))[par * 256 + c.tid] = ra / rc; ((LAS float*)(c.lds + G2_YROW))[par * 256 + c.tid] = rc;
        }
        return true;
    }
};
struct Epi4 {
    static constexpr bool HAS_MID = true, HAS_SUB = false;
    const LAS float* fT; const LAS float* rcT; const bf16_t* H0; bf16_t* Y1; float* pst;
    __device__ __forceinline__ void mid(f32x16 (&acc)[4][2], const G2Unit& U, int st, int nmi, int wr, int r32) const {
        if (st != 7) return;
#pragma unroll
        for (int mi = 0; mi < 4; ++mi) {
            const float f = fT[U.par * 256 + 64 * mi + 32 * wr + r32];
#pragma unroll
            for (int ni = 0; ni < 2; ++ni)
#pragma unroll
                for (int q = 0; q < 16; ++q) acc[mi][ni][q] *= f;
        }
    }
    __device__ __forceinline__ void operator()(f32x16 (&acc)[4][2], const G2Unit& U, int nmi, int wr, int wc, int r32, int hi) const {
        asm volatile("" : "+v"(r32), "+v"(hi));
        const int s0 = U.i1 * 256 + wc * 64;
#pragma unroll
        for (int mi = 0; mi < 4; ++mi) {
            const int r = 64 * mi + 32 * wr + r32, row = U.i0 + r;
            const float rc = rcT[U.par * 256 + r];
            float s = 0.f, ss = 0.f;
#pragma unroll
            for (int ni = 0; ni < 2; ++ni) {
                f32x16 v;
#pragma unroll
                for (int g = 0; g < 4; ++g) {
                    const u32x2 hw = *(const u32x2*)(H0 + (size_t)row * D + s0 + ni * 32 + 8 * g + 4 * hi);
                    v[4 * g + 0] = acc[mi][ni][4 * g + 0] * rc + ALPHA * bflo(hw.x); v[4 * g + 1] = acc[mi][ni][4 * g + 1] * rc + ALPHA * bfhi(hw.x);
                    v[4 * g + 2] = acc[mi][ni][4 * g + 2] * rc + ALPHA * bflo(hw.y); v[4 * g + 3] = acc[mi][ni][4 * g + 3] * rc + ALPHA * bfhi(hw.y);
                }
#pragma unroll
                for (int q = 0; q < 16; ++q) { s += v[q]; ss += v[q] * v[q]; }
                store_blk32_bf16(Y1 + (size_t)row * D + s0 + ni * 32, v, hi);
            }
            s += __shfl_xor(s, 32); ss += __shfl_xor(ss, 32);
            if (hi == 0) { float* q = pst + ((size_t)row * 16 + U.i1 * 4 + wc) * 2; q[0] = s; q[1] = ss; }
        }
    }
};
__device__ __forceinline__ void phase4_g2(const Params& p, const Ctx& c) {
    Sched4 S{p, c, 0};
    Epi4 E{(const LAS float*)(c.lds + G2_GATE), (const LAS float*)(c.lds + G2_YROW), (const bf16_t*)(p.ws + WS_H0), (bf16_t*)(p.ws + WS_Y1), (float*)(p.ws + WS_PST)};
    gemm256_stream<BM_BF16T, true>(c, S, E);
}


struct Sched2 {
    const Params& p; const Ctx& c; int i; bool kv;
    __device__ __forceinline__ const void* abase() const { return p.ws + WS_Z; }
    __device__ __forceinline__ void issue() {}
    __device__ __forceinline__ void commit() {}
    __device__ __forceinline__ bool next(G2Unit& U, int par) {
        const int NT = kv ? 4 : 3, NU = kv ? 65 * 4 : 64 * 3;
        const int idx = (kv ? ((c.vcu + 64) & 255) : c.vcu) + i * 256; ++i;
        if (idx >= NU) return false;
        const int mt = idx / NT, nt = idx - mt * NT, row0 = mt * 256, nrows = min(256, (kv ? NROWS : NTOK) - row0);
        const int K = kv ? KVLORA : QLORA;
        U.b0 = (const bf16_t*)(p.ws + (kv ? WS_WUKV : WS_WUQ)) + (size_t)nt * 256 * K; U.b1 = nullptr; U.ldb = K; U.nsteps = K / 64; U.nrows = nrows; U.par = par;
        U.i0 = row0; U.i1 = nt; U.i2 = 0; U.kshift = 30; U.bsub = 0;
        if (c.tid < 256) ((LAS unsigned*)(c.lds + G2_MISC))[par * 256 + c.tid] = (unsigned)(row0 + min(c.tid, nrows - 1)) * (ZC * 2) + (kv ? ZKV : ZQ) * 2;
        return true;
    }
};
struct Epi2q {
    static constexpr bool HAS_MID = false, HAS_SUB = false;
    const float* psq; const float* rope; bf16_t* Q;
    __device__ __forceinline__ void mid(f32x16 (&)[4][2], const G2Unit&, int, int, int, int) const {}
    __device__ __forceinline__ void operator()(f32x16 (&acc)[4][2], const G2Unit& U, int nmi, int wr, int wc, int r32, int hi) const {
        asm volatile("" : "+v"(r32), "+v"(hi));
#pragma unroll
        for (int mi = 0; mi < 4; ++mi) {
            const int row = U.i0 + 64 * mi + 32 * wr + r32;
            const f32x4 pa = *(const f32x4*)(psq + (size_t)row * 16), pb = *(const f32x4*)(psq + (size_t)row * 16 + 4);
            const float rq = rsqrtf((((pa[0] + pa[1]) + (pa[2] + pa[3])) + (pb[0] + pb[1])) * (1.f / QLORA) + 1e-6f) * QSCALE;
            const int pos = NMETA + (row & (SEQ - 1));
#pragma unroll
            for (int ni = 0; ni < 2; ++ni) {
                const int c0 = U.i1 * 256 + wc * 64 + ni * 32;
                f32x16 v = acc[mi][ni];
#pragma unroll
                for (int q = 0; q < 16; ++q) v[q] *= rq;
                if ((c0 % 96) == 64) {
#pragma unroll
                    for (int g = 0; g < 2; ++g) {
                        const float* rp = rope + ((size_t)pos * 16 + 8 * g + 4 * hi) * 2;
                        const f32x4 cs0 = *(const f32x4*)rp, cs1 = *(const f32x4*)(rp + 4);
                        const float co[4] = {cs0[0], cs0[2], cs1[0], cs1[2]}, si[4] = {cs0[1], cs0[3], cs1[1], cs1[3]};
#pragma unroll
                        for (int j = 0; j < 4; ++j) { const float x1 = v[4 * g + j], x2 = v[4 * g + j + 8]; v[4 * g + j] = x1 * co[j] - x2 * si[j]; v[4 * g + j + 8] = x2 * co[j] + x1 * si[j]; }
                    }
                }
                store_blk32_bf16(Q + (size_t)row * 768 + c0, v, hi);
            }
        }
    }
};
struct Epi2kv {
    static constexpr bool HAS_MID = false, HAS_SUB = false;
    const float* psq; bf16_t* Kb; bf16_t* Vb;
    __device__ __forceinline__ void mid(f32x16 (&)[4][2], const G2Unit&, int, int, int, int) const {}
    __device__ __forceinline__ void operator()(f32x16 (&acc)[4][2], const G2Unit& U, int nmi, int wr, int wc, int r32, int hi) const {
        asm volatile("" : "+v"(r32), "+v"(hi));
        const int s0 = U.i1 * 256 + wc * 64, h = s0 >> 7; const bool isv = (s0 & 64) != 0;
#pragma unroll
        for (int mi = 0; mi < 4; ++mi) {
            if (mi < nmi) {
                const int r = 64 * mi + 32 * wr + r32, row = U.i0 + min(r, U.nrows - 1);
                const f32x4 pa = *(const f32x4*)(psq + (size_t)row * 16 + 4), pb = *(const f32x4*)(psq + (size_t)row * 16 + 8);
                const float rk = rsqrtf(((pa[2] + pa[3]) + (pb[0] + pb[1])) * (1.f / KVLORA) + 1e-6f);
                const bool meta = U.i0 >= NTOK;
                const int ncopy = meta ? NBATCH : 1;
                const int pos = meta ? row - NTOK : NMETA + (row & (SEQ - 1));
#pragma unroll
                for (int ni = 0; ni < 2; ++ni) {
                    f32x16 v = acc[mi][ni];
#pragma unroll
                    for (int q = 0; q < 16; ++q) v[q] *= rk;
                    for (int bb = 0; bb < ncopy; ++bb) {
                        const size_t prow = (size_t)(meta ? bb : (row >> 11)) * LPOS + pos;
                        bf16_t* dst = isv ? Vb + prow * 512 + h * 64 + ni * 32 : Kb + prow * 768 + h * 96 + ni * 32;
                        store_blk32_bf16(dst, v, hi, r < U.nrows);
                    }
                }
            }
        }
    }
};

__device__ __forceinline__ void phase2_gemms(const Params& p, const Ctx& c) {
    { Sched2 S{p, c, 0, false}; Epi2q E{(const float*)(p.ws + WS_PSQ), (const float*)(p.ws + WS_ROPE), (bf16_t*)(p.ws + WS_Q)}; gemm256_stream<BM_BF16T, true>(c, S, E); }
    __syncthreads();
    { Sched2 S{p, c, 0, true}; Epi2kv E{(const float*)(p.ws + WS_PSQ), (bf16_t*)(p.ws + WS_K), (bf16_t*)(p.ws + WS_V)}; gemm256_stream<BM_BF16T, false>(c, S, E); }
}

__device__ __forceinline__ void phase8(const Params& p, const Ctx& c) {
    unsigned char* ws = p.ws;
    const bf16_t* H1 = (const bf16_t*)(ws + WS_H1); const unsigned char* Y8 = (const unsigned char*)(ws + WS_Y);
    const int gw = c.vcu * NWAVES + c.wave, NGW = c.G * NWAVES, lane = c.lane;
    const int col = lane * 16;
    float gg[16], bb[16];
#pragma unroll
    for (int e = 0; e < 4; ++e) { const f32x4 g4 = *(const f32x4*)(p.ln2_g + col + 4 * e), b4 = *(const f32x4*)(p.ln2_b + col + 4 * e);
#pragma unroll
        for (int q = 0; q < 4; ++q) { gg[4 * e + q] = g4[q]; bb[4 * e + q] = b4[q]; } }
    for (int t = gw; t < NTOK; t += NGW) {
        float v[16], y[16];
        const u32x4 w0 = *(const u32x4*)(H1 + (size_t)t * D + col), w1 = *(const u32x4*)(H1 + (size_t)t * D + col + 8);
#pragma unroll
        for (int e = 0; e < 4; ++e) { v[2 * e] = ALPHA * bflo(w0[e]); v[2 * e + 1] = ALPHA * bfhi(w0[e]); v[8 + 2 * e] = ALPHA * bflo(w1[e]); v[8 + 2 * e + 1] = ALPHA * bfhi(w1[e]); }
#pragma unroll
        for (int e = 0; e < 16; ++e) y[e] = 0.f;
#pragma unroll
        for (int k = 0; k < 9; ++k) {
            const u32x4 yw = *(const u32x4*)(Y8 + ((size_t)t * 9 + k) * D + col);
#pragma unroll
            for (int e = 0; e < 4; ++e) {
                const f32x2 lo = __builtin_amdgcn_cvt_pk_f32_fp8((int)yw[e], false), hi2 = __builtin_amdgcn_cvt_pk_f32_fp8((int)yw[e], true);
                y[4 * e] += lo[0]; y[4 * e + 1] += lo[1]; y[4 * e + 2] += hi2[0]; y[4 * e + 3] += hi2[1];
            }
        }
        float s = 0.f;
#pragma unroll
        for (int e = 0; e < 16; ++e) { v[e] += y[e] * (1.f / Y8_SCALE); s += v[e]; }
        const float mean = wave_sum(s) * (1.f / D);
        float ss = 0.f;
#pragma unroll
        for (int e = 0; e < 16; ++e) { v[e] -= mean; ss += v[e] * v[e]; }
        const float rstd = rsqrtf(wave_sum(ss) * (1.f / D) + 1e-5f);
#pragma unroll
        for (int e = 0; e < 4; ++e) {
            f32x4 o;
#pragma unroll
            for (int q = 0; q < 4; ++q) o[q] = v[4 * e + q] * rstd * gg[4 * e + q] + bb[4 * e + q];
            *(f32x4*)(p.out + (size_t)t * D + col + 4 * e) = o;
        }
    }
}


#define XB_TMO      128
#define XB_XCNT(j)  (256  + 64 * (j))
#define XB_XSUB(j)  (1280 + 64 * (j))
#define XB_XGEN(j)  (2304 + 64 * (j))
#define XB_TOP      3328
#define XB_TOPGEN   3392
#define XB_SPIN_CAP (1u << 22)
__device__ __forceinline__ unsigned xb_ld(unsigned* p)              { return __hip_atomic_load(p, __ATOMIC_RELAXED, __HIP_MEMORY_SCOPE_AGENT); }
__device__ __forceinline__ unsigned xb_add(unsigned* p, unsigned v) { return __hip_atomic_fetch_add(p, v, __ATOMIC_RELAXED, __HIP_MEMORY_SCOPE_AGENT); }
__device__ __forceinline__ unsigned xb_xcc_id() { return (unsigned)__builtin_amdgcn_s_getreg((3 << 11) | 20) & 0xFu; }
#define XB_SPIN(cond, bar) do { unsigned _sp = 0; while (cond) { __builtin_amdgcn_s_sleep(1); \
    if ((++_sp & 255u) == 0u) { if (xb_ld(&(bar)[XB_TMO])) break; if (_sp > XB_SPIN_CAP) { atomicAdd(&(bar)[XB_TMO], 1u); break; } } } } while (0)
struct XcdBarrier { unsigned* bar; unsigned x; volatile LAS unsigned* st; };
__device__ __forceinline__ XcdBarrier xcd_barrier_post(unsigned* bar, volatile LAS unsigned* st) {
    XcdBarrier b; b.bar = bar; b.x = xb_xcc_id(); b.st = st;
    if (threadIdx.x == 0) (void)xb_add(&bar[XB_XCNT(b.x)], 1u);
    return b;
}
__device__ __forceinline__ void xcd_barrier_complete(unsigned* bar, unsigned x, unsigned& nloc, unsigned& nx) {
    const unsigned G = gridDim.x * gridDim.y * gridDim.z;
    unsigned sum, cnt, mine, sp = 0u;
    for (;;) {
        sum = 0u; cnt = 0u; mine = 0u;
#pragma unroll
        for (unsigned j = 0; j < 16; ++j) { const unsigned c = xb_ld(&bar[XB_XCNT(j)]); sum += c; cnt += (c > 0u) ? 1u : 0u; mine = (j == x) ? c : mine; }
        if (sum == G) break;
        __builtin_amdgcn_s_sleep(1);
        if ((++sp & 255u) == 0u) { if (xb_ld(&bar[XB_TMO])) break; if (sp > XB_SPIN_CAP) { atomicAdd(&bar[XB_TMO], 1u); break; } }
    }
    nloc = mine > 0u ? mine : 1u; nx = cnt > 0u ? cnt : 1u;
}
__device__ __forceinline__ void xcd_barrier(const XcdBarrier& b) {
    asm volatile("s_waitcnt vmcnt(0)" ::: "memory");
    __syncthreads();
    if (threadIdx.x == 0) {
        unsigned* bar = b.bar;
        __builtin_amdgcn_s_waitcnt(0);
        unsigned nloc = b.st[0], nx = b.st[1];
        if (nloc == 0u) { xcd_barrier_complete(bar, b.x, nloc, nx); b.st[0] = nloc; b.st[1] = nx; }
        const unsigned old = xb_add(&bar[XB_XSUB(b.x)], 1u);
        const unsigned gen = old / nloc;
        if (old + 1u == (gen + 1u) * nloc) {
            __builtin_amdgcn_fence(__ATOMIC_RELEASE, "agent");
            asm volatile("s_waitcnt vmcnt(0)" ::: "memory");
            const unsigned og = xb_add(&bar[XB_TOP], 1u);
            const unsigned tg = og / nx;
            if (og + 1u == (tg + 1u) * nx) xb_add(&bar[XB_TOPGEN], 1u);
            else XB_SPIN(xb_ld(&bar[XB_TOPGEN]) == tg, bar);
            __builtin_amdgcn_fence(__ATOMIC_ACQUIRE, "agent");
            xb_add(&bar[XB_XGEN(b.x)], 1u);
            asm volatile("s_waitcnt vmcnt(0)" ::: "memory");
        } else {
            XB_SPIN(xb_ld(&bar[XB_XGEN(b.x)]) == gen, bar);
            __builtin_amdgcn_fence(__ATOMIC_ACQUIRE, "agent");
            asm volatile("s_waitcnt vmcnt(0)" ::: "memory");
        }
    }
    __syncthreads();
}

template <int PH> __device__ __forceinline__ void run_phase(const Params& p, const Ctx& c0) {
    Ctx c = c0;
    { int l; asm volatile("v_mbcnt_lo_u32_b32 %0, -1, 0\n\tv_mbcnt_hi_u32_b32 %0, -1, %0" : "=v"(l)); c.lane = l; c.tid = c0.wave * 64 + l; c.wave = c0.wave; }
    if (PH == 0) phase0(p, c);
    if (PH == 1) phase1_g2(p, c);
    if (PH == 2) phase2(p, c);
#if NAIVE_ATTN
    if (PH == 3) phase3_naive(p, c);
#else
    if (PH == 3) phase3(p, c);
#endif
    if (PH == 4) phase4_g2(p, c);
    if (PH == 5) phase5_fused(p, c);
    if (PH == 8) phase_moeA(p, c);
    if (PH == 9) phase_moeB(p, c);
    if (PH == 10) phase8(p, c);
}
constexpr int NPHASES = 11;
__device__ __forceinline__ Ctx make_ctx(unsigned char* lds) {
    Ctx c; c.lds = (LAS unsigned char*)lds; c.tid = threadIdx.x; c.lane = c.tid & 63; c.wave = __builtin_amdgcn_readfirstlane(c.tid >> 6);
    c.G = gridDim.x; const int bx = blockIdx.x; c.vcu = (c.G % 8 == 0) ? (bx % 8) * (c.G / 8) + bx / 8 : bx;
    return c;
}
template <int PH> __global__ void __launch_bounds__(NTHREADS, 2) phase_kernel(Params p) {
    extern __shared__ __attribute__((aligned(16))) unsigned char lds[];
    const Ctx c = make_ctx(lds);
    run_phase<PH>(p, c);
}
#if MEGA
__global__ void __launch_bounds__(NTHREADS, 2) mega_kernel(Params p) {
    extern __shared__ __attribute__((aligned(16))) unsigned char lds[];
    Ctx c = make_ctx(lds);
    cg::grid_group grid = cg::this_grid();
    volatile LAS unsigned* bst = (volatile LAS unsigned*)(c.lds + LDS_BYTES - 64);
    if (c.tid < 4) bst[c.tid] = 0u;
    __syncthreads();
    XcdBarrier bar; bar.bar = (unsigned*)(p.ws + WS_CTL + CT_BAR); bar.x = xb_xcc_id(); bar.st = bst;
    if (c.tid == 0) bst[2] = xb_add(&bar.bar[XB_XCNT(bar.x)], 1u);
    if (p.out == nullptr) grid.sync();
    run_phase<0>(p, c); xcd_barrier(bar);
    if (c.tid == 0) {
        unsigned pre = 0;
        for (unsigned j = 0; j < 16; ++j) { const unsigned n = xb_ld(&bar.bar[XB_XCNT(j)]); if (j < bar.x) pre += n; }
        bst[3] = pre + bst[2];
    }
    __syncthreads();
    c.vcu = (int)bst[3];
    run_phase<1>(p, c); xcd_barrier(bar);
    run_phase<2>(p, c); xcd_barrier(bar);
    run_phase<3>(p, c); xcd_barrier(bar);
    run_phase<4>(p, c); xcd_barrier(bar);
    run_phase<5>(p, c); xcd_barrier(bar);
    run_phase<8>(p, c); xcd_barrier(bar);
    run_phase<9>(p, c); xcd_barrier(bar);
    run_phase<10>(p, c);
}

#endif
template <int PH> static void launch_phase(const Params& p, int grid, hipStream_t stream) {
    static bool attr = false;
    if (!attr) { (void)hipFuncSetAttribute((const void*)phase_kernel<PH>, hipFuncAttributeMaxDynamicSharedMemorySize, LDS_BYTES); attr = true; }
    hipLaunchKernelGGL(phase_kernel<PH>, dim3(grid), dim3(NTHREADS), LDS_BYTES, stream, p);
}

extern "C" void kernel_launch(void* const* d_in, const int* in_sizes, int n_in, void* d_out, int out_size, void* d_ws, size_t ws_size, hipStream_t stream) {
    if (n_in != 25 || ws_size < WS_END) { fprintf(stderr, "kernel_launch: unexpected n_in %d or ws_size %zu (need %zu)\n", n_in, ws_size, (size_t)WS_END); return; }
    Params p{};
    const float** pp = (const float**)&p;
    for (int i = 0; i < 25; ++i) pp[i] = (const float*)d_in[i];
    p.out = (float*)d_out; p.ws = (unsigned char*)d_ws;
    (void)hipMemsetAsync((char*)d_ws + WS_CTL, 0, CTL_BYTES, stream);
#if MEGA
    static int grid = 0;
    if (!grid) {
        int dev = 0, cus = 0, per_cu = 0;
        (void)hipGetDevice(&dev);
        (void)hipDeviceGetAttribute(&cus, hipDeviceAttributeMultiprocessorCount, dev);
        (void)hipFuncSetAttribute((const void*)mega_kernel, hipFuncAttributeMaxDynamicSharedMemorySize, LDS_BYTES);
        (void)hipOccupancyMaxActiveBlocksPerMultiprocessor(&per_cu, (const void*)mega_kernel, NTHREADS, LDS_BYTES);
        if (per_cu < 1) per_cu = 1;
        grid = cus;
        (void)per_cu;
    }
    void* args[] = {&p};
    hipError_t e = hipLaunchCooperativeKernel((const void*)mega_kernel, dim3(grid), dim3(NTHREADS), args, LDS_BYTES, stream);
    if (e != hipSuccess) fprintf(stderr, "cooperative launch failed: %s (grid %d)\n", hipGetErrorString(e), grid);
#else
    const int grid = 256;
#define LP(k) do { launch_phase<k>(p, grid, stream); if (REPEAT_PH == k) { if (k == 5) (void)hipMemsetAsync((char*)d_ws + WS_CTL + CT_CNT, 0, 1024, stream); (void)hipMemsetAsync((char*)d_ws + WS_CTL + CT_Q, 0, 4096, stream); launch_phase<k>(p, grid, stream); } } while (0)
    LP(0); LP(1); LP(2); LP(3); LP(4); LP(5); LP(8); LP(9); LP(10);
#undef LP
#endif
}
```

```cpp
#include <hip/hip_runtime.h>
#include <hip/hip_cooperative_groups.h>
#include <cstdint>
#include <cstdio>
namespace cg = cooperative_groups;

#ifndef NAIVE_GEMM
#define NAIVE_GEMM 0
#endif
#ifndef NAIVE_ATTN
#define NAIVE_ATTN 0
#endif
#ifndef REPEAT_PH
#define REPEAT_PH -1
#endif
#ifndef MEGA
#define MEGA 1
#endif

#define LAS __attribute__((address_space(3)))
#define GAS __attribute__((address_space(1)))
typedef unsigned short bf16_t;
typedef short bf16x8 __attribute__((ext_vector_type(8)));
typedef float f32x4 __attribute__((ext_vector_type(4)));
typedef unsigned u32x4 __attribute__((ext_vector_type(4)));
typedef unsigned u32x2 __attribute__((ext_vector_type(2)));

constexpr int D = 1024, NBATCH = 8, SEQ = 2048, NMETA = 16, LPOS = SEQ + NMETA;
constexpr int NTOK = NBATCH * SEQ;
constexpr int NROWS = NTOK + NMETA;
constexpr int NROWSP = 16512;
constexpr int NH = 8, DQK = 96, DNOPE = 64, DROPE = 32, DV = 64;
constexpr int QLORA = 384, KVLORA = 256;
constexpr int ZC = 2304;
constexpr int ZQ = 0, ZKV = 384, ZKPE = 640, ZB = 704, ZCG = 1216, ZU = 1728;
constexpr int DIN = 2208;
constexpr int NEXP = 256, DEXP = 256, TOPK = 8, CAP = 16384;
constexpr float ALPHA = 1.189207115002721f;
constexpr float QSCALE = 0.10206207261596577f * 1.4426950408889634f;

constexpr int NTHREADS = 512, NWAVES = 8;
constexpr int LDS_BYTES = 147456;
constexpr int STAGE_BYTES = 49152;
constexpr int LDS_MISC = 2 * STAGE_BYTES;

constexpr size_t MiB = 1u << 20;
constexpr size_t WS_CTL = 0;
constexpr size_t CTL_BYTES = 1 * MiB;
constexpr size_t CT_CNT = 0;
constexpr size_t CT_Q = 1024;
constexpr size_t CT_BAR = 8192;
constexpr size_t CT_SSQ_Q = 32768;
constexpr size_t CT_SSQ_KV = CT_SSQ_Q + 66048;
constexpr size_t CT_SSQ_ATT = CT_SSQ_KV + 66048;
constexpr size_t CT_STATS1 = CT_SSQ_ATT + 65536;
static_assert(CT_STATS1 + 131072 <= CTL_BYTES, "ctl");
constexpr size_t WS_WIN = 1 * MiB;
constexpr size_t WS_WUQ = 6 * MiB;
constexpr size_t WS_WUKV = 7 * MiB;
constexpr size_t WS_WO = 8 * MiB;
constexpr size_t WS_WR = 10 * MiB;
constexpr size_t WS_WSGU = 11 * MiB;
constexpr size_t WS_WSD = 12 * MiB;
constexpr size_t WS_ROPE = 13 * MiB;
constexpr size_t WS_WGU = 14 * MiB;
constexpr size_t WS_WD = 270 * MiB;
constexpr size_t WS_H1 = 398 * MiB;
constexpr size_t WS_HID = 430 * MiB;
constexpr size_t WS_LAID = 502 * MiB;
constexpr size_t WS_LGATE = 518 * MiB;
constexpr size_t WS_Y = 534 * MiB;
constexpr size_t WS_Z = WS_Y;
constexpr size_t WS_H0 = WS_Y + 73 * MiB;
constexpr size_t WS_Q = WS_Y + 106 * MiB;
constexpr size_t WS_K = WS_Y + 130 * MiB;
constexpr size_t WS_V = WS_Y + 155 * MiB;
constexpr size_t WS_ATT = WS_Y + 172 * MiB;
constexpr size_t WS_CONV = WS_Y + 188 * MiB;
constexpr size_t WS_SSQC = WS_Y + 204 * MiB;
constexpr size_t WS_Y1 = WS_Y + 205 * MiB;
constexpr size_t WS_LOG = WS_Y + 237 * MiB;
constexpr size_t WS_PSQ = WS_Y + 253 * MiB;
constexpr size_t WS_PATT = WS_Y + 254 * MiB;
constexpr size_t WS_PST = WS_Y + 255 * MiB;
constexpr size_t WS_END = WS_Y + 288 * MiB;

struct Params {
    const float *x, *meta, *emb_g, *emb_b, *w_in, *q_norm, *w_uq, *kv_norm, *w_ukv, *conv_w, *attn_on, *conv_on, *w_o,
        *ln1_g, *ln1_b, *w_router, *router_bias, *w_gate, *w_up, *w_down, *ws_gate, *ws_up, *ws_down, *ln2_g, *ln2_b;
    float* out;
    unsigned char* ws;
};

__device__ __forceinline__ unsigned f2bf(float f) { unsigned u = __float_as_uint(f); return (u + 0x7fffu + ((u >> 16) & 1u)) >> 16; }
typedef float f32x2 __attribute__((ext_vector_type(2)));
typedef __bf16 bf16x2_t __attribute__((ext_vector_type(2)));
__device__ __forceinline__ unsigned cvtpk(float lo, float hi) { f32x2 v = {lo, hi}; bf16x2_t b = __builtin_convertvector(v, bf16x2_t); return __builtin_bit_cast(unsigned, b); }
__device__ __forceinline__ unsigned pk2(float lo, float hi) { return cvtpk(lo, hi); }
__device__ __forceinline__ float bf2f(unsigned b) { return __uint_as_float(b << 16); }
__device__ __forceinline__ float bflo(unsigned w) { return __uint_as_float(w << 16); }
__device__ __forceinline__ float bfhi(unsigned w) { return __uint_as_float(w & 0xffff0000u); }
__device__ __forceinline__ float wave_sum(float v) {
#pragma unroll
    for (int o = 1; o < 64; o <<= 1) v += __shfl_xor(v, o);
    return v;
}
__device__ __forceinline__ float wave_max(float v) {
#pragma unroll
    for (int o = 1; o < 64; o <<= 1) v = fmaxf(v, __shfl_xor(v, o));
    return v;
}

struct Ctx {
    LAS unsigned char* lds;
    int tid, lane, wave, vcu, G;
};

template <class RowPtr>
__device__ __forceinline__ void gemm_kloop(f32x4 (&acc)[4][4], const Ctx& c, const RowPtr& rp, const bf16_t* Bt, long ldb, int K) {
    const int tid = c.tid, lane = c.lane, wid = c.wave, wr = wid >> 2, wc = wid & 3, fr = lane & 15, fq = lane >> 4;
#if NAIVE_GEMM
    const bf16_t* ar[4];
#pragma unroll
    for (int mi = 0; mi < 4; ++mi) ar[mi] = rp(wr * 64 + mi * 16 + fr);
    const bf16_t* br = Bt + (long)(wc * 64 + fq * 4) * ldb;
#pragma nounroll
    for (int k = 0; k < K; k += 2) {
        unsigned av[4];
#pragma unroll
        for (int mi = 0; mi < 4; ++mi) av[mi] = *(const unsigned*)(ar[mi] + k);
#pragma unroll
        for (int ni = 0; ni < 4; ++ni)
#pragma unroll
            for (int j = 0; j < 4; ++j) {
                const unsigned bv = *(const unsigned*)(br + (long)(ni * 16 + j) * ldb + k);
#pragma unroll
                for (int mi = 0; mi < 4; ++mi) acc[mi][ni][j] += bflo(av[mi]) * bflo(bv) + bfhi(av[mi]) * bfhi(bv);
            }
    }
#else
    LAS unsigned char* lds = c.lds;
    const int nt = K >> 6;
    const int srow = tid >> 3, sch = tid & 7;
    const bf16_t* ap0 = rp(srow) + sch * 8;
    const bf16_t* ap1 = rp(srow + 64) + sch * 8;
    const bf16_t* bp = Bt + (long)srow * ldb + sch * 8;
    const long bstep = 64 * ldb;
    const int so = srow * 128 + ((sch ^ ((srow >> 1) & 7)) << 4);
    u32x4 ra0, ra1, rb0, rb1, rb2, rb3;
#define G_LOAD(t) do { const int ko = (t) * 64; ra0 = *(const u32x4*)(ap0 + ko); ra1 = *(const u32x4*)(ap1 + ko); \
        rb0 = *(const u32x4*)(bp + ko); rb1 = *(const u32x4*)(bp + bstep + ko); rb2 = *(const u32x4*)(bp + 2 * bstep + ko); rb3 = *(const u32x4*)(bp + 3 * bstep + ko); } while (0)
#define G_STORE(buf) do { LAS unsigned char* sb = lds + (buf) * STAGE_BYTES; \
        *(LAS u32x4*)(sb + so) = ra0; *(LAS u32x4*)(sb + so + 8192) = ra1; \
        *(LAS u32x4*)(sb + 16384 + so) = rb0; *(LAS u32x4*)(sb + 16384 + so + 8192) = rb1; \
        *(LAS u32x4*)(sb + 16384 + so + 16384) = rb2; *(LAS u32x4*)(sb + 16384 + so + 24576) = rb3; } while (0)
    __syncthreads();
    G_LOAD(0);
    G_STORE(0);
    __syncthreads();
    const int sw0 = ((0 + fq) ^ ((fr >> 1) & 7)) << 4, sw1 = ((4 + fq) ^ ((fr >> 1) & 7)) << 4;
    const int aoff = (wr * 64 + fr) * 128, boff = 16384 + (wc * 64 + fr) * 128;
    for (int t = 0; t < nt; ++t) {
        if (t + 1 < nt) G_LOAD(t + 1);
        const LAS unsigned char* sb = lds + (t & 1) * STAGE_BYTES;
#pragma unroll
        for (int ks = 0; ks < 2; ++ks) {
            const int sw = ks ? sw1 : sw0;
            bf16x8 af[4], bfr[4];
#pragma unroll
            for (int mi = 0; mi < 4; ++mi) af[mi] = *(const LAS bf16x8*)(sb + aoff + mi * 2048 + sw);
#pragma unroll
            for (int ni = 0; ni < 4; ++ni) bfr[ni] = *(const LAS bf16x8*)(sb + boff + ni * 2048 + sw);
#pragma unroll
            for (int mi = 0; mi < 4; ++mi)
#pragma unroll
                for (int ni = 0; ni < 4; ++ni) acc[mi][ni] = __builtin_amdgcn_mfma_f32_16x16x32_bf16(bfr[ni], af[mi], acc[mi][ni], 0, 0, 0);
        }
        if (t + 1 < nt) G_STORE((t + 1) & 1);
        __syncthreads();
    }
#undef G_LOAD
#undef G_STORE
#endif
}
__device__ __forceinline__ void acc_zero(f32x4 (&acc)[4][4]) {
#pragma unroll
    for (int a = 0; a < 4; ++a)
#pragma unroll
        for (int b = 0; b < 4; ++b) acc[a][b] = (f32x4){0.f, 0.f, 0.f, 0.f};
}
__device__ __forceinline__ void store_bf4(bf16_t* p, f32x4 v) { u32x2 w; w.x = pk2(v[0], v[1]); w.y = pk2(v[2], v[3]); *(u32x2*)p = w; }

enum { MAP_ID = 0, MAP_WIN = 1, MAP_GATE = 2, MAP_UP = 3 };
template <int MAP> __device__ __forceinline__ int rowmap(int n) {
    if (MAP == MAP_WIN) return n < 672 ? n : n + 32;
    if (MAP == MAP_GATE) return 32 * (n >> 4) + (n & 15);
    if (MAP == MAP_UP) return 32 * (n >> 4) + 16 + (n & 15);
    return n;
}
template <int MAP>
__device__ __forceinline__ void transpose_item(const float* W, int K, int N, bf16_t* WT, const float* gain, LAS float* scr, int item, int lane) {
    const int nblk = N / 32, kb = item / nblk, nb = item % nblk, k0 = 64 * kb, n0 = 32 * nb;
#pragma unroll 8
    for (int i = 0; i < 32; ++i) {
        const int kk = 2 * i + (lane >> 5);
        float v = W[(size_t)(k0 + kk) * N + n0 + (lane & 31)];
        if (gain) v *= gain[k0 + kk];
        scr[kk * 33 + (lane & 31)] = v;
    }
    asm volatile("s_waitcnt lgkmcnt(0)" ::: "memory");
    const int ch = lane & 7;
#pragma unroll
    for (int j = 0; j < 4; ++j) {
        const int n = (lane >> 3) + 8 * j;
        const LAS float* s = scr + (8 * ch) * 33 + n;
        u32x4 o;
        o.x = pk2(s[0 * 33], s[1 * 33]); o.y = pk2(s[2 * 33], s[3 * 33]); o.z = pk2(s[4 * 33], s[5 * 33]); o.w = pk2(s[6 * 33], s[7 * 33]);
        *(u32x4*)(WT + (size_t)rowmap<MAP>(n0 + n) * K + k0 + 8 * ch) = o;
    }
    asm volatile("s_waitcnt lgkmcnt(0)" ::: "memory");
}
__device__ __forceinline__ void phase0(const Params& p, const Ctx& c) {
    unsigned char* ws = p.ws;
    LAS float* scr = (LAS float*)(c.lds + c.wave * 8704);
    const int gw = c.vcu * NWAVES + c.wave, NGW = c.G * NWAVES, lane = c.lane;
    bf16_t* H0 = (bf16_t*)(ws + WS_H0);
    {
        f32x4 eg[4], eb[4];
#pragma unroll
        for (int j = 0; j < 4; ++j) { eg[j] = *((const f32x4*)p.emb_g + lane + 64 * j); eb[j] = *((const f32x4*)p.emb_b + lane + 64 * j); }
        for (int r0 = gw; r0 < NROWSP; r0 += 2 * NGW) {
            const int r1 = r0 + NGW;
            const bool h1 = r1 < NROWSP;
            const int q0 = min(r0, NROWS - 1), q1 = min(h1 ? r1 : r0, NROWS - 1);
            const float* x0 = q0 < NTOK ? p.x + (size_t)q0 * D : p.meta + (size_t)(q0 - NTOK) * D;
            const float* x1 = q1 < NTOK ? p.x + (size_t)q1 * D : p.meta + (size_t)(q1 - NTOK) * D;
            f32x4 v0[4], v1[4]; float s0 = 0.f, s1 = 0.f;
#pragma unroll
            for (int j = 0; j < 4; ++j) { v0[j] = *((const f32x4*)x0 + lane + 64 * j); v1[j] = *((const f32x4*)x1 + lane + 64 * j); }
#pragma unroll
            for (int j = 0; j < 4; ++j) { s0 += (v0[j][0] + v0[j][1]) + (v0[j][2] + v0[j][3]); s1 += (v1[j][0] + v1[j][1]) + (v1[j][2] + v1[j][3]); }
#pragma unroll
            for (int o = 1; o < 64; o <<= 1) { s0 += __shfl_xor(s0, o); s1 += __shfl_xor(s1, o); }
            const float m0 = s0 * (1.f / D), m1 = s1 * (1.f / D);
            float t0 = 0.f, t1 = 0.f;
#pragma unroll
            for (int j = 0; j < 4; ++j) { v0[j] = v0[j] - m0; v1[j] = v1[j] - m1;
                t0 += (v0[j][0] * v0[j][0] + v0[j][1] * v0[j][1]) + (v0[j][2] * v0[j][2] + v0[j][3] * v0[j][3]); t1 += (v1[j][0] * v1[j][0] + v1[j][1] * v1[j][1]) + (v1[j][2] * v1[j][2] + v1[j][3] * v1[j][3]); }
#pragma unroll
            for (int o = 1; o < 64; o <<= 1) { t0 += __shfl_xor(t0, o); t1 += __shfl_xor(t1, o); }
            const float rs0 = r0 < NROWS ? 1.f / sqrtf(t0 * (1.f / D) + 1e-5f) : 0.f, rs1 = r1 < NROWS ? 1.f / sqrtf(t1 * (1.f / D) + 1e-5f) : 0.f;
            u32x2* o0 = (u32x2*)(H0 + (size_t)r0 * D) + lane; u32x2* o1 = (u32x2*)(H0 + (size_t)r1 * D) + lane;
#pragma unroll
            for (int j = 0; j < 4; ++j) {
                const f32x4 y0 = r0 < NROWS ? v0[j] * rs0 * eg[j] + eb[j] : (f32x4){0.f, 0.f, 0.f, 0.f}, y1 = r1 < NROWS ? v1[j] * rs1 * eg[j] + eb[j] : (f32x4){0.f, 0.f, 0.f, 0.f};
                o0[64 * j] = (u32x2){pk2(y0[0], y0[1]), pk2(y0[2], y0[3])};
                if (h1) o1[64 * j] = (u32x2){pk2(y1[0], y1[1]), pk2(y1[2], y1[3])};
            }
        }
    }
    {
        float* rope = (float*)(ws + WS_ROPE);
        for (int idx = gw * 64 + lane; idx < LPOS * 16; idx += NGW * 64) {
            const int pos = idx >> 4, i = idx & 15;
            const float inv = exp2f(-(float)i * (13.287712379549449f / 16.f));
            const float ang = (float)pos * inv;
            double rev = (double)ang * 0.15915494309189535; rev -= floor(rev);
            const float rf = (float)rev;
            rope[idx * 2 + 0] = __builtin_amdgcn_cosf(rf);
            rope[idx * 2 + 1] = __builtin_amdgcn_sinf(rf);
        }
    }
    {
        bf16_t* WinT = (bf16_t*)(ws + WS_WIN);
        for (int it = gw; it < 96; it += NGW) {
            const int row = it < 32 ? 672 + it : 2240 + (it - 32);
            u32x2* o = (u32x2*)(WinT + (size_t)row * D) + lane;
#pragma unroll
            for (int j = 0; j < 4; ++j) o[64 * j] = (u32x2){0u, 0u};
        }
    }
    constexpr int I_WIN = 16 * 69, I_UQ = 6 * 24, I_UKV = 4 * 32, I_WO = 16 * 32, I_WR = 16 * 8, I_SG = 128, I_SD = 128;
    constexpr int I_SMALL = I_WIN + I_UQ + I_UKV + I_WO + I_WR + 2 * I_SG + I_SD;
    constexpr int I_EXP = NEXP * 128;
    constexpr int NITEMS = I_WIN + I_UQ + I_UKV + I_WO + I_WR;
    for (int it = gw; it < NITEMS; it += NGW) {
        int r = it;
        if (r < I_WIN) { transpose_item<MAP_WIN>(p.w_in, D, DIN, (bf16_t*)(ws + WS_WIN), nullptr, scr, r, lane); continue; } r -= I_WIN;
        if (r < I_UQ) { transpose_item<MAP_ID>(p.w_uq, QLORA, 768, (bf16_t*)(ws + WS_WUQ), p.q_norm, scr, r, lane); continue; } r -= I_UQ;
        if (r < I_UKV) { transpose_item<MAP_ID>(p.w_ukv, KVLORA, 1024, (bf16_t*)(ws + WS_WUKV), p.kv_norm, scr, r, lane); continue; } r -= I_UKV;
        if (r < I_WO) {
            const int kb = r / 32;
            transpose_item<MAP_ID>(p.w_o, D, D, (bf16_t*)(ws + WS_WO), kb < 8 ? p.attn_on : p.conv_on - 512, scr, r, lane); continue; } r -= I_WO;
        if (r < I_WR) { transpose_item<MAP_ID>(p.w_router, D, 256, (bf16_t*)(ws + WS_WR), nullptr, scr, r, lane); continue; } r -= I_WR;
        if (r < I_SG) { transpose_item<MAP_GATE>(p.ws_gate, D, 256, (bf16_t*)(ws + WS_WSGU), nullptr, scr, r, lane); continue; } r -= I_SG;
        if (r < I_SG) { transpose_item<MAP_UP>(p.ws_up, D, 256, (bf16_t*)(ws + WS_WSGU), nullptr, scr, r, lane); continue; } r -= I_SG;
        if (r < I_SD) { transpose_item<MAP_ID>(p.ws_down, DEXP, D, (bf16_t*)(ws + WS_WSD), nullptr, scr, r, lane); continue; } r -= I_SD;
        if (r < I_EXP) { const int e = r >> 7; transpose_item<MAP_GATE>(p.w_gate + (size_t)e * D * DEXP, D, 256, (bf16_t*)(ws + WS_WGU) + (size_t)e * 512 * D, nullptr, scr, r & 127, lane); continue; } r -= I_EXP;
        if (r < I_EXP) { const int e = r >> 7; transpose_item<MAP_UP>(p.w_up + (size_t)e * D * DEXP, D, 256, (bf16_t*)(ws + WS_WGU) + (size_t)e * 512 * D, nullptr, scr, r & 127, lane); continue; } r -= I_EXP;
        { const int e = r >> 7; transpose_item<MAP_ID>(p.w_down + (size_t)e * DEXP * D, DEXP, D, (bf16_t*)(ws + WS_WD) + (size_t)e * D * DEXP, nullptr, scr, r & 127, lane); }
    }
}

__device__ __forceinline__ void phase1(const Params& p, const Ctx& c) {
    unsigned char* ws = p.ws;
    const bf16_t* H0 = (const bf16_t*)(ws + WS_H0); const bf16_t* WinT = (const bf16_t*)(ws + WS_WIN);
    bf16_t* Z = (bf16_t*)(ws + WS_Z);
    float* psq = (float*)(ws + WS_PSQ);
    const int lane = c.lane, wr = c.wave >> 2, wc = c.wave & 3, fr = lane & 15, fq = lane >> 4;
    constexpr int NU = 129 * 9;
    for (int u = c.vcu; u < NU; u += c.G) {
        const int mt = u / 9, nt = u % 9, row0 = mt * 128, n0 = nt * 256;
        f32x4 acc[4][4]; acc_zero(acc);
        auto rp = [&](int r) { return H0 + (size_t)(row0 + r) * D; };
        gemm_kloop(acc, c, rp, WinT + (size_t)n0 * D, D, D);
        const int s0 = n0 + wc * 64;
#pragma unroll
        for (int mi = 0; mi < 4; ++mi) {
            const int row = row0 + wr * 64 + mi * 16 + fr;
            float ss = 0.f;
#pragma unroll
            for (int ni = 0; ni < 4; ++ni) {
                const f32x4 v = acc[mi][ni];
                store_bf4(Z + (size_t)row * ZC + s0 + ni * 16 + fq * 4, v);
                ss += (v[0] * v[0] + v[1] * v[1]) + (v[2] * v[2] + v[3] * v[3]);
            }
            if (s0 < ZKPE) {
                ss += __shfl_xor(ss, 16); ss += __shfl_xor(ss, 32);
                if (fq == 0) psq[(size_t)row * 16 + (s0 >> 6)] = ss;
            }
        }
    }
}

__device__ __forceinline__ void phase2_gemms(const Params& p, const Ctx& c);
__device__ __forceinline__ void phase2(const Params& p, const Ctx& c) {
    unsigned char* ws = p.ws;
    const bf16_t* Z = (const bf16_t*)(ws + WS_Z);
    const float* psq = (const float*)(ws + WS_PSQ);
    const float* rope = (const float*)(ws + WS_ROPE);
    bf16_t* Q = (bf16_t*)(ws + WS_Q); bf16_t* Kb = (bf16_t*)(ws + WS_K); bf16_t* Vb = (bf16_t*)(ws + WS_V);
    const int lane = c.lane, wr = c.wave >> 2, wc = c.wave & 3, fr = lane & 15, fq = lane >> 4;
    phase2_gemms(p, c);
    __syncthreads();
    const int gw = c.vcu * NWAVES + c.wave, NGW = c.G * NWAVES;
    const bf16_t* Zc = Z;
    for (int row = gw; row < NROWS; row += NGW) {
        const int nb = row < NTOK ? 1 : NBATCH;
        const int b0 = row < NTOK ? (row >> 11) : 0, pos = row < NTOK ? NMETA + (row & (SEQ - 1)) : row - NTOK;
        if (lane < 16) {
            const float x1 = bf2f(Zc[(size_t)row * ZC + ZKPE + lane]), x2 = bf2f(Zc[(size_t)row * ZC + ZKPE + 16 + lane]);
            const float co = rope[((size_t)pos * 16 + lane) * 2], si = rope[((size_t)pos * 16 + lane) * 2 + 1];
            const bf16_t o1 = (bf16_t)f2bf(x1 * co - x2 * si), o2 = (bf16_t)f2bf(x2 * co + x1 * si);
            for (int bb = 0; bb < nb; ++bb) {
                bf16_t* kp = Kb + ((size_t)(b0 + bb) * LPOS + pos) * 768;
#pragma unroll
                for (int h = 0; h < NH; ++h) { kp[h * 96 + 64 + lane] = o1; kp[h * 96 + 80 + lane] = o2; }
            }
        }
        if (row < NTOK) {
            const int i = row & (SEQ - 1);
            const int r1 = i >= 1 ? row - 1 : NTOK + 15;
            const int r2 = i >= 2 ? row - 2 : (i == 1 ? NTOK + 15 : NTOK + 14);
            const int ch = lane * 8;
            const u32x4 c0 = *(const u32x4*)(Zc + (size_t)row * ZC + ZCG + ch), u0 = *(const u32x4*)(Zc + (size_t)row * ZC + ZU + ch);
            const u32x4 c1 = *(const u32x4*)(Zc + (size_t)r1 * ZC + ZCG + ch), u1 = *(const u32x4*)(Zc + (size_t)r1 * ZC + ZU + ch);
            const u32x4 c2 = *(const u32x4*)(Zc + (size_t)r2 * ZC + ZCG + ch), u2 = *(const u32x4*)(Zc + (size_t)r2 * ZC + ZU + ch);
            const u32x4 bg = *(const u32x4*)(Zc + (size_t)row * ZC + ZB + ch);
            float y[8]; float ss = 0.f;
#pragma unroll
            for (int e = 0; e < 4; ++e) {
#pragma unroll
                for (int hh = 0; hh < 2; ++hh) {
                    const int cc = ch + e * 2 + hh;
                    const float w0 = p.conv_w[cc], w1 = p.conv_w[512 + cc], w2 = p.conv_w[1024 + cc];
                    const float v0 = hh ? bfhi(c0[e]) * bfhi(u0[e]) : bflo(c0[e]) * bflo(u0[e]);
                    const float v1 = hh ? bfhi(c1[e]) * bfhi(u1[e]) : bflo(c1[e]) * bflo(u1[e]);
                    const float v2 = hh ? bfhi(c2[e]) * bfhi(u2[e]) : bflo(c2[e]) * bflo(u2[e]);
                    const float bgv = hh ? bfhi(bg[e]) : bflo(bg[e]);
                    const float yy = bgv * (w0 * v2 + w1 * v1 + w2 * v0);
                    y[e * 2 + hh] = yy; ss += yy * yy;
                }
            }
            ss = wave_sum(ss);
            u32x4 o; o.x = pk2(y[0], y[1]); o.y = pk2(y[2], y[3]); o.z = pk2(y[4], y[5]); o.w = pk2(y[6], y[7]);
            *(u32x4*)((bf16_t*)(ws + WS_ATT) + (size_t)row * D + 512 + ch) = o;
            if (lane == 0) ((float*)(ws + WS_SSQC))[row] = ss;
        }
    }
}

__device__ __forceinline__ void phase3_naive(const Params& p, const Ctx& c) {
    unsigned char* ws = p.ws;
    const bf16_t* Q = (const bf16_t*)(ws + WS_Q); const bf16_t* Kb = (const bf16_t*)(ws + WS_K); const bf16_t* Vb = (const bf16_t*)(ws + WS_V);
    bf16_t* ATT = (bf16_t*)(ws + WS_ATT); float* patt = (float*)(ws + WS_PATT);
    const int gw = c.vcu * NWAVES + c.wave, NGW = c.G * NWAVES, lane = c.lane;
    for (int it = gw; it < NTOK * NH; it += NGW) {
        const int row = it >> 3, h = it & 7, b = row >> 11, i = row & (SEQ - 1), nkeys = NMETA + i + 1;
        float q[96];
#pragma unroll
        for (int j = 0; j < 12; ++j) {
            const u32x4 w = *(const u32x4*)(Q + (size_t)row * 768 + h * 96 + j * 8);
#pragma unroll
            for (int e = 0; e < 4; ++e) { q[j * 8 + e * 2] = bflo(w[e]); q[j * 8 + e * 2 + 1] = bfhi(w[e]); }
        }
        float m = -INFINITY, l = 0.f; float o[64];
#pragma unroll
        for (int d = 0; d < 64; ++d) o[d] = 0.f;
        for (int kk = lane; kk < nkeys; kk += 64) {
            const bf16_t* kp = Kb + ((size_t)b * LPOS + kk) * 768 + h * 96;
            float s = 0.f;
#pragma unroll
            for (int j = 0; j < 12; ++j) {
                const u32x4 w = *(const u32x4*)(kp + j * 8);
#pragma unroll
                for (int e = 0; e < 4; ++e) { s += q[j * 8 + e * 2] * bflo(w[e]); s += q[j * 8 + e * 2 + 1] * bfhi(w[e]); }
            }
            const float mn = fmaxf(m, s), f = exp2f(m - mn), pe = exp2f(s - mn);
            l = l * f + pe; m = mn;
            const bf16_t* vp = Vb + ((size_t)b * LPOS + kk) * 512 + h * 64;
#pragma unroll
            for (int j = 0; j < 8; ++j) {
                const u32x4 w = *(const u32x4*)(vp + j * 8);
#pragma unroll
                for (int e = 0; e < 4; ++e) { o[j * 8 + e * 2] = o[j * 8 + e * 2] * f + pe * bflo(w[e]); o[j * 8 + e * 2 + 1] = o[j * 8 + e * 2 + 1] * f + pe * bfhi(w[e]); }
            }
        }
        const float M = wave_max(m);
        const float f = (m == -INFINITY) ? 0.f : exp2f(m - M);
        const float lt = wave_sum(l * f);
        float res = 0.f;
#pragma unroll
        for (int d = 0; d < 64; ++d) { const float v = wave_sum(o[d] * f); if (lane == d) res = v; }
        res /= lt;
        ATT[(size_t)row * D + h * 64 + lane] = (bf16_t)f2bf(res);
        const float ss = wave_sum(res * res);
        if (lane == 0) patt[(size_t)row * 8 + h] = ss;
    }
}


typedef float f32x16 __attribute__((ext_vector_type(16)));
typedef short s16x4 __attribute__((ext_vector_type(4)));
constexpr int AK_PITCH = 208, AK_BYTES = 64 * AK_PITCH, AV_BYTES = 8192, ASTAGE = AK_BYTES + AV_BYTES, A_WSF = 4 * ASTAGE;
__device__ __forceinline__ int crow(int r, int hi) { return (r & 3) + 8 * (r >> 2) + 4 * hi; }
__device__ __forceinline__ s16x4 vtr(const LAS unsigned char* p) {
    return __builtin_bit_cast(s16x4, __builtin_amdgcn_ds_read_tr16_b64_v4i16((LAS s16x4*)p));
}
__device__ __forceinline__ void attn_unit(const Params& p, const Ctx& c, int b, int h, int qb) {
    unsigned char* ws = p.ws;
    const bf16_t* Q = (const bf16_t*)(ws + WS_Q); const bf16_t* Kb = (const bf16_t*)(ws + WS_K); const bf16_t* Vb = (const bf16_t*)(ws + WS_V);
    bf16_t* ATT = (bf16_t*)(ws + WS_ATT); float* patt = (float*)(ws + WS_PATT);
    const int tid = c.tid, lane = c.lane, w = c.wave, r32 = lane & 31, hi = lane >> 5;
    LAS unsigned char* lds = c.lds;
    LAS float* wsf = (LAS float*)(lds + A_WSF) + w * 32;
    const int row0 = b * SEQ + qb * 256;
    const int qpos0 = NMETA + qb * 256 + w * 32, myq = qpos0 + r32;
    bf16x8 qf[6];
#pragma unroll
    for (int ds = 0; ds < 6; ++ds) qf[ds] = *(const bf16x8*)(Q + (size_t)(row0 + w * 32 + r32) * 768 + h * 96 + ds * 16 + hi * 8);
    const bf16_t* Kg = Kb + (size_t)b * LPOS * 768 + h * 96;
    const bf16_t* Vg = Vb + (size_t)b * LPOS * 512 + h * 64;
    const int T = 4 * qb + 5;
    const int tl = (qpos0 + 31) >> 6;
    const int vrow = tid >> 3, vch = tid & 7;
    const int voff = AK_BYTES + (vch >> 2) * 4096 + vrow * 64 + (vch & 3) * 16;
    const int k1c = 512 + (tid & 255);
    const int k0row = tid / 12, k0ch = tid % 12, k1row = k1c / 12, k1ch = k1c % 12;
    const int k0off = k0row * AK_PITCH + k0ch * 16, k1off = k1row * AK_PITCH + k1ch * 16;
    u32x4 rkA0, rkA1, rvA, rkA2, rkA3, rvA2;
#define A_LOAD1(k0, k1, v, t) do { const int kb_ = min((t), T - 1) * 64; \
        k0 = *(const u32x4*)(Kg + (size_t)min(kb_ + k0row, LPOS - 1) * 768 + k0ch * 8); \
        k1 = *(const u32x4*)(Kg + (size_t)min(kb_ + k1row, LPOS - 1) * 768 + k1ch * 8); \
        v = *(const u32x4*)(Vg + (size_t)min(kb_ + vrow, LPOS - 1) * 512 + vch * 8); } while (0)
#define A_STORE1(k0, k1, v, off) do { LAS unsigned char* sb_ = lds + (off); \
        *(LAS u32x4*)(sb_ + k0off) = k0; *(LAS u32x4*)(sb_ + k1off) = k1; *(LAS u32x4*)(sb_ + voff) = v; } while (0)
#define A_LOAD_A(t2) do { A_LOAD1(rkA0, rkA1, rvA, 2 * (t2)); A_LOAD1(rkA2, rkA3, rvA2, 2 * (t2) + 1); } while (0)
#define A_STORE_A(buf) do { A_STORE1(rkA0, rkA1, rvA, (buf) * 2 * ASTAGE); A_STORE1(rkA2, rkA3, rvA2, (buf) * 2 * ASTAGE + ASTAGE); } while (0)
    float m = -INFINITY, l = 0.f;
    f32x16 o0, o1;
#pragma unroll
    for (int r = 0; r < 16; ++r) { o0[r] = 0.f; o1[r] = 0.f; }
    const int kfo = r32 * AK_PITCH + hi * 16;
    const int vfo = AK_BYTES + ((lane >> 4) & 1) * 32 + (lane & 3) * 8 + (4 * hi + ((lane & 15) >> 2)) * 64;
    const int T2 = (T + 1) >> 1;
    __syncthreads();
    A_LOAD_A(0);
    A_STORE_A(0);
    __syncthreads();
    auto compute_tile = [&](int t) __attribute__((always_inline)) {
        if (t <= tl) {
            const LAS unsigned char* sb = lds + ((t >> 1) & 1) * 2 * ASTAGE + (t & 1) * ASTAGE;
            f32x16 p0, p1;
#pragma unroll
            for (int r = 0; r < 16; ++r) { p0[r] = 0.f; p1[r] = 0.f; }
#pragma unroll
            for (int ds = 0; ds < 6; ++ds) {
                const bf16x8 a0 = *(const LAS bf16x8*)(sb + kfo + ds * 32);
                const bf16x8 a1 = *(const LAS bf16x8*)(sb + kfo + 32 * AK_PITCH + ds * 32);
                p0 = __builtin_amdgcn_mfma_f32_32x32x16_bf16(a0, qf[ds], p0, 0, 0, 0);
                p1 = __builtin_amdgcn_mfma_f32_32x32x16_bf16(a1, qf[ds], p1, 0, 0, 0);
            }
            if (t * 64 + 63 > qpos0) {
                const int kb0 = t * 64 + 4 * hi;
#pragma unroll
                for (int r = 0; r < 16; ++r) {
                    const int kv = kb0 + (r & 3) + 8 * (r >> 2);
                    if (kv > myq) p0[r] = -INFINITY;
                    if (kv + 32 > myq) p1[r] = -INFINITY;
                }
            }
            float mx = fmaxf(p0[0], p1[0]);
#pragma unroll
            for (int r = 1; r < 16; ++r) mx = fmaxf(mx, fmaxf(p0[r], p1[r]));
            mx = fmaxf(mx, __shfl_xor(mx, 32));
            if (__any(mx > m)) {
                const float mn = fmaxf(m, mx), alpha = __builtin_amdgcn_exp2f(m - mn);
                m = mn; l *= alpha;
                if (hi == 0) wsf[r32] = alpha;
                asm volatile("s_waitcnt lgkmcnt(0)" ::: "memory");
#pragma unroll
                for (int k = 0; k < 4; ++k) {
                    const f32x4 a = *(const LAS f32x4*)(wsf + 8 * k + 4 * hi);
#pragma unroll
                    for (int j = 0; j < 4; ++j) { o0[4 * k + j] *= a[j]; o1[4 * k + j] *= a[j]; }
                }
                asm volatile("s_waitcnt lgkmcnt(0)" ::: "memory");
            }
            float ls = 0.f;
#pragma unroll
            for (int r = 0; r < 16; ++r) { p0[r] = __builtin_amdgcn_exp2f(p0[r] - m); p1[r] = __builtin_amdgcn_exp2f(p1[r] - m); ls += p0[r] + p1[r]; }
            l += ls;
            bf16x8 pa[4];
#pragma unroll
            for (int s = 0; s < 4; ++s) {
                u32x4 wv;
#pragma unroll
                for (int e = 0; e < 4; ++e) {
                    const int r = 8 * (s & 1) + 2 * e;
                    wv[e] = (s >> 1) ? pk2(p1[r], p1[r + 1]) : pk2(p0[r], p0[r + 1]);
                }
                pa[s] = __builtin_bit_cast(bf16x8, wv);
            }
#pragma unroll
            for (int s = 0; s < 4; ++s) {
                const s16x4 l0 = vtr(sb + vfo + s * 1024), h0 = vtr(sb + vfo + s * 1024 + 512);
                const s16x4 l1 = vtr(sb + vfo + 4096 + s * 1024), h1 = vtr(sb + vfo + 4096 + s * 1024 + 512);
                const bf16x8 v0 = (bf16x8){l0[0], l0[1], l0[2], l0[3], h0[0], h0[1], h0[2], h0[3]};
                const bf16x8 v1 = (bf16x8){l1[0], l1[1], l1[2], l1[3], h1[0], h1[1], h1[2], h1[3]};
                o0 = __builtin_amdgcn_mfma_f32_32x32x16_bf16(pa[s], v0, o0, 0, 0, 0);
                o1 = __builtin_amdgcn_mfma_f32_32x32x16_bf16(pa[s], v1, o1, 0, 0, 0);
            }
        }
    };
#pragma unroll 1
    for (int t2 = 0; t2 < T2; ++t2) {
        A_LOAD_A(t2 + 1);
        compute_tile(2 * t2); compute_tile(2 * t2 + 1);
        A_STORE_A((t2 + 1) & 1);
        __syncthreads();
    }
#undef A_LOAD1
#undef A_STORE1
#undef A_LOAD_A
#undef A_STORE_A
    l += __shfl_xor(l, 32);
    if (hi == 0) wsf[r32] = 1.f / l;
    asm volatile("s_waitcnt lgkmcnt(0)" ::: "memory");
    float sq[16];
#pragma unroll
    for (int k = 0; k < 4; ++k) {
        const f32x4 a = *(const LAS f32x4*)(wsf + 8 * k + 4 * hi);
#pragma unroll
        for (int j = 0; j < 4; ++j) {
            const int r = 4 * k + j;
            const float x0 = o0[r] * a[j], x1 = o1[r] * a[j];
            bf16_t* op = ATT + (size_t)(row0 + w * 32 + crow(r, hi)) * D + h * 64 + r32;
            op[0] = (bf16_t)f2bf(x0); op[32] = (bf16_t)f2bf(x1);
            sq[r] = x0 * x0 + x1 * x1;
        }
    }
#pragma unroll
    for (int r = 0; r < 16; ++r) {
        float v = sq[r];
#pragma unroll
        for (int o = 1; o < 32; o <<= 1) v += __shfl_xor(v, o);
        if (r32 == 0) patt[(size_t)(row0 + w * 32 + crow(r, hi)) * 8 + h] = v;
    }
    asm volatile("s_waitcnt lgkmcnt(0)" ::: "memory");
}
__device__ __forceinline__ void phase3(const Params& p, const Ctx& c) {
    for (int pi = c.vcu; pi < 256; pi += c.G) {
        const int bh = pi >> 2, s = pi & 3;
        attn_unit(p, c, bh >> 3, bh & 7, 7 - s);
        attn_unit(p, c, bh >> 3, bh & 7, s);
    }
}

__device__ __forceinline__ void phase4(const Params& p, const Ctx& c) {
    unsigned char* ws = p.ws;
    const bf16_t* ATT = (const bf16_t*)(ws + WS_ATT); const bf16_t* CONV = (const bf16_t*)(ws + WS_CONV);
    const bf16_t* WoT = (const bf16_t*)(ws + WS_WO); const bf16_t* H0 = (const bf16_t*)(ws + WS_H0);
    const float* patt = (const float*)(ws + WS_PATT); const float* ssq_c = (const float*)(ws + WS_SSQC);
    bf16_t* Y1 = (bf16_t*)(ws + WS_Y1); float* pst = (float*)(ws + WS_PST);
    const int lane = c.lane, wr = c.wave >> 2, wc = c.wave & 3, fr = lane & 15, fq = lane >> 4;
    constexpr int NU = 128 * 4;
    for (int u = c.vcu; u < NU; u += c.G) {
        const int mt = u >> 2, nt = u & 3, row0 = mt * 128, n0 = nt * 256;
        f32x4 acc[4][4]; acc_zero(acc);
        auto rpa = [&](int r) { return ATT + (size_t)(row0 + r) * 512; };
        gemm_kloop(acc, c, rpa, WoT + (size_t)n0 * D, D, 512);
        float rc[4];
#pragma unroll
        for (int mi = 0; mi < 4; ++mi) {
            const int row = row0 + wr * 64 + mi * 16 + fr;
            const f32x4 pa = *(const f32x4*)(patt + (size_t)row * 8), pb = *(const f32x4*)(patt + (size_t)row * 8 + 4);
            const float ra = rsqrtf((((pa[0] + pa[1]) + (pa[2] + pa[3])) + ((pb[0] + pb[1]) + (pb[2] + pb[3]))) * (1.f / 512) + 1e-6f);
            rc[mi] = rsqrtf(ssq_c[row] * (1.f / 512) + 1e-6f);
            const float f = ra / rc[mi];
#pragma unroll
            for (int ni = 0; ni < 4; ++ni) acc[mi][ni] = acc[mi][ni] * f;
        }
        auto rpc = [&](int r) { return CONV + (size_t)(row0 + r) * 512; };
        gemm_kloop(acc, c, rpc, WoT + (size_t)n0 * D + 512, D, 512);
        const int s0 = n0 + wc * 64;
#pragma unroll
        for (int mi = 0; mi < 4; ++mi) {
            const int row = row0 + wr * 64 + mi * 16 + fr;
            float s = 0.f, ss = 0.f;
#pragma unroll
            for (int ni = 0; ni < 4; ++ni) {
                const int col = s0 + ni * 16 + fq * 4;
                const u32x2 hw = *(const u32x2*)(H0 + (size_t)row * D + col);
                f32x4 v = acc[mi][ni] * rc[mi];
                v[0] += ALPHA * bflo(hw.x); v[1] += ALPHA * bfhi(hw.x); v[2] += ALPHA * bflo(hw.y); v[3] += ALPHA * bfhi(hw.y);
                store_bf4(Y1 + (size_t)row * D + col, v);
                s += (v[0] + v[1]) + (v[2] + v[3]);
                ss += (v[0] * v[0] + v[1] * v[1]) + (v[2] * v[2] + v[3] * v[3]);
            }
            s += __shfl_xor(s, 16); s += __shfl_xor(s, 32);
            ss += __shfl_xor(ss, 16); ss += __shfl_xor(ss, 32);
            if (fq == 0) { float* q = pst + ((size_t)row * 16 + nt * 4 + wc) * 2; q[0] = s; q[1] = ss; }
        }
    }
}

__device__ __forceinline__ void phase5a(const Params& p, const Ctx& c) {
    unsigned char* ws = p.ws;
    const bf16_t* Y1 = (const bf16_t*)(ws + WS_Y1); bf16_t* H1 = (bf16_t*)(ws + WS_H1); const float* pst = (const float*)(ws + WS_PST);
    const int gw = c.vcu * NWAVES + c.wave, NGW = c.G * NWAVES, lane = c.lane;
    for (int row = gw; row < NTOK; row += NGW) {
        float s1 = 0.f, s2 = 0.f;
#pragma unroll
        for (int k = 0; k < 16; ++k) { s1 += pst[((size_t)row * 16 + k) * 2]; s2 += pst[((size_t)row * 16 + k) * 2 + 1]; }
        const float mean = s1 * (1.f / D), var = fmaxf(s2 * (1.f / D) - mean * mean, 0.f), rstd = rsqrtf(var + 1e-5f);
#pragma unroll
        for (int j = 0; j < 2; ++j) {
            const int col = (lane + 64 * j) * 8;
            const u32x4 w = *(const u32x4*)(Y1 + (size_t)row * D + col);
            float y[8];
#pragma unroll
            for (int e = 0; e < 4; ++e) { y[2 * e] = bflo(w[e]); y[2 * e + 1] = bfhi(w[e]); }
#pragma unroll
            for (int e = 0; e < 8; ++e) y[e] = (y[e] - mean) * rstd * p.ln1_g[col + e] + p.ln1_b[col + e];
            u32x4 o; o.x = pk2(y[0], y[1]); o.y = pk2(y[2], y[3]); o.z = pk2(y[4], y[5]); o.w = pk2(y[6], y[7]);
            *(u32x4*)(H1 + (size_t)row * D + col) = o;
        }
    }
}
__device__ __forceinline__ void phase5b(const Params& p, const Ctx& c) {
    unsigned char* ws = p.ws;
    const bf16_t* H1 = (const bf16_t*)(ws + WS_H1); float* LOG = (float*)(ws + WS_LOG);
    const int lane = c.lane, wr = c.wave >> 2, wc = c.wave & 3, fr = lane & 15, fq = lane >> 4;
    for (int u = c.vcu; u < 128; u += c.G) {
        const int row0 = u * 128;
        f32x4 acc[4][4]; acc_zero(acc);
        auto rp = [&](int r) { return H1 + (size_t)(row0 + r) * D; };
        gemm_kloop(acc, c, rp, (const bf16_t*)(ws + WS_WR), D, D);
#pragma unroll
        for (int mi = 0; mi < 4; ++mi) {
            const int row = row0 + wr * 64 + mi * 16 + fr;
#pragma unroll
            for (int ni = 0; ni < 4; ++ni) *(f32x4*)(LOG + (size_t)row * 256 + wc * 64 + ni * 16 + fq * 4) = acc[mi][ni];
        }
    }
}
__device__ __forceinline__ void phase5c(const Params& p, const Ctx& c) {
    unsigned char* ws = p.ws;
    const float* LOG = (const float*)(ws + WS_LOG);
    unsigned* cnt = (unsigned*)(ws + WS_CTL + CT_CNT); unsigned* laid = (unsigned*)(ws + WS_LAID); float* lgate = (float*)(ws + WS_LGATE);
    const int gw = c.vcu * NWAVES + c.wave, NGW = c.G * NWAVES, lane = c.lane;
    const f32x4 bias = *((const f32x4*)p.router_bias + lane);
    for (int t = gw; t < NTOK; t += NGW) {
        const f32x4 lg = *((const f32x4*)(LOG + (size_t)t * 256) + lane);
        float s[4], sel[4];
#pragma unroll
        for (int i = 0; i < 4; ++i) { s[i] = 1.f / (1.f + expf(-lg[i])); sel[i] = s[i] + bias[i]; }
        float a = fmaxf(sel[0], sel[1]), b = fminf(sel[0], sel[1]), cc = fmaxf(sel[2], sel[3]), d = fminf(sel[2], sel[3]);
        float t1 = fmaxf(a, cc), t2 = fmaxf(fminf(a, cc), a >= cc ? b : d);
#pragma unroll
        for (int o = 1; o < 8; o <<= 1) {
            const float y1 = __shfl_xor(t1, o), y2 = __shfl_xor(t2, o);
            const float n1 = fmaxf(t1, y1), n2 = fmaxf(fminf(t1, y1), t1 >= y1 ? t2 : y2);
            t1 = n1; t2 = n2;
        }
        const float gs = t1 + t2; const int g = lane >> 3;
        int better = 0;
#pragma unroll
        for (int gg = 0; gg < 8; ++gg) { const float o = __shfl(gs, gg * 8); better += (o > gs || (o == gs && gg < g)) ? 1 : 0; }
        if (better >= 4) { sel[0] = sel[1] = sel[2] = sel[3] = -INFINITY; }
        int ek[8]; float sk[8]; float ssum = 0.f;
#pragma unroll
        for (int k = 0; k < 8; ++k) {
            float bv = sel[0]; int bi = 0;
            if (sel[1] > bv) { bv = sel[1]; bi = 1; }
            if (sel[2] > bv) { bv = sel[2]; bi = 2; }
            if (sel[3] > bv) { bv = sel[3]; bi = 3; }
            const float wm = wave_max(bv);
            const unsigned long long mask = __ballot(bv == wm);
            const int src = __ffsll((long long)mask) - 1;
            const float sb = bi == 0 ? s[0] : bi == 1 ? s[1] : bi == 2 ? s[2] : s[3];
            ek[k] = src * 4 + __shfl(bi, src); sk[k] = __shfl(sb, src); ssum += sk[k];
            if (lane == src) { if (bi == 0) sel[0] = -INFINITY; else if (bi == 1) sel[1] = -INFINITY; else if (bi == 2) sel[2] = -INFINITY; else sel[3] = -INFINITY; }
        }
        int me = ek[0]; float mg = sk[0];
#pragma unroll
        for (int k = 1; k < 8; ++k) if (lane == k) { me = ek[k]; mg = sk[k]; }
        if (lane < 8) {
            const unsigned pos = atomicAdd(cnt + me, 1u);
            laid[(size_t)me * CAP + pos] = (unsigned)(t * 8 + lane);
            lgate[(size_t)me * CAP + pos] = mg / ssum * 2.5f;
        }
    }
}


__device__ __forceinline__ void route_token(const Params& p, int t, const f32x4 lg, const f32x4 bias, int lane, unsigned* cnt, unsigned* laid, float* lgate) {
    float s[4], sel[4];
#pragma unroll
    for (int i = 0; i < 4; ++i) { s[i] = 1.f / (1.f + expf(-lg[i])); sel[i] = s[i] + bias[i]; }
    float a = fmaxf(sel[0], sel[1]), b = fminf(sel[0], sel[1]), cc = fmaxf(sel[2], sel[3]), d = fminf(sel[2], sel[3]);
    float t1 = fmaxf(a, cc), t2 = fmaxf(fminf(a, cc), a >= cc ? b : d);
#pragma unroll
    for (int o = 1; o < 8; o <<= 1) {
        const float y1 = __shfl_xor(t1, o), y2 = __shfl_xor(t2, o);
        const float n1 = fmaxf(t1, y1), n2 = fmaxf(fminf(t1, y1), t1 >= y1 ? t2 : y2);
        t1 = n1; t2 = n2;
    }
    const float gs = t1 + t2; const int g = lane >> 3;
    int better = 0;
#pragma unroll
    for (int gg = 0; gg < 8; ++gg) { const float o = __shfl(gs, gg * 8); better += (o > gs || (o == gs && gg < g)) ? 1 : 0; }
    if (better >= 4) { sel[0] = sel[1] = sel[2] = sel[3] = -INFINITY; }
    int ek[8]; float sk[8]; float ssum = 0.f;
#pragma unroll
    for (int k = 0; k < 8; ++k) {
        float bv = sel[0]; int bi = 0;
        if (sel[1] > bv) { bv = sel[1]; bi = 1; }
        if (sel[2] > bv) { bv = sel[2]; bi = 2; }
        if (sel[3] > bv) { bv = sel[3]; bi = 3; }
        const float wm = wave_max(bv);
        const unsigned long long mask = __ballot(bv == wm);
        const int src = __ffsll((long long)mask) - 1;
        const float sb = bi == 0 ? s[0] : bi == 1 ? s[1] : bi == 2 ? s[2] : s[3];
        ek[k] = src * 4 + __shfl(bi, src); sk[k] = __shfl(sb, src); ssum += sk[k];
        if (lane == src) { if (bi == 0) sel[0] = -INFINITY; else if (bi == 1) sel[1] = -INFINITY; else if (bi == 2) sel[2] = -INFINITY; else sel[3] = -INFINITY; }
    }
    int me = ek[0]; float mg = sk[0];
#pragma unroll
    for (int k = 1; k < 8; ++k) if (lane == k) { me = ek[k]; mg = sk[k]; }
    if (lane < 8) {
        const unsigned pos = atomicAdd(cnt + me, 1u);
        laid[(size_t)me * CAP + pos] = (unsigned)(t * 8 + lane);
        lgate[(size_t)me * CAP + pos] = mg / ssum * 2.5f;
    }
}
__device__ __forceinline__ void route_select(const f32x4 lg, const f32x4 bias, int lane, int& me_out, float& gate_out) {
    float s[4], sel[4];
#pragma unroll
    for (int i = 0; i < 4; ++i) { s[i] = 1.f / (1.f + expf(-lg[i])); sel[i] = s[i] + bias[i]; }
    float a = fmaxf(sel[0], sel[1]), b = fminf(sel[0], sel[1]), cc = fmaxf(sel[2], sel[3]), d = fminf(sel[2], sel[3]);
    float t1 = fmaxf(a, cc), t2 = fmaxf(fminf(a, cc), a >= cc ? b : d);
#pragma unroll
    for (int o = 1; o < 8; o <<= 1) {
        const float y1 = __shfl_xor(t1, o), y2 = __shfl_xor(t2, o);
        const float n1 = fmaxf(t1, y1), n2 = fmaxf(fminf(t1, y1), t1 >= y1 ? t2 : y2);
        t1 = n1; t2 = n2;
    }
    const float gs = t1 + t2; const int g = lane >> 3;
    int better = 0;
#pragma unroll
    for (int gg = 0; gg < 8; ++gg) { const float o = __shfl(gs, gg * 8); better += (o > gs || (o == gs && gg < g)) ? 1 : 0; }
    if (better >= 4) { sel[0] = sel[1] = sel[2] = sel[3] = -INFINITY; }
    int ek[8]; float sk[8]; float ssum = 0.f;
#pragma unroll
    for (int k = 0; k < 8; ++k) {
        float bv = sel[0]; int bi = 0;
        if (sel[1] > bv) { bv = sel[1]; bi = 1; }
        if (sel[2] > bv) { bv = sel[2]; bi = 2; }
        if (sel[3] > bv) { bv = sel[3]; bi = 3; }
        const float wm = wave_max(bv);
        const unsigned long long mask = __ballot(bv == wm);
        const int src = __ffsll((long long)mask) - 1;
        const float sb = bi == 0 ? s[0] : bi == 1 ? s[1] : bi == 2 ? s[2] : s[3];
        ek[k] = src * 4 + __shfl(bi, src); sk[k] = __shfl(sb, src); ssum += sk[k];
        if (lane == src) { if (bi == 0) sel[0] = -INFINITY; else if (bi == 1) sel[1] = -INFINITY; else if (bi == 2) sel[2] = -INFINITY; else sel[3] = -INFINITY; }
    }
    int me = ek[0]; float mg = sk[0];
#pragma unroll
    for (int k = 1; k < 8; ++k) if (lane == k) { me = ek[k]; mg = sk[k]; }
    me_out = me; gate_out = mg / ssum * 2.5f;
}
__device__ __forceinline__ void phase5_fused(const Params& p, const Ctx& c) {
    unsigned char* ws = p.ws;
    const bf16_t* Y1 = (const bf16_t*)(ws + WS_Y1); bf16_t* H1 = (bf16_t*)(ws + WS_H1); const float* pst = (const float*)(ws + WS_PST);
    const bf16_t* WrT = (const bf16_t*)(ws + WS_WR);
    unsigned* cnt = (unsigned*)(ws + WS_CTL + CT_CNT); unsigned* laid = (unsigned*)(ws + WS_LAID); float* lgate = (float*)(ws + WS_LGATE);
    const int lane = c.lane, w = c.wave, r32 = lane & 31, hi = lane >> 5;
    LAS unsigned char* lds = c.lds;
    const f32x4 bias = *((const f32x4*)p.router_bias + lane);
    for (int u = c.vcu; u < NTOK / 64; u += c.G) {
        const int row0 = u * 64;
        __syncthreads();
        {
            float gg[16], bb[16];
#pragma unroll
            for (int j = 0; j < 2; ++j) {
                const int col = (lane + 64 * j) * 8;
#pragma unroll
                for (int e = 0; e < 2; ++e) { const f32x4 g4 = *(const f32x4*)(p.ln1_g + col + 4 * e), b4 = *(const f32x4*)(p.ln1_b + col + 4 * e);
#pragma unroll
                    for (int q = 0; q < 4; ++q) { gg[j * 8 + e * 4 + q] = g4[q]; bb[j * 8 + e * 4 + q] = b4[q]; } }
            }
#pragma unroll 2
            for (int rr = 0; rr < 8; ++rr) {
                const int lr = w * 8 + rr, row = row0 + lr;
                float s1 = 0.f, s2 = 0.f;
                if (lane < 16) { const float* q = pst + ((size_t)row * 16 + lane) * 2; s1 = q[0]; s2 = q[1]; }
#pragma unroll
                for (int o = 1; o < 16; o <<= 1) { s1 += __shfl_xor(s1, o); s2 += __shfl_xor(s2, o); }
                s1 = __shfl(s1, 0); s2 = __shfl(s2, 0);
                const float mean = s1 * (1.f / D), var = fmaxf(s2 * (1.f / D) - mean * mean, 0.f), rstd = rsqrtf(var + 1e-5f);
#pragma unroll
                for (int j = 0; j < 2; ++j) {
                    const int ch = lane + 64 * j, col = ch * 8;
                    const u32x4 wv = *(const u32x4*)(Y1 + (size_t)row * D + col);
                    float y[8];
#pragma unroll
                    for (int e = 0; e < 4; ++e) { y[2 * e] = bflo(wv[e]); y[2 * e + 1] = bfhi(wv[e]); }
#pragma unroll
                    for (int e = 0; e < 8; ++e) y[e] = (y[e] - mean) * rstd * gg[j * 8 + e] + bb[j * 8 + e];
                    u32x4 o; o.x = cvtpk(y[0], y[1]); o.y = cvtpk(y[2], y[3]); o.z = cvtpk(y[4], y[5]); o.w = cvtpk(y[6], y[7]);
                    *(u32x4*)(H1 + (size_t)row * D + col) = o;
                    *(LAS u32x4*)(lds + lr * 2048 + ((ch ^ (lr & 15)) << 4)) = o;
                }
            }
        }
        __syncthreads();
        f32x16 acc0, acc1;
#pragma unroll
        for (int r = 0; r < 16; ++r) { acc0[r] = 0.f; acc1[r] = 0.f; }
        {
            const bf16_t* bp = WrT + (size_t)(w * 32 + r32) * D + hi * 8;
            const LAS unsigned char* a0 = lds + r32 * 2048, * a1 = lds + (32 + r32) * 2048;
            const int sx = r32 & 15;
#pragma unroll 1
            for (int kb = 0; kb < 64; kb += 8) {
                bf16x8 bf[8];
#pragma unroll
                for (int q = 0; q < 8; ++q) bf[q] = *(const bf16x8*)(bp + (kb + q) * 16);
#pragma unroll
                for (int q = 0; q < 8; ++q) {
                    const int ch = 2 * (kb + q) + hi;
                    const bf16x8 f0 = *(const LAS bf16x8*)(a0 + ((ch ^ sx) << 4)), f1 = *(const LAS bf16x8*)(a1 + ((ch ^ sx) << 4));
                    acc0 = __builtin_amdgcn_mfma_f32_32x32x16_bf16(bf[q], f0, acc0, 0, 0, 0);
                    acc1 = __builtin_amdgcn_mfma_f32_32x32x16_bf16(bf[q], f1, acc1, 0, 0, 0);
                }
            }
        }
        __syncthreads();
        if (c.tid < 256) ((LAS unsigned*)(lds + 65536))[c.tid] = 0u;
#pragma unroll
        for (int g = 0; g < 4; ++g) {
            *(LAS f32x4*)(lds + (size_t)r32 * 1024 + (w * 32 + 8 * g + 4 * hi) * 4) = (f32x4){acc0[4 * g], acc0[4 * g + 1], acc0[4 * g + 2], acc0[4 * g + 3]};
            *(LAS f32x4*)(lds + (size_t)(32 + r32) * 1024 + (w * 32 + 8 * g + 4 * hi) * 4) = (f32x4){acc1[4 * g], acc1[4 * g + 1], acc1[4 * g + 2], acc1[4 * g + 3]};
        }
        __syncthreads();
        LAS unsigned* hist = (LAS unsigned*)(lds + 65536); LAS unsigned* basev = hist + 256; LAS int* asgE = (LAS int*)(basev + 256); LAS int* asgP = asgE + 512; LAS float* asgG = (LAS float*)(asgP + 512);
#pragma unroll 1
        for (int rr = 0; rr < 8; ++rr) {
            const int lr = w * 8 + rr;
            const f32x4 lg = *(const LAS f32x4*)(lds + lr * 1024 + lane * 16);
            int me; float gate;
            route_select(lg, bias, lane, me, gate);
            if (lane < 8) {
                const unsigned lp = __hip_atomic_fetch_add(hist + me, 1u, __ATOMIC_RELAXED, __HIP_MEMORY_SCOPE_WORKGROUP);
                asgE[lr * 8 + lane] = me; asgP[lr * 8 + lane] = (int)lp; asgG[lr * 8 + lane] = gate;
            }
        }
        __syncthreads();
        if (c.tid < 256) { const unsigned hc = hist[c.tid]; basev[c.tid] = hc ? atomicAdd(cnt + c.tid, hc) : 0u; }
        __syncthreads();
        {
            const int i = c.tid, e = asgE[i];
            const unsigned pos = basev[e] + (unsigned)asgP[i];
            ((u32x2*)(ws + WS_LAID))[(size_t)e * CAP + pos] = (u32x2){(unsigned)((row0 + (i >> 3)) * 8 + (i & 7)), __float_as_uint(asgG[i])};
        }
    }
}

struct MoeTab { LAS int* tstart; LAS int* roff; LAS int* tok; LAS float* gate; };
__device__ __forceinline__ MoeTab moe_tab_build(const Params& p, const Ctx& c) {
    MoeTab T; T.tstart = (LAS int*)(c.lds + LDS_MISC); T.roff = T.tstart + 260; T.tok = T.roff + 260; T.gate = (LAS float*)(T.tok + 128);
    const unsigned* cnt = (const unsigned*)(p.ws + WS_CTL + CT_CNT);
    __syncthreads();
    if (c.tid < 64) {
        int cv[4], tv[4]; int ls = 0, lt = 0;
#pragma unroll
        for (int i = 0; i < 4; ++i) { cv[i] = (int)cnt[c.tid * 4 + i]; tv[i] = (cv[i] + 127) >> 7; ls += cv[i]; lt += tv[i]; }
        int ps = ls, pt = lt;
#pragma unroll
        for (int o = 1; o < 64; o <<= 1) { const int a = __shfl_up(ps, o), b = __shfl_up(pt, o); if (c.tid >= o) { ps += a; pt += b; } }
        int es = ps - ls, et = pt - lt;
#pragma unroll
        for (int i = 0; i < 4; ++i) { T.roff[c.tid * 4 + i] = es; T.tstart[c.tid * 4 + i] = et; es += cv[i]; et += tv[i]; }
        if (c.tid == 63) { T.roff[256] = es; T.tstart[256] = et; }
    }
    __syncthreads();
    return T;
}
__device__ __forceinline__ int moe_find(const MoeTab& T, int g) {
    int lo = 0, hi = 255;
    while (lo < hi) { const int mid = (lo + hi + 1) >> 1; if (T.tstart[mid] <= g) lo = mid; else hi = mid - 1; }
    return lo;
}

__device__ __forceinline__ void phase6(const Params& p, const Ctx& c) {
    unsigned char* ws = p.ws;
    const bf16_t* H1 = (const bf16_t*)(ws + WS_H1); bf16_t* HID = (bf16_t*)(ws + WS_HID);
    const unsigned* laid = (const unsigned*)(ws + WS_LAID);
    const unsigned* cnt = (const unsigned*)(ws + WS_CTL + CT_CNT);
    const int lane = c.lane, wr = c.wave >> 2, wc = c.wave & 3, fr = lane & 15, fq = lane >> 4;
    const MoeTab T = moe_tab_build(p, c);
    const int tmt = T.tstart[256], NU = (tmt + 128) * 2;
    for (int u = c.vcu; u < NU; u += c.G) {
        const int g = u >> 1, nt = u & 1;
        int e, mt, nrows; size_t hbase;
        __syncthreads();
        if (g < tmt) {
            e = moe_find(T, g); mt = g - T.tstart[e]; nrows = min(128, (int)cnt[e] - mt * 128); hbase = (size_t)T.roff[e] + mt * 128;
            if (c.tid < 128) T.tok[c.tid] = (int)(laid[(size_t)e * CAP + mt * 128 + min(c.tid, nrows - 1)] >> 3);
        } else {
            e = NEXP; mt = g - tmt; nrows = 128; hbase = (size_t)NTOK * 8 + mt * 128;
            if (c.tid < 128) T.tok[c.tid] = mt * 128 + c.tid;
        }
        __syncthreads();
        f32x4 acc[4][4]; acc_zero(acc);
        auto rp = [&](int r) { return H1 + (size_t)T.tok[r] * D; };
        const bf16_t* Bt = (e < NEXP ? (const bf16_t*)(ws + WS_WGU) + (size_t)e * 512 * D : (const bf16_t*)(ws + WS_WSGU)) + (size_t)nt * 256 * D;
        gemm_kloop(acc, c, rp, Bt, D, D);
#pragma unroll
        for (int mi = 0; mi < 4; ++mi) {
            const int r = wr * 64 + mi * 16 + fr;
            if (r >= nrows) continue;
#pragma unroll
            for (int np = 0; np < 2; ++np) {
                const f32x4 gt = acc[mi][2 * np], up = acc[mi][2 * np + 1];
                f32x4 hv;
#pragma unroll
                for (int j = 0; j < 4; ++j) hv[j] = gt[j] / (1.f + __expf(-gt[j])) * up[j];
                store_bf4(HID + (hbase + r) * DEXP + nt * 128 + wc * 32 + np * 16 + fq * 4, hv);
            }
        }
    }
}
__device__ __forceinline__ void phase7(const Params& p, const Ctx& c) {
    unsigned char* ws = p.ws;
    const bf16_t* HID = (const bf16_t*)(ws + WS_HID); bf16_t* Y = (bf16_t*)(ws + WS_Y);
    const unsigned* laid = (const unsigned*)(ws + WS_LAID); const float* lgate = (const float*)(ws + WS_LGATE);
    const unsigned* cnt = (const unsigned*)(ws + WS_CTL + CT_CNT);
    const int lane = c.lane, wr = c.wave >> 2, wc = c.wave & 3, fr = lane & 15, fq = lane >> 4;
    const MoeTab T = moe_tab_build(p, c);
    const int tmt = T.tstart[256], NU = (tmt + 128) * 4;
    for (int u = c.vcu; u < NU; u += c.G) {
        const int g = u >> 2, nt = u & 3;
        int e, mt, nrows; size_t hbase;
        __syncthreads();
        if (g < tmt) {
            e = moe_find(T, g); mt = g - T.tstart[e]; nrows = min(128, (int)cnt[e] - mt * 128); hbase = (size_t)T.roff[e] + mt * 128;
            if (c.tid < 128) {
                const int rr = min(c.tid, nrows - 1);
                const unsigned aid = laid[(size_t)e * CAP + mt * 128 + rr];
                T.tok[c.tid] = (int)((aid >> 3) * 9 + (aid & 7)); T.gate[c.tid] = lgate[(size_t)e * CAP + mt * 128 + rr];
            }
        } else {
            e = NEXP; mt = g - tmt; nrows = 128; hbase = (size_t)NTOK * 8 + mt * 128;
            if (c.tid < 128) { T.tok[c.tid] = (mt * 128 + c.tid) * 9 + 8; T.gate[c.tid] = 1.f; }
        }
        __syncthreads();
        f32x4 acc[4][4]; acc_zero(acc);
        auto rp = [&](int r) { return HID + (hbase + min(r, nrows - 1)) * DEXP; };
        const bf16_t* Bt = (e < NEXP ? (const bf16_t*)(ws + WS_WD) + (size_t)e * D * DEXP : (const bf16_t*)(ws + WS_WSD)) + (size_t)nt * 256 * DEXP;
        gemm_kloop(acc, c, rp, Bt, DEXP, DEXP);
#pragma unroll
        for (int mi = 0; mi < 4; ++mi) {
            const int r = wr * 64 + mi * 16 + fr;
            if (r >= nrows) continue;
            const float gt = T.gate[r]; const size_t yrow = (size_t)T.tok[r];
#pragma unroll
            for (int ni = 0; ni < 4; ++ni) store_bf4(Y + yrow * D + nt * 256 + wc * 64 + ni * 16 + fq * 4, acc[mi][ni] * gt);
        }
    }
}

__device__ __forceinline__ int moe_find_l(const LAS int* tstart, int g) {
    int lo = 0, hi = 255;
    while (lo < hi) { const int mid = (lo + hi + 1) >> 1; if (tstart[mid] <= g) lo = mid; else hi = mid - 1; }
    return lo;
}

constexpr int MOE_A = 0, MOE_B = 32768, MOE_H0 = 98304, MOE_H1 = 0, MOE_MISC = 131072;
struct MoeUnit { const float* wg; const float* wu; const float* wd; int nrows; int par; };

__device__ __forceinline__ void phase_moe(const Params& p, const Ctx& c) {
    unsigned char* ws = p.ws;
    const bf16_t* H1 = (const bf16_t*)(ws + WS_H1); bf16_t* Y = (bf16_t*)(ws + WS_Y);
    const unsigned* laid = (const unsigned*)(ws + WS_LAID); const float* lgate = (const float*)(ws + WS_LGATE);
    const unsigned* cnt = (const unsigned*)(ws + WS_CTL + CT_CNT);
    const int tid = c.tid, lane = c.lane, wr = c.wave >> 2, wc = c.wave & 3, fr = lane & 15, fq = lane >> 4;
    LAS unsigned char* lds = c.lds;
    LAS int* tstart = (LAS int*)(lds + MOE_MISC); LAS int* cntl = tstart + 260;
    LAS int* tokT = cntl + 260; LAS int* yrowT = tokT + 256; LAS float* gateT = (LAS float*)(yrowT + 256);
    __syncthreads();
    if (tid < 64) {
        int cv[4], tv[4]; int lt = 0;
#pragma unroll
        for (int i = 0; i < 4; ++i) { cv[i] = (int)cnt[tid * 4 + i]; tv[i] = (cv[i] + 127) >> 7; lt += tv[i]; }
        int pt = lt;
#pragma unroll
        for (int o = 1; o < 64; o <<= 1) { const int b = __shfl_up(pt, o); if (tid >= o) pt += b; }
        int et = pt - lt;
#pragma unroll
        for (int i = 0; i < 4; ++i) { cntl[tid * 4 + i] = cv[i]; tstart[tid * 4 + i] = et; et += tv[i]; }
        if (tid == 63) tstart[256] = et;
    }
    __syncthreads();
    const int tmt = tstart[256], NU = tmt + 128;
    if (c.vcu >= NU) return;

    const int srow = tid >> 3, sch = tid & 7;
    const int soA = srow * 128 + ((sch ^ ((srow >> 1) & 7)) << 4);
    const int kk1 = tid >> 5, n4 = tid & 31;
    const int s1 = (kk1 & 3) | (((kk1 >> 3) & 1) << 2);
    const int soB1g = kk1 * 512 + (((2 * (n4 >> 2)) ^ s1) << 5) + (n4 & 3) * 8;
    const int soB1u = kk1 * 512 + (((2 * (n4 >> 2) + 1) ^ s1) << 5) + (n4 & 3) * 8;
    const int kk2 = tid >> 6, c4 = tid & 63;
    const int soB2e = kk2 * 512 + ((((c4 >> 2)) ^ (kk2 & 3)) << 5) + (c4 & 3) * 8;
    const int soB2o = kk2 * 512 + ((((c4 >> 2)) ^ ((kk2 & 3) | 4)) << 5) + (c4 & 3) * 8;
    const int sw0 = ((0 + fq) ^ ((fr >> 1) & 7)) << 4, sw1 = ((4 + fq) ^ ((fr >> 1) & 7)) << 4;
    const int aoff = (wr * 64 + fr) * 128;
    const int qp = fr >> 2, pp = fr & 3, sB = qp | ((fq & 1) << 2);
    const int brow = (8 * fq + qp) * 512 + pp * 8;
    int bblk[4];
#pragma unroll
    for (int ni = 0; ni < 4; ++ni) bblk[ni] = ((4 * wc + ni) ^ sB) << 5;
    const int hoff = (wr * 64 + fr) * 256;

    const unsigned lo1 = (unsigned)(kk1 * 256 + n4 * 4), lo2 = (unsigned)(kk2 * D + c4 * 4);
    u32x4 ra0, ra1; f32x4 rb[8];
    f32x4 acc[4][4];

#define M_LOAD1(U, nt, kt) do { \
        const int t0_ = tokT[(U).par * 128 + srow], t1_ = tokT[(U).par * 128 + srow + 64]; \
        ra0 = *(const u32x4*)(H1 + (size_t)t0_ * D + (kt) * 64 + sch * 8); ra1 = *(const u32x4*)(H1 + (size_t)t1_ * D + (kt) * 64 + sch * 8); \
        const float* g_ = (U).wg + ((kt) * 64 * 256 + (nt) * 128); const float* u_ = (U).wu + ((kt) * 64 * 256 + (nt) * 128); \
        _Pragma("unroll") for (int j = 0; j < 4; ++j) { rb[j] = *(const f32x4*)(g_ + j * 4096 + lo1); rb[4 + j] = *(const f32x4*)(u_ + j * 4096 + lo1); } } while (0)
#define M_STORE1(buf) do { LAS unsigned char* sa_ = lds + MOE_A + (buf) * 16384; LAS unsigned char* sb_ = lds + MOE_B + (buf) * 32768; \
        *(LAS u32x4*)(sa_ + soA) = ra0; *(LAS u32x4*)(sa_ + soA + 8192) = ra1; \
        _Pragma("unroll") for (int j = 0; j < 4; ++j) { \
            *(LAS u32x2*)(sb_ + soB1g + j * 8192) = (u32x2){cvtpk(rb[j][0], rb[j][1]), cvtpk(rb[j][2], rb[j][3])}; \
            *(LAS u32x2*)(sb_ + soB1u + j * 8192) = (u32x2){cvtpk(rb[4 + j][0], rb[4 + j][1]), cvtpk(rb[4 + j][2], rb[4 + j][3])}; } } while (0)
#define M_LOAD2(U, nt2, ksm) do { \
        const float* d_ = (U).wd + ((ksm) * 64 * D + (nt2) * 256); \
        _Pragma("unroll") for (int j = 0; j < 8; ++j) rb[j] = *(const f32x4*)(d_ + j * 8192 + lo2); } while (0)
#define M_STORE2(buf) do { LAS unsigned char* sb_ = lds + MOE_B + (buf) * 32768; \
        _Pragma("unroll") for (int j = 0; j < 8; ++j) \
            *(LAS u32x2*)(sb_ + ((j & 1) ? soB2o : soB2e) + j * 4096) = (u32x2){cvtpk(rb[j][0], rb[j][1]), cvtpk(rb[j][2], rb[j][3])}; } while (0)
#define M_BFRAG(dst, sbB, ks) do { _Pragma("unroll") for (int ni = 0; ni < 4; ++ni) { \
            const s16x4 lo_ = vtr((sbB) + brow + (ks) * 16384 + bblk[ni]), hi_ = vtr((sbB) + brow + (ks) * 16384 + 2048 + bblk[ni]); \
            dst[ni] = (bf16x8){lo_[0], lo_[1], lo_[2], lo_[3], hi_[0], hi_[1], hi_[2], hi_[3]}; } } while (0)
#define M_COMPUTE1(buf) do { const LAS unsigned char* sa_ = lds + MOE_A + (buf) * 16384; const LAS unsigned char* sbb_ = lds + MOE_B + (buf) * 32768; \
        _Pragma("unroll") for (int ks = 0; ks < 2; ++ks) { bf16x8 af[4], bfr[4]; \
            _Pragma("unroll") for (int mi = 0; mi < 4; ++mi) af[mi] = *(const LAS bf16x8*)(sa_ + aoff + mi * 2048 + (ks ? sw1 : sw0)); \
            M_BFRAG(bfr, sbb_, ks); \
            _Pragma("unroll") for (int mi = 0; mi < 4; ++mi) _Pragma("unroll") for (int ni = 0; ni < 4; ++ni) \
                acc[mi][ni] = __builtin_amdgcn_mfma_f32_16x16x32_bf16(bfr[ni], af[mi], acc[mi][ni], 0, 0, 0); } } while (0)
#define M_COMPUTE2(buf, ksm) do { const LAS unsigned char* sh_ = lds + (((ksm) >> 1) ? MOE_H1 : MOE_H0); const LAS unsigned char* sbb_ = lds + MOE_B + (buf) * 32768; \
        _Pragma("unroll") for (int ks = 0; ks < 2; ++ks) { bf16x8 af[4], bfr[4]; \
            _Pragma("unroll") for (int mi = 0; mi < 4; ++mi) af[mi] = *(const LAS bf16x8*)(sh_ + hoff + mi * 4096 + (((((ksm) & 1) * 8 + ks * 4 + fq) ^ fr) << 4)); \
            M_BFRAG(bfr, sbb_, ks); \
            _Pragma("unroll") for (int mi = 0; mi < 4; ++mi) _Pragma("unroll") for (int ni = 0; ni < 4; ++ni) \
                acc[mi][ni] = __builtin_amdgcn_mfma_f32_16x16x32_bf16(bfr[ni], af[mi], acc[mi][ni], 0, 0, 0); } } while (0)

    auto unit_make = [&](int u, int par, MoeUnit& U, int& e, int& mt) {
        if (u < tmt) { e = moe_find_l(tstart, u); mt = u - tstart[e]; U.nrows = min(128, cntl[e] - mt * 128);
            U.wg = p.w_gate + (size_t)e * D * DEXP; U.wu = p.w_up + (size_t)e * D * DEXP; U.wd = p.w_down + (size_t)e * D * DEXP; }
        else { e = NEXP; mt = u - tmt; U.nrows = 128; U.wg = p.ws_gate; U.wu = p.ws_up; U.wd = p.ws_down; }
        U.par = par;
    };
    auto unit_tables = [&](const MoeUnit& U, int e, int mt) {
        if (tid < 128) {
            int tok, yr; float gt;
            if (e < NEXP) { const int rr = min(tid, U.nrows - 1); const unsigned aid = laid[(size_t)e * CAP + mt * 128 + rr];
                tok = (int)(aid >> 3); yr = tok * 9 + (int)(aid & 7); gt = lgate[(size_t)e * CAP + mt * 128 + rr]; }
            else { tok = mt * 128 + tid; yr = tok * 9 + 8; gt = 1.f; }
            tokT[U.par * 128 + tid] = tok; yrowT[U.par * 128 + tid] = yr; gateT[U.par * 128 + tid] = gt;
        }
    };

    MoeUnit cur, nxt; int e_, mt_;
    unit_make(c.vcu, 0, cur, e_, mt_);
    unit_tables(cur, e_, mt_);
    __syncthreads();
    M_LOAD1(cur, 0, 0);
    M_STORE1(0);
    __syncthreads();
    for (int u = c.vcu, ui = 0; u < NU; u += c.G, ++ui) {
        const bool has_next = (u + c.G) < NU;
#pragma unroll 1
        for (int nt = 0; nt < 2; ++nt) {
            acc_zero(acc);
#pragma unroll 1
            for (int kt = 0; kt < 16; ++kt) {
                const bool last = (kt == 15);
                if (!last) M_LOAD1(cur, nt, kt + 1);
                else if (nt == 0) M_LOAD1(cur, 1, 0);
                else M_LOAD2(cur, 0, 2);
                M_COMPUTE1(kt & 1);
                if (!(last && nt == 1)) M_STORE1((kt + 1) & 1); else M_STORE2(0);
                __syncthreads();
            }
            {
                LAS unsigned char* hb = lds + (nt ? MOE_H1 : MOE_H0);
#pragma unroll
                for (int mi = 0; mi < 4; ++mi) {
                    const int r = wr * 64 + mi * 16 + fr;
#pragma unroll
                    for (int np = 0; np < 2; ++np) {
                        const f32x4 gt = acc[mi][2 * np], up = acc[mi][2 * np + 1];
                        float hv[4];
#pragma unroll
                        for (int j = 0; j < 4; ++j) hv[j] = gt[j] / (1.f + __expf(-gt[j])) * up[j];
                        const int chunk = wc * 4 + np * 2 + (fq >> 1);
                        *(LAS u32x2*)(hb + r * 256 + ((chunk ^ fr) << 4) + (fq & 1) * 8) = (u32x2){cvtpk(hv[0], hv[1]), cvtpk(hv[2], hv[3])};
                    }
                }
            }
            if (nt == 1) __syncthreads();
        }
#pragma unroll 1
        for (int nt2 = 0; nt2 < 4; ++nt2) {
            acc_zero(acc);
            if (nt2 == 0 && has_next) { unit_make(u + c.G, (ui + 1) & 1, nxt, e_, mt_); unit_tables(nxt, e_, mt_); }
#pragma unroll 1
            for (int kq = 0; kq < 4; ++kq) {
                const int ksm = kq ^ 2;
                const bool last = (kq == 3);
                if (!last) M_LOAD2(cur, nt2, (kq + 1) ^ 2);
                else if (nt2 < 3) M_LOAD2(cur, nt2 + 1, 2);
                else if (has_next) M_LOAD1(nxt, 0, 0);
                M_COMPUTE2(kq & 1, ksm);
                if (!(last && nt2 == 3)) M_STORE2((kq + 1) & 1); else if (has_next) M_STORE1(0);
                __syncthreads();
            }
#pragma unroll
            for (int mi = 0; mi < 4; ++mi) {
                const int r = wr * 64 + mi * 16 + fr;
                if (r < cur.nrows) {
                    const float gt = gateT[cur.par * 128 + r]; const size_t yrow = (size_t)yrowT[cur.par * 128 + r];
#pragma unroll
                    for (int ni = 0; ni < 4; ++ni) store_bf4(Y + yrow * D + nt2 * 256 + wc * 64 + ni * 16 + fq * 4, acc[mi][ni] * gt);
                }
            }
        }
        cur = nxt;
    }
#undef M_LOAD1
#undef M_STORE1
#undef M_LOAD2
#undef M_STORE2
#undef M_BFRAG
#undef M_COMPUTE1
#undef M_COMPUTE2
}


__device__ __forceinline__ void store_blk32_bf16(bf16_t* p, const f32x16& v, int hi, bool pred = true) {
#pragma unroll
    for (int pr = 0; pr < 2; ++pr) {
        unsigned ax = cvtpk(v[8 * pr + 0], v[8 * pr + 1]), ay = cvtpk(v[8 * pr + 2], v[8 * pr + 3]);
        unsigned bx = cvtpk(v[8 * pr + 4], v[8 * pr + 5]), by = cvtpk(v[8 * pr + 6], v[8 * pr + 7]);
        { auto r_ = __builtin_amdgcn_permlane32_swap(ax, bx, false, false); ax = r_[0]; bx = r_[1]; }
        { auto r_ = __builtin_amdgcn_permlane32_swap(ay, by, false, false); ay = r_[0]; by = r_[1]; }
        if (pred) *(u32x4*)(p + 16 * pr + (hi ? 8 : 0)) = (u32x4){ax, ay, bx, by};
    }
}

constexpr int G2_A = 0, G2_B = 65536, G2_MISC = 131072;
constexpr int G2_GATE = G2_MISC + 4096, G2_YROW = G2_GATE + 2048, G2_TAB = G2_YROW + 2048;
constexpr int BM_BF16T = 0, BM_F32 = 1, BM_F32_GU = 2;
struct G2Unit { const void* b0; const void* b1; int ldb; int nsteps; int nrows; int par; int i0, i1, i2; int kshift, bsub; };

#define G2_SGB(mask, n) __builtin_amdgcn_sched_group_barrier(mask, n, 0)
#define G2_MFMA_BODY(NMI, KM, kh) \
        _Pragma("unroll") for (int kq = 0; kq < 2; ++kq) { const int k16_ = 2 * (kh) + kq; bf16x8 bfr[2]; \
            if (KM) { _Pragma("unroll") for (int ni = 0; ni < 2; ++ni) { const int bb_ = ((4 * wc + 2 * ni + bsel) ^ sB2) << 5; \
                const s16x4 lo_ = vtr(sbb_ + brow + k16_ * 8192 + bb_); const s16x4 hi_ = vtr(sbb_ + brow + k16_ * 8192 + 2048 + bb_); \
                bf16x8 t_; t_[0] = lo_[0]; t_[1] = lo_[1]; t_[2] = lo_[2]; t_[3] = lo_[3]; t_[4] = hi_[0]; t_[5] = hi_[1]; t_[6] = hi_[2]; t_[7] = hi_[3]; bfr[ni] = t_; } } \
            else { _Pragma("unroll") for (int ni = 0; ni < 2; ++ni) bfr[ni] = *(const LAS bf16x8*)(sbb_ + boffT + ni * 4096 + (((2 * k16_ + hi) ^ swx) << 4)); } \
            _Pragma("unroll") for (int mi = 0; mi < (NMI); ++mi) { \
                const bf16x8 af_ = *(const LAS bf16x8*)(sa_ + aoff + mi * 8192 + (((2 * k16_ + hi) ^ swx) << 4)); \
                _Pragma("unroll") for (int ni = 0; ni < 2; ++ni) acc[mi][ni] = __builtin_amdgcn_mfma_f32_32x32x16_bf16(bfr[ni], af_, acc[mi][ni], 0, 0, 0); } }
#define G2_MFMA_HALF(NMI, KM, kh) do { \
        __builtin_amdgcn_sched_barrier(0); \
        G2_MFMA_BODY(NMI, KM, kh) \
        if (!(KM)) { _Pragma("unroll") for (int kq = 0; kq < 2; ++kq) { G2_SGB(0x100, 3); \
            _Pragma("unroll") for (int g = 0; g < (NMI) - 1; ++g) { G2_SGB(0x100, 1); G2_SGB(0x008, 2); } \
            G2_SGB(0x008, 2); } } \
        __builtin_amdgcn_sched_barrier(0); \
    } while (0)
#define G2_MFMA_KQ(NMI, k16_) do { bf16x8 bfr[2]; \
            _Pragma("unroll") for (int ni = 0; ni < 2; ++ni) { const int bb_ = ((4 * wc + 2 * ni + bsel) ^ sB2) << 5; \
                const s16x4 lo_ = vtr(sbb_ + brow + (k16_) * 8192 + bb_); const s16x4 hi_ = vtr(sbb_ + brow + (k16_) * 8192 + 2048 + bb_); \
                bf16x8 t_; t_[0] = lo_[0]; t_[1] = lo_[1]; t_[2] = lo_[2]; t_[3] = lo_[3]; t_[4] = hi_[0]; t_[5] = hi_[1]; t_[6] = hi_[2]; t_[7] = hi_[3]; bfr[ni] = t_; } \
            _Pragma("unroll") for (int mi = 0; mi < (NMI); ++mi) { \
                const bf16x8 af_ = *(const LAS bf16x8*)(sa_ + aoff + mi * 8192 + (((2 * (k16_) + hi) ^ swx) << 4)); \
                _Pragma("unroll") for (int ni = 0; ni < 2; ++ni) acc[mi][ni] = __builtin_amdgcn_mfma_f32_32x32x16_bf16(bfr[ni], af_, acc[mi][ni], 0, 0, 0); } } while (0)
#define G2_SEL(off) const int nst_ = st + (off); const bool wrap_ = nst_ >= cur.nsteps, usen_ = wrap_ && has_next; \
        const void* sb0_ = usen_ ? nxt.b0 : cur.b0; const void* sb1_ = usen_ ? nxt.b1 : cur.b1; const int spar_ = usen_ ? nxt.par : cur.par; \
        const int sk0_ = wrap_ ? (has_next ? nst_ - cur.nsteps : cur.nsteps - 1) : nst_; const int ldb_ = cur.ldb; (void)sb1_; \
        const int ssub_ = sk0_ >> cur.kshift, sk_ = sk0_ - (ssub_ << cur.kshift); const int sboff_ = ssub_ * cur.bsub; (void)sboff_

typedef __amdgpu_buffer_rsrc_t rsrc_t;
__device__ __forceinline__ rsrc_t make_rsrc(const void* p) {
    const unsigned long long a = (unsigned long long)(uintptr_t)p;
    const unsigned lo = __builtin_amdgcn_readfirstlane((unsigned)a), hi = __builtin_amdgcn_readfirstlane((unsigned)(a >> 32));
    return __builtin_amdgcn_make_buffer_rsrc((void*)(uintptr_t)(((unsigned long long)hi << 32) | lo), (short)0, 0x7fffffff, 0x00020000);
}
__device__ __forceinline__ u32x4 bload16(rsrc_t r, int voff, int soff) { return __builtin_bit_cast(u32x4, __builtin_amdgcn_raw_buffer_load_b128(r, voff, soff, 0)); }
template <int BMODE, bool FULL, class Sched, class Epi>
__device__ __forceinline__ void gemm256_stream(const Ctx& c, Sched& S, const Epi& E) {
    const int tid = c.tid, lane = c.lane, wr = c.wave >> 2, wc = c.wave & 3, r32 = lane & 31, hi = lane >> 5;
    LAS unsigned char* lds = c.lds;
    const LAS unsigned* rowT = (const LAS unsigned*)(lds + G2_MISC);
    const rsrc_t rsA = make_rsrc(S.abase());
    const int srow = tid >> 3, sch = tid & 7;
    const int soA = srow * 128 + ((sch ^ ((srow >> 1) & 7)) << 4);
    const int kk1 = tid >> 5, n4 = tid & 31;
    const int soB1g = kk1 * 512 + (((2 * (n4 >> 2)) ^ (2 * (kk1 & 3))) << 5) + (n4 & 3) * 8;
    const int soB1u = kk1 * 512 + (((2 * (n4 >> 2) + 1) ^ (2 * (kk1 & 3))) << 5) + (n4 & 3) * 8;
    const int kk2 = tid >> 6, c4 = tid & 63;
    const int soB2 = kk2 * 512 + ((((c4 >> 2)) ^ (2 * (kk2 & 3))) << 5) + (c4 & 3) * 8;
    const int swx = (r32 >> 1) & 7;
    const int aoff = (32 * wr + r32) * 128;
    const int boffT = (wc * 64 + r32) * 128;
    const int qp = (lane & 15) >> 2, pp = lane & 3, bsel = (lane >> 4) & 1, sB2 = 2 * qp;
    const int brow = (8 * hi + qp) * 512 + pp * 8;
    (void)boffT; (void)brow; (void)sB2; (void)bsel; (void)soB1g; (void)soB1u; (void)soB2;
    u32x4 ra[4]; u32x4 rbh[4]; f32x4 rb[8];
    f32x16 acc[4][2];
#define G1_LOAD(b0, b1, par, kst, ldb) do { \
        const LAS unsigned* rt_ = rowT + (par) * 256 + srow; \
        const int ksoff_ = __builtin_amdgcn_readfirstlane((kst) * 128); \
        _Pragma("unroll") for (int j = 0; j < 4; ++j) ra[j] = bload16(rsA, (int)rt_[64 * j] + sch * 16, ksoff_); \
        const rsrc_t rb0_ = make_rsrc(b0); \
        if (BMODE == BM_BF16T) { const int so_ = __builtin_amdgcn_readfirstlane((kst) * 128), js_ = __builtin_amdgcn_readfirstlane(128 * (ldb)); \
            _Pragma("unroll") for (int j = 0; j < 4; ++j) rbh[j] = bload16(rb0_, voB, so_ + j * js_); } \
        else if (BMODE == BM_F32) { const int so_ = __builtin_amdgcn_readfirstlane((kst) * 256 * (ldb)), js_ = __builtin_amdgcn_readfirstlane(32 * (ldb)); \
            _Pragma("unroll") for (int j = 0; j < 8; ++j) rb[j] = __builtin_bit_cast(f32x4, bload16(rb0_, voB, so_ + j * js_)); } \
        else { const rsrc_t rb1_ = make_rsrc(b1); const int so_ = __builtin_amdgcn_readfirstlane((kst) * 256 * (ldb)), js_ = __builtin_amdgcn_readfirstlane(64 * (ldb)); \
            _Pragma("unroll") for (int j = 0; j < 4; ++j) { rb[j] = __builtin_bit_cast(f32x4, bload16(rb0_, voB, so_ + j * js_)); rb[4 + j] = __builtin_bit_cast(f32x4, bload16(rb1_, voB, so_ + j * js_)); } } \
    } while (0)
#define G1_STORE(buf) do { LAS unsigned char* sa_ = lds + G2_A + (buf) * 32768; LAS unsigned char* sb_ = lds + G2_B + (buf) * 32768; \
        _Pragma("unroll") for (int j = 0; j < 4; ++j) *(LAS u32x4*)(sa_ + soA + j * 8192) = ra[j]; \
        if (BMODE == BM_BF16T) { _Pragma("unroll") for (int j = 0; j < 4; ++j) *(LAS u32x4*)(sb_ + soA + j * 8192) = rbh[j]; } \
        else if (BMODE == BM_F32) { _Pragma("unroll") for (int j = 0; j < 8; ++j) \
            *(LAS u32x2*)(sb_ + soB2 + j * 4096) = (u32x2){cvtpk(rb[j][0], rb[j][1]), cvtpk(rb[j][2], rb[j][3])}; } \
        else { _Pragma("unroll") for (int j = 0; j < 4; ++j) { \
            *(LAS u32x2*)(sb_ + soB1g + j * 8192) = (u32x2){cvtpk(rb[j][0], rb[j][1]), cvtpk(rb[j][2], rb[j][3])}; \
            *(LAS u32x2*)(sb_ + soB1u + j * 8192) = (u32x2){cvtpk(rb[4 + j][0], rb[4 + j][1]), cvtpk(rb[4 + j][2], rb[4 + j][3])}; } } \
    } while (0)
    G2Unit cur, nxt;
    if (!S.next(cur, 0)) return;
    nxt = cur;
    const int voB = BMODE == BM_BF16T ? (srow * cur.ldb + sch * 8) * 2 : BMODE == BM_F32 ? (kk2 * cur.ldb + c4 * 4) * 4 : (kk1 * cur.ldb + n4 * 4) * 4;
    __syncthreads();
    G1_LOAD(cur.b0, cur.b1, cur.par, 0, cur.ldb);
    G1_STORE(0);
    G1_LOAD(cur.b0, cur.b1, cur.par, 1, cur.ldb);
    __syncthreads();
    int gs = 0;
    bool has_cur = true;
    while (has_cur) {
#pragma unroll
        for (int a = 0; a < 4; ++a)
#pragma unroll
            for (int b = 0; b < 2; ++b)
#pragma unroll
                for (int r = 0; r < 16; ++r) acc[a][b][r] = 0.f;
        const int nb = (cur.nrows + 31) >> 5, nmi = (nb - wr + 1) >> 1;
        bool has_next = false;
#define G1_UNIT_LOOP(NMI) do { _Pragma("unroll 1") for (int st = 0; st < cur.nsteps; ++st) { \
            if (st == 1) has_next = S.next(nxt, cur.par ^ 1);     \
            if (st == 0) S.issue(); \
            { const LAS unsigned char* sa_ = lds + G2_A + (gs & 1) * 32768; const LAS unsigned char* sbb_ = lds + G2_B + (gs & 1) * 32768; \
              if (BMODE == BM_BF16T) { \
              G2_MFMA_HALF(NMI, false, 0); \
              G1_STORE((gs + 1) & 1);                             \
              __builtin_amdgcn_sched_barrier(0); \
              { G2_SEL(2); G1_LOAD(sb0_, sb1_, spar_, sk_, ldb_); }     \
              G2_MFMA_HALF(NMI, false, 1); } \
              else {                                              \
              G2_SEL(2); \
              const void* pb0_ = (BMODE == BM_F32 ? (const void*)((const float*)sb0_ + sboff_) : sb0_); \
              const LAS unsigned* rt_ = rowT + spar_ * 256 + srow; \
              const int ksoff_ = __builtin_amdgcn_readfirstlane(sk_ * 128); \
              const rsrc_t rb0_ = make_rsrc(pb0_); const rsrc_t rb1_ = make_rsrc(BMODE == BM_F32 ? pb0_ : sb1_); \
              const int so_ = __builtin_amdgcn_readfirstlane(sk_ * 256 * ldb_), js_ = __builtin_amdgcn_readfirstlane((BMODE == BM_F32 ? 32 : 64) * ldb_); \
              LAS unsigned char* wa_ = lds + G2_A + ((gs + 1) & 1) * 32768; LAS unsigned char* wb_ = lds + G2_B + ((gs + 1) & 1) * 32768; \
              _Pragma("unroll") for (int q_ = 0; q_ < 4; ++q_) { \
                  __builtin_amdgcn_sched_barrier(0); \
                  G2_MFMA_KQ(NMI, q_); \
                  *(LAS u32x4*)(wa_ + soA + q_ * 8192) = ra[q_]; \
                  if (BMODE == BM_F32) { _Pragma("unroll") for (int h_ = 0; h_ < 2; ++h_) { const int j_ = 2 * q_ + h_; \
                      *(LAS u32x2*)(wb_ + soB2 + j_ * 4096) = (u32x2){cvtpk(rb[j_][0], rb[j_][1]), cvtpk(rb[j_][2], rb[j_][3])}; } } \
                  else { *(LAS u32x2*)(wb_ + soB1g + q_ * 8192) = (u32x2){cvtpk(rb[q_][0], rb[q_][1]), cvtpk(rb[q_][2], rb[q_][3])}; \
                      *(LAS u32x2*)(wb_ + soB1u + q_ * 8192) = (u32x2){cvtpk(rb[4 + q_][0], rb[4 + q_][1]), cvtpk(rb[4 + q_][2], rb[4 + q_][3])}; } \
                  ra[q_] = bload16(rsA, (int)rt_[64 * q_] + sch * 16, ksoff_); \
                  if (BMODE == BM_F32) { _Pragma("unroll") for (int h_ = 0; h_ < 2; ++h_) { const int j_ = 2 * q_ + h_; rb[j_] = __builtin_bit_cast(f32x4, bload16(rb0_, voB, so_ + j_ * js_)); } } \
                  else { rb[q_] = __builtin_bit_cast(f32x4, bload16(rb0_, voB, so_ + q_ * js_)); rb[4 + q_] = __builtin_bit_cast(f32x4, bload16(rb1_, voB, so_ + q_ * js_)); } \
                  _Pragma("unroll") for (int g_ = 0; g_ < (NMI) - 1; ++g_) { G2_SGB(0x008, 2); G2_SGB(0x200, 1); } \
                  G2_SGB(0x008, 2); G2_SGB(0x200, 3); \
              } \
              __builtin_amdgcn_sched_barrier(0); } } \
            if (st == 0) S.commit(); \
            __syncthreads(); \
            ++gs; \
            if (Epi::HAS_MID) E.mid(acc, cur, st, nmi, wr, r32); } } while (0)
        if (FULL || nmi >= 4) G1_UNIT_LOOP(4); else if (nmi == 3) G1_UNIT_LOOP(3); else if (nmi == 2) G1_UNIT_LOOP(2); else G1_UNIT_LOOP(1);
#undef G1_UNIT_LOOP
        E(acc, cur, nmi, wr, wc, r32, hi);
        cur = nxt; has_cur = has_next;
    }
#undef G1_LOAD
#undef G1_STORE
}

struct MoeSched2 {
    const Params& p; const Ctx& c; int NT; bool isB; int tru, NU, i;
    LAS int* tstart; LAS int* roff; LAS int* cntl; LAS int* rpuT; LAS int* qslot; unsigned* qctr; unsigned pend;
    __device__ __forceinline__ const void* abase() const { return isB ? p.ws + WS_HID : p.ws + WS_H1; }
    __device__ __forceinline__ void issue() { if (c.tid == 0) pend = __hip_atomic_fetch_add(qctr, 1u, __ATOMIC_RELAXED, __HIP_MEMORY_SCOPE_AGENT); }
    __device__ __forceinline__ void commit() { if (c.tid == 0) qslot[0] = (int)(32u + pend); }
    __device__ __forceinline__ MoeSched2(const Params& p_, const Ctx& c_, int NT_, bool isB_) : p(p_), c(c_), NT(NT_), isB(isB_), i(0) {
        tstart = (LAS int*)(c.lds + G2_TAB); roff = tstart + 260; cntl = roff + 260; rpuT = cntl + 260; qslot = rpuT + 260; pend = 0;
        qctr = (unsigned*)(p.ws + WS_CTL + CT_Q) + (isB_ ? 8 * 64 : 0) + (c.vcu >> 5) * 64;
        const unsigned* cnt = (const unsigned*)(p.ws + WS_CTL + CT_CNT);
        __syncthreads();
        if (c.tid < 64) {
            int cv[4], tv[4], rp[4]; int ls = 0, lt = 0;
#pragma unroll
            for (int k = 0; k < 4; ++k) { cv[k] = (int)cnt[c.tid * 4 + k]; tv[k] = (cv[k] + 255) >> 8; rp[k] = tv[k] ? ((((cv[k] + tv[k] - 1) / tv[k]) + 31) & ~31) : 0; ls += cv[k]; lt += tv[k]; }
            int ps = ls, pt = lt;
#pragma unroll
            for (int o = 1; o < 64; o <<= 1) { const int a = __shfl_up(ps, o), b = __shfl_up(pt, o); if (c.tid >= o) { ps += a; pt += b; } }
            int es = ps - ls, et = pt - lt;
#pragma unroll
            for (int k = 0; k < 4; ++k) { cntl[c.tid * 4 + k] = cv[k]; rpuT[c.tid * 4 + k] = rp[k]; roff[c.tid * 4 + k] = es; tstart[c.tid * 4 + k] = et; es += cv[k]; et += tv[k]; }
            if (c.tid == 63) { roff[256] = es; tstart[256] = et; }
        }
        __syncthreads();
        tru = tstart[256]; NU = (tru + 64) * NT;
    }
    __device__ __forceinline__ bool next(G2Unit& U, int par) {
        int tid_ = c.tid; asm volatile("" : "+v"(tid_));
        const int NUx = (NU + 7) >> 3, xg = c.vcu >> 5, pos = (i == 0) ? (c.vcu & 31) : qslot[0]; ++i;
        const int idx = xg * NUx + pos;
        if (pos >= NUx || idx >= NU) return false;
        int e, r0, nrows, nt; size_t hbase, lbase = 0;
        if (idx < tru * NT) { e = __builtin_amdgcn_readfirstlane(moe_find_l(tstart, idx / NT)); const int ts = __builtin_amdgcn_readfirstlane(tstart[e]), nu = __builtin_amdgcn_readfirstlane(tstart[e + 1]) - ts, loc = __builtin_amdgcn_readfirstlane(idx) - ts * NT, rpu = __builtin_amdgcn_readfirstlane(rpuT[e]);
            nt = (nu == 1) ? loc : (nu == 2) ? (loc >> 1) : loc / nu; const int ui = loc - nt * nu;
            r0 = ui * rpu; nrows = min(rpu, cntl[e] - r0); hbase = (size_t)roff[e] + r0; lbase = (size_t)e * CAP + r0; }
        else { const int loc = idx - tru * NT; e = NEXP; nt = loc >> 6; r0 = (loc & 63) * 256; nrows = 256; hbase = (size_t)NTOK * 8 + r0; }
        U.nrows = nrows; U.par = par; U.i0 = (int)hbase; U.i1 = nt; U.i2 = 0; U.kshift = 30; U.bsub = 0;
        const unsigned* laid = (const unsigned*)(p.ws + WS_LAID); const float* lgate = (const float*)(p.ws + WS_LGATE);
        LAS unsigned* rowT = (LAS unsigned*)(c.lds + G2_MISC) + par * 256;
        if (!isB) {
            U.b0 = (e < NEXP ? p.w_gate + (size_t)e * D * DEXP : p.ws_gate) + nt * 128; U.b1 = (e < NEXP ? p.w_up + (size_t)e * D * DEXP : p.ws_up) + nt * 128;
            U.ldb = DEXP; U.nsteps = D / 64;
            if (tid_ < 256) {
                const int rr = min(tid_, nrows - 1);
                const int tok = e < NEXP ? (int)(((const u32x2*)laid)[lbase + rr].x >> 3) : r0 + rr;
                rowT[tid_] = (unsigned)tok * (D * 2);
            }
        } else {
            U.b0 = (e < NEXP ? p.w_down + (size_t)e * DEXP * D : p.ws_down) + nt * 256; U.b1 = nullptr;
            U.ldb = D; U.nsteps = DEXP / 64;
            if (tid_ < 256) {
                const int rr = min(tid_, nrows - 1);
                rowT[tid_] = (unsigned)(hbase + rr) * (DEXP * 2);
                int yr; float gt;
                if (e < NEXP) { const u32x2 le = ((const u32x2*)laid)[lbase + rr]; yr = (int)((le.x >> 3) * 9 + (le.x & 7)); gt = __uint_as_float(le.y); }
                else { yr = (r0 + rr) * 9 + 8; gt = 1.f; }
                ((LAS float*)(c.lds + G2_GATE))[par * 256 + tid_] = gt; ((LAS int*)(c.lds + G2_YROW))[par * 256 + tid_] = yr;
            }
        }
        return true;
    }
};
struct EpiMoeA {
    static constexpr bool HAS_MID = false, HAS_SUB = false;
    bf16_t* HID;
    __device__ __forceinline__ void mid(f32x16 (&)[4][2], const G2Unit&, int, int, int, int) const {}
    __device__ __forceinline__ void operator()(f32x16 (&acc)[4][2], const G2Unit& U, int nmi, int wr, int wc, int r32, int hi) const {
        asm volatile("" : "+v"(r32), "+v"(hi));
#pragma unroll
        for (int mi = 0; mi < 4; ++mi) {
            if (mi < nmi) {
                const int r = 64 * mi + 32 * wr + r32;
#pragma unroll
                for (int ni = 0; ni < 2; ++ni) {
                    float hv[8];
#pragma unroll
                    for (int q = 0; q < 8; ++q) { const float gt = acc[mi][ni][q], up = acc[mi][ni][q + 8]; hv[q] = gt * __builtin_amdgcn_rcpf(1.f + __builtin_amdgcn_exp2f(-1.4426950408889634f * gt)) * up; }
                    unsigned ax = cvtpk(hv[0], hv[1]), ay = cvtpk(hv[2], hv[3]), bx = cvtpk(hv[4], hv[5]), by = cvtpk(hv[6], hv[7]);
                    { auto r_ = __builtin_amdgcn_permlane32_swap(ax, bx, false, false); ax = r_[0]; bx = r_[1]; }
                    { auto r_ = __builtin_amdgcn_permlane32_swap(ay, by, false, false); ay = r_[0]; by = r_[1]; }
                    if (r < U.nrows) *(u32x4*)(HID + ((size_t)U.i0 + r) * DEXP + U.i1 * 128 + (2 * wc + ni) * 16 + (hi ? 8 : 0)) = (u32x4){ax, ay, bx, by};
                }
            }
        }
    }
};
constexpr float Y8_SCALE = 64.f;
struct EpiMoeB {
    static constexpr bool HAS_MID = false, HAS_SUB = false;
    unsigned char* Y8; const LAS float* gateT; const LAS int* yrowT;
    __device__ __forceinline__ void mid(f32x16 (&)[4][2], const G2Unit&, int, int, int, int) const {}
    __device__ __forceinline__ void operator()(f32x16 (&acc)[4][2], const G2Unit& U, int nmi, int wr, int wc, int r32, int hi) const {
        asm volatile("" : "+v"(r32), "+v"(hi));
#pragma unroll
        for (int mi = 0; mi < 4; ++mi) {
            if (mi < nmi) {
                const int r = 64 * mi + 32 * wr + r32;
                const float gt = gateT[U.par * 256 + r] * Y8_SCALE; const size_t yrow = (size_t)yrowT[U.par * 256 + r];
#pragma unroll
                for (int ni = 0; ni < 2; ++ni) {
                    unsigned d[4];
#pragma unroll
                    for (int g = 0; g < 4; ++g) {
                        int wv = __builtin_amdgcn_cvt_pk_fp8_f32(acc[mi][ni][4 * g] * gt, acc[mi][ni][4 * g + 1] * gt, 0, false);
                        wv = __builtin_amdgcn_cvt_pk_fp8_f32(acc[mi][ni][4 * g + 2] * gt, acc[mi][ni][4 * g + 3] * gt, wv, true);
                        d[g] = (unsigned)wv;
                    }
                    { auto r_ = __builtin_amdgcn_permlane32_swap(d[0], d[1], false, false); d[0] = r_[0]; d[1] = r_[1]; }
                    { auto r_ = __builtin_amdgcn_permlane32_swap(d[2], d[3], false, false); d[2] = r_[0]; d[3] = r_[1]; }
                    { auto r_ = __builtin_amdgcn_permlane32_swap(d[0], d[2], false, false); d[0] = r_[0]; d[2] = r_[1]; }
                    { auto r_ = __builtin_amdgcn_permlane32_swap(d[1], d[3], false, false); d[1] = r_[0]; d[3] = r_[1]; }
                    if (r < U.nrows) *(u32x4*)(Y8 + yrow * D + U.i1 * 256 + wc * 64 + ni * 32 + (hi ? 16 : 0)) = (u32x4){d[0], d[1], d[2], d[3]};
                }
            }
        }
    }
};
__device__ __forceinline__ void phase_moeA(const Params& p, const Ctx& c) {
    MoeSched2 S(p, c, 2, false);
    EpiMoeA E{(bf16_t*)(p.ws + WS_HID)};
    gemm256_stream<BM_F32_GU, true>(c, S, E);
}
__device__ __forceinline__ void phase_moeB(const Params& p, const Ctx& c) {
    MoeSched2 S(p, c, 4, true);
    EpiMoeB E{(unsigned char*)(p.ws + WS_Y), (const LAS float*)(c.lds + G2_GATE), (const LAS int*)(c.lds + G2_YROW)};
    gemm256_stream<BM_F32, true>(c, S, E);
}


struct Sched1 {
    const Params& p; const Ctx& c; int i;
    __device__ __forceinline__ const void* abase() const { return p.ws + WS_H0; }
    __device__ __forceinline__ void issue() {}
    __device__ __forceinline__ void commit() {}
    __device__ __forceinline__ bool next(G2Unit& U, int par) {
        int mt, nt, row0, nrows;
        if (i < 2) { const int idx = c.vcu + 256 * i; mt = idx / 9; nt = idx - mt * 9; row0 = mt * 256; nrows = 256; }
        else if (i == 2 && c.vcu < 137) {
            if (c.vcu < 128) { const int idx = 512 + (c.vcu >> 1); mt = idx / 9; nt = idx - mt * 9; row0 = mt * 256 + (c.vcu & 1) * 128; nrows = 128; }
            else { mt = 64; nt = c.vcu - 128; row0 = NTOK; nrows = NMETA; }
        } else return false;
        ++i;
        U.b0 = (const bf16_t*)(p.ws + WS_WIN) + (size_t)nt * 256 * D; U.b1 = nullptr; U.ldb = D; U.nsteps = D / 64; U.nrows = nrows; U.par = par; U.i0 = row0; U.i1 = nt; U.i2 = 0; U.kshift = 30; U.bsub = 0;
        if (c.tid < 256) ((LAS unsigned*)(c.lds + G2_MISC))[par * 256 + c.tid] = (unsigned)(row0 + min(c.tid, nrows - 1)) * (D * 2);
        return true;
    }
};
struct Epi1 {
    static constexpr bool HAS_MID = false, HAS_SUB = false;
    bf16_t* Z; float* psq;
    __device__ __forceinline__ void mid(f32x16 (&)[4][2], const G2Unit&, int, int, int, int) const {}
    __device__ __forceinline__ void operator()(f32x16 (&acc)[4][2], const G2Unit& U, int nmi, int wr, int wc, int r32, int hi) const {
        asm volatile("" : "+v"(r32), "+v"(hi));
        const int s0 = U.i1 * 256 + wc * 64;
#pragma unroll
        for (int mi = 0; mi < 4; ++mi) {
            if (mi < nmi) {
                const int r = 64 * mi + 32 * wr + r32, row = U.i0 + min(r, U.nrows - 1);
                float ss = 0.f;
#pragma unroll
                for (int ni = 0; ni < 2; ++ni) {
                    store_blk32_bf16(Z + (size_t)row * ZC + s0 + ni * 32, acc[mi][ni], hi, r < U.nrows);
#pragma unroll
                    for (int q = 0; q < 16; ++q) ss += acc[mi][ni][q] * acc[mi][ni][q];
                }
                if (s0 < ZKPE) {
                    ss += __shfl_xor(ss, 32);
                    if (hi == 0 && r < U.nrows) psq[(size_t)row * 16 + (s0 >> 6)] = ss;
                }
            }
        }
    }
};
__device__ __forceinline__ void phase1_g2(const Params& p, const Ctx& c) {
    Sched1 S{p, c, 0};
    Epi1 E{(bf16_t*)(p.ws + WS_Z), (float*)(p.ws + WS_PSQ)};
    gemm256_stream<BM_BF16T, false>(c, S, E);
}

struct Sched4 {
    const Params& p; const Ctx& c; int i;
    __device__ __forceinline__ const void* abase() const { return p.ws + WS_ATT; }
    __device__ __forceinline__ void issue() {}
    __device__ __forceinline__ void commit() {}
    __device__ __forceinline__ bool next(G2Unit& U, int par) {
        const int idx = c.vcu + i * c.G; ++i;
        if (idx >= 256) return false;
        const int mt = idx >> 2, nt = idx & 3, row0 = mt * 256;
        U.b0 = (const bf16_t*)(p.ws + WS_WO) + (size_t)nt * 256 * D; U.b1 = nullptr; U.ldb = D; U.nsteps = D / 64; U.nrows = 256; U.par = par; U.i0 = row0; U.i1 = nt; U.i2 = 0; U.kshift = 30; U.bsub = 0;
        if (c.tid < 256) {
            const int row = row0 + c.tid;
            ((LAS unsigned*)(c.lds + G2_MISC))[par * 256 + c.tid] = (unsigned)row * (D * 2);
            const float* patt = (const float*)(p.ws + WS_PATT);
            const f32x4 pa = *(const f32x4*)(patt + (size_t)row * 8), pb = *(const f32x4*)(patt + (size_t)row * 8 + 4);
            const float ra = rsqrtf((((pa[0] + pa[1]) + (pa[2] + pa[3])) + ((pb[0] + pb[1]) + (pb[2] + pb[3]))) * (1.f / 512) + 1e-6f);
            const float rc = rsqrtf(((const float*)(p.ws + WS_SSQC))[row] * (1.f / 512) + 1e-6f);
            ((LAS float*)(c.lds + G2_GATE))[par * 256 + c.tid] = ra / rc; ((LAS float*)(c.lds + G2_YROW))[par * 256 + c.tid] = rc;
        }
        return true;
    }
};
struct Epi4 {
    static constexpr bool HAS_MID = true, HAS_SUB = false;
    const LAS float* fT; const LAS float* rcT; const bf16_t* H0; bf16_t* Y1; float* pst;
    __device__ __forceinline__ void mid(f32x16 (&acc)[4][2], const G2Unit& U, int st, int nmi, int wr, int r32) const {
        if (st != 7) return;
#pragma unroll
        for (int mi = 0; mi < 4; ++mi) {
            const float f = fT[U.par * 256 + 64 * mi + 32 * wr + r32];
#pragma unroll
            for (int ni = 0; ni < 2; ++ni)
#pragma unroll
                for (int q = 0; q < 16; ++q) acc[mi][ni][q] *= f;
        }
    }
    __device__ __forceinline__ void operator()(f32x16 (&acc)[4][2], const G2Unit& U, int nmi, int wr, int wc, int r32, int hi) const {
        asm volatile("" : "+v"(r32), "+v"(hi));
        const int s0 = U.i1 * 256 + wc * 64;
#pragma unroll
        for (int mi = 0; mi < 4; ++mi) {
            const int r = 64 * mi + 32 * wr + r32, row = U.i0 + r;
            const float rc = rcT[U.par * 256 + r];
            float s = 0.f, ss = 0.f;
#pragma unroll
            for (int ni = 0; ni < 2; ++ni) {
                f32x16 v;
#pragma unroll
                for (int g = 0; g < 4; ++g) {
                    const u32x2 hw = *(const u32x2*)(H0 + (size_t)row * D + s0 + ni * 32 + 8 * g + 4 * hi);
                    v[4 * g + 0] = acc[mi][ni][4 * g + 0] * rc + ALPHA * bflo(hw.x); v[4 * g + 1] = acc[mi][ni][4 * g + 1] * rc + ALPHA * bfhi(hw.x);
                    v[4 * g + 2] = acc[mi][ni][4 * g + 2] * rc + ALPHA * bflo(hw.y); v[4 * g + 3] = acc[mi][ni][4 * g + 3] * rc + ALPHA * bfhi(hw.y);
                }
#pragma unroll
                for (int q = 0; q < 16; ++q) { s += v[q]; ss += v[q] * v[q]; }
                store_blk32_bf16(Y1 + (size_t)row * D + s0 + ni * 32, v, hi);
            }
            s += __shfl_xor(s, 32); ss += __shfl_xor(ss, 32);
            if (hi == 0) { float* q = pst + ((size_t)row * 16 + U.i1 * 4 + wc) * 2; q[0] = s; q[1] = ss; }
        }
    }
};
__device__ __forceinline__ void phase4_g2(const Params& p, const Ctx& c) {
    Sched4 S{p, c, 0};
    Epi4 E{(const LAS float*)(c.lds + G2_GATE), (const LAS float*)(c.lds + G2_YROW), (const bf16_t*)(p.ws + WS_H0), (bf16_t*)(p.ws + WS_Y1), (float*)(p.ws + WS_PST)};
    gemm256_stream<BM_BF16T, true>(c, S, E);
}


struct Sched2 {
    const Params& p; const Ctx& c; int i; bool kv;
    __device__ __forceinline__ const void* abase() const { return p.ws + WS_Z; }
    __device__ __forceinline__ void issue() {}
    __device__ __forceinline__ void commit() {}
    __device__ __forceinline__ bool next(G2Unit& U, int par) {
        const int NT = kv ? 4 : 3, NU = kv ? 65 * 4 : 64 * 3;
        const int idx = (kv ? ((c.vcu + 64) & 255) : c.vcu) + i * 256; ++i;
        if (idx >= NU) return false;
        const int mt = idx / NT, nt = idx - mt * NT, row0 = mt * 256, nrows = min(256, (kv ? NROWS : NTOK) - row0);
        const int K = kv ? KVLORA : QLORA;
        U.b0 = (const bf16_t*)(p.ws + (kv ? WS_WUKV : WS_WUQ)) + (size_t)nt * 256 * K; U.b1 = nullptr; U.ldb = K; U.nsteps = K / 64; U.nrows = nrows; U.par = par;
        U.i0 = row0; U.i1 = nt; U.i2 = 0; U.kshift = 30; U.bsub = 0;
        if (c.tid < 256) ((LAS unsigned*)(c.lds + G2_MISC))[par * 256 + c.tid] = (unsigned)(row0 + min(c.tid, nrows - 1)) * (ZC * 2) + (kv ? ZKV : ZQ) * 2;
        return true;
    }
};
struct Epi2q {
    static constexpr bool HAS_MID = false, HAS_SUB = false;
    const float* psq; const float* rope; bf16_t* Q;
    __device__ __forceinline__ void mid(f32x16 (&)[4][2], const G2Unit&, int, int, int, int) const {}
    __device__ __forceinline__ void operator()(f32x16 (&acc)[4][2], const G2Unit& U, int nmi, int wr, int wc, int r32, int hi) const {
        asm volatile("" : "+v"(r32), "+v"(hi));
#pragma unroll
        for (int mi = 0; mi < 4; ++mi) {
            const int row = U.i0 + 64 * mi + 32 * wr + r32;
            const f32x4 pa = *(const f32x4*)(psq + (size_t)row * 16), pb = *(const f32x4*)(psq + (size_t)row * 16 + 4);
            const float rq = rsqrtf((((pa[0] + pa[1]) + (pa[2] + pa[3])) + (pb[0] + pb[1])) * (1.f / QLORA) + 1e-6f) * QSCALE;
            const int pos = NMETA + (row & (SEQ - 1));
#pragma unroll
            for (int ni = 0; ni < 2; ++ni) {
                const int c0 = U.i1 * 256 + wc * 64 + ni * 32;
                f32x16 v = acc[mi][ni];
#pragma unroll
                for (int q = 0; q < 16; ++q) v[q] *= rq;
                if ((c0 % 96) == 64) {
#pragma unroll
                    for (int g = 0; g < 2; ++g) {
                        const float* rp = rope + ((size_t)pos * 16 + 8 * g + 4 * hi) * 2;
                        const f32x4 cs0 = *(const f32x4*)rp, cs1 = *(const f32x4*)(rp + 4);
                        const float co[4] = {cs0[0], cs0[2], cs1[0], cs1[2]}, si[4] = {cs0[1], cs0[3], cs1[1], cs1[3]};
#pragma unroll
                        for (int j = 0; j < 4; ++j) { const float x1 = v[4 * g + j], x2 = v[4 * g + j + 8]; v[4 * g + j] = x1 * co[j] - x2 * si[j]; v[4 * g + j + 8] = x2 * co[j] + x1 * si[j]; }
                    }
                }
                store_blk32_bf16(Q + (size_t)row * 768 + c0, v, hi);
            }
        }
    }
};
struct Epi2kv {
    static constexpr bool HAS_MID = false, HAS_SUB = false;
    const float* psq; bf16_t* Kb; bf16_t* Vb;
    __device__ __forceinline__ void mid(f32x16 (&)[4][2], const G2Unit&, int, int, int, int) const {}
    __device__ __forceinline__ void operator()(f32x16 (&acc)[4][2], const G2Unit& U, int nmi, int wr, int wc, int r32, int hi) const {
        asm volatile("" : "+v"(r32), "+v"(hi));
        const int s0 = U.i1 * 256 + wc * 64, h = s0 >> 7; const bool isv = (s0 & 64) != 0;
#pragma unroll
        for (int mi = 0; mi < 4; ++mi) {
            if (mi < nmi) {
                const int r = 64 * mi + 32 * wr + r32, row = U.i0 + min(r, U.nrows - 1);
                const f32x4 pa = *(const f32x4*)(psq + (size_t)row * 16 + 4), pb = *(const f32x4*)(psq + (size_t)row * 16 + 8);
                const float rk = rsqrtf(((pa[2] + pa[3]) + (pb[0] + pb[1])) * (1.f / KVLORA) + 1e-6f);
                const bool meta = U.i0 >= NTOK;
                const int ncopy = meta ? NBATCH : 1;
                const int pos = meta ? row - NTOK : NMETA + (row & (SEQ - 1));
#pragma unroll
                for (int ni = 0; ni < 2; ++ni) {
                    f32x16 v = acc[mi][ni];
#pragma unroll
                    for (int q = 0; q < 16; ++q) v[q] *= rk;
                    for (int bb = 0; bb < ncopy; ++bb) {
                        const size_t prow = (size_t)(meta ? bb : (row >> 11)) * LPOS + pos;
                        bf16_t* dst = isv ? Vb + prow * 512 + h * 64 + ni * 32 : Kb + prow * 768 + h * 96 + ni * 32;
                        store_blk32_bf16(dst, v, hi, r < U.nrows);
                    }
                }
            }
        }
    }
};

__device__ __forceinline__ void phase2_gemms(const Params& p, const Ctx& c) {
    { Sched2 S{p, c, 0, false}; Epi2q E{(const float*)(p.ws + WS_PSQ), (const float*)(p.ws + WS_ROPE), (bf16_t*)(p.ws + WS_Q)}; gemm256_stream<BM_BF16T, true>(c, S, E); }
    __syncthreads();
    { Sched2 S{p, c, 0, true}; Epi2kv E{(const float*)(p.ws + WS_PSQ), (bf16_t*)(p.ws + WS_K), (bf16_t*)(p.ws + WS_V)}; gemm256_stream<BM_BF16T, false>(c, S, E); }
}

__device__ __forceinline__ void phase8(const Params& p, const Ctx& c) {
    unsigned char* ws = p.ws;
    const bf16_t* H1 = (const bf16_t*)(ws + WS_H1); const unsigned char* Y8 = (const unsigned char*)(ws + WS_Y);
    const int gw = c.vcu * NWAVES + c.wave, NGW = c.G * NWAVES, lane = c.lane;
    const int col = lane * 16;
    float gg[16], bb[16];
#pragma unroll
    for (int e = 0; e < 4; ++e) { const f32x4 g4 = *(const f32x4*)(p.ln2_g + col + 4 * e), b4 = *(const f32x4*)(p.ln2_b + col + 4 * e);
#pragma unroll
        for (int q = 0; q < 4; ++q) { gg[4 * e + q] = g4[q]; bb[4 * e + q] = b4[q]; } }
    for (int t = gw; t < NTOK; t += NGW) {
        float v[16], y[16];
        const u32x4 w0 = *(const u32x4*)(H1 + (size_t)t * D + col), w1 = *(const u32x4*)(H1 + (size_t)t * D + col + 8);
#pragma unroll
        for (int e = 0; e < 4; ++e) { v[2 * e] = ALPHA * bflo(w0[e]); v[2 * e + 1] = ALPHA * bfhi(w0[e]); v[8 + 2 * e] = ALPHA * bflo(w1[e]); v[8 + 2 * e + 1] = ALPHA * bfhi(w1[e]); }
#pragma unroll
        for (int e = 0; e < 16; ++e) y[e] = 0.f;
#pragma unroll
        for (int k = 0; k < 9; ++k) {
            const u32x4 yw = *(const u32x4*)(Y8 + ((size_t)t * 9 + k) * D + col);
#pragma unroll
            for (int e = 0; e < 4; ++e) {
                const f32x2 lo = __builtin_amdgcn_cvt_pk_f32_fp8((int)yw[e], false), hi2 = __builtin_amdgcn_cvt_pk_f32_fp8((int)yw[e], true);
                y[4 * e] += lo[0]; y[4 * e + 1] += lo[1]; y[4 * e + 2] += hi2[0]; y[4 * e + 3] += hi2[1];
            }
        }
        float s = 0.f;
#pragma unroll
        for (int e = 0; e < 16; ++e) { v[e] += y[e] * (1.f / Y8_SCALE); s += v[e]; }
        const float mean = wave_sum(s) * (1.f / D);
        float ss = 0.f;
#pragma unroll
        for (int e = 0; e < 16; ++e) { v[e] -= mean; ss += v[e] * v[e]; }
        const float rstd = rsqrtf(wave_sum(ss) * (1.f / D) + 1e-5f);
#pragma unroll
        for (int e = 0; e < 4; ++e) {
            f32x4 o;
#pragma unroll
            for (int q = 0; q < 4; ++q) o[q] = v[4 * e + q] * rstd * gg[4 * e + q] + bb[4 * e + q];
            *(f32x4*)(p.out + (size_t)t * D + col + 4 * e) = o;
        }
    }
}


#define XB_TMO      128
#define XB_XCNT(j)  (256  + 64 * (j))
#define XB_XSUB(j)  (1280 + 64 * (j))
#define XB_XGEN(j)  (2304 + 64 * (j))
#define XB_TOP      3328
#define XB_TOPGEN   3392
#define XB_SPIN_CAP (1u << 22)
__device__ __forceinline__ unsigned xb_ld(unsigned* p)              { return __hip_atomic_load(p, __ATOMIC_RELAXED, __HIP_MEMORY_SCOPE_AGENT); }
__device__ __forceinline__ unsigned xb_add(unsigned* p, unsigned v) { return __hip_atomic_fetch_add(p, v, __ATOMIC_RELAXED, __HIP_MEMORY_SCOPE_AGENT); }
__device__ __forceinline__ unsigned xb_xcc_id() { return (unsigned)__builtin_amdgcn_s_getreg((3 << 11) | 20) & 0xFu; }
#define XB_SPIN(cond, bar) do { unsigned _sp = 0; while (cond) { __builtin_amdgcn_s_sleep(1); \
    if ((++_sp & 255u) == 0u) { if (xb_ld(&(bar)[XB_TMO])) break; if (_sp > XB_SPIN_CAP) { atomicAdd(&(bar)[XB_TMO], 1u); break; } } } } while (0)
struct XcdBarrier { unsigned* bar; unsigned x; volatile LAS unsigned* st; };
__device__ __forceinline__ XcdBarrier xcd_barrier_post(unsigned* bar, volatile LAS unsigned* st) {
    XcdBarrier b; b.bar = bar; b.x = xb_xcc_id(); b.st = st;
    if (threadIdx.x == 0) (void)xb_add(&bar[XB_XCNT(b.x)], 1u);
    return b;
}
__device__ __forceinline__ void xcd_barrier_complete(unsigned* bar, unsigned x, unsigned& nloc, unsigned& nx) {
    const unsigned G = gridDim.x * gridDim.y * gridDim.z;
    unsigned sum, cnt, mine, sp = 0u;
    for (;;) {
        sum = 0u; cnt = 0u; mine = 0u;
#pragma unroll
        for (unsigned j = 0; j < 16; ++j) { const unsigned c = xb_ld(&bar[XB_XCNT(j)]); sum += c; cnt += (c > 0u) ? 1u : 0u; mine = (j == x) ? c : mine; }
        if (sum == G) break;
        __builtin_amdgcn_s_sleep(1);
        if ((++sp & 255u) == 0u) { if (xb_ld(&bar[XB_TMO])) break; if (sp > XB_SPIN_CAP) { atomicAdd(&bar[XB_TMO], 1u); break; } }
    }
    nloc = mine > 0u ? mine : 1u; nx = cnt > 0u ? cnt : 1u;
}
__device__ __forceinline__ void xcd_barrier(const XcdBarrier& b) {
    asm volatile("s_waitcnt vmcnt(0)" ::: "memory");
    __syncthreads();
    if (threadIdx.x == 0) {
        unsigned* bar = b.bar;
        __builtin_amdgcn_s_waitcnt(0);
        unsigned nloc = b.st[0], nx = b.st[1];
        if (nloc == 0u) { xcd_barrier_complete(bar, b.x, nloc, nx); b.st[0] = nloc; b.st[1] = nx; }
        const unsigned old = xb_add(&bar[XB_XSUB(b.x)], 1u);
        const unsigned gen = old / nloc;
        if (old + 1u == (gen + 1u) * nloc) {
            __builtin_amdgcn_fence(__ATOMIC_RELEASE, "agent");
            asm volatile("s_waitcnt vmcnt(0)" ::: "memory");
            const unsigned og = xb_add(&bar[XB_TOP], 1u);
            const unsigned tg = og / nx;
            if (og + 1u == (tg + 1u) * nx) xb_add(&bar[XB_TOPGEN], 1u);
            else XB_SPIN(xb_ld(&bar[XB_TOPGEN]) == tg, bar);
            __builtin_amdgcn_fence(__ATOMIC_ACQUIRE, "agent");
            xb_add(&bar[XB_XGEN(b.x)], 1u);
            asm volatile("s_waitcnt vmcnt(0)" ::: "memory");
        } else {
            XB_SPIN(xb_ld(&bar[XB_XGEN(b.x)]) == gen, bar);
            __builtin_amdgcn_fence(__ATOMIC_ACQUIRE, "agent");
            asm volatile("s_waitcnt vmcnt(0)" ::: "memory");
        }
    }
    __syncthreads();
}

template <int PH> __device__ __forceinline__ void run_phase(const Params& p, const Ctx& c0) {
    Ctx c = c0;
    { int l; asm volatile("v_mbcnt_lo_u32_b32 %0, -1, 0\n\tv_mbcnt_hi_u32_b32 %0, -1, %0" : "=v"(l)); c.lane = l; c.tid = c0.wave * 64 + l; c.wave = c0.wave; }
    if (PH == 0) phase0(p, c);
    if (PH == 1) phase1_g2(p, c);
    if (PH == 2) phase2(p, c);
#if NAIVE_ATTN
    if (PH == 3) phase3_naive(p, c);
#else
    if (PH == 3) phase3(p, c);
#endif
    if (PH == 4) phase4_g2(p, c);
    if (PH == 5) phase5_fused(p, c);
    if (PH == 8) phase_moeA(p, c);
    if (PH == 9) phase_moeB(p, c);
    if (PH == 10) phase8(p, c);
}
constexpr int NPHASES = 11;
__device__ __forceinline__ Ctx make_ctx(unsigned char* lds) {
    Ctx c; c.lds = (LAS unsigned char*)lds; c.tid = threadIdx.x; c.lane = c.tid & 63; c.wave = __builtin_amdgcn_readfirstlane(c.tid >> 6);
    c.G = gridDim.x; const int bx = blockIdx.x; c.vcu = (c.G % 8 == 0) ? (bx % 8) * (c.G / 8) + bx / 8 : bx;
    return c;
}
template <int PH> __global__ void __launch_bounds__(NTHREADS, 2) phase_kernel(Params p) {
    extern __shared__ __attribute__((aligned(16))) unsigned char lds[];
    const Ctx c = make_ctx(lds);
    run_phase<PH>(p, c);
}
#if MEGA
__global__ void __launch_bounds__(NTHREADS, 2) mega_kernel(Params p) {
    extern __shared__ __attribute__((aligned(16))) unsigned char lds[];
    Ctx c = make_ctx(lds);
    cg::grid_group grid = cg::this_grid();
    volatile LAS unsigned* bst = (volatile LAS unsigned*)(c.lds + LDS_BYTES - 64);
    if (c.tid < 4) bst[c.tid] = 0u;
    __syncthreads();
    XcdBarrier bar; bar.bar = (unsigned*)(p.ws + WS_CTL + CT_BAR); bar.x = xb_xcc_id(); bar.st = bst;
    if (c.tid == 0) bst[2] = xb_add(&bar.bar[XB_XCNT(bar.x)], 1u);
    if (p.out == nullptr) grid.sync();
    run_phase<0>(p, c); xcd_barrier(bar);
    if (c.tid == 0) {
        unsigned pre = 0;
        for (unsigned j = 0; j < 16; ++j) { const unsigned n = xb_ld(&bar.bar[XB_XCNT(j)]); if (j < bar.x) pre += n; }
        bst[3] = pre + bst[2];
    }
    __syncthreads();
    c.vcu = (int)bst[3];
    run_phase<1>(p, c); xcd_barrier(bar);
    run_phase<2>(p, c); xcd_barrier(bar);
    run_phase<3>(p, c); xcd_barrier(bar);
    run_phase<4>(p, c); xcd_barrier(bar);
    run_phase<5>(p, c); xcd_barrier(bar);
    run_phase<8>(p, c); xcd_barrier(bar);
    run_phase<9>(p, c); xcd_barrier(bar);
    run_phase<10>(p, c);
}

#endif
template <int PH> static void launch_phase(const Params& p, int grid, hipStream_t stream) {
    static bool attr = false;
    if (!attr) { (void)hipFuncSetAttribute((const void*)phase_kernel<PH>, hipFuncAttributeMaxDynamicSharedMemorySize, LDS_BYTES); attr = true; }
    hipLaunchKernelGGL(phase_kernel<PH>, dim3(grid), dim3(NTHREADS), LDS_BYTES, stream, p);
}

extern "C" void kernel_launch(void* const* d_in, const int* in_sizes, int n_in, void* d_out, int out_size, void* d_ws, size_t ws_size, hipStream_t stream) {
    if (n_in != 25 || ws_size < WS_END) { fprintf(stderr, "kernel_launch: unexpected n_in %d or ws_size %zu (need %zu)\n", n_in, ws_size, (size_t)WS_END); return; }
    Params p{};
    const float** pp = (const float**)&p;
    for (int i = 0; i < 25; ++i) pp[i] = (const float*)d_in[i];
    p.out = (float*)d_out; p.ws = (unsigned char*)d_ws;
    (void)hipMemsetAsync((char*)d_ws + WS_CTL, 0, CTL_BYTES, stream);
#if MEGA
    static int grid = 0;
    if (!grid) {
        int dev = 0, cus = 0, per_cu = 0;
        (void)hipGetDevice(&dev);
        (void)hipDeviceGetAttribute(&cus, hipDeviceAttributeMultiprocessorCount, dev);
        (void)hipFuncSetAttribute((const void*)mega_kernel, hipFuncAttributeMaxDynamicSharedMemorySize, LDS_BYTES);
        (void)hipOccupancyMaxActiveBlocksPerMultiprocessor(&per_cu, (const void*)mega_kernel, NTHREADS, LDS_BYTES);
        if (per_cu < 1) per_cu = 1;
        grid = cus;
        (void)per_cu;
    }
    void* args[] = {&p};
    hipError_t e = hipLaunchCooperativeKernel((const void*)mega_kernel, dim3(grid), dim3(NTHREADS), args, LDS_BYTES, stream);
    if (e != hipSuccess) fprintf(stderr, "cooperative launch failed: %s (grid %d)\n", hipGetErrorString(e), grid);
#else
    const int grid = 256;
#define LP(k) do { launch_phase<k>(p, grid, stream); if (REPEAT_PH == k) { if (k == 5) (void)hipMemsetAsync((char*)d_ws + WS_CTL + CT_CNT, 0, 1024, stream); (void)hipMemsetAsync((char*)d_ws + WS_CTL + CT_Q, 0, 4096, stream); launch_phase<k>(p, grid, stream); } } while (0)
    LP(0); LP(1); LP(2); LP(3); LP(4); LP(5); LP(8); LP(9); LP(10);
#undef LP
#endif
}
```
